# Optimizing an MI355X kernel written in HIP

```python
import math
import jax
import jax.numpy as jnp
from jax import lax
import numpy as np


D_MODEL = 1024
BATCH = 8
SEQ = 2048
DEPTH = 4

GRID_W = 64
CTX_LEN = 256
N_MIXERS = 4
EPS = 1e-6
NEG_INF = -1e30
ROPE_BASE = 10000.0
HEAD_DIM = 64

LRU_WIDTH = 1408
LRU_BLOCKS = 16
LRU_BW = LRU_WIDTH // LRU_BLOCKS
CONV_W = 4
LRU_C = 8.0

SWA_HEADS = 16
SWA_KV_HEADS = 4
WINDOW = 128
BLOCK_Q = 128

NA_HEADS = 16
NA_ROWS = 8
NA_COLS = 16

S5_WIDTH = 1024
S5_GROUP = 16
S5_GROUPS = S5_WIDTH // S5_GROUP
S5_STATE = 64

kernel_name = 'hybrid_interleaved_dit_trunk'


def rmsnorm(x, g):
    xf = x.astype(jnp.float32)
    y = xf * lax.rsqrt(jnp.mean(xf * xf, axis=-1, keepdims=True) + EPS)
    return (y * g.astype(jnp.float32)).astype(x.dtype)


def modulation(vec, w, b):
    m = jax.nn.silu(vec) @ w + b
    shift, scale, gate = jnp.split(m, 3, axis=-1)
    return shift[:, None, :], scale[:, None, :], gate[:, None, :]


def axial_rope(t_len):
    pos = jnp.arange(t_len)
    row = (pos // GRID_W).astype(jnp.float32)
    col = (pos % GRID_W).astype(jnp.float32)
    n_ax = HEAD_DIM // 4
    freqs = ROPE_BASE ** (-jnp.arange(n_ax, dtype=jnp.float32) / n_ax)
    ang = jnp.concatenate([row[:, None] * freqs, col[:, None] * freqs], axis=-1)
    return jnp.cos(ang), jnp.sin(ang)


def apply_rope(x, cos, sin):
    shape = (1, x.shape[1]) + (1,) * (x.ndim - 3) + (cos.shape[-1],)
    cos = cos.reshape(shape)
    sin = sin.reshape(shape)
    x1, x2 = jnp.split(x.astype(jnp.float32), 2, axis=-1)
    return jnp.concatenate([x1 * cos - x2 * sin, x2 * cos + x1 * sin], axis=-1).astype(x.dtype)


def sink_softmax(s, sink):
    s = s.astype(jnp.float32)
    sk = jnp.broadcast_to(sink.astype(jnp.float32), s.shape[:-1] + (1,))
    return jax.nn.softmax(jnp.concatenate([sk, s], axis=-1), axis=-1)[..., 1:]


def linear_scan(a, b, h0=None):
    def combine(l, r):
        return l[0] * r[0], r[0] * l[1] + r[1]
    a_cum, h = lax.associative_scan(combine, (a, b), axis=1)
    if h0 is not None:
        h = h + a_cum * h0[:, None]
    return h


def scan_with_prefix(a_c, b_c, a_l, b_l, reverse):
    if reverse:
        a_c, b_c, a_l, b_l = [jnp.flip(t, axis=1) for t in (a_c, b_c, a_l, b_l)]
    h_c = linear_scan(a_c, b_c)
    h_l = linear_scan(a_l, b_l, h_c[:, -1])
    if reverse:
        h_c, h_l = jnp.flip(h_c, axis=1), jnp.flip(h_l, axis=1)
    return h_c, h_l


def centred_dwconv(u, w, b):
    pad_l = CONV_W // 2
    y = lax.conv_general_dilated(u, w[:, None, :], window_strides=(1,), padding=[(pad_l, CONV_W - 1 - pad_l)],
                                 dimension_numbers=('NWC', 'WIO', 'NWC'), feature_group_count=u.shape[-1])
    return y + b


def lru_coeffs(u, wa, ba, wx, bx, lam):
    bsz, t_len, _ = u.shape
    uf = u.astype(jnp.float32)
    ub = uf.reshape(bsz, t_len, LRU_BLOCKS, LRU_BW)
    r = jax.nn.sigmoid(jnp.einsum('btki,kij->btkj', ub, wa.astype(jnp.float32)).reshape(bsz, t_len, LRU_WIDTH)
                       + ba.astype(jnp.float32))
    i = jax.nn.sigmoid(jnp.einsum('btki,kij->btkj', ub, wx.astype(jnp.float32)).reshape(bsz, t_len, LRU_WIDTH)
                       + bx.astype(jnp.float32))
    log_a = -LRU_C * r * jax.nn.softplus(-lam.astype(jnp.float32))
    a = jnp.exp(log_a)
    b = jnp.sqrt(-jnp.expm1(2.0 * log_a)) * (i * uf)
    return a, b


def rglru_mixer(n_c, n_l, w_in, conv_w, conv_b, wa, ba, wx, bx, lam, w_out, ctx_out):
    if ctx_out:
        u_c, g_c = jnp.split(n_c @ w_in, 2, axis=-1)
    else:
        u_c = n_c @ w_in[:, :LRU_WIDTH]
    u_l, g_l = jnp.split(n_l @ w_in, 2, axis=-1)
    u_c = centred_dwconv(u_c, conv_w, conv_b)
    u_l = centred_dwconv(u_l, conv_w, conv_b)
    hc_dirs, hl_dirs = [], []
    for d in range(2):
        a_c, b_c = lru_coeffs(u_c, wa[d], ba[d], wx[d], bx[d], lam[d])
        a_l, b_l = lru_coeffs(u_l, wa[d], ba[d], wx[d], bx[d], lam[d])
        h_c, h_l = scan_with_prefix(a_c, b_c, a_l, b_l, reverse=(d == 1))
        hc_dirs.append(h_c)
        hl_dirs.append(h_l)
    h_l = hl_dirs[0] + hl_dirs[1]
    y_l = (h_l * jax.nn.silu(g_l.astype(jnp.float32))).astype(n_l.dtype) @ w_out
    y_c = None
    if ctx_out:
        h_c = hc_dirs[0] + hc_dirs[1]
        y_c = (h_c * jax.nn.silu(g_c.astype(jnp.float32))).astype(n_c.dtype) @ w_out
    return y_c, y_l


def swa_mixer(n_c, n_l, w_in, sink, w_out, ctx_out):
    bsz, t_len, _ = n_l.shape
    c_len = n_c.shape[1]
    qd = SWA_HEADS * HEAD_DIM
    kvd = SWA_KV_HEADS * HEAD_DIM
    grp = SWA_HEADS // SWA_KV_HEADS
    scale = HEAD_DIM ** -0.5
    sink_kg = sink.reshape(SWA_KV_HEADS, grp)[:, :, None, None]
    q, k, v, g = jnp.split(n_l @ w_in, [qd, qd + kvd, qd + 2 * kvd], axis=-1)
    q = (q * scale).reshape(bsz, t_len, SWA_KV_HEADS, grp, HEAD_DIM)
    k = k.reshape(bsz, t_len, SWA_KV_HEADS, HEAD_DIM)
    v = v.reshape(bsz, t_len, SWA_KV_HEADS, HEAD_DIM)
    if ctx_out:
        q_c, k_c, v_c, g_c = jnp.split(n_c @ w_in, [qd, qd + kvd, qd + 2 * kvd], axis=-1)
    else:
        k_c, v_c = jnp.split(n_c @ w_in[:, qd:qd + 2 * kvd], 2, axis=-1)
    k_c = k_c.reshape(bsz, c_len, SWA_KV_HEADS, HEAD_DIM)
    v_c = v_c.reshape(bsz, c_len, SWA_KV_HEADS, HEAD_DIM)
    cos, sin = axial_rope(t_len)
    q_rot = apply_rope(q, cos, sin)
    k_rot = apply_rope(k, cos, sin)
    nb = t_len // BLOCK_Q
    qb_rot = q_rot.reshape(bsz, nb, BLOCK_Q, SWA_KV_HEADS, grp, HEAD_DIM)
    qb = q.reshape(bsz, nb, BLOCK_Q, SWA_KV_HEADS, grp, HEAD_DIM)
    pad = ((0, 0), (BLOCK_Q, BLOCK_Q), (0, 0), (0, 0))
    kp = jnp.pad(k_rot, pad).reshape(bsz, nb + 2, BLOCK_Q, SWA_KV_HEADS, HEAD_DIM)
    vp = jnp.pad(v, pad).reshape(bsz, nb + 2, BLOCK_Q, SWA_KV_HEADS, HEAD_DIM)
    kb = jnp.concatenate([kp[:, :-2], kp[:, 1:-1], kp[:, 2:]], axis=2)
    vb = jnp.concatenate([vp[:, :-2], vp[:, 1:-1], vp[:, 2:]], axis=2)
    s_band = jnp.einsum('bnqkgd,bnskd->bnkgqs', qb_rot, kb).astype(jnp.float32)
    blk = jnp.arange(nb)[:, None]
    qpos = blk * BLOCK_Q + jnp.arange(BLOCK_Q)[None, :]
    kpos = (blk - 1) * BLOCK_Q + jnp.arange(3 * BLOCK_Q)[None, :]
    valid = ((jnp.abs(qpos[:, :, None] - kpos[:, None, :]) <= WINDOW)
             & (kpos[:, None, :] >= 0) & (kpos[:, None, :] < t_len))
    s_band = jnp.where(valid[None, :, None, None], s_band, NEG_INF)
    s_ctx = jnp.einsum('bnqkgd,bckd->bnkgqc', qb, k_c).astype(jnp.float32)
    p = sink_softmax(jnp.concatenate([s_ctx, s_band], axis=-1), sink_kg).astype(v.dtype)
    o = (jnp.einsum('bnkgqc,bckd->bnqkgd', p[..., :c_len], v_c)
         + jnp.einsum('bnkgqs,bnskd->bnqkgd', p[..., c_len:], vb)).reshape(bsz, t_len, qd)
    y_l = (o * jax.nn.silu(g)) @ w_out
    y_c = None
    if ctx_out:
        q_c = (q_c * scale).reshape(bsz, c_len, SWA_KV_HEADS, grp, HEAD_DIM)
        pc = sink_softmax(jnp.einsum('bckgd,bskd->bkgcs', q_c, k_c), sink_kg).astype(v_c.dtype)
        o_c = jnp.einsum('bkgcs,bskd->bckgd', pc, v_c).reshape(bsz, c_len, qd)
        y_c = (o_c * jax.nn.silu(g_c)) @ w_out
    return y_c, y_l


def na_mixer(n_c, n_l, w_in, rpb, w_out, ctx_out):
    bsz, t_len, _ = n_l.shape
    c_len = n_c.shape[1]
    rows = t_len // GRID_W
    kr = min(NA_ROWS, rows)
    wd = NA_HEADS * HEAD_DIM
    scale = HEAD_DIM ** -0.5
    q, k, v, g = jnp.split(n_l @ w_in, 4, axis=-1)
    if ctx_out:
        q_c, k_c, v_c, g_c = jnp.split(n_c @ w_in, 4, axis=-1)
    else:
        k_c, v_c = jnp.split(n_c @ w_in[:, wd:3 * wd], 2, axis=-1)
    k_c = k_c.reshape(bsz, c_len, NA_HEADS, HEAD_DIM)
    v_c = v_c.reshape(bsz, c_len, NA_HEADS, HEAD_DIM)
    qg = (q * scale).reshape(bsz, rows, GRID_W, NA_HEADS, HEAD_DIM)
    kg = k.reshape(bsz, rows, GRID_W, NA_HEADS, HEAD_DIM)
    vg = v.reshape(bsz, rows, GRID_W, NA_HEADS, HEAD_DIM)
    r = jnp.arange(rows)
    ridx = jnp.clip(r - kr // 2, 0, rows - kr)[:, None] + jnp.arange(kr)[None, :]
    kb = kg[:, ridx].reshape(bsz, rows, kr * GRID_W, NA_HEADS, HEAD_DIM)
    vb = vg[:, ridx].reshape(bsz, rows, kr * GRID_W, NA_HEADS, HEAD_DIM)
    s_nb = jnp.einsum('brqhd,brkhd->brhqk', qg, kb).astype(jnp.float32)
    cq = jnp.arange(GRID_W)
    cstart = jnp.clip(cq - NA_COLS // 2, 0, GRID_W - NA_COLS)
    col_ok = (cq[None, :] >= cstart[:, None]) & (cq[None, :] < cstart[:, None] + NA_COLS)
    dy = ridx - r[:, None]
    dxi = jnp.clip(cq[None, :] - cq[:, None] + NA_COLS - 1, 0, 2 * NA_COLS - 2)
    bias = rpb[:, dy[:, None, :, None] + NA_ROWS - 1, dxi[None, :, None, :]]
    bias = jnp.moveaxis(bias, 0, 1).reshape(rows, NA_HEADS, GRID_W, kr * GRID_W).astype(jnp.float32)
    mask = jnp.broadcast_to(col_ok[:, None, :], (GRID_W, kr, GRID_W)).reshape(GRID_W, kr * GRID_W)
    s_nb = jnp.where(mask, s_nb + bias, NEG_INF)
    s_ctx = jnp.einsum('brqhd,bchd->brhqc', qg, k_c).astype(jnp.float32)
    p = jax.nn.softmax(jnp.concatenate([s_ctx, s_nb], axis=-1), axis=-1).astype(v.dtype)
    o = (jnp.einsum('brhqc,bchd->brqhd', p[..., :c_len], v_c)
         + jnp.einsum('brhqk,brkhd->brqhd', p[..., c_len:], vb)).reshape(bsz, t_len, wd)
    y_l = (o * jax.nn.silu(g)) @ w_out
    y_c = None
    if ctx_out:
        q_c = (q_c * scale).reshape(bsz, c_len, NA_HEADS, HEAD_DIM)
        pc = jax.nn.softmax(jnp.einsum('bchd,bshd->bhcs', q_c, k_c).astype(jnp.float32), axis=-1).astype(v_c.dtype)
        o_c = jnp.einsum('bhcs,bshd->bchd', pc, v_c).reshape(bsz, c_len, wd)
        y_c = (o_c * jax.nn.silu(g_c)) @ w_out
    return y_c, y_l


def s5_readout(y, g, glu_w, glu_b, w_out, dtype):
    y = jax.nn.gelu(y)
    y = y * jax.nn.sigmoid(y @ glu_w.astype(jnp.float32) + glu_b.astype(jnp.float32))
    return (y * jax.nn.silu(g.astype(jnp.float32))).astype(dtype) @ w_out


def s5_mixer(n_c, n_l, w_in, a_re, a_im, log_dt, b_re, b_im, c_re, c_im, d_skip, glu_w, glu_b, w_out, ctx_out):
    bsz, t_len, _ = n_l.shape
    c_len = n_c.shape[1]
    f32 = jnp.float32
    u_l, g_l = jnp.split(n_l @ w_in, 2, axis=-1)
    if ctx_out:
        u_c, g_c = jnp.split(n_c @ w_in, 2, axis=-1)
    else:
        u_c = n_c @ w_in[:, :S5_WIDTH]

    def groups(u):
        return u.astype(f32).reshape(u.shape[0], u.shape[1], S5_GROUPS, S5_GROUP).astype(jnp.complex64)

    uc_g, ul_g = groups(u_c), groups(u_l)
    y_l = d_skip.astype(f32) * u_l.astype(f32)
    y_c = d_skip.astype(f32) * u_c.astype(f32)
    for d in range(2):
        lam = lax.complex(a_re[d].astype(f32), a_im[d].astype(f32))
        dt = jnp.exp(log_dt[d].astype(f32))[:, None]
        lam_bar = jnp.exp(lam * dt)
        b_bar = ((lam_bar - 1.0) / lam)[..., None] * lax.complex(b_re[d].astype(f32), b_im[d].astype(f32))
        c_mat = lax.complex(c_re[d].astype(f32), c_im[d].astype(f32))
        bu_c = jnp.einsum('btgi,gpi->btgp', uc_g, b_bar)
        bu_l = jnp.einsum('btgi,gpi->btgp', ul_g, b_bar)
        a_c = jnp.broadcast_to(lam_bar, (1, c_len, S5_GROUPS, S5_STATE))
        a_l = jnp.broadcast_to(lam_bar, (1, t_len, S5_GROUPS, S5_STATE))
        h_c, h_l = scan_with_prefix(a_c, bu_c, a_l, bu_l, reverse=(d == 1))
        y_l = y_l + jnp.einsum('btgp,gip->btgi', h_l, c_mat).real.reshape(bsz, t_len, S5_WIDTH)
        if ctx_out:
            y_c = y_c + jnp.einsum('btgp,gip->btgi', h_c, c_mat).real.reshape(bsz, c_len, S5_WIDTH)
    out_l = s5_readout(y_l, g_l, glu_w, glu_b, w_out, n_l.dtype)
    out_c = s5_readout(y_c, g_c, glu_w, glu_b, w_out, n_c.dtype) if ctx_out else None
    return out_c, out_l


def setup_inputs(seed: int = 0) -> dict:
    key = jax.random.key(seed)
    keys = iter(jax.random.split(key, 64))
    f32 = jnp.float32
    D = D_MODEL

    def nrm(shape, scale):
        return scale * jax.random.normal(next(keys), shape, f32)

    def gain(n):
        return 1.0 + nrm((n,), 0.05)

    qd = SWA_HEADS * HEAD_DIM
    kvd = SWA_KV_HEADS * HEAD_DIM
    wd = NA_HEADS * HEAD_DIM
    inp = {}
    inp['x'] = nrm((BATCH, SEQ, D), 1.0)
    inp['c'] = nrm((BATCH, D), 1.0)
    inp['ctx'] = nrm((BATCH, CTX_LEN, D), 1.0)
    inp['c_ctx'] = nrm((D,), 1.0)
    inp['ada_w0'] = nrm((D, 3 * D), 0.5 * D ** -0.5)
    inp['ada_b0'] = nrm((3 * D,), 0.02)
    inp['norm0'] = gain(D)
    inp['w_in0'] = nrm((D, 2 * LRU_WIDTH), D ** -0.5)
    inp['conv_w0'] = nrm((CONV_W, LRU_WIDTH), CONV_W ** -0.5)
    inp['conv_b0'] = nrm((LRU_WIDTH,), 0.02)
    inp['lru_wa0'] = nrm((2, LRU_BLOCKS, LRU_BW, LRU_BW), LRU_BW ** -0.5)
    inp['lru_ba0'] = nrm((2, LRU_WIDTH), 0.02)
    inp['lru_wx0'] = nrm((2, LRU_BLOCKS, LRU_BW, LRU_BW), LRU_BW ** -0.5)
    inp['lru_bx0'] = nrm((2, LRU_WIDTH), 0.02)
    a0 = jax.random.uniform(next(keys), (2, LRU_WIDTH), f32, 0.9 ** (1.0 / LRU_C), 0.999 ** (1.0 / LRU_C))
    inp['lru_lam0'] = jnp.log(a0) - jnp.log1p(-a0)
    inp['w_out0'] = nrm((LRU_WIDTH, D), LRU_WIDTH ** -0.5)
    inp['ada_w1'] = nrm((D, 3 * D), 0.5 * D ** -0.5)
    inp['ada_b1'] = nrm((3 * D,), 0.02)
    inp['norm1'] = gain(D)
    inp['w_in1'] = nrm((D, 2 * qd + 2 * kvd), D ** -0.5)
    inp['sink1'] = nrm((SWA_HEADS,), 1.0)
    inp['w_out1'] = nrm((qd, D), qd ** -0.5)
    inp['ada_w2'] = nrm((D, 3 * D), 0.5 * D ** -0.5)
    inp['ada_b2'] = nrm((3 * D,), 0.02)
    inp['norm2'] = gain(D)
    inp['w_in2'] = nrm((D, 4 * wd), D ** -0.5)
    inp['rpb2'] = nrm((NA_HEADS, 2 * NA_ROWS - 1, 2 * NA_COLS - 1), 0.1)
    inp['w_out2'] = nrm((wd, D), wd ** -0.5)
    inp['ada_w3'] = nrm((D, 3 * D), 0.5 * D ** -0.5)
    inp['ada_b3'] = nrm((3 * D,), 0.02)
    inp['norm3'] = gain(D)
    inp['w_in3'] = nrm((D, 2 * S5_WIDTH), D ** -0.5)
    inp['s5_a_re3'] = -0.5 + nrm((2, S5_GROUPS, S5_STATE), 0.01)
    inp['s5_a_im3'] = math.pi * jnp.arange(S5_STATE, dtype=f32) + nrm((2, S5_GROUPS, S5_STATE), 0.01)
    inp['s5_log_dt3'] = jax.random.uniform(next(keys), (2, S5_GROUPS), f32, math.log(1e-3), math.log(1e-1))
    inp['s5_b_re3'] = nrm((2, S5_GROUPS, S5_STATE, S5_GROUP), (2 * S5_GROUP) ** -0.5)
    inp['s5_b_im3'] = nrm((2, S5_GROUPS, S5_STATE, S5_GROUP), (2 * S5_GROUP) ** -0.5)
    inp['s5_c_re3'] = nrm((2, S5_GROUPS, S5_GROUP, S5_STATE), (2 * S5_STATE) ** -0.5)
    inp['s5_c_im3'] = nrm((2, S5_GROUPS, S5_GROUP, S5_STATE), (2 * S5_STATE) ** -0.5)
    inp['s5_d3'] = nrm((S5_WIDTH,), 1.0)
    inp['glu_w3'] = nrm((S5_WIDTH, S5_WIDTH), S5_WIDTH ** -0.5)
    inp['glu_b3'] = nrm((S5_WIDTH,), 0.02)
    inp['w_out3'] = nrm((S5_WIDTH, D), S5_WIDTH ** -0.5)
    inp['norm_f'] = gain(D)
    return inp


def reference(x, c, ctx, c_ctx,
              ada_w0, ada_b0, norm0, w_in0, conv_w0, conv_b0, lru_wa0, lru_ba0, lru_wx0, lru_bx0, lru_lam0, w_out0,
              ada_w1, ada_b1, norm1, w_in1, sink1, w_out1,
              ada_w2, ada_b2, norm2, w_in2, rpb2, w_out2,
              ada_w3, ada_b3, norm3, w_in3, s5_a_re3, s5_a_im3, s5_log_dt3, s5_b_re3, s5_b_im3, s5_c_re3, s5_c_im3,
              s5_d3, glu_w3, glu_b3, w_out3,
              norm_f):
    mixers = (rglru_mixer, swa_mixer, na_mixer, s5_mixer)
    layers = (
        ((ada_w0, ada_b0, norm0), (w_in0, conv_w0, conv_b0, lru_wa0, lru_ba0, lru_wx0, lru_bx0, lru_lam0, w_out0)),
        ((ada_w1, ada_b1, norm1), (w_in1, sink1, w_out1)),
        ((ada_w2, ada_b2, norm2), (w_in2, rpb2, w_out2)),
        ((ada_w3, ada_b3, norm3), (w_in3, s5_a_re3, s5_a_im3, s5_log_dt3, s5_b_re3, s5_b_im3, s5_c_re3, s5_c_im3,
                                   s5_d3, glu_w3, glu_b3, w_out3)),
    )
    h_lat, h_ctx = x, ctx
    for i in range(DEPTH):
        (ada_w, ada_b, g_norm), margs = layers[i]
        ctx_out = i < DEPTH - 1
        sh_l, sc_l, gt_l = modulation(c, ada_w, ada_b)
        sh_c, sc_c, gt_c = modulation(c_ctx[None, :], ada_w, ada_b)
        n_l = rmsnorm(h_lat, g_norm) * (1.0 + sc_l) + sh_l
        n_c = rmsnorm(h_ctx, g_norm) * (1.0 + sc_c) + sh_c
        y_c, y_l = mixers[i % N_MIXERS](n_c, n_l, *margs, ctx_out=ctx_out)
        h_lat = h_lat + gt_l * y_l
        if ctx_out:
            h_ctx = h_ctx + gt_c * y_c
    return rmsnorm(h_lat, norm_f)
```

```cpp
#include <hip/hip_runtime.h>
#include <hip/hip_cooperative_groups.h>
#include <cstdio>
namespace cg = cooperative_groups;

#define DI __device__ __forceinline__
typedef unsigned short bf16_t;
typedef short bf16x8 __attribute__((ext_vector_type(8)));
typedef short s16x4 __attribute__((ext_vector_type(4)));
typedef float f32x16 __attribute__((ext_vector_type(16)));
typedef float f32x4 __attribute__((ext_vector_type(4)));
typedef unsigned u32x2 __attribute__((ext_vector_type(2)));
typedef unsigned u32x4 __attribute__((ext_vector_type(4)));

#define MFMA32(a, b, c) __builtin_amdgcn_mfma_f32_32x32x16_bf16((a), (b), (c), 0, 0, 0)
#define MFMA16(a, b, c) __builtin_amdgcn_mfma_f32_16x16x32_bf16((a), (b), (c), 0, 0, 0)

constexpr int D = 1024, NB = 8, SEQ = 2048, CTXL = 256;
constexpr int RL = NB * SEQ;
constexpr int RC = NB * CTXL;
constexpr int R = RL + RC;
constexpr int LW = 1408;
constexpr int NCH = R / 16;

constexpr size_t O_WT_IN0 = 0;
constexpr size_t O_WT_OUT0 = O_WT_IN0 + (size_t)2816 * 1024 * 2;
constexpr size_t O_WT_IN1 = O_WT_OUT0 + (size_t)1024 * 1408 * 2;
constexpr size_t O_WT_OUT1 = O_WT_IN1 + (size_t)2560 * 1024 * 2;
constexpr size_t O_WT_IN2 = O_WT_OUT1 + (size_t)1024 * 1024 * 2;
constexpr size_t O_WT_OUT2 = O_WT_IN2 + (size_t)4096 * 1024 * 2;
constexpr size_t O_WT_IN3 = O_WT_OUT2 + (size_t)1024 * 1024 * 2;
constexpr size_t O_WT_GLU = O_WT_IN3 + (size_t)2048 * 1024 * 2;
constexpr size_t O_WT_OUT3 = O_WT_GLU + (size_t)1024 * 1024 * 2;
constexpr size_t O_WG = O_WT_OUT3 + (size_t)1024 * 1024 * 2;
constexpr size_t O_MOD = O_WG + (size_t)16 * 2 * 192 * 96 * 2;
constexpr size_t O_ROPEC = O_MOD + (size_t)4 * 9 * 3072 * 4;
constexpr size_t O_ROPES = O_ROPEC + (size_t)2048 * 32 * 4;
constexpr size_t O_POW = O_ROPES + (size_t)2048 * 32 * 4;
constexpr size_t O_BBAR = O_POW + (size_t)2 * 64 * 17 * 64 * 8;
constexpr size_t O_HCTX = O_BBAR + (size_t)2 * 64 * 64 * 16 * 8;
constexpr size_t O_DYN = O_HCTX + (size_t)RC * 1024 * 4;
constexpr size_t O_U0 = O_DYN;
constexpr size_t O_G0 = O_U0 + (size_t)R * LW * 2;
constexpr size_t O_ACT0 = O_G0 + (size_t)R * LW * 2;
constexpr size_t O_NBUF0 = O_ACT0;
constexpr size_t O_NBUF = O_DYN;
constexpr size_t O_Q1 = O_NBUF + (size_t)R * 1024 * 2;
constexpr size_t O_QR1 = O_Q1 + (size_t)R * 1024 * 2;
constexpr size_t O_K1 = O_QR1 + (size_t)RL * 1024 * 2;
constexpr size_t O_VTL1 = O_K1 + (size_t)R * 256 * 2;
constexpr size_t O_VTC1 = O_VTL1 + (size_t)8 * 4 * 64 * 2048 * 2;
constexpr size_t O_G1 = O_VTC1 + (size_t)8 * 4 * 64 * 256 * 2;
constexpr size_t O_ACT1 = O_G1 + (size_t)R * 1024 * 2;
constexpr size_t O_Q2 = O_NBUF + (size_t)R * 1024 * 2;
constexpr size_t O_K2 = O_Q2 + (size_t)R * 1024 * 2;
constexpr size_t O_VTL2 = O_K2 + (size_t)R * 1024 * 2;
constexpr size_t O_VTC2 = O_VTL2 + (size_t)8 * 16 * 64 * 2048 * 2;
constexpr size_t O_G2 = O_VTC2 + (size_t)8 * 16 * 64 * 256 * 2;
constexpr size_t O_ACT2 = O_NBUF;
constexpr size_t O_SLOC = O_DYN;
constexpr size_t O_YG = O_DYN;
constexpr size_t O_ACT3 = O_YG + (size_t)RL * 1024 * 2;
constexpr size_t O_ACAT = O_DYN + (size_t)64 * NCH * 256 * 4;
constexpr size_t O_G3 = O_ACAT + (size_t)64 * NCH * 512 * 2;
constexpr size_t O_GT = O_G3 + (size_t)RL * 1024 * 2;
constexpr size_t O_MYT = O_GT + (size_t)64 * 256 * 256 * 2;
constexpr size_t WS_END = O_MYT + (size_t)64 * 256 * 512 * 2;

struct Params {
  const float* in[44];
  float* out;
  char* ws;
};

DI bf16_t f2bf(float x) { unsigned u = __float_as_uint(x); u += 0x7fffu + ((u >> 16) & 1u); return (bf16_t)(u >> 16); }
DI float bf2f(bf16_t b) { return __uint_as_float(((unsigned)b) << 16); }
DI unsigned pack2(float lo, float hi) { return (unsigned)f2bf(lo) | ((unsigned)f2bf(hi) << 16); }
DI float bflo(unsigned u) { return __uint_as_float(u << 16); }
DI float bfhi(unsigned u) { return __uint_as_float(u & 0xffff0000u); }
DI float sigm(float x) { return 1.f / (1.f + __expf(-x)); }
DI float silu(float x) { return x / (1.f + __expf(-x)); }
DI float gelu_tanh(float x) {
  float z = 0.7978845608028654f * (x + 0.044715f * x * x * x);
  float e = __expf(2.f * z);
  float t = 1.f - 2.f / (e + 1.f);
  return 0.5f * x * (1.f + t);
}
DI int crow(int i, int h) { return (i & 3) + 8 * (i >> 2) + 4 * h; }
DI f32x16 zero16() { f32x16 z; _Pragma("unroll") for (int i = 0; i < 16; ++i) z[i] = 0.f; return z; }
DI void sincos_rev(float rev, float& s, float& c) { rev = rev - rintf(rev); s = __builtin_amdgcn_sinf(rev); c = __builtin_amdgcn_cosf(rev); }

DI int lds_off(int row, int chunk) { return row * 128 + ((chunk ^ ((row >> 1) & 7)) << 4); }

template <bool DUAL, class Epi>
DI void gemm_tile(const bf16_t* A, const bf16_t* A2, int lda, const bf16_t* Bt, int ldb, int K, int row0, int col0, int bz,
                  const Epi& epi, char* smem) {
  const int tid = threadIdx.x, lane = tid & 63, wave = tid >> 6, wm = wave >> 1, wn = wave & 1, r = lane & 31, h = lane >> 5;
  char* As = smem;
  char* Bs = smem + 32768;
  f32x16 acc[2][2];
  _Pragma("unroll") for (int mi = 0; mi < 2; ++mi) _Pragma("unroll") for (int ni = 0; ni < 2; ++ni) acc[mi][ni] = zero16();
  const int nk = K >> 6;
  const int lrow = tid >> 3, lch = tid & 7;
  const bf16_t* ap = A + (size_t)(row0 + lrow) * lda + lch * 8;
  const bf16_t* ap2 = DUAL ? (A2 + (size_t)(row0 + lrow) * lda + lch * 8) : nullptr;
  const bf16_t* bp = Bt + (size_t)(col0 + lrow) * ldb + lch * 8;
  u32x4 ra[4], rb[4];
  auto gload = [&](int kt) {
    _Pragma("unroll") for (int i = 0; i < 4; ++i) {
      ra[i] = *(const u32x4*)(ap + (size_t)(32 * i) * lda + kt * 64);
      if (DUAL) {
        u32x4 t2 = *(const u32x4*)(ap2 + (size_t)(32 * i) * lda + kt * 64);
        _Pragma("unroll") for (int e = 0; e < 4; ++e) ra[i][e] = pack2(bflo(ra[i][e]) + bflo(t2[e]), bfhi(ra[i][e]) + bfhi(t2[e]));
      }
      rb[i] = *(const u32x4*)(bp + (size_t)(32 * i) * ldb + kt * 64);
    }
  };
  auto sstore = [&](int buf) {
    _Pragma("unroll") for (int i = 0; i < 4; ++i) {
      *(u32x4*)(As + buf * 16384 + lds_off(lrow + 32 * i, lch)) = ra[i];
      *(u32x4*)(Bs + buf * 16384 + lds_off(lrow + 32 * i, lch)) = rb[i];
    }
  };
  gload(0);
  sstore(0);
  __syncthreads();
  for (int kt = 0; kt < nk; ++kt) {
    const int buf = kt & 1;
    if (kt + 1 < nk) gload(kt + 1);
    const char* a_ = As + buf * 16384;
    const char* b_ = Bs + buf * 16384;
    _Pragma("unroll") for (int ks = 0; ks < 4; ++ks) {
      bf16x8 af[2], bfr[2];
      _Pragma("unroll") for (int mi = 0; mi < 2; ++mi) af[mi] = *(const bf16x8*)(a_ + lds_off(64 * wm + 32 * mi + r, 2 * ks + h));
      _Pragma("unroll") for (int ni = 0; ni < 2; ++ni) bfr[ni] = *(const bf16x8*)(b_ + lds_off(64 * wn + 32 * ni + r, 2 * ks + h));
      _Pragma("unroll") for (int mi = 0; mi < 2; ++mi) _Pragma("unroll") for (int ni = 0; ni < 2; ++ni) acc[mi][ni] = MFMA32(af[mi], bfr[ni], acc[mi][ni]);
    }
    if (kt + 1 < nk) sstore(buf ^ 1);
    __syncthreads();
  }
  epi(acc, row0 + 64 * wm, col0 + 64 * wn, r, h, bz);
}

template <bool DUAL, class Epi>
DI void gemm_phase(const bf16_t* A, const bf16_t* A2, int lda, size_t strideA, const bf16_t* Bt, int ldb, size_t strideB, int M, int N, int K,
                   int nbatch, const Epi& epi, char* smem) {
  const int tm = M >> 7, tn = N >> 7, per = tm * tn, total = per * nbatch;
  for (int t = blockIdx.x; t < total; t += gridDim.x) {
    const int bz = t / per, rem = t - bz * per, im = rem / tn, in_ = rem - im * tn;
    gemm_tile<DUAL>(A + bz * strideA, DUAL ? A2 + bz * strideA : nullptr, lda, Bt + bz * strideB, ldb, K, im * 128, in_ * 128, bz, epi, smem);
  }
}

#define FOR_ACC _Pragma("unroll") for (int mi = 0; mi < 2; ++mi) _Pragma("unroll") for (int ni = 0; ni < 2; ++ni) _Pragma("unroll") for (int i = 0; i < 16; ++i)

struct EpiL0In {
  bf16_t* U0; bf16_t* G0;
  DI void operator()(const f32x16 (&acc)[2][2], int rb, int cb, int r, int h, int) const {
    bf16_t* dst; int c0;
    if (cb < LW) { dst = U0; c0 = cb; } else { dst = G0; c0 = cb - LW; }
    FOR_ACC dst[(size_t)(rb + 32 * mi + crow(i, h)) * LW + c0 + 32 * ni + r] = f2bf(acc[mi][ni][i]);
  }
};

struct EpiOut {
  const float* in_lat; const float* in_ctx; float* out_lat; float* out_ctx; const float* gate;
  DI void operator()(const f32x16 (&acc)[2][2], int rb, int cb, int r, int h, int) const {
    const float* src; float* dst; const float* g; int rr;
    if (rb < RL) { src = in_lat; dst = out_lat; rr = rb; g = gate + (size_t)(rb >> 11) * 3072; }
    else { src = in_ctx; dst = out_ctx; rr = rb - RL; g = gate + (size_t)8 * 3072; }
    FOR_ACC {
      const size_t idx = (size_t)(rr + 32 * mi + crow(i, h)) * 1024 + cb + 32 * ni + r;
      dst[idx] = src[idx] + g[cb + 32 * ni + r] * acc[mi][ni][i];
    }
  }
};

DI void store_vt(const f32x16 (&acc)[2][2], bf16_t* vt_head  , int T, int t0  , int r, int h) {
  _Pragma("unroll") for (int mi = 0; mi < 2; ++mi) _Pragma("unroll") for (int ni = 0; ni < 2; ++ni) _Pragma("unroll") for (int q = 0; q < 4; ++q) {
    u32x2 v;
    v[0] = pack2(acc[mi][ni][4 * q + 0], acc[mi][ni][4 * q + 1]);
    v[1] = pack2(acc[mi][ni][4 * q + 2], acc[mi][ni][4 * q + 3]);
    *(u32x2*)(vt_head + (size_t)(32 * ni + r) * T + t0 + 32 * mi + 8 * q + 4 * h) = v;
  }
}

struct EpiL1In {
  bf16_t *Q, *QR, *Kb, *VtL, *VtC, *G; const float *rc, *rs;
  DI void operator()(const f32x16 (&acc)[2][2], int rb, int cb, int r, int h, int) const {
    const bool lat = rb < RL;
    if (cb < 1024) {
      _Pragma("unroll") for (int mi = 0; mi < 2; ++mi) _Pragma("unroll") for (int i = 0; i < 16; ++i) {
        const int row = rb + 32 * mi + crow(i, h);
        const float a1 = acc[mi][0][i] * 0.125f, a2 = acc[mi][1][i] * 0.125f;
        Q[(size_t)row * 1024 + cb + r] = f2bf(a1);
        Q[(size_t)row * 1024 + cb + 32 + r] = f2bf(a2);
        if (lat) {
          const int t = row & 2047;
          const float c = rc[t * 32 + r], s = rs[t * 32 + r];
          QR[(size_t)row * 1024 + cb + r] = f2bf(a1 * c - a2 * s);
          QR[(size_t)row * 1024 + cb + 32 + r] = f2bf(a2 * c + a1 * s);
        }
      }
    } else if (cb < 1280) {
      const int c0 = cb - 1024;
      _Pragma("unroll") for (int mi = 0; mi < 2; ++mi) _Pragma("unroll") for (int i = 0; i < 16; ++i) {
        const int row = rb + 32 * mi + crow(i, h);
        float a1 = acc[mi][0][i], a2 = acc[mi][1][i];
        if (lat) {
          const int t = row & 2047;
          const float c = rc[t * 32 + r], s = rs[t * 32 + r];
          const float b1 = a1 * c - a2 * s, b2 = a2 * c + a1 * s;
          a1 = b1; a2 = b2;
        }
        Kb[(size_t)row * 256 + c0 + r] = f2bf(a1);
        Kb[(size_t)row * 256 + c0 + 32 + r] = f2bf(a2);
      }
    } else if (cb < 1536) {
      const int kvh = (cb - 1280) >> 6;
      if (lat) store_vt(acc, VtL + (size_t)((rb >> 11) * 4 + kvh) * 64 * 2048, 2048, rb & 2047, r, h);
      else { const int rr = rb - RL; store_vt(acc, VtC + (size_t)((rr >> 8) * 4 + kvh) * 64 * 256, 256, rr & 255, r, h); }
    } else {
      const int c0 = cb - 1536;
      FOR_ACC G[(size_t)(rb + 32 * mi + crow(i, h)) * 1024 + c0 + 32 * ni + r] = f2bf(acc[mi][ni][i]);
    }
  }
};

struct EpiL2In {
  bf16_t *Q, *Kb, *VtL, *VtC, *G;
  DI void operator()(const f32x16 (&acc)[2][2], int rb, int cb, int r, int h, int) const {
    if (cb < 1024) {
      FOR_ACC Q[(size_t)(rb + 32 * mi + crow(i, h)) * 1024 + cb + 32 * ni + r] = f2bf(acc[mi][ni][i] * 0.125f);
    } else if (cb < 2048) {
      FOR_ACC Kb[(size_t)(rb + 32 * mi + crow(i, h)) * 1024 + cb - 1024 + 32 * ni + r] = f2bf(acc[mi][ni][i]);
    } else if (cb < 3072) {
      const int hd = (cb - 2048) >> 6;
      if (rb < RL) store_vt(acc, VtL + (size_t)((rb >> 11) * 16 + hd) * 64 * 2048, 2048, rb & 2047, r, h);
      else { const int rr = rb - RL; store_vt(acc, VtC + (size_t)((rr >> 8) * 16 + hd) * 64 * 256, 256, rr & 255, r, h); }
    } else {
      FOR_ACC G[(size_t)(rb + 32 * mi + crow(i, h)) * 1024 + cb - 3072 + 32 * ni + r] = f2bf(acc[mi][ni][i]);
    }
  }
};

struct EpiL3In {
  bf16_t *ACAT, *G;
  DI void operator()(const f32x16 (&acc)[2][2], int rb, int cb, int r, int h, int) const {
    if (cb < 1024) {
      FOR_ACC {
        const int row = rb + 32 * mi + crow(i, h), col = cb + 32 * ni + r;
        ACAT[((size_t)(col >> 4) * NCH + (row >> 4)) * 512 + (row & 15) * 16 + (col & 15)] = f2bf(acc[mi][ni][i]);
      }
    } else if (rb < RL) {
      FOR_ACC G[(size_t)(rb + 32 * mi + crow(i, h)) * 1024 + cb - 1024 + 32 * ni + r] = f2bf(acc[mi][ni][i]);
    }
  }
};

struct EpiS5State {
  float* S;
  DI void operator()(const f32x16 (&acc)[2][2], int rb, int cb, int r, int h, int bz) const {
    FOR_ACC S[((size_t)bz * NCH + rb + 32 * mi + crow(i, h)) * 256 + cb + 32 * ni + r] = acc[mi][ni][i];
  }
};

struct EpiS5Y {
  bf16_t* YG;
  DI void operator()(const f32x16 (&acc)[2][2], int rb, int cb, int r, int h, int bz) const {
    FOR_ACC {
      const int chunk = rb + 32 * mi + crow(i, h), n = cb + 32 * ni + r;
      YG[((size_t)chunk * 16 + (n >> 4)) * 1024 + bz * 16 + (n & 15)] = f2bf(gelu_tanh(acc[mi][ni][i]));
    }
  }
};

struct EpiGlu {
  const bf16_t *YG, *G; const float* gb; bf16_t* ACT;
  DI void operator()(const f32x16 (&acc)[2][2], int rb, int cb, int r, int h, int) const {
    FOR_ACC {
      const int col = cb + 32 * ni + r;
      const size_t idx = (size_t)(rb + 32 * mi + crow(i, h)) * 1024 + col;
      ACT[idx] = f2bf(bf2f(YG[idx]) * sigm(acc[mi][ni][i] + gb[col]) * silu(bf2f(G[idx])));
    }
  }
};

DI void transpose_tile(const float* W, int K, int N, bf16_t* WT, int tile, float* sm) {
  const int tn = N >> 6, tk_i = tile / tn, tn_i = tile - tk_i * tn, k0 = tk_i * 64, n0 = tn_i * 64;
  const int c = threadIdx.x & 63, rr = threadIdx.x >> 6;
  _Pragma("unroll 4") for (int i = 0; i < 16; ++i) { const int k = i * 4 + rr; sm[k * 65 + c] = W[(size_t)(k0 + k) * N + n0 + c]; }
  __syncthreads();
  _Pragma("unroll 4") for (int i = 0; i < 16; ++i) { const int n = i * 4 + rr; WT[(size_t)(n0 + n) * K + k0 + c] = f2bf(sm[c * 65 + n]); }
  __syncthreads();
}

DI void phase0(const Params& p, char* smem) {
  char* ws = p.ws;
  float* smf = (float*)smem;
  for (int job = blockIdx.x; job < 192; job += gridDim.x) {
    const int l = job / 48, n0 = (job % 48) * 64;
    const float* aw = l == 0 ? p.in[4] : l == 1 ? p.in[16] : l == 2 ? p.in[22] : p.in[28];
    const float* ab = l == 0 ? p.in[5] : l == 1 ? p.in[17] : l == 2 ? p.in[23] : p.in[29];
    float* sv = smf;
    float* red = smf + 9 * 1024;
    for (int idx = threadIdx.x; idx < 9 * 1024; idx += 256) {
      const int v = idx >> 10, k = idx & 1023;
      const float x = v < 8 ? p.in[1][v * 1024 + k] : p.in[3][k];
      sv[idx] = silu(x);
    }
    __syncthreads();
    const int col = threadIdx.x & 63, ks = threadIdx.x >> 6;
    float a[9];
    _Pragma("unroll") for (int v = 0; v < 9; ++v) a[v] = 0.f;
    _Pragma("unroll 8") for (int k = ks * 256; k < ks * 256 + 256; ++k) {
      const float w = aw[(size_t)k * 3072 + n0 + col];
      _Pragma("unroll") for (int v = 0; v < 9; ++v) a[v] += sv[v * 1024 + k] * w;
    }
    _Pragma("unroll") for (int v = 0; v < 9; ++v) red[(ks * 9 + v) * 64 + col] = a[v];
    __syncthreads();
    float* MOD = (float*)(ws + O_MOD);
    for (int idx = threadIdx.x; idx < 9 * 64; idx += 256) {
      const int v = idx >> 6, cc = idx & 63;
      const float s = red[(0 * 9 + v) * 64 + cc] + red[(1 * 9 + v) * 64 + cc] + red[(2 * 9 + v) * 64 + cc] + red[(3 * 9 + v) * 64 + cc] + ab[n0 + cc];
      MOD[(size_t)(l * 9 + v) * 3072 + n0 + cc] = s;
    }
    __syncthreads();
  }
  {
    constexpr int T0 = 16 * 44, T1 = T0 + 22 * 16, T2 = T1 + 16 * 40, T3 = T2 + 256, T4 = T3 + 16 * 64, T5 = T4 + 256, T6 = T5 + 16 * 32, T7 = T6 + 256, T8 = T7 + 256;
    for (int j = blockIdx.x; j < T8; j += gridDim.x) {
      if (j < T0) transpose_tile(p.in[7], 1024, 2816, (bf16_t*)(ws + O_WT_IN0), j, smf);
      else if (j < T1) transpose_tile(p.in[15], 1408, 1024, (bf16_t*)(ws + O_WT_OUT0), j - T0, smf);
      else if (j < T2) transpose_tile(p.in[19], 1024, 2560, (bf16_t*)(ws + O_WT_IN1), j - T1, smf);
      else if (j < T3) transpose_tile(p.in[21], 1024, 1024, (bf16_t*)(ws + O_WT_OUT1), j - T2, smf);
      else if (j < T4) transpose_tile(p.in[25], 1024, 4096, (bf16_t*)(ws + O_WT_IN2), j - T3, smf);
      else if (j < T5) transpose_tile(p.in[27], 1024, 1024, (bf16_t*)(ws + O_WT_OUT2), j - T4, smf);
      else if (j < T6) transpose_tile(p.in[31], 1024, 2048, (bf16_t*)(ws + O_WT_IN3), j - T5, smf);
      else if (j < T7) transpose_tile(p.in[40], 1024, 1024, (bf16_t*)(ws + O_WT_GLU), j - T6, smf);
      else transpose_tile(p.in[42], 1024, 1024, (bf16_t*)(ws + O_WT_OUT3), j - T7, smf);
    }
  }
  const int gt = blockIdx.x * 256 + threadIdx.x, gn = gridDim.x * 256;
  {
    bf16_t* WG = (bf16_t*)(ws + O_WG);
    for (int idx = gt; idx < 16 * 2 * 192 * 96; idx += gn) {
      const int kk = idx % 96; int t = idx / 96; const int n = t % 192; t /= 192; const int d = t & 1, k = t >> 1;
      const int c = n >> 5, gate = (n >> 4) & 1, ch = c * 16 + (n & 15);
      float v = 0.f;
      if (ch < 88 && kk < 88) { const float* w = gate ? p.in[12] : p.in[10]; v = w[((size_t)(d * 16 + k) * 88 + kk) * 88 + ch]; }
      WG[idx] = f2bf(v);
    }
  }
  {
    float* RCt = (float*)(ws + O_ROPEC); float* RSt = (float*)(ws + O_ROPES);
    for (int idx = gt; idx < 2048 * 32; idx += gn) {
      const int t = idx >> 5, j = idx & 31;
      const float pos = (float)(j < 16 ? (t >> 6) : (t & 63));
      const float freq = exp2f(-(float)(j & 15) * (13.287712379549449f / 16.f));
      float s, c; sincos_rev(pos * freq * 0.15915494309189535f, s, c);
      RCt[idx] = c; RSt[idx] = s;
    }
  }
  {
    float2* POW = (float2*)(ws + O_POW); float2* BB = (float2*)(ws + O_BBAR);
    for (int idx = gt; idx < 2 * 64 * 17 * 64; idx += gn) {
      const int pp = idx & 63; int t = idx >> 6; const int n = t % 17; t /= 17;
      const float are = p.in[32][t * 64 + pp], aim = p.in[33][t * 64 + pp], dt = expf(p.in[34][t]);
      const float mag = expf((float)n * are * dt);
      const double rev = (double)n * (double)aim * (double)dt * 0.15915494309189535;
      float s, c; sincos_rev((float)(rev - rint(rev)), s, c);
      POW[idx] = make_float2(mag * c, mag * s);
    }
    for (int idx = gt; idx < 2 * 64 * 64 * 16; idx += gn) {
      const int t = idx >> 4;
      const int dg = t >> 6;
      const float are = p.in[32][t], aim = p.in[33][t], dt = expf(p.in[34][dg]);
      const float mag = expf(are * dt);
      const double rev = (double)aim * (double)dt * 0.15915494309189535;
      float s, c; sincos_rev((float)(rev - rint(rev)), s, c);
      const float nr = mag * c - 1.f, ni = mag * s;
      const float den = 1.f / (are * are + aim * aim);
      const float cr = (nr * are + ni * aim) * den, ci = (ni * are - nr * aim) * den;
      const float br = p.in[35][idx], bi = p.in[36][idx];
      BB[idx] = make_float2(cr * br - ci * bi, cr * bi + ci * br);
    }
  }
}

DI void norm_phase(const float* lat, const float* ctx, const float* gn, const float* mod  , bf16_t* NB_) {
  const int lane = threadIdx.x & 63;
  const int w0 = blockIdx.x * 4 + (threadIdx.x >> 6), nw = gridDim.x * 4;
  for (int row = w0; row < R; row += nw) {
    const float* src; const float* m;
    if (row < RL) { src = lat + (size_t)row * 1024; m = mod + (size_t)(row >> 11) * 3072; }
    else { src = ctx + (size_t)(row - RL) * 1024; m = mod + (size_t)8 * 3072; }
    f32x4 v[4]; float ss = 0.f;
    _Pragma("unroll") for (int i = 0; i < 4; ++i) { v[i] = *(const f32x4*)(src + (i * 64 + lane) * 4); ss += v[i][0] * v[i][0] + v[i][1] * v[i][1] + v[i][2] * v[i][2] + v[i][3] * v[i][3]; }
    _Pragma("unroll") for (int o = 32; o >= 1; o >>= 1) ss += __shfl_xor(ss, o);
    const float rstd = rsqrtf(ss * (1.f / 1024.f) + 1e-6f);
    _Pragma("unroll") for (int i = 0; i < 4; ++i) {
      const int k = (i * 64 + lane) * 4;
      const f32x4 g = *(const f32x4*)(gn + k), sh = *(const f32x4*)(m + k), sc = *(const f32x4*)(m + 1024 + k);
      u32x2 o;
      o[0] = pack2(v[i][0] * rstd * g[0] * (1.f + sc[0]) + sh[0], v[i][1] * rstd * g[1] * (1.f + sc[1]) + sh[1]);
      o[1] = pack2(v[i][2] * rstd * g[2] * (1.f + sc[2]) + sh[2], v[i][3] * rstd * g[3] * (1.f + sc[3]) + sh[3]);
      *(u32x2*)(NB_ + (size_t)row * 1024 + k) = o;
    }
  }
}

DI void final_norm_phase(float* H, const float* gn) {
  const int lane = threadIdx.x & 63;
  const int w0 = blockIdx.x * 4 + (threadIdx.x >> 6), nw = gridDim.x * 4;
  for (int row = w0; row < RL; row += nw) {
    float* src = H + (size_t)row * 1024;
    f32x4 v[4]; float ss = 0.f;
    _Pragma("unroll") for (int i = 0; i < 4; ++i) { v[i] = *(const f32x4*)(src + (i * 64 + lane) * 4); ss += v[i][0] * v[i][0] + v[i][1] * v[i][1] + v[i][2] * v[i][2] + v[i][3] * v[i][3]; }
    _Pragma("unroll") for (int o = 32; o >= 1; o >>= 1) ss += __shfl_xor(ss, o);
    const float rstd = rsqrtf(ss * (1.f / 1024.f) + 1e-6f);
    _Pragma("unroll") for (int i = 0; i < 4; ++i) {
      const int k = (i * 64 + lane) * 4;
      const f32x4 g = *(const f32x4*)(gn + k);
      f32x4 o; o[0] = v[i][0] * rstd * g[0]; o[1] = v[i][1] * rstd * g[1]; o[2] = v[i][2] * rstd * g[2]; o[3] = v[i][3] * rstd * g[3];
      *(f32x4*)(src + k) = o;
    }
  }
}

DI void lru_phase(const Params& p, char* smem) {
  char* ws = p.ws;
  bf16_t* Wl = (bf16_t*)smem;
  bf16_t* Uc = Wl + 192 * 96;
  float* aggA = (float*)(Uc + 64 * 96);
  float* aggH = aggA + 16 * 96;
  const bf16_t* U0 = (const bf16_t*)(ws + O_U0);
  const bf16_t* G0 = (const bf16_t*)(ws + O_G0);
  const int tid = threadIdx.x, lane = tid & 63, w = tid >> 6, col = lane & 15, quad = lane >> 4;
  for (int item = blockIdx.x; item < 256; item += gridDim.x) {
    const int dir = item & 1, k = (item >> 1) & 15, b = item >> 5;
    bf16_t* ACT = (bf16_t*)(ws + O_ACT0) + (size_t)dir * R * LW;
    __syncthreads();
    {
      const u32x4* src = (const u32x4*)((const bf16_t*)(ws + O_WG) + (size_t)(k * 2 + dir) * 192 * 96);
      u32x4* dst = (u32x4*)Wl;
      for (int i = tid; i < 192 * 96 / 8; i += 256) dst[i] = src[i];
      if (tid < 64) { u32x4 z; z[0] = z[1] = z[2] = z[3] = 0u; *(u32x4*)(Uc + tid * 96 + 88) = z; }
    }
    float ba[6], bx[6], sp8[6];
    _Pragma("unroll") for (int c = 0; c < 6; ++c) {
      const int ch = 16 * c + col;
      if (ch < 88) {
        ba[c] = p.in[11][dir * LW + k * 88 + ch]; bx[c] = p.in[13][dir * LW + k * 88 + ch];
        sp8[c] = 8.f * log1pf(expf(-p.in[14][dir * LW + k * 88 + ch]));
      } else { ba[c] = 0.f; bx[c] = 0.f; sp8[c] = 0.f; }
    }
    const int cp = tid % 44, run = tid / 44;
    float cw[4][2], cb2[2];
    _Pragma("unroll") for (int t = 0; t < 4; ++t) { cw[t][0] = p.in[8][t * LW + k * 88 + 2 * cp]; cw[t][1] = p.in[8][t * LW + k * 88 + 2 * cp + 1]; }
    cb2[0] = p.in[9][k * 88 + 2 * cp]; cb2[1] = p.in[9][k * 88 + 2 * cp + 1];
    float carry = 0.f;
    unsigned un[19];
    auto tile_info = [&](int ti, int& rowbase, int& L, int& t0) {
      if (ti < 4) { rowbase = RL + b * 256; L = 256; t0 = (dir ? 3 - ti : ti) * 64; }
      else { rowbase = b * 2048; L = 2048; t0 = (dir ? 31 - (ti - 4) : (ti - 4)) * 64; }
    };
    auto prefetch = [&](int ti) {
      int rowbase, L, t0; tile_info(ti, rowbase, L, t0);
      _Pragma("unroll") for (int i = 0; i < 19; ++i) {
        const int tt = t0 + 16 * run - 2 + i;
        unsigned v = 0u;
        if (tid < 176 && tt >= 0 && tt < L) v = *(const unsigned*)(U0 + (size_t)(rowbase + tt) * LW + k * 88 + 2 * cp);
        un[i] = v;
      }
    };
    prefetch(0);
    for (int ti = 0; ti < 36; ++ti) {
      int rowbase, L, t0; tile_info(ti, rowbase, L, t0);
      if (tid < 176) {
        _Pragma("unroll") for (int t = 0; t < 16; ++t) {
          const float y0 = cb2[0] + cw[0][0] * bflo(un[t]) + cw[1][0] * bflo(un[t + 1]) + cw[2][0] * bflo(un[t + 2]) + cw[3][0] * bflo(un[t + 3]);
          const float y1 = cb2[1] + cw[0][1] * bfhi(un[t]) + cw[1][1] * bfhi(un[t + 1]) + cw[2][1] * bfhi(un[t + 2]) + cw[3][1] * bfhi(un[t + 3]);
          *(unsigned*)(Uc + (16 * run + t) * 96 + 2 * cp) = pack2(y0, y1);
        }
      }
      if (ti + 1 < 36) prefetch(ti + 1);
      __syncthreads();
      bf16x8 af[3];
      _Pragma("unroll") for (int ks = 0; ks < 3; ++ks) af[ks] = *(const bf16x8*)(Uc + (16 * w + col) * 96 + ks * 32 + quad * 8);
      float hl[6][4], ac[6][4];
      _Pragma("unroll") for (int c = 0; c < 6; ++c) {
        f32x4 gA = {0.f, 0.f, 0.f, 0.f}, gX = {0.f, 0.f, 0.f, 0.f};
        _Pragma("unroll") for (int ks = 0; ks < 3; ++ks) {
          const bf16x8 bA = *(const bf16x8*)(Wl + ((c * 2 + 0) * 16 + col) * 96 + ks * 32 + quad * 8);
          const bf16x8 bX = *(const bf16x8*)(Wl + ((c * 2 + 1) * 16 + col) * 96 + ks * 32 + quad * 8);
          gA = MFMA16(af[ks], bA, gA);
          gX = MFMA16(af[ks], bX, gX);
        }
        float a[4], bb[4];
        _Pragma("unroll") for (int j = 0; j < 4; ++j) {
          const float uval = bf2f(Uc[(16 * w + 4 * quad + j) * 96 + 16 * c + col]);
          const float rg = sigm(gA[j] + ba[c]), ig = sigm(gX[j] + bx[c]);
          a[j] = __expf(-sp8[c] * rg);
          bb[j] = sqrtf(fmaxf(1.f - a[j] * a[j], 0.f)) * ig * uval;
        }
        if (dir == 0) {
          hl[c][0] = bb[0]; ac[c][0] = a[0];
          _Pragma("unroll") for (int j = 1; j < 4; ++j) { hl[c][j] = a[j] * hl[c][j - 1] + bb[j]; ac[c][j] = a[j] * ac[c][j - 1]; }
          aggA[(4 * w + quad) * 96 + 16 * c + col] = ac[c][3]; aggH[(4 * w + quad) * 96 + 16 * c + col] = hl[c][3];
        } else {
          hl[c][3] = bb[3]; ac[c][3] = a[3];
          _Pragma("unroll") for (int j = 2; j >= 0; --j) { hl[c][j] = a[j] * hl[c][j + 1] + bb[j]; ac[c][j] = a[j] * ac[c][j + 1]; }
          aggA[(4 * w + quad) * 96 + 16 * c + col] = ac[c][0]; aggH[(4 * w + quad) * 96 + 16 * c + col] = hl[c][0];
        }
      }
      __syncthreads();
      if (tid < 88) {
        float cin = carry;
        if (dir == 0) { for (int s = 0; s < 16; ++s) { const float A_ = aggA[s * 96 + tid], H_ = aggH[s * 96 + tid]; aggA[s * 96 + tid] = cin; cin = A_ * cin + H_; } }
        else { for (int s = 15; s >= 0; --s) { const float A_ = aggA[s * 96 + tid], H_ = aggH[s * 96 + tid]; aggA[s * 96 + tid] = cin; cin = A_ * cin + H_; } }
        carry = cin;
      }
      __syncthreads();
      _Pragma("unroll") for (int c = 0; c < 6; ++c) {
        const int ch = 16 * c + col;
        if (ch < 88) {
          const float cin = aggA[(4 * w + quad) * 96 + ch];
          _Pragma("unroll") for (int j = 0; j < 4; ++j) {
            const size_t idx = (size_t)(rowbase + t0 + 16 * w + 4 * quad + j) * LW + k * 88 + ch;
            const float hv = hl[c][j] + ac[c][j] * cin;
            ACT[idx] = f2bf(hv * silu(bf2f(G0[idx])));
          }
        }
      }
    }
  }
}

struct AttnSt { f32x16 O0, O1; float m, l; };
DI bf16x8 ld16(const bf16_t* p) { return *(const bf16x8*)p; }
DI bf16x8 ld8x2(const bf16_t* p0) { const s16x4 a = *(const s16x4*)p0; const s16x4 b = *(const s16x4*)(p0 + 8); return __builtin_shufflevector(a, b, 0, 1, 2, 3, 4, 5, 6, 7); }
DI bf16x8 pack8(const f32x16& P, int s) {
  u32x4 u;
  _Pragma("unroll") for (int j = 0; j < 4; ++j) u[j] = pack2(P[8 * s + 2 * j], P[8 * s + 2 * j + 1]);
  return __builtin_bit_cast(bf16x8, u);
}

template <class F>
DI void attn_tile(AttnSt& st, const bf16x8 (&qf)[4], const bf16_t* kp, const bf16_t* vp, int ldv, F fmod) {
  const bf16x8 k0 = ld16(kp), k1 = ld16(kp + 16), k2 = ld16(kp + 32), k3 = ld16(kp + 48);
  const bf16x8 v00 = ld8x2(vp), v01 = ld8x2(vp + 16);
  const bf16_t* vp1 = vp + (size_t)32 * ldv;
  const bf16x8 v10 = ld8x2(vp1), v11 = ld8x2(vp1 + 16);
  f32x16 S = zero16();
  S = MFMA32(k0, qf[0], S); S = MFMA32(k1, qf[1], S); S = MFMA32(k2, qf[2], S); S = MFMA32(k3, qf[3], S);
  float mx = -3.0e38f;
  _Pragma("unroll") for (int i = 0; i < 16; ++i) { S[i] = fmod(i, S[i]); mx = fmaxf(mx, S[i]); }
  mx = fmaxf(mx, __shfl_xor(mx, 32));
  const float mn = fmaxf(st.m, mx);
  const float alpha = __expf(st.m - mn);
  st.m = mn;
  float ls = 0.f;
  f32x16 P;
  _Pragma("unroll") for (int i = 0; i < 16; ++i) { P[i] = __expf(S[i] - mn); ls += P[i]; }
  st.l = st.l * alpha + ls;
  _Pragma("unroll") for (int i = 0; i < 16; ++i) { st.O0[i] *= alpha; st.O1[i] *= alpha; }
  const bf16x8 p0 = pack8(P, 0), p1 = pack8(P, 1);
  st.O0 = MFMA32(v00, p0, st.O0); st.O0 = MFMA32(v01, p1, st.O0);
  st.O1 = MFMA32(v10, p0, st.O1); st.O1 = MFMA32(v11, p1, st.O1);
}

DI void attn_finish(AttnSt& st, const bf16_t* Grow  , bf16_t* Arow  , int h) {
  const float lt = st.l + __shfl_xor(st.l, 32);
  const float inv = 1.f / lt;
  _Pragma("unroll") for (int q = 0; q < 4; ++q) {
    const int d0 = 8 * q + 4 * h;
    {
      const u32x2 g = *(const u32x2*)(Grow + d0);
      u32x2 o;
      o[0] = pack2(st.O0[4 * q + 0] * inv * silu(bflo(g[0])), st.O0[4 * q + 1] * inv * silu(bfhi(g[0])));
      o[1] = pack2(st.O0[4 * q + 2] * inv * silu(bflo(g[1])), st.O0[4 * q + 3] * inv * silu(bfhi(g[1])));
      *(u32x2*)(Arow + d0) = o;
    }
    {
      const u32x2 g = *(const u32x2*)(Grow + 32 + d0);
      u32x2 o;
      o[0] = pack2(st.O1[4 * q + 0] * inv * silu(bflo(g[0])), st.O1[4 * q + 1] * inv * silu(bfhi(g[0])));
      o[1] = pack2(st.O1[4 * q + 2] * inv * silu(bflo(g[1])), st.O1[4 * q + 3] * inv * silu(bfhi(g[1])));
      *(u32x2*)(Arow + 32 + d0) = o;
    }
  }
}

DI void swa_phase(const Params& p) {
  char* ws = p.ws;
  const bf16_t* Q = (const bf16_t*)(ws + O_Q1); const bf16_t* QR = (const bf16_t*)(ws + O_QR1); const bf16_t* Kb = (const bf16_t*)(ws + O_K1);
  const bf16_t* VtL = (const bf16_t*)(ws + O_VTL1); const bf16_t* VtC = (const bf16_t*)(ws + O_VTC1);
  const bf16_t* G = (const bf16_t*)(ws + O_G1); bf16_t* ACT = (bf16_t*)(ws + O_ACT1);
  const float* sink = p.in[20];
  const int lane = threadIdx.x & 63, r = lane & 31, h = lane >> 5;
  const int wid = blockIdx.x * 4 + (threadIdx.x >> 6), nw = gridDim.x * 4;
  auto ident = [](int, float s) { return s; };
  for (int it = wid; it < 8192 + 1024; it += nw) {
    int b, kvh, g4, qt; bool lat = it < 8192;
    if (lat) { g4 = it & 3; qt = (it >> 2) & 63; kvh = (it >> 8) & 3; b = it >> 10; }
    else { const int j = it - 8192; g4 = j & 3; qt = (j >> 2) & 7; kvh = (j >> 5) & 3; b = j >> 7; }
    const int head = kvh * 4 + g4;
    const size_t qrow = lat ? (size_t)b * 2048 + qt * 32 + r : (size_t)RL + b * 256 + qt * 32 + r;
    AttnSt st; st.O0 = zero16(); st.O1 = zero16(); st.m = sink[head]; st.l = h == 0 ? 1.f : 0.f;
    bf16x8 qf[4];
    _Pragma("unroll") for (int ks = 0; ks < 4; ++ks) qf[ks] = ld16(Q + qrow * 1024 + head * 64 + ks * 16 + 8 * h);
    const bf16_t* kc = Kb + ((size_t)RL + b * 256 + r) * 256 + kvh * 64 + 8 * h;
    const bf16_t* vc = VtC + ((size_t)(b * 4 + kvh) * 64 + r) * 256 + 4 * h;
    for (int kt = 0; kt < 8; ++kt) attn_tile(st, qf, kc + (size_t)kt * 32 * 256, vc + kt * 32, 256, ident);
    if (lat) {
      _Pragma("unroll") for (int ks = 0; ks < 4; ++ks) qf[ks] = ld16(QR + qrow * 1024 + head * 64 + ks * 16 + 8 * h);
      const bf16_t* kl = Kb + ((size_t)b * 2048 + r) * 256 + kvh * 64 + 8 * h;
      const bf16_t* vl = VtL + ((size_t)(b * 4 + kvh) * 64 + r) * 2048 + 4 * h;
      for (int dk = -4; dk <= 4; ++dk) {
        const int kt = qt + dk;
        if (kt < 0 || kt >= 64) continue;
        const int dq = qt * 32 + r - kt * 32;
        attn_tile(st, qf, kl + (size_t)kt * 32 * 256, vl + kt * 32, 2048, [&](int i, float s) { const int d = dq - crow(i, h); return (d <= 128 && d >= -128) ? s : -1.0e30f; });
      }
    }
    attn_finish(st, G + qrow * 1024 + head * 64, ACT + qrow * 1024 + head * 64, h);
  }
}

DI void na_phase(const Params& p) {
  char* ws = p.ws;
  const bf16_t* Q = (const bf16_t*)(ws + O_Q2); const bf16_t* Kb = (const bf16_t*)(ws + O_K2);
  const bf16_t* VtL = (const bf16_t*)(ws + O_VTL2); const bf16_t* VtC = (const bf16_t*)(ws + O_VTC2);
  const bf16_t* G = (const bf16_t*)(ws + O_G2); bf16_t* ACT = (bf16_t*)(ws + O_ACT2);
  const float* rpb = p.in[26];
  const int lane = threadIdx.x & 63, r = lane & 31, h = lane >> 5;
  const int wid = blockIdx.x * 4 + (threadIdx.x >> 6), nw = gridDim.x * 4;
  auto ident = [](int, float s) { return s; };
  for (int it = wid; it < 8192 + 1024; it += nw) {
    int b, head, half, gr; bool lat = it < 8192;
    if (lat) { half = it & 1; head = (it >> 1) & 15; gr = (it >> 5) & 31; b = it >> 10; }
    else { const int j = it - 8192; half = 0; head = j & 15; gr = (j >> 4) & 7; b = j >> 7; }
    const size_t qrow = lat ? (size_t)b * 2048 + gr * 64 + half * 32 + r : (size_t)RL + b * 256 + gr * 32 + r;
    AttnSt st; st.O0 = zero16(); st.O1 = zero16(); st.m = -1.0e30f; st.l = 0.f;
    bf16x8 qf[4];
    _Pragma("unroll") for (int ks = 0; ks < 4; ++ks) qf[ks] = ld16(Q + qrow * 1024 + head * 64 + ks * 16 + 8 * h);
    const bf16_t* kc = Kb + ((size_t)RL + b * 256 + r) * 1024 + head * 64 + 8 * h;
    const bf16_t* vc = VtC + ((size_t)(b * 16 + head) * 64 + r) * 256 + 4 * h;
    for (int kt = 0; kt < 8; ++kt) attn_tile(st, qf, kc + (size_t)kt * 32 * 1024, vc + kt * 32, 256, ident);
    if (lat) {
      const int cq = half * 32 + r;
      const int cs = min(max(cq - 8, 0), 48);
      const int rs_ = min(max(gr - 4, 0), 24);
      const bf16_t* kl = Kb + ((size_t)b * 2048 + r) * 1024 + head * 64 + 8 * h;
      const bf16_t* vl = VtL + ((size_t)(b * 16 + head) * 64 + r) * 2048 + 4 * h;
      for (int i8 = 0; i8 < 8; ++i8) {
        const int krow = rs_ + i8;
        const float* rp = rpb + (size_t)(head * 15 + (krow - gr + 7)) * 31;
        for (int ct = 0; ct < 2; ++ct) {
          const int key0 = krow * 64 + ct * 32;
          attn_tile(st, qf, kl + (size_t)key0 * 1024, vl + key0, 2048, [&](int i, float s) {
            const int ck = ct * 32 + crow(i, h);
            const bool ok = (ck >= cs) && (ck < cs + 16);
            const int dx = min(max(ck - cq + 15, 0), 30);
            return ok ? s + rp[dx] : -1.0e30f;
          });
        }
      }
    }
    attn_finish(st, G + qrow * 1024 + head * 64, ACT + qrow * 1024 + head * 64, h);
  }
}

DI void s5_mats_phase(const Params& p) {
  char* ws = p.ws;
  const float2* POW = (const float2*)(ws + O_POW); const float2* BB = (const float2*)(ws + O_BBAR);
  bf16_t* GT = (bf16_t*)(ws + O_GT); bf16_t* MYT = (bf16_t*)(ws + O_MYT);
  const float* cre = p.in[37]; const float* cim = p.in[38]; const float* dsk = p.in[39];
  const int gt = blockIdx.x * 256 + threadIdx.x, gn = gridDim.x * 256;
  for (int idx = gt; idx < 64 * 256 * 256; idx += gn) {
    const int g = idx >> 16, n = (idx >> 8) & 255, k = idx & 255;
    {
      const int dir = n >> 7, pp = (n >> 1) & 63, ri = n & 1, i = k >> 4, c = k & 15;
      const int e = dir ? i : 15 - i;
      const float2 pw = POW[((size_t)(dir * 64 + g) * 17 + e) * 64 + pp];
      const float2 bb = BB[((size_t)(dir * 64 + g) * 64 + pp) * 16 + c];
      const float zr = pw.x * bb.x - pw.y * bb.y, zi = pw.x * bb.y + pw.y * bb.x;
      GT[idx] = f2bf(ri ? zi : zr);
    }
    {
      const int j = n >> 4, o = n & 15, dir = k >> 7, pp = (k >> 1) & 63, ri = k & 1;
      const int e = dir ? 16 - j : j + 1;
      const float2 pw = POW[((size_t)(dir * 64 + g) * 17 + e) * 64 + pp];
      const size_t ci = ((size_t)(dir * 64 + g) * 16 + o) * 64 + pp;
      const float cr = cre[ci], cm = cim[ci];
      const float zr = cr * pw.x - cm * pw.y, zi = cr * pw.y + cm * pw.x;
      MYT[((size_t)g * 256 + n) * 512 + 256 + k] = f2bf(ri ? -zi : zr);
    }
  }
  for (int idx = gt; idx < 64 * 16 * 256; idx += gn) {
    const int g = idx >> 12, lag = (idx >> 8) & 15, o = (idx >> 4) & 15, c = idx & 15;
    float kf = 0.f, kb = 0.f;
    for (int pp = 0; pp < 64; ++pp) {
      {
        const float2 pw = POW[((size_t)(0 * 64 + g) * 17 + lag) * 64 + pp];
        const float2 bb = BB[((size_t)(0 * 64 + g) * 64 + pp) * 16 + c];
        const size_t ci = ((size_t)(0 * 64 + g) * 16 + o) * 64 + pp;
        const float zr = pw.x * bb.x - pw.y * bb.y, zi = pw.x * bb.y + pw.y * bb.x;
        kf += cre[ci] * zr - cim[ci] * zi;
      }
      {
        const float2 pw = POW[((size_t)(1 * 64 + g) * 17 + lag) * 64 + pp];
        const float2 bb = BB[((size_t)(1 * 64 + g) * 64 + pp) * 16 + c];
        const size_t ci = ((size_t)(1 * 64 + g) * 16 + o) * 64 + pp;
        const float zr = pw.x * bb.x - pw.y * bb.y, zi = pw.x * bb.y + pw.y * bb.x;
        kb += cre[ci] * zr - cim[ci] * zi;
      }
    }
    bf16_t* Mg = MYT + (size_t)g * 256 * 512;
    if (lag == 0) {
      const bf16_t v = f2bf(kf + kb + (o == c ? dsk[g * 16 + o] : 0.f));
      for (int j = 0; j < 16; ++j) Mg[(size_t)(j * 16 + o) * 512 + j * 16 + c] = v;
    } else {
      const bf16_t vf = f2bf(kf), vb = f2bf(kb);
      for (int i = 0; i + lag < 16; ++i) {
        Mg[(size_t)((i + lag) * 16 + o) * 512 + i * 16 + c] = vf;
        Mg[(size_t)(i * 16 + o) * 512 + (i + lag) * 16 + c] = vb;
      }
    }
  }
}

DI void s5_scan_phase(const Params& p) {
  char* ws = p.ws;
  const float2* POW = (const float2*)(ws + O_POW);
  const float* SL = (const float*)(ws + O_SLOC);
  bf16_t* ACAT = (bf16_t*)(ws + O_ACAT);
  for (int gid = blockIdx.x * 256 + threadIdx.x; gid < 65536; gid += gridDim.x * 256) {
    const int pp = gid & 63, g = (gid >> 6) & 63, dir = (gid >> 12) & 1, b = gid >> 13;
    const float2 lam = POW[((size_t)(dir * 64 + g) * 17 + 16) * 64 + pp];
    float hr = 0.f, hi = 0.f;
    for (int q0 = 0; q0 < 144; q0 += 16) {
      float2 s[16];
      _Pragma("unroll") for (int j = 0; j < 16; ++j) {
        const int q = q0 + j;
        const int chunk = q < 16 ? (1024 + b * 16 + (dir ? 15 - q : q)) : (b * 128 + (dir ? 127 - (q - 16) : (q - 16)));
        s[j] = *(const float2*)(SL + ((size_t)g * NCH + chunk) * 256 + dir * 128 + 2 * pp);
      }
      _Pragma("unroll") for (int j = 0; j < 16; ++j) {
        const int q = q0 + j;
        const int chunk = q < 16 ? (1024 + b * 16 + (dir ? 15 - q : q)) : (b * 128 + (dir ? 127 - (q - 16) : (q - 16)));
        *(unsigned*)(ACAT + ((size_t)g * NCH + chunk) * 512 + 256 + dir * 128 + 2 * pp) = pack2(hr, hi);
        const float nr = lam.x * hr - lam.y * hi + s[j].x, ni = lam.x * hi + lam.y * hr + s[j].y;
        hr = nr; hi = ni;
      }
    }
  }
}

__global__ void __launch_bounds__(256, 2) fwd_megakernel(Params p) {
  __shared__ __attribute__((aligned(16))) char smem[65536];
  cg::grid_group grid = cg::this_grid();
  char* ws = p.ws;
  float* MOD = (float*)(ws + O_MOD);
  float* HCTX = (float*)(ws + O_HCTX);
  const bf16_t* NBUF = (const bf16_t*)(ws + O_NBUF);

  phase0(p, smem);
  grid.sync();
  norm_phase(p.in[0], p.in[2], p.in[6], MOD, (bf16_t*)(ws + O_NBUF0));
  grid.sync();
  {
    EpiL0In e{(bf16_t*)(ws + O_U0), (bf16_t*)(ws + O_G0)};
    gemm_phase<false>((const bf16_t*)(ws + O_NBUF0), nullptr, 1024, 0, (const bf16_t*)(ws + O_WT_IN0), 1024, 0, R, 2816, 1024, 1, e, smem);
  }
  grid.sync();
  lru_phase(p, smem);
  grid.sync();
  {
    EpiOut e{p.in[0], p.in[2], p.out, HCTX, MOD + 2048};
    gemm_phase<true>((const bf16_t*)(ws + O_ACT0), (const bf16_t*)(ws + O_ACT0) + (size_t)R * LW, LW, 0, (const bf16_t*)(ws + O_WT_OUT0), LW, 0, R, 1024, LW, 1, e, smem);
  }
  grid.sync();
  norm_phase(p.out, HCTX, p.in[18], MOD + 9 * 3072, (bf16_t*)(ws + O_NBUF));
  grid.sync();
  {
    EpiL1In e{(bf16_t*)(ws + O_Q1), (bf16_t*)(ws + O_QR1), (bf16_t*)(ws + O_K1), (bf16_t*)(ws + O_VTL1), (bf16_t*)(ws + O_VTC1), (bf16_t*)(ws + O_G1),
              (const float*)(ws + O_ROPEC), (const float*)(ws + O_ROPES)};
    gemm_phase<false>(NBUF, nullptr, 1024, 0, (const bf16_t*)(ws + O_WT_IN1), 1024, 0, R, 2560, 1024, 1, e, smem);
  }
  grid.sync();
  swa_phase(p);
  grid.sync();
  {
    EpiOut e{p.out, HCTX, p.out, HCTX, MOD + 9 * 3072 + 2048};
    gemm_phase<false>((const bf16_t*)(ws + O_ACT1), nullptr, 1024, 0, (const bf16_t*)(ws + O_WT_OUT1), 1024, 0, R, 1024, 1024, 1, e, smem);
  }
  grid.sync();
  norm_phase(p.out, HCTX, p.in[24], MOD + 2 * 9 * 3072, (bf16_t*)(ws + O_NBUF));
  grid.sync();
  {
    EpiL2In e{(bf16_t*)(ws + O_Q2), (bf16_t*)(ws + O_K2), (bf16_t*)(ws + O_VTL2), (bf16_t*)(ws + O_VTC2), (bf16_t*)(ws + O_G2)};
    gemm_phase<false>(NBUF, nullptr, 1024, 0, (const bf16_t*)(ws + O_WT_IN2), 1024, 0, R, 4096, 1024, 1, e, smem);
  }
  grid.sync();
  na_phase(p);
  grid.sync();
  {
    EpiOut e{p.out, HCTX, p.out, HCTX, MOD + 2 * 9 * 3072 + 2048};
    gemm_phase<false>((const bf16_t*)(ws + O_ACT2), nullptr, 1024, 0, (const bf16_t*)(ws + O_WT_OUT2), 1024, 0, R, 1024, 1024, 1, e, smem);
  }
  grid.sync();
  norm_phase(p.out, HCTX, p.in[30], MOD + 3 * 9 * 3072, (bf16_t*)(ws + O_NBUF));
  s5_mats_phase(p);
  grid.sync();
  {
    EpiL3In e{(bf16_t*)(ws + O_ACAT), (bf16_t*)(ws + O_G3)};
    gemm_phase<false>(NBUF, nullptr, 1024, 0, (const bf16_t*)(ws + O_WT_IN3), 1024, 0, R, 2048, 1024, 1, e, smem);
  }
  grid.sync();
  {
    EpiS5State e{(float*)(ws + O_SLOC)};
    gemm_phase<false>((const bf16_t*)(ws + O_ACAT), nullptr, 512, (size_t)NCH * 512, (const bf16_t*)(ws + O_GT), 256, (size_t)256 * 256, NCH, 256, 256, 64, e, smem);
  }
  grid.sync();
  s5_scan_phase(p);
  grid.sync();
  {
    EpiS5Y e{(bf16_t*)(ws + O_YG)};
    gemm_phase<false>((const bf16_t*)(ws + O_ACAT), nullptr, 512, (size_t)NCH * 512, (const bf16_t*)(ws + O_MYT), 512, (size_t)256 * 512, 1024, 256, 512, 64, e, smem);
  }
  grid.sync();
  {
    EpiGlu e{(const bf16_t*)(ws + O_YG), (const bf16_t*)(ws + O_G3), p.in[41], (bf16_t*)(ws + O_ACT3)};
    gemm_phase<false>((const bf16_t*)(ws + O_YG), nullptr, 1024, 0, (const bf16_t*)(ws + O_WT_GLU), 1024, 0, RL, 1024, 1024, 1, e, smem);
  }
  grid.sync();
  {
    EpiOut e{p.out, HCTX, p.out, HCTX, MOD + 3 * 9 * 3072 + 2048};
    gemm_phase<false>((const bf16_t*)(ws + O_ACT3), nullptr, 1024, 0, (const bf16_t*)(ws + O_WT_OUT3), 1024, 0, RL, 1024, 1024, 1, e, smem);
  }
  grid.sync();
  final_norm_phase(p.out, p.in[43]);
}

extern "C" void kernel_launch(void* const* d_in, const int* in_sizes, int n_in, void* d_out, int out_size, void* d_ws, size_t ws_size,
                              hipStream_t stream) {
  static int grid_blocks = 0;
  if (!grid_blocks) {
    int dev = 0, cus = 0, per_cu = 0;
    hipGetDevice(&dev);
    hipDeviceGetAttribute(&cus, hipDeviceAttributeMultiprocessorCount, dev);
    hipOccupancyMaxActiveBlocksPerMultiprocessor(&per_cu, fwd_megakernel, 256, 0);
    if (per_cu > 2) per_cu = 2;
    if (per_cu < 1) per_cu = 1;
    grid_blocks = cus * per_cu;
  }
  if (n_in != 44 || ws_size < WS_END) { fprintf(stderr, "kernel_launch: unexpected n_in %d or ws_size %zu < %zu\n", n_in, ws_size, (size_t)WS_END); return; }
  Params p{};
  for (int i = 0; i < 44; ++i) p.in[i] = (const float*)d_in[i];
  p.out = (float*)d_out;
  p.ws = (char*)d_ws;
  void* args[] = {&p};
  hipError_t e = hipLaunchCooperativeKernel((void*)fwd_megakernel, dim3(grid_blocks), dim3(256), args, 0, stream);
  if (e != hipSuccess) fprintf(stderr, "cooperative launch failed: %s (grid %d)\n", hipGetErrorString(e), grid_blocks);
}
```

```cpp
#include <hip/hip_runtime.h>
#include <hip/hip_cooperative_groups.h>
#include <cstdio>
namespace cg = cooperative_groups;

#define DI __device__ __forceinline__
typedef unsigned short bf16_t;
typedef short bf16x8 __attribute__((ext_vector_type(8)));
typedef short s16x4 __attribute__((ext_vector_type(4)));
typedef float f32x16 __attribute__((ext_vector_type(16)));
typedef float f32x4 __attribute__((ext_vector_type(4)));
typedef unsigned u32x2 __attribute__((ext_vector_type(2)));
typedef unsigned u32x4 __attribute__((ext_vector_type(4)));

#define MFMA32(a, b, c) __builtin_amdgcn_mfma_f32_32x32x16_bf16((a), (b), (c), 0, 0, 0)
#define MFMA16(a, b, c) __builtin_amdgcn_mfma_f32_16x16x32_bf16((a), (b), (c), 0, 0, 0)

constexpr int D = 1024, NB = 8, SEQ = 2048, CTXL = 256;
constexpr int RL = NB * SEQ;
constexpr int RC = NB * CTXL;
constexpr int R = RL + RC;
constexpr int LW = 1408;
constexpr int NCH = R / 16;

constexpr size_t O_WT_IN0 = 0;
constexpr size_t O_WT_OUT0 = O_WT_IN0 + (size_t)2816 * 1024 * 2;
constexpr size_t O_WT_IN1 = O_WT_OUT0 + (size_t)1024 * 1408 * 2;
constexpr size_t O_WT_OUT1 = O_WT_IN1 + (size_t)2560 * 1024 * 2;
constexpr size_t O_WT_IN2 = O_WT_OUT1 + (size_t)1024 * 1024 * 2;
constexpr size_t O_WT_OUT2 = O_WT_IN2 + (size_t)4096 * 1024 * 2;
constexpr size_t O_WT_IN3 = O_WT_OUT2 + (size_t)1024 * 1024 * 2;
constexpr size_t O_WT_GLU = O_WT_IN3 + (size_t)2048 * 1024 * 2;
constexpr size_t O_WT_OUT3 = O_WT_GLU + (size_t)1024 * 1024 * 2;
constexpr size_t O_WG = O_WT_OUT3 + (size_t)1024 * 1024 * 2;
constexpr size_t O_MOD = O_WG + (size_t)16 * 2 * 192 * 96 * 2;
constexpr size_t O_ROPEC = O_MOD + (size_t)4 * 9 * 3072 * 4;
constexpr size_t O_ROPES = O_ROPEC + (size_t)2048 * 32 * 4;
constexpr size_t O_POW = O_ROPES + (size_t)2048 * 32 * 4;
constexpr size_t O_BBAR = O_POW + (size_t)2 * 64 * 17 * 64 * 8;
constexpr size_t O_HCTX = O_BBAR + (size_t)2 * 64 * 64 * 16 * 8;
constexpr size_t O_DYN = O_HCTX + (size_t)RC * 1024 * 4;
constexpr size_t O_U0 = O_DYN;
constexpr size_t O_G0 = O_U0 + (size_t)R * LW * 2;
constexpr size_t O_ACT0 = O_G0 + (size_t)R * LW * 2;
constexpr size_t O_NBUF0 = O_ACT0;
constexpr size_t O_NBUF = O_DYN;
constexpr size_t O_Q1 = O_NBUF + (size_t)R * 1024 * 2;
constexpr size_t O_QR1 = O_Q1 + (size_t)R * 1024 * 2;
constexpr size_t O_K1 = O_QR1 + (size_t)RL * 1024 * 2;
constexpr size_t O_VTL1 = O_K1 + (size_t)R * 256 * 2;
constexpr size_t O_VTC1 = O_VTL1 + (size_t)8 * 4 * 64 * 2048 * 2;
constexpr size_t O_G1 = O_VTC1 + (size_t)8 * 4 * 64 * 256 * 2;
constexpr size_t O_ACT1 = O_G1 + (size_t)R * 1024 * 2;
constexpr size_t O_Q2 = O_NBUF + (size_t)R * 1024 * 2;
constexpr size_t O_K2 = O_Q2 + (size_t)R * 1024 * 2;
constexpr size_t O_VTL2 = O_K2 + (size_t)R * 1024 * 2;
constexpr size_t O_VTC2 = O_VTL2 + (size_t)8 * 16 * 64 * 2048 * 2;
constexpr size_t O_G2 = O_VTC2 + (size_t)8 * 16 * 64 * 256 * 2;
constexpr size_t O_ACT2 = O_NBUF;
constexpr size_t O_SLOC = O_DYN;
constexpr size_t O_YG = O_DYN;
constexpr size_t O_ACT3 = O_YG + (size_t)RL * 1024 * 2;
constexpr size_t O_ACAT = O_DYN + (size_t)64 * NCH * 256 * 4;
constexpr size_t O_G3 = O_ACAT + (size_t)64 * NCH * 512 * 2;
constexpr size_t O_GT = O_G3 + (size_t)RL * 1024 * 2;
constexpr size_t O_MYT = O_GT + (size_t)64 * 256 * 256 * 2;
constexpr size_t O_BAR = O_MYT + (size_t)64 * 256 * 512 * 2;
constexpr size_t WS_END = O_BAR + 16384;

struct Params {
  const float* in[44];
  float* out;
  char* ws;
};

DI bf16_t f2bf(float x) { unsigned u = __float_as_uint(x); u += 0x7fffu + ((u >> 16) & 1u); return (bf16_t)(u >> 16); }
DI float bf2f(bf16_t b) { return __uint_as_float(((unsigned)b) << 16); }
DI unsigned pack2(float lo, float hi) { return (unsigned)f2bf(lo) | ((unsigned)f2bf(hi) << 16); }
DI float bflo(unsigned u) { return __uint_as_float(u << 16); }
DI float bfhi(unsigned u) { return __uint_as_float(u & 0xffff0000u); }
DI float sigm(float x) { return 1.f / (1.f + __expf(-x)); }
DI float silu(float x) { return x / (1.f + __expf(-x)); }
DI float gelu_tanh(float x) {
  float z = 0.7978845608028654f * (x + 0.044715f * x * x * x);
  float e = __expf(2.f * z);
  float t = 1.f - 2.f / (e + 1.f);
  return 0.5f * x * (1.f + t);
}
DI int crow(int i, int h) { return (i & 3) + 8 * (i >> 2) + 4 * h; }
DI f32x16 zero16() { f32x16 z; _Pragma("unroll") for (int i = 0; i < 16; ++i) z[i] = 0.f; return z; }
DI void sincos_rev(float rev, float& s, float& c) { rev = rev - rintf(rev); s = __builtin_amdgcn_sinf(rev); c = __builtin_amdgcn_cosf(rev); }

DI int lds_off(int row, int chunk) { return row * 128 + ((chunk ^ ((row >> 1) & 7)) << 4); }

template <bool DUAL, class Epi>
DI void gemm_tile(const bf16_t* A, const bf16_t* A2, int lda, const bf16_t* Bt, int ldb, int K, int row0, int col0, int bz,
                  const Epi& epi, char* smem) {
  const int tid = threadIdx.x, lane = tid & 63, wave = tid >> 6, wm = wave >> 1, wn = wave & 1, r = lane & 31, h = lane >> 5;
  char* As = smem;
  char* Bs = smem + 32768;
  f32x16 acc[2][2];
  _Pragma("unroll") for (int mi = 0; mi < 2; ++mi) _Pragma("unroll") for (int ni = 0; ni < 2; ++ni) acc[mi][ni] = zero16();
  const int nk = K >> 6;
  const int lrow = tid >> 3, lch = tid & 7;
  const bf16_t* ap = A + (size_t)(row0 + lrow) * lda + lch * 8;
  const bf16_t* ap2 = DUAL ? (A2 + (size_t)(row0 + lrow) * lda + lch * 8) : nullptr;
  const bf16_t* bp = Bt + (size_t)(col0 + lrow) * ldb + lch * 8;
  u32x4 ra[4], rb[4];
  auto gload = [&](int kt) {
    _Pragma("unroll") for (int i = 0; i < 4; ++i) {
      ra[i] = *(const u32x4*)(ap + (size_t)(32 * i) * lda + kt * 64);
      if (DUAL) {
        u32x4 t2 = *(const u32x4*)(ap2 + (size_t)(32 * i) * lda + kt * 64);
        _Pragma("unroll") for (int e = 0; e < 4; ++e) ra[i][e] = pack2(bflo(ra[i][e]) + bflo(t2[e]), bfhi(ra[i][e]) + bfhi(t2[e]));
      }
      rb[i] = *(const u32x4*)(bp + (size_t)(32 * i) * ldb + kt * 64);
    }
  };
  auto sstore = [&](int buf) {
    _Pragma("unroll") for (int i = 0; i < 4; ++i) {
      *(u32x4*)(As + buf * 16384 + lds_off(lrow + 32 * i, lch)) = ra[i];
      *(u32x4*)(Bs + buf * 16384 + lds_off(lrow + 32 * i, lch)) = rb[i];
    }
  };
  gload(0);
  sstore(0);
  __syncthreads();
  for (int kt = 0; kt < nk; ++kt) {
    const int buf = kt & 1;
    if (kt + 1 < nk) gload(kt + 1);
    const char* a_ = As + buf * 16384;
    const char* b_ = Bs + buf * 16384;
    _Pragma("unroll") for (int ks = 0; ks < 4; ++ks) {
      bf16x8 af[2], bfr[2];
      _Pragma("unroll") for (int mi = 0; mi < 2; ++mi) af[mi] = *(const bf16x8*)(a_ + lds_off(64 * wm + 32 * mi + r, 2 * ks + h));
      _Pragma("unroll") for (int ni = 0; ni < 2; ++ni) bfr[ni] = *(const bf16x8*)(b_ + lds_off(64 * wn + 32 * ni + r, 2 * ks + h));
      _Pragma("unroll") for (int mi = 0; mi < 2; ++mi) _Pragma("unroll") for (int ni = 0; ni < 2; ++ni) acc[mi][ni] = MFMA32(af[mi], bfr[ni], acc[mi][ni]);
    }
    if (kt + 1 < nk) sstore(buf ^ 1);
    __syncthreads();
  }
  epi(acc, row0 + 64 * wm, col0 + 64 * wn, r, h, bz);
}

template <bool DUAL, class Epi>
DI void gemm_phase(const bf16_t* A, const bf16_t* A2, int lda, size_t strideA, const bf16_t* Bt, int ldb, size_t strideB, int M, int N, int K,
                   int nbatch, const Epi& epi, char* smem) {
  const int tm = M >> 7, tn = N >> 7, per = tm * tn, total = per * nbatch;
  for (int t = blockIdx.x; t < total; t += gridDim.x) {
    const int bz = t / per, rem = t - bz * per, im = rem / tn, in_ = rem - im * tn;
    gemm_tile<DUAL>(A + bz * strideA, DUAL ? A2 + bz * strideA : nullptr, lda, Bt + bz * strideB, ldb, K, im * 128, in_ * 128, bz, epi, smem);
  }
}

#define FOR_ACC _Pragma("unroll") for (int mi = 0; mi < 2; ++mi) _Pragma("unroll") for (int ni = 0; ni < 2; ++ni) _Pragma("unroll") for (int i = 0; i < 16; ++i)

struct EpiL0In {
  bf16_t* U0; bf16_t* G0;
  DI void operator()(const f32x16 (&acc)[2][2], int rb, int cb, int r, int h, int) const {
    bf16_t* dst; int c0;
    if (cb < LW) { dst = U0; c0 = cb; } else { dst = G0; c0 = cb - LW; }
    FOR_ACC dst[(size_t)(rb + 32 * mi + crow(i, h)) * LW + c0 + 32 * ni + r] = f2bf(acc[mi][ni][i]);
  }
};

struct EpiOut {
  const float* in_lat; const float* in_ctx; float* out_lat; float* out_ctx; const float* gate;
  DI void operator()(const f32x16 (&acc)[2][2], int rb, int cb, int r, int h, int) const {
    const float* src; float* dst; const float* g; int rr;
    if (rb < RL) { src = in_lat; dst = out_lat; rr = rb; g = gate + (size_t)(rb >> 11) * 3072; }
    else { src = in_ctx; dst = out_ctx; rr = rb - RL; g = gate + (size_t)8 * 3072; }
    FOR_ACC {
      const size_t idx = (size_t)(rr + 32 * mi + crow(i, h)) * 1024 + cb + 32 * ni + r;
      dst[idx] = src[idx] + g[cb + 32 * ni + r] * acc[mi][ni][i];
    }
  }
};

DI void store_vt(const f32x16 (&acc)[2][2], bf16_t* vt_head  , int T, int t0  , int r, int h) {
  _Pragma("unroll") for (int mi = 0; mi < 2; ++mi) _Pragma("unroll") for (int ni = 0; ni < 2; ++ni) _Pragma("unroll") for (int q = 0; q < 4; ++q) {
    u32x2 v;
    v[0] = pack2(acc[mi][ni][4 * q + 0], acc[mi][ni][4 * q + 1]);
    v[1] = pack2(acc[mi][ni][4 * q + 2], acc[mi][ni][4 * q + 3]);
    *(u32x2*)(vt_head + (size_t)(32 * ni + r) * T + t0 + 32 * mi + 8 * q + 4 * h) = v;
  }
}

struct EpiL1In {
  bf16_t *Q, *QR, *Kb, *VtL, *VtC, *G; const float *rc, *rs;
  DI void operator()(const f32x16 (&acc)[2][2], int rb, int cb, int r, int h, int) const {
    const bool lat = rb < RL;
    if (cb < 1024) {
      _Pragma("unroll") for (int mi = 0; mi < 2; ++mi) _Pragma("unroll") for (int i = 0; i < 16; ++i) {
        const int row = rb + 32 * mi + crow(i, h);
        const float a1 = acc[mi][0][i] * 0.125f, a2 = acc[mi][1][i] * 0.125f;
        Q[(size_t)row * 1024 + cb + r] = f2bf(a1);
        Q[(size_t)row * 1024 + cb + 32 + r] = f2bf(a2);
        if (lat) {
          const int t = row & 2047;
          const float c = rc[t * 32 + r], s = rs[t * 32 + r];
          QR[(size_t)row * 1024 + cb + r] = f2bf(a1 * c - a2 * s);
          QR[(size_t)row * 1024 + cb + 32 + r] = f2bf(a2 * c + a1 * s);
        }
      }
    } else if (cb < 1280) {
      const int c0 = cb - 1024;
      _Pragma("unroll") for (int mi = 0; mi < 2; ++mi) _Pragma("unroll") for (int i = 0; i < 16; ++i) {
        const int row = rb + 32 * mi + crow(i, h);
        float a1 = acc[mi][0][i], a2 = acc[mi][1][i];
        if (lat) {
          const int t = row & 2047;
          const float c = rc[t * 32 + r], s = rs[t * 32 + r];
          const float b1 = a1 * c - a2 * s, b2 = a2 * c + a1 * s;
          a1 = b1; a2 = b2;
        }
        Kb[(size_t)row * 256 + c0 + r] = f2bf(a1);
        Kb[(size_t)row * 256 + c0 + 32 + r] = f2bf(a2);
      }
    } else if (cb < 1536) {
      const int kvh = (cb - 1280) >> 6;
      if (lat) store_vt(acc, VtL + (size_t)((rb >> 11) * 4 + kvh) * 64 * 2048, 2048, rb & 2047, r, h);
      else { const int rr = rb - RL; store_vt(acc, VtC + (size_t)((rr >> 8) * 4 + kvh) * 64 * 256, 256, rr & 255, r, h); }
    } else {
      const int c0 = cb - 1536;
      FOR_ACC G[(size_t)(rb + 32 * mi + crow(i, h)) * 1024 + c0 + 32 * ni + r] = f2bf(acc[mi][ni][i]);
    }
  }
};

struct EpiL2In {
  bf16_t *Q, *Kb, *VtL, *VtC, *G;
  DI void operator()(const f32x16 (&acc)[2][2], int rb, int cb, int r, int h, int) const {
    if (cb < 1024) {
      FOR_ACC Q[(size_t)(rb + 32 * mi + crow(i, h)) * 1024 + cb + 32 * ni + r] = f2bf(acc[mi][ni][i] * 0.125f);
    } else if (cb < 2048) {
      FOR_ACC Kb[(size_t)(rb + 32 * mi + crow(i, h)) * 1024 + cb - 1024 + 32 * ni + r] = f2bf(acc[mi][ni][i]);
    } else if (cb < 3072) {
      const int hd = (cb - 2048) >> 6;
      if (rb < RL) store_vt(acc, VtL + (size_t)((rb >> 11) * 16 + hd) * 64 * 2048, 2048, rb & 2047, r, h);
      else { const int rr = rb - RL; store_vt(acc, VtC + (size_t)((rr >> 8) * 16 + hd) * 64 * 256, 256, rr & 255, r, h); }
    } else {
      FOR_ACC G[(size_t)(rb + 32 * mi + crow(i, h)) * 1024 + cb - 3072 + 32 * ni + r] = f2bf(acc[mi][ni][i]);
    }
  }
};

struct EpiL3In {
  bf16_t *ACAT, *G;
  DI void operator()(const f32x16 (&acc)[2][2], int rb, int cb, int r, int h, int) const {
    if (cb < 1024) {
      FOR_ACC {
        const int row = rb + 32 * mi + crow(i, h), col = cb + 32 * ni + r;
        ACAT[((size_t)(col >> 4) * NCH + (row >> 4)) * 512 + (row & 15) * 16 + (col & 15)] = f2bf(acc[mi][ni][i]);
      }
    } else if (rb < RL) {
      FOR_ACC G[(size_t)(rb + 32 * mi + crow(i, h)) * 1024 + cb - 1024 + 32 * ni + r] = f2bf(acc[mi][ni][i]);
    }
  }
};

struct EpiS5State {
  float* S;
  DI void operator()(const f32x16 (&acc)[2][2], int rb, int cb, int r, int h, int bz) const {
    FOR_ACC S[((size_t)bz * NCH + rb + 32 * mi + crow(i, h)) * 256 + cb + 32 * ni + r] = acc[mi][ni][i];
  }
};

struct EpiS5Y {
  bf16_t* YG;
  DI void operator()(const f32x16 (&acc)[2][2], int rb, int cb, int r, int h, int bz) const {
    FOR_ACC {
      const int chunk = rb + 32 * mi + crow(i, h), n = cb + 32 * ni + r;
      YG[((size_t)chunk * 16 + (n >> 4)) * 1024 + bz * 16 + (n & 15)] = f2bf(gelu_tanh(acc[mi][ni][i]));
    }
  }
};

struct EpiGlu {
  const bf16_t *YG, *G; const float* gb; bf16_t* ACT;
  DI void operator()(const f32x16 (&acc)[2][2], int rb, int cb, int r, int h, int) const {
    FOR_ACC {
      const int col = cb + 32 * ni + r;
      const size_t idx = (size_t)(rb + 32 * mi + crow(i, h)) * 1024 + col;
      ACT[idx] = f2bf(bf2f(YG[idx]) * sigm(acc[mi][ni][i] + gb[col]) * silu(bf2f(G[idx])));
    }
  }
};

DI void transpose_tile(const float* W, int K, int N, bf16_t* WT, int tile, float* sm) {
  const int tn = N >> 6, tk_i = tile / tn, tn_i = tile - tk_i * tn, k0 = tk_i * 64, n0 = tn_i * 64;
  const int c = threadIdx.x & 63, rr = threadIdx.x >> 6;
  _Pragma("unroll 4") for (int i = 0; i < 16; ++i) { const int k = i * 4 + rr; sm[k * 65 + c] = W[(size_t)(k0 + k) * N + n0 + c]; }
  __syncthreads();
  _Pragma("unroll 4") for (int i = 0; i < 16; ++i) { const int n = i * 4 + rr; WT[(size_t)(n0 + n) * K + k0 + c] = f2bf(sm[c * 65 + n]); }
  __syncthreads();
}

DI void phase0(const Params& p, char* smem) {
  char* ws = p.ws;
  float* smf = (float*)smem;
  for (int job = blockIdx.x; job < 192; job += gridDim.x) {
    const int l = job / 48, n0 = (job % 48) * 64;
    const float* aw = l == 0 ? p.in[4] : l == 1 ? p.in[16] : l == 2 ? p.in[22] : p.in[28];
    const float* ab = l == 0 ? p.in[5] : l == 1 ? p.in[17] : l == 2 ? p.in[23] : p.in[29];
    float* sv = smf;
    float* red = smf + 9 * 1024;
    for (int idx = threadIdx.x; idx < 9 * 1024; idx += 256) {
      const int v = idx >> 10, k = idx & 1023;
      const float x = v < 8 ? p.in[1][v * 1024 + k] : p.in[3][k];
      sv[idx] = silu(x);
    }
    __syncthreads();
    const int col = threadIdx.x & 63, ks = threadIdx.x >> 6;
    float a[9];
    _Pragma("unroll") for (int v = 0; v < 9; ++v) a[v] = 0.f;
    _Pragma("unroll 8") for (int k = ks * 256; k < ks * 256 + 256; ++k) {
      const float w = aw[(size_t)k * 3072 + n0 + col];
      _Pragma("unroll") for (int v = 0; v < 9; ++v) a[v] += sv[v * 1024 + k] * w;
    }
    _Pragma("unroll") for (int v = 0; v < 9; ++v) red[(ks * 9 + v) * 64 + col] = a[v];
    __syncthreads();
    float* MOD = (float*)(ws + O_MOD);
    for (int idx = threadIdx.x; idx < 9 * 64; idx += 256) {
      const int v = idx >> 6, cc = idx & 63;
      const float s = red[(0 * 9 + v) * 64 + cc] + red[(1 * 9 + v) * 64 + cc] + red[(2 * 9 + v) * 64 + cc] + red[(3 * 9 + v) * 64 + cc] + ab[n0 + cc];
      MOD[(size_t)(l * 9 + v) * 3072 + n0 + cc] = s;
    }
    __syncthreads();
  }
  {
    constexpr int T0 = 16 * 44, T1 = T0 + 22 * 16, T2 = T1 + 16 * 40, T3 = T2 + 256, T4 = T3 + 16 * 64, T5 = T4 + 256, T6 = T5 + 16 * 32, T7 = T6 + 256, T8 = T7 + 256;
    for (int j = blockIdx.x; j < T8; j += gridDim.x) {
      if (j < T0) transpose_tile(p.in[7], 1024, 2816, (bf16_t*)(ws + O_WT_IN0), j, smf);
      else if (j < T1) transpose_tile(p.in[15], 1408, 1024, (bf16_t*)(ws + O_WT_OUT0), j - T0, smf);
      else if (j < T2) transpose_tile(p.in[19], 1024, 2560, (bf16_t*)(ws + O_WT_IN1), j - T1, smf);
      else if (j < T3) transpose_tile(p.in[21], 1024, 1024, (bf16_t*)(ws + O_WT_OUT1), j - T2, smf);
      else if (j < T4) transpose_tile(p.in[25], 1024, 4096, (bf16_t*)(ws + O_WT_IN2), j - T3, smf);
      else if (j < T5) transpose_tile(p.in[27], 1024, 1024, (bf16_t*)(ws + O_WT_OUT2), j - T4, smf);
      else if (j < T6) transpose_tile(p.in[31], 1024, 2048, (bf16_t*)(ws + O_WT_IN3), j - T5, smf);
      else if (j < T7) transpose_tile(p.in[40], 1024, 1024, (bf16_t*)(ws + O_WT_GLU), j - T6, smf);
      else transpose_tile(p.in[42], 1024, 1024, (bf16_t*)(ws + O_WT_OUT3), j - T7, smf);
    }
  }
  const int gt = blockIdx.x * 256 + threadIdx.x, gn = gridDim.x * 256;
  {
    bf16_t* WG = (bf16_t*)(ws + O_WG);
    for (int idx = gt; idx < 16 * 2 * 192 * 96; idx += gn) {
      const int kk = idx % 96; int t = idx / 96; const int n = t % 192; t /= 192; const int d = t & 1, k = t >> 1;
      const int c = n >> 5, gate = (n >> 4) & 1, ch = c * 16 + (n & 15);
      float v = 0.f;
      if (ch < 88 && kk < 88) { const float* w = gate ? p.in[12] : p.in[10]; v = w[((size_t)(d * 16 + k) * 88 + kk) * 88 + ch]; }
      WG[idx] = f2bf(v);
    }
  }
  {
    float* RCt = (float*)(ws + O_ROPEC); float* RSt = (float*)(ws + O_ROPES);
    for (int idx = gt; idx < 2048 * 32; idx += gn) {
      const int t = idx >> 5, j = idx & 31;
      const float pos = (float)(j < 16 ? (t >> 6) : (t & 63));
      const float freq = exp2f(-(float)(j & 15) * (13.287712379549449f / 16.f));
      float s, c; sincos_rev(pos * freq * 0.15915494309189535f, s, c);
      RCt[idx] = c; RSt[idx] = s;
    }
  }
  {
    float2* POW = (float2*)(ws + O_POW); float2* BB = (float2*)(ws + O_BBAR);
    for (int idx = gt; idx < 2 * 64 * 17 * 64; idx += gn) {
      const int pp = idx & 63; int t = idx >> 6; const int n = t % 17; t /= 17;
      const float are = p.in[32][t * 64 + pp], aim = p.in[33][t * 64 + pp], dt = expf(p.in[34][t]);
      const float mag = expf((float)n * are * dt);
      const double rev = (double)n * (double)aim * (double)dt * 0.15915494309189535;
      float s, c; sincos_rev((float)(rev - rint(rev)), s, c);
      POW[idx] = make_float2(mag * c, mag * s);
    }
    for (int idx = gt; idx < 2 * 64 * 64 * 16; idx += gn) {
      const int t = idx >> 4;
      const int dg = t >> 6;
      const float are = p.in[32][t], aim = p.in[33][t], dt = expf(p.in[34][dg]);
      const float mag = expf(are * dt);
      const double rev = (double)aim * (double)dt * 0.15915494309189535;
      float s, c; sincos_rev((float)(rev - rint(rev)), s, c);
      const float nr = mag * c - 1.f, ni = mag * s;
      const float den = 1.f / (are * are + aim * aim);
      const float cr = (nr * are + ni * aim) * den, ci = (ni * are - nr * aim) * den;
      const float br = p.in[35][idx], bi = p.in[36][idx];
      BB[idx] = make_float2(cr * br - ci * bi, cr * bi + ci * br);
    }
  }
}

DI void norm_phase(const float* lat, const float* ctx, const float* gn, const float* mod  , bf16_t* NB_) {
  const int lane = threadIdx.x & 63;
  const int w0 = blockIdx.x * 4 + (threadIdx.x >> 6), nw = gridDim.x * 4;
  for (int row = w0; row < R; row += nw) {
    const float* src; const float* m;
    if (row < RL) { src = lat + (size_t)row * 1024; m = mod + (size_t)(row >> 11) * 3072; }
    else { src = ctx + (size_t)(row - RL) * 1024; m = mod + (size_t)8 * 3072; }
    f32x4 v[4]; float ss = 0.f;
    _Pragma("unroll") for (int i = 0; i < 4; ++i) { v[i] = *(const f32x4*)(src + (i * 64 + lane) * 4); ss += v[i][0] * v[i][0] + v[i][1] * v[i][1] + v[i][2] * v[i][2] + v[i][3] * v[i][3]; }
    _Pragma("unroll") for (int o = 32; o >= 1; o >>= 1) ss += __shfl_xor(ss, o);
    const float rstd = rsqrtf(ss * (1.f / 1024.f) + 1e-6f);
    _Pragma("unroll") for (int i = 0; i < 4; ++i) {
      const int k = (i * 64 + lane) * 4;
      const f32x4 g = *(const f32x4*)(gn + k), sh = *(const f32x4*)(m + k), sc = *(const f32x4*)(m + 1024 + k);
      u32x2 o;
      o[0] = pack2(v[i][0] * rstd * g[0] * (1.f + sc[0]) + sh[0], v[i][1] * rstd * g[1] * (1.f + sc[1]) + sh[1]);
      o[1] = pack2(v[i][2] * rstd * g[2] * (1.f + sc[2]) + sh[2], v[i][3] * rstd * g[3] * (1.f + sc[3]) + sh[3]);
      *(u32x2*)(NB_ + (size_t)row * 1024 + k) = o;
    }
  }
}

DI void final_norm_phase(float* H, const float* gn) {
  const int lane = threadIdx.x & 63;
  const int w0 = blockIdx.x * 4 + (threadIdx.x >> 6), nw = gridDim.x * 4;
  for (int row = w0; row < RL; row += nw) {
    float* src = H + (size_t)row * 1024;
    f32x4 v[4]; float ss = 0.f;
    _Pragma("unroll") for (int i = 0; i < 4; ++i) { v[i] = *(const f32x4*)(src + (i * 64 + lane) * 4); ss += v[i][0] * v[i][0] + v[i][1] * v[i][1] + v[i][2] * v[i][2] + v[i][3] * v[i][3]; }
    _Pragma("unroll") for (int o = 32; o >= 1; o >>= 1) ss += __shfl_xor(ss, o);
    const float rstd = rsqrtf(ss * (1.f / 1024.f) + 1e-6f);
    _Pragma("unroll") for (int i = 0; i < 4; ++i) {
      const int k = (i * 64 + lane) * 4;
      const f32x4 g = *(const f32x4*)(gn + k);
      f32x4 o; o[0] = v[i][0] * rstd * g[0]; o[1] = v[i][1] * rstd * g[1]; o[2] = v[i][2] * rstd * g[2]; o[3] = v[i][3] * rstd * g[3];
      *(f32x4*)(src + k) = o;
    }
  }
}

DI void lru_phase(const Params& p, char* smem) {
  char* ws = p.ws;
  bf16_t* Wl = (bf16_t*)smem;
  bf16_t* Uc = Wl + 192 * 96;
  float* aggA = (float*)(Uc + 64 * 96);
  float* aggH = aggA + 16 * 96;
  const bf16_t* U0 = (const bf16_t*)(ws + O_U0);
  const bf16_t* G0 = (const bf16_t*)(ws + O_G0);
  const int tid = threadIdx.x, lane = tid & 63, w = tid >> 6, col = lane & 15, quad = lane >> 4;
  for (int item = blockIdx.x; item < 256; item += gridDim.x) {
    const int dir = item & 1, k = (item >> 1) & 15, b = item >> 5;
    bf16_t* ACT = (bf16_t*)(ws + O_ACT0) + (size_t)dir * R * LW;
    __syncthreads();
    {
      const u32x4* src = (const u32x4*)((const bf16_t*)(ws + O_WG) + (size_t)(k * 2 + dir) * 192 * 96);
      u32x4* dst = (u32x4*)Wl;
      for (int i = tid; i < 192 * 96 / 8; i += 256) dst[i] = src[i];
      if (tid < 64) { u32x4 z; z[0] = z[1] = z[2] = z[3] = 0u; *(u32x4*)(Uc + tid * 96 + 88) = z; }
    }
    float ba[6], bx[6], sp8[6];
    _Pragma("unroll") for (int c = 0; c < 6; ++c) {
      const int ch = 16 * c + col;
      if (ch < 88) {
        ba[c] = p.in[11][dir * LW + k * 88 + ch]; bx[c] = p.in[13][dir * LW + k * 88 + ch];
        sp8[c] = 8.f * log1pf(expf(-p.in[14][dir * LW + k * 88 + ch]));
      } else { ba[c] = 0.f; bx[c] = 0.f; sp8[c] = 0.f; }
    }
    const int cp = tid % 44, run = tid / 44;
    float cw[4][2], cb2[2];
    _Pragma("unroll") for (int t = 0; t < 4; ++t) { cw[t][0] = p.in[8][t * LW + k * 88 + 2 * cp]; cw[t][1] = p.in[8][t * LW + k * 88 + 2 * cp + 1]; }
    cb2[0] = p.in[9][k * 88 + 2 * cp]; cb2[1] = p.in[9][k * 88 + 2 * cp + 1];
    float carry = 0.f;
    unsigned un[19];
    auto tile_info = [&](int ti, int& rowbase, int& L, int& t0) {
      if (ti < 4) { rowbase = RL + b * 256; L = 256; t0 = (dir ? 3 - ti : ti) * 64; }
      else { rowbase = b * 2048; L = 2048; t0 = (dir ? 31 - (ti - 4) : (ti - 4)) * 64; }
    };
    auto prefetch = [&](int ti) {
      int rowbase, L, t0; tile_info(ti, rowbase, L, t0);
      _Pragma("unroll") for (int i = 0; i < 19; ++i) {
        const int tt = t0 + 16 * run - 2 + i;
        unsigned v = 0u;
        if (tid < 176 && tt >= 0 && tt < L) v = *(const unsigned*)(U0 + (size_t)(rowbase + tt) * LW + k * 88 + 2 * cp);
        un[i] = v;
      }
    };
    prefetch(0);
    for (int ti = 0; ti < 36; ++ti) {
      int rowbase, L, t0; tile_info(ti, rowbase, L, t0);
      if (tid < 176) {
        _Pragma("unroll") for (int t = 0; t < 16; ++t) {
          const float y0 = cb2[0] + cw[0][0] * bflo(un[t]) + cw[1][0] * bflo(un[t + 1]) + cw[2][0] * bflo(un[t + 2]) + cw[3][0] * bflo(un[t + 3]);
          const float y1 = cb2[1] + cw[0][1] * bfhi(un[t]) + cw[1][1] * bfhi(un[t + 1]) + cw[2][1] * bfhi(un[t + 2]) + cw[3][1] * bfhi(un[t + 3]);
          *(unsigned*)(Uc + (16 * run + t) * 96 + 2 * cp) = pack2(y0, y1);
        }
      }
      if (ti + 1 < 36) prefetch(ti + 1);
      __syncthreads();
      bf16x8 af[3];
      _Pragma("unroll") for (int ks = 0; ks < 3; ++ks) af[ks] = *(const bf16x8*)(Uc + (16 * w + col) * 96 + ks * 32 + quad * 8);
      float hl[6][4], ac[6][4];
      _Pragma("unroll") for (int c = 0; c < 6; ++c) {
        f32x4 gA = {0.f, 0.f, 0.f, 0.f}, gX = {0.f, 0.f, 0.f, 0.f};
        _Pragma("unroll") for (int ks = 0; ks < 3; ++ks) {
          const bf16x8 bA = *(const bf16x8*)(Wl + ((c * 2 + 0) * 16 + col) * 96 + ks * 32 + quad * 8);
          const bf16x8 bX = *(const bf16x8*)(Wl + ((c * 2 + 1) * 16 + col) * 96 + ks * 32 + quad * 8);
          gA = MFMA16(af[ks], bA, gA);
          gX = MFMA16(af[ks], bX, gX);
        }
        float a[4], bb[4];
        _Pragma("unroll") for (int j = 0; j < 4; ++j) {
          const float uval = bf2f(Uc[(16 * w + 4 * quad + j) * 96 + 16 * c + col]);
          const float rg = sigm(gA[j] + ba[c]), ig = sigm(gX[j] + bx[c]);
          a[j] = __expf(-sp8[c] * rg);
          bb[j] = sqrtf(fmaxf(1.f - a[j] * a[j], 0.f)) * ig * uval;
        }
        if (dir == 0) {
          hl[c][0] = bb[0]; ac[c][0] = a[0];
          _Pragma("unroll") for (int j = 1; j < 4; ++j) { hl[c][j] = a[j] * hl[c][j - 1] + bb[j]; ac[c][j] = a[j] * ac[c][j - 1]; }
          aggA[(4 * w + quad) * 96 + 16 * c + col] = ac[c][3]; aggH[(4 * w + quad) * 96 + 16 * c + col] = hl[c][3];
        } else {
          hl[c][3] = bb[3]; ac[c][3] = a[3];
          _Pragma("unroll") for (int j = 2; j >= 0; --j) { hl[c][j] = a[j] * hl[c][j + 1] + bb[j]; ac[c][j] = a[j] * ac[c][j + 1]; }
          aggA[(4 * w + quad) * 96 + 16 * c + col] = ac[c][0]; aggH[(4 * w + quad) * 96 + 16 * c + col] = hl[c][0];
        }
      }
      __syncthreads();
      if (tid < 88) {
        float cin = carry;
        if (dir == 0) { for (int s = 0; s < 16; ++s) { const float A_ = aggA[s * 96 + tid], H_ = aggH[s * 96 + tid]; aggA[s * 96 + tid] = cin; cin = A_ * cin + H_; } }
        else { for (int s = 15; s >= 0; --s) { const float A_ = aggA[s * 96 + tid], H_ = aggH[s * 96 + tid]; aggA[s * 96 + tid] = cin; cin = A_ * cin + H_; } }
        carry = cin;
      }
      __syncthreads();
      _Pragma("unroll") for (int c = 0; c < 6; ++c) {
        const int ch = 16 * c + col;
        if (ch < 88) {
          const float cin = aggA[(4 * w + quad) * 96 + ch];
          _Pragma("unroll") for (int j = 0; j < 4; ++j) {
            const size_t idx = (size_t)(rowbase + t0 + 16 * w + 4 * quad + j) * LW + k * 88 + ch;
            const float hv = hl[c][j] + ac[c][j] * cin;
            ACT[idx] = f2bf(hv * silu(bf2f(G0[idx])));
          }
        }
      }
    }
  }
}

struct AttnSt { f32x16 O0, O1; float m, l; };
DI bf16x8 ld16(const bf16_t* p) { return *(const bf16x8*)p; }
DI bf16x8 ld8x2(const bf16_t* p0) { const s16x4 a = *(const s16x4*)p0; const s16x4 b = *(const s16x4*)(p0 + 8); return __builtin_shufflevector(a, b, 0, 1, 2, 3, 4, 5, 6, 7); }
DI bf16x8 pack8(const f32x16& P, int s) {
  u32x4 u;
  _Pragma("unroll") for (int j = 0; j < 4; ++j) u[j] = pack2(P[8 * s + 2 * j], P[8 * s + 2 * j + 1]);
  return __builtin_bit_cast(bf16x8, u);
}

template <class F>
DI void attn_tile(AttnSt& st, const bf16x8 (&qf)[4], const bf16_t* kp, const bf16_t* vp, int ldv, F fmod) {
  const bf16x8 k0 = ld16(kp), k1 = ld16(kp + 16), k2 = ld16(kp + 32), k3 = ld16(kp + 48);
  const bf16x8 v00 = ld8x2(vp), v01 = ld8x2(vp + 16);
  const bf16_t* vp1 = vp + (size_t)32 * ldv;
  const bf16x8 v10 = ld8x2(vp1), v11 = ld8x2(vp1 + 16);
  f32x16 S = zero16();
  S = MFMA32(k0, qf[0], S); S = MFMA32(k1, qf[1], S); S = MFMA32(k2, qf[2], S); S = MFMA32(k3, qf[3], S);
  float mx = -3.0e38f;
  _Pragma("unroll") for (int i = 0; i < 16; ++i) { S[i] = fmod(i, S[i]); mx = fmaxf(mx, S[i]); }
  mx = fmaxf(mx, __shfl_xor(mx, 32));
  const float mn = fmaxf(st.m, mx);
  const float alpha = __expf(st.m - mn);
  st.m = mn;
  float ls = 0.f;
  f32x16 P;
  _Pragma("unroll") for (int i = 0; i < 16; ++i) { P[i] = __expf(S[i] - mn); ls += P[i]; }
  st.l = st.l * alpha + ls;
  _Pragma("unroll") for (int i = 0; i < 16; ++i) { st.O0[i] *= alpha; st.O1[i] *= alpha; }
  const bf16x8 p0 = pack8(P, 0), p1 = pack8(P, 1);
  st.O0 = MFMA32(v00, p0, st.O0); st.O0 = MFMA32(v01, p1, st.O0);
  st.O1 = MFMA32(v10, p0, st.O1); st.O1 = MFMA32(v11, p1, st.O1);
}

DI void attn_finish(AttnSt& st, const bf16_t* Grow  , bf16_t* Arow  , int h) {
  const float lt = st.l + __shfl_xor(st.l, 32);
  const float inv = 1.f / lt;
  _Pragma("unroll") for (int q = 0; q < 4; ++q) {
    const int d0 = 8 * q + 4 * h;
    {
      const u32x2 g = *(const u32x2*)(Grow + d0);
      u32x2 o;
      o[0] = pack2(st.O0[4 * q + 0] * inv * silu(bflo(g[0])), st.O0[4 * q + 1] * inv * silu(bfhi(g[0])));
      o[1] = pack2(st.O0[4 * q + 2] * inv * silu(bflo(g[1])), st.O0[4 * q + 3] * inv * silu(bfhi(g[1])));
      *(u32x2*)(Arow + d0) = o;
    }
    {
      const u32x2 g = *(const u32x2*)(Grow + 32 + d0);
      u32x2 o;
      o[0] = pack2(st.O1[4 * q + 0] * inv * silu(bflo(g[0])), st.O1[4 * q + 1] * inv * silu(bfhi(g[0])));
      o[1] = pack2(st.O1[4 * q + 2] * inv * silu(bflo(g[1])), st.O1[4 * q + 3] * inv * silu(bfhi(g[1])));
      *(u32x2*)(Arow + 32 + d0) = o;
    }
  }
}

DI void swa_phase(const Params& p) {
  char* ws = p.ws;
  const bf16_t* Q = (const bf16_t*)(ws + O_Q1); const bf16_t* QR = (const bf16_t*)(ws + O_QR1); const bf16_t* Kb = (const bf16_t*)(ws + O_K1);
  const bf16_t* VtL = (const bf16_t*)(ws + O_VTL1); const bf16_t* VtC = (const bf16_t*)(ws + O_VTC1);
  const bf16_t* G = (const bf16_t*)(ws + O_G1); bf16_t* ACT = (bf16_t*)(ws + O_ACT1);
  const float* sink = p.in[20];
  const int lane = threadIdx.x & 63, r = lane & 31, h = lane >> 5;
  const int wid = blockIdx.x * 4 + (threadIdx.x >> 6), nw = gridDim.x * 4;
  auto ident = [](int, float s) { return s; };
  for (int it = wid; it < 8192 + 1024; it += nw) {
    int b, kvh, g4, qt; bool lat = it < 8192;
    if (lat) { g4 = it & 3; qt = (it >> 2) & 63; kvh = (it >> 8) & 3; b = it >> 10; }
    else { const int j = it - 8192; g4 = j & 3; qt = (j >> 2) & 7; kvh = (j >> 5) & 3; b = j >> 7; }
    const int head = kvh * 4 + g4;
    const size_t qrow = lat ? (size_t)b * 2048 + qt * 32 + r : (size_t)RL + b * 256 + qt * 32 + r;
    AttnSt st; st.O0 = zero16(); st.O1 = zero16(); st.m = sink[head]; st.l = h == 0 ? 1.f : 0.f;
    bf16x8 qf[4];
    _Pragma("unroll") for (int ks = 0; ks < 4; ++ks) qf[ks] = ld16(Q + qrow * 1024 + head * 64 + ks * 16 + 8 * h);
    const bf16_t* kc = Kb + ((size_t)RL + b * 256 + r) * 256 + kvh * 64 + 8 * h;
    const bf16_t* vc = VtC + ((size_t)(b * 4 + kvh) * 64 + r) * 256 + 4 * h;
    for (int kt = 0; kt < 8; ++kt) attn_tile(st, qf, kc + (size_t)kt * 32 * 256, vc + kt * 32, 256, ident);
    if (lat) {
      _Pragma("unroll") for (int ks = 0; ks < 4; ++ks) qf[ks] = ld16(QR + qrow * 1024 + head * 64 + ks * 16 + 8 * h);
      const bf16_t* kl = Kb + ((size_t)b * 2048 + r) * 256 + kvh * 64 + 8 * h;
      const bf16_t* vl = VtL + ((size_t)(b * 4 + kvh) * 64 + r) * 2048 + 4 * h;
      for (int dk = -4; dk <= 4; ++dk) {
        const int kt = qt + dk;
        if (kt < 0 || kt >= 64) continue;
        const int dq = qt * 32 + r - kt * 32;
        attn_tile(st, qf, kl + (size_t)kt * 32 * 256, vl + kt * 32, 2048, [&](int i, float s) { const int d = dq - crow(i, h); return (d <= 128 && d >= -128) ? s : -1.0e30f; });
      }
    }
    attn_finish(st, G + qrow * 1024 + head * 64, ACT + qrow * 1024 + head * 64, h);
  }
}

DI void na_phase(const Params& p) {
  char* ws = p.ws;
  const bf16_t* Q = (const bf16_t*)(ws + O_Q2); const bf16_t* Kb = (const bf16_t*)(ws + O_K2);
  const bf16_t* VtL = (const bf16_t*)(ws + O_VTL2); const bf16_t* VtC = (const bf16_t*)(ws + O_VTC2);
  const bf16_t* G = (const bf16_t*)(ws + O_G2); bf16_t* ACT = (bf16_t*)(ws + O_ACT2);
  const float* rpb = p.in[26];
  const int lane = threadIdx.x & 63, r = lane & 31, h = lane >> 5;
  const int wid = blockIdx.x * 4 + (threadIdx.x >> 6), nw = gridDim.x * 4;
  auto ident = [](int, float s) { return s; };
  for (int it = wid; it < 8192 + 1024; it += nw) {
    int b, head, half, gr; bool lat = it < 8192;
    if (lat) { half = it & 1; head = (it >> 1) & 15; gr = (it >> 5) & 31; b = it >> 10; }
    else { const int j = it - 8192; half = 0; head = j & 15; gr = (j >> 4) & 7; b = j >> 7; }
    const size_t qrow = lat ? (size_t)b * 2048 + gr * 64 + half * 32 + r : (size_t)RL + b * 256 + gr * 32 + r;
    AttnSt st; st.O0 = zero16(); st.O1 = zero16(); st.m = -1.0e30f; st.l = 0.f;
    bf16x8 qf[4];
    _Pragma("unroll") for (int ks = 0; ks < 4; ++ks) qf[ks] = ld16(Q + qrow * 1024 + head * 64 + ks * 16 + 8 * h);
    const bf16_t* kc = Kb + ((size_t)RL + b * 256 + r) * 1024 + head * 64 + 8 * h;
    const bf16_t* vc = VtC + ((size_t)(b * 16 + head) * 64 + r) * 256 + 4 * h;
    for (int kt = 0; kt < 8; ++kt) attn_tile(st, qf, kc + (size_t)kt * 32 * 1024, vc + kt * 32, 256, ident);
    if (lat) {
      const int cq = half * 32 + r;
      const int cs = min(max(cq - 8, 0), 48);
      const int rs_ = min(max(gr - 4, 0), 24);
      const bf16_t* kl = Kb + ((size_t)b * 2048 + r) * 1024 + head * 64 + 8 * h;
      const bf16_t* vl = VtL + ((size_t)(b * 16 + head) * 64 + r) * 2048 + 4 * h;
      for (int i8 = 0; i8 < 8; ++i8) {
        const int krow = rs_ + i8;
        const float* rp = rpb + (size_t)(head * 15 + (krow - gr + 7)) * 31;
        for (int ct = 0; ct < 2; ++ct) {
          const int key0 = krow * 64 + ct * 32;
          attn_tile(st, qf, kl + (size_t)key0 * 1024, vl + key0, 2048, [&](int i, float s) {
            const int ck = ct * 32 + crow(i, h);
            const bool ok = (ck >= cs) && (ck < cs + 16);
            const int dx = min(max(ck - cq + 15, 0), 30);
            return ok ? s + rp[dx] : -1.0e30f;
          });
        }
      }
    }
    attn_finish(st, G + qrow * 1024 + head * 64, ACT + qrow * 1024 + head * 64, h);
  }
}

DI void s5_mats_phase(const Params& p) {
  char* ws = p.ws;
  const float2* POW = (const float2*)(ws + O_POW); const float2* BB = (const float2*)(ws + O_BBAR);
  bf16_t* GT = (bf16_t*)(ws + O_GT); bf16_t* MYT = (bf16_t*)(ws + O_MYT);
  const float* cre = p.in[37]; const float* cim = p.in[38]; const float* dsk = p.in[39];
  const int gt = blockIdx.x * 256 + threadIdx.x, gn = gridDim.x * 256;
  for (int idx = gt; idx < 64 * 256 * 256; idx += gn) {
    const int g = idx >> 16, n = (idx >> 8) & 255, k = idx & 255;
    {
      const int dir = n >> 7, pp = (n >> 1) & 63, ri = n & 1, i = k >> 4, c = k & 15;
      const int e = dir ? i : 15 - i;
      const float2 pw = POW[((size_t)(dir * 64 + g) * 17 + e) * 64 + pp];
      const float2 bb = BB[((size_t)(dir * 64 + g) * 64 + pp) * 16 + c];
      const float zr = pw.x * bb.x - pw.y * bb.y, zi = pw.x * bb.y + pw.y * bb.x;
      GT[idx] = f2bf(ri ? zi : zr);
    }
    {
      const int j = n >> 4, o = n & 15, dir = k >> 7, pp = (k >> 1) & 63, ri = k & 1;
      const int e = dir ? 16 - j : j + 1;
      const float2 pw = POW[((size_t)(dir * 64 + g) * 17 + e) * 64 + pp];
      const size_t ci = ((size_t)(dir * 64 + g) * 16 + o) * 64 + pp;
      const float cr = cre[ci], cm = cim[ci];
      const float zr = cr * pw.x - cm * pw.y, zi = cr * pw.y + cm * pw.x;
      MYT[((size_t)g * 256 + n) * 512 + 256 + k] = f2bf(ri ? -zi : zr);
    }
  }
  for (int idx = gt; idx < 64 * 16 * 256; idx += gn) {
    const int g = idx >> 12, lag = (idx >> 8) & 15, o = (idx >> 4) & 15, c = idx & 15;
    float kf = 0.f, kb = 0.f;
    for (int pp = 0; pp < 64; ++pp) {
      {
        const float2 pw = POW[((size_t)(0 * 64 + g) * 17 + lag) * 64 + pp];
        const float2 bb = BB[((size_t)(0 * 64 + g) * 64 + pp) * 16 + c];
        const size_t ci = ((size_t)(0 * 64 + g) * 16 + o) * 64 + pp;
        const float zr = pw.x * bb.x - pw.y * bb.y, zi = pw.x * bb.y + pw.y * bb.x;
        kf += cre[ci] * zr - cim[ci] * zi;
      }
      {
        const float2 pw = POW[((size_t)(1 * 64 + g) * 17 + lag) * 64 + pp];
        const float2 bb = BB[((size_t)(1 * 64 + g) * 64 + pp) * 16 + c];
        const size_t ci = ((size_t)(1 * 64 + g) * 16 + o) * 64 + pp;
        const float zr = pw.x * bb.x - pw.y * bb.y, zi = pw.x * bb.y + pw.y * bb.x;
        kb += cre[ci] * zr - cim[ci] * zi;
      }
    }
    bf16_t* Mg = MYT + (size_t)g * 256 * 512;
    if (lag == 0) {
      const bf16_t v = f2bf(kf + kb + (o == c ? dsk[g * 16 + o] : 0.f));
      for (int j = 0; j < 16; ++j) Mg[(size_t)(j * 16 + o) * 512 + j * 16 + c] = v;
    } else {
      const bf16_t vf = f2bf(kf), vb = f2bf(kb);
      for (int i = 0; i + lag < 16; ++i) {
        Mg[(size_t)((i + lag) * 16 + o) * 512 + i * 16 + c] = vf;
        Mg[(size_t)(i * 16 + o) * 512 + (i + lag) * 16 + c] = vb;
      }
    }
  }
}

DI void s5_scan_phase(const Params& p) {
  char* ws = p.ws;
  const float2* POW = (const float2*)(ws + O_POW);
  const float* SL = (const float*)(ws + O_SLOC);
  bf16_t* ACAT = (bf16_t*)(ws + O_ACAT);
  for (int gid = blockIdx.x * 256 + threadIdx.x; gid < 65536; gid += gridDim.x * 256) {
    const int pp = gid & 63, g = (gid >> 6) & 63, dir = (gid >> 12) & 1, b = gid >> 13;
    const float2 lam = POW[((size_t)(dir * 64 + g) * 17 + 16) * 64 + pp];
    float hr = 0.f, hi = 0.f;
    for (int q0 = 0; q0 < 144; q0 += 16) {
      float2 s[16];
      _Pragma("unroll") for (int j = 0; j < 16; ++j) {
        const int q = q0 + j;
        const int chunk = q < 16 ? (1024 + b * 16 + (dir ? 15 - q : q)) : (b * 128 + (dir ? 127 - (q - 16) : (q - 16)));
        s[j] = *(const float2*)(SL + ((size_t)g * NCH + chunk) * 256 + dir * 128 + 2 * pp);
      }
      _Pragma("unroll") for (int j = 0; j < 16; ++j) {
        const int q = q0 + j;
        const int chunk = q < 16 ? (1024 + b * 16 + (dir ? 15 - q : q)) : (b * 128 + (dir ? 127 - (q - 16) : (q - 16)));
        *(unsigned*)(ACAT + ((size_t)g * NCH + chunk) * 512 + 256 + dir * 128 + 2 * pp) = pack2(hr, hi);
        const float nr = lam.x * hr - lam.y * hi + s[j].x, ni = lam.x * hi + lam.y * hr + s[j].y;
        hr = nr; hi = ni;
      }
    }
  }
}


#define XB_TMO      128
#define XB_XCNT(j)  (256  + 64 * (j))
#define XB_XSUB(j)  (1280 + 64 * (j))
#define XB_XGEN(j)  (2304 + 64 * (j))
#define XB_TOP      3328
#define XB_TOPGEN   3392
#define XCD_BAR_WORDS 3456
#define XB_SPIN_CAP (1u << 18)
#define LAS __attribute__((address_space(3)))
DI unsigned xb_ld(unsigned* p)              { return __hip_atomic_load(p, __ATOMIC_RELAXED, __HIP_MEMORY_SCOPE_AGENT); }
DI unsigned xb_add(unsigned* p, unsigned v) { return __hip_atomic_fetch_add(p, v, __ATOMIC_RELAXED, __HIP_MEMORY_SCOPE_AGENT); }
DI unsigned xb_xcc_id() { return (unsigned)__builtin_amdgcn_s_getreg((3 << 11) | 20) & 0xFu; }
#define XB_SPIN(cond, bar) do { unsigned _sp = 0; while (cond) { __builtin_amdgcn_s_sleep(1); \
    if ((++_sp & 255u) == 0u) { if (xb_ld(&(bar)[XB_TMO])) break; if (_sp > XB_SPIN_CAP) { atomicAdd(&(bar)[XB_TMO], 1u); break; } } } } while (0)
struct XcdBarrier { unsigned* bar; unsigned x; unsigned nloc, nx; };
DI XcdBarrier xcd_barrier_post(unsigned* bar) {
    XcdBarrier b; b.bar = bar; b.x = xb_xcc_id(); b.nloc = 0u; b.nx = 0u;
    if (threadIdx.x == 0) (void)xb_add(&bar[XB_XCNT(b.x)], 1u);
    return b;
}
DI void xcd_barrier_complete(unsigned* bar, unsigned x, unsigned& nloc, unsigned& nx) {
    const unsigned G = gridDim.x * gridDim.y * gridDim.z;
    unsigned sum, cnt, mine, sp = 0u;
    for (;;) {
        sum = 0u; cnt = 0u; mine = 0u;
#pragma unroll
        for (unsigned j = 0; j < 16; ++j) { const unsigned c = xb_ld(&bar[XB_XCNT(j)]); sum += c; cnt += (c > 0u) ? 1u : 0u; mine = (j == x) ? c : mine; }
        if (sum == G) break;
        __builtin_amdgcn_s_sleep(1);
        if ((++sp & 255u) == 0u) { if (xb_ld(&bar[XB_TMO])) break; if (sp > XB_SPIN_CAP) { atomicAdd(&bar[XB_TMO], 1u); break; } }
    }
    nloc = mine > 0u ? mine : 1u; nx = cnt > 0u ? cnt : 1u;
}
DI void xcd_barrier(XcdBarrier& b) {
    asm volatile("s_waitcnt vmcnt(0)" ::: "memory");
    __syncthreads();
    if (threadIdx.x == 0) {
        unsigned* bar = b.bar;
        __builtin_amdgcn_s_waitcnt(0);
        unsigned nloc = b.nloc, nx = b.nx;
        if (nloc == 0u) { xcd_barrier_complete(bar, b.x, nloc, nx); b.nloc = nloc; b.nx = nx; }
        const unsigned old = xb_add(&bar[XB_XSUB(b.x)], 1u);
        const unsigned gen = old / nloc;
        if (old + 1u == (gen + 1u) * nloc) {
            __builtin_amdgcn_fence(__ATOMIC_RELEASE, "agent");
            asm volatile("s_waitcnt vmcnt(0)" ::: "memory");
            const unsigned og = xb_add(&bar[XB_TOP], 1u);
            const unsigned tg = og / nx;
            if (og + 1u == (tg + 1u) * nx) xb_add(&bar[XB_TOPGEN], 1u);
            else XB_SPIN(xb_ld(&bar[XB_TOPGEN]) == tg, bar);
            __builtin_amdgcn_fence(__ATOMIC_ACQUIRE, "agent");
            xb_add(&bar[XB_XGEN(b.x)], 1u);
            asm volatile("s_waitcnt vmcnt(0)" ::: "memory");
        } else {
            XB_SPIN(xb_ld(&bar[XB_XGEN(b.x)]) == gen, bar);
            __builtin_amdgcn_fence(__ATOMIC_ACQUIRE, "agent");
            asm volatile("s_waitcnt vmcnt(0)" ::: "memory");
        }
    }
    __syncthreads();
}

#define REP_P0 1
#define REP_NORM 1
#define REP_GIN 1
#define REP_LRU 1
#define REP_SWA 1
#define REP_NA 1
#define REP_S5 1
#define REP_SYNC 0
__global__ void __launch_bounds__(256, 2) fwd_megakernel(Params p) {
  __shared__ __attribute__((aligned(16))) char smem[65536];
  cg::grid_group grid = cg::this_grid();
  char* ws = p.ws;
  XcdBarrier xb = xcd_barrier_post((unsigned*)(ws + O_BAR));
#define GSYNC() xcd_barrier(xb)
  float* MOD = (float*)(ws + O_MOD);
  float* HCTX = (float*)(ws + O_HCTX);
  const bf16_t* NBUF = (const bf16_t*)(ws + O_NBUF);

  for (int rep = 0; rep < REP_P0; ++rep) { phase0(p, smem); grid.sync(); }
  for (int rep = 0; rep < REP_SYNC; ++rep) GSYNC();
  for (int rep = 0; rep < REP_NORM; ++rep) { norm_phase(p.in[0], p.in[2], p.in[6], MOD, (bf16_t*)(ws + O_NBUF0)); GSYNC(); }
  for (int rep = 0; rep < REP_GIN; ++rep) {
    EpiL0In e{(bf16_t*)(ws + O_U0), (bf16_t*)(ws + O_G0)};
    gemm_phase<false>((const bf16_t*)(ws + O_NBUF0), nullptr, 1024, 0, (const bf16_t*)(ws + O_WT_IN0), 1024, 0, R, 2816, 1024, 1, e, smem);
    GSYNC();
  }
  for (int rep = 0; rep < REP_LRU; ++rep) { lru_phase(p, smem); GSYNC(); }
  {
    EpiOut e{p.in[0], p.in[2], p.out, HCTX, MOD + 2048};
    gemm_phase<true>((const bf16_t*)(ws + O_ACT0), (const bf16_t*)(ws + O_ACT0) + (size_t)R * LW, LW, 0, (const bf16_t*)(ws + O_WT_OUT0), LW, 0, R, 1024, LW, 1, e, smem);
  }
  GSYNC();
  for (int rep = 0; rep < REP_NORM; ++rep) { norm_phase(p.out, HCTX, p.in[18], MOD + 9 * 3072, (bf16_t*)(ws + O_NBUF)); GSYNC(); }
  for (int rep = 0; rep < REP_GIN; ++rep) {
    EpiL1In e{(bf16_t*)(ws + O_Q1), (bf16_t*)(ws + O_QR1), (bf16_t*)(ws + O_K1), (bf16_t*)(ws + O_VTL1), (bf16_t*)(ws + O_VTC1), (bf16_t*)(ws + O_G1),
              (const float*)(ws + O_ROPEC), (const float*)(ws + O_ROPES)};
    gemm_phase<false>(NBUF, nullptr, 1024, 0, (const bf16_t*)(ws + O_WT_IN1), 1024, 0, R, 2560, 1024, 1, e, smem);
    GSYNC();
  }
  for (int rep = 0; rep < REP_SWA; ++rep) { swa_phase(p); GSYNC(); }
  {
    EpiOut e{p.out, HCTX, p.out, HCTX, MOD + 9 * 3072 + 2048};
    gemm_phase<false>((const bf16_t*)(ws + O_ACT1), nullptr, 1024, 0, (const bf16_t*)(ws + O_WT_OUT1), 1024, 0, R, 1024, 1024, 1, e, smem);
  }
  GSYNC();
  for (int rep = 0; rep < REP_NORM; ++rep) { norm_phase(p.out, HCTX, p.in[24], MOD + 2 * 9 * 3072, (bf16_t*)(ws + O_NBUF)); GSYNC(); }
  for (int rep = 0; rep < REP_GIN; ++rep) {
    EpiL2In e{(bf16_t*)(ws + O_Q2), (bf16_t*)(ws + O_K2), (bf16_t*)(ws + O_VTL2), (bf16_t*)(ws + O_VTC2), (bf16_t*)(ws + O_G2)};
    gemm_phase<false>(NBUF, nullptr, 1024, 0, (const bf16_t*)(ws + O_WT_IN2), 1024, 0, R, 4096, 1024, 1, e, smem);
    GSYNC();
  }
  for (int rep = 0; rep < REP_NA; ++rep) { na_phase(p); GSYNC(); }
  {
    EpiOut e{p.out, HCTX, p.out, HCTX, MOD + 2 * 9 * 3072 + 2048};
    gemm_phase<false>((const bf16_t*)(ws + O_ACT2), nullptr, 1024, 0, (const bf16_t*)(ws + O_WT_OUT2), 1024, 0, R, 1024, 1024, 1, e, smem);
  }
  GSYNC();
  for (int rep = 0; rep < REP_NORM; ++rep) { norm_phase(p.out, HCTX, p.in[30], MOD + 3 * 9 * 3072, (bf16_t*)(ws + O_NBUF)); GSYNC(); }
  for (int rep = 0; rep < REP_S5; ++rep) { s5_mats_phase(p); GSYNC(); }
  for (int rep = 0; rep < REP_GIN; ++rep) {
    EpiL3In e{(bf16_t*)(ws + O_ACAT), (bf16_t*)(ws + O_G3)};
    gemm_phase<false>(NBUF, nullptr, 1024, 0, (const bf16_t*)(ws + O_WT_IN3), 1024, 0, R, 2048, 1024, 1, e, smem);
    GSYNC();
  }
  for (int rep = 0; rep < REP_S5; ++rep) {
    EpiS5State e{(float*)(ws + O_SLOC)};
    gemm_phase<false>((const bf16_t*)(ws + O_ACAT), nullptr, 512, (size_t)NCH * 512, (const bf16_t*)(ws + O_GT), 256, (size_t)256 * 256, NCH, 256, 256, 64, e, smem);
    GSYNC();
  }
  for (int rep = 0; rep < REP_S5; ++rep) { s5_scan_phase(p); GSYNC(); }
  for (int rep = 0; rep < REP_S5; ++rep) {
    EpiS5Y e{(bf16_t*)(ws + O_YG)};
    gemm_phase<false>((const bf16_t*)(ws + O_ACAT), nullptr, 512, (size_t)NCH * 512, (const bf16_t*)(ws + O_MYT), 512, (size_t)256 * 512, 1024, 256, 512, 64, e, smem);
    GSYNC();
  }
  {
    EpiGlu e{(const bf16_t*)(ws + O_YG), (const bf16_t*)(ws + O_G3), p.in[41], (bf16_t*)(ws + O_ACT3)};
    gemm_phase<false>((const bf16_t*)(ws + O_YG), nullptr, 1024, 0, (const bf16_t*)(ws + O_WT_GLU), 1024, 0, RL, 1024, 1024, 1, e, smem);
  }
  GSYNC();
  {
    EpiOut e{p.out, HCTX, p.out, HCTX, MOD + 3 * 9 * 3072 + 2048};
    gemm_phase<false>((const bf16_t*)(ws + O_ACT3), nullptr, 1024, 0, (const bf16_t*)(ws + O_WT_OUT3), 1024, 0, RL, 1024, 1024, 1, e, smem);
  }
  GSYNC();
  final_norm_phase(p.out, p.in[43]);
}

extern "C" void kernel_launch(void* const* d_in, const int* in_sizes, int n_in, void* d_out, int out_size, void* d_ws, size_t ws_size,
                              hipStream_t stream) {
  static int grid_blocks = 0;
  if (!grid_blocks) {
    int dev = 0, cus = 0, per_cu = 0;
    hipGetDevice(&dev);
    hipDeviceGetAttribute(&cus, hipDeviceAttributeMultiprocessorCount, dev);
    hipOccupancyMaxActiveBlocksPerMultiprocessor(&per_cu, fwd_megakernel, 256, 0);
    if (per_cu > 2) per_cu = 2;
    if (per_cu < 1) per_cu = 1;
    grid_blocks = cus * per_cu;
  }
  if (n_in != 44 || ws_size < WS_END) { fprintf(stderr, "kernel_launch: unexpected n_in %d or ws_size %zu < %zu\n", n_in, ws_size, (size_t)WS_END); return; }
  Params p{};
  for (int i = 0; i < 44; ++i) p.in[i] = (const float*)d_in[i];
  p.out = (float*)d_out;
  p.ws = (char*)d_ws;
  if (hipMemsetAsync((char*)d_ws + O_BAR, 0, 16384, stream) != hipSuccess) { fprintf(stderr, "memset failed\n"); return; }
  void* args[] = {&p};
  hipError_t e = hipLaunchCooperativeKernel((void*)fwd_megakernel, dim3(grid_blocks), dim3(256), args, 0, stream);
  if (e != hipSuccess) fprintf(stderr, "cooperative launch failed: %s (grid %d)\n", hipGetErrorString(e), grid_blocks);
}
```

```cpp
#include <hip/hip_runtime.h>
#include <hip/hip_cooperative_groups.h>
#include <cstdio>
namespace cg = cooperative_groups;

#define DI __device__ __forceinline__
typedef unsigned short bf16_t;
typedef short bf16x8 __attribute__((ext_vector_type(8)));
typedef short s16x4 __attribute__((ext_vector_type(4)));
typedef float f32x16 __attribute__((ext_vector_type(16)));
typedef float f32x4 __attribute__((ext_vector_type(4)));
typedef unsigned u32x2 __attribute__((ext_vector_type(2)));
typedef unsigned u32x4 __attribute__((ext_vector_type(4)));

#define MFMA32(a, b, c) __builtin_amdgcn_mfma_f32_32x32x16_bf16((a), (b), (c), 0, 0, 0)
#define MFMA16(a, b, c) __builtin_amdgcn_mfma_f32_16x16x32_bf16((a), (b), (c), 0, 0, 0)

constexpr int D = 1024, NB = 8, SEQ = 2048, CTXL = 256;
constexpr int RL = NB * SEQ;
constexpr int RC = NB * CTXL;
constexpr int R = RL + RC;
constexpr int LW = 1408;
constexpr int NCH = R / 16;

constexpr size_t O_WT_IN0 = 0;
constexpr size_t O_WT_OUT0 = O_WT_IN0 + (size_t)2816 * 1024 * 2;
constexpr size_t O_WT_IN1 = O_WT_OUT0 + (size_t)1024 * 1408 * 2;
constexpr size_t O_WT_OUT1 = O_WT_IN1 + (size_t)2560 * 1024 * 2;
constexpr size_t O_WT_IN2 = O_WT_OUT1 + (size_t)1024 * 1024 * 2;
constexpr size_t O_WT_OUT2 = O_WT_IN2 + (size_t)4096 * 1024 * 2;
constexpr size_t O_WT_IN3 = O_WT_OUT2 + (size_t)1024 * 1024 * 2;
constexpr size_t O_WT_GLU = O_WT_IN3 + (size_t)2048 * 1024 * 2;
constexpr size_t O_WT_OUT3 = O_WT_GLU + (size_t)1024 * 1024 * 2;
constexpr size_t O_WG = O_WT_OUT3 + (size_t)1024 * 1024 * 2;
constexpr size_t O_MOD = O_WG + (size_t)16 * 2 * 192 * 96 * 2;
constexpr size_t O_ROPEC = O_MOD + (size_t)4 * 9 * 3072 * 4;
constexpr size_t O_ROPES = O_ROPEC + (size_t)2048 * 32 * 4;
constexpr size_t O_POW = O_ROPES + (size_t)2048 * 32 * 4;
constexpr size_t O_BBAR = O_POW + (size_t)2 * 64 * 17 * 64 * 8;
constexpr size_t O_HCTX = O_BBAR + (size_t)2 * 64 * 64 * 16 * 8;
constexpr size_t O_DYN = O_HCTX + (size_t)RC * 1024 * 4;
constexpr size_t O_U0 = O_DYN;
constexpr size_t O_G0 = O_U0 + (size_t)R * LW * 2;
constexpr size_t O_ACT0 = O_G0 + (size_t)R * LW * 2;
constexpr size_t O_NBUF0 = O_ACT0;
constexpr size_t O_NBUF = O_DYN;
constexpr size_t O_Q1 = O_NBUF + (size_t)R * 1024 * 2;
constexpr size_t O_QR1 = O_Q1 + (size_t)R * 1024 * 2;
constexpr size_t O_K1 = O_QR1 + (size_t)RL * 1024 * 2;
constexpr size_t O_VTL1 = O_K1 + (size_t)R * 256 * 2;
constexpr size_t O_VTC1 = O_VTL1 + (size_t)8 * 4 * 64 * 2048 * 2;
constexpr size_t O_G1 = O_VTC1 + (size_t)8 * 4 * 64 * 256 * 2;
constexpr size_t O_ACT1 = O_G1 + (size_t)R * 1024 * 2;
constexpr size_t O_Q2 = O_NBUF + (size_t)R * 1024 * 2;
constexpr size_t O_K2 = O_Q2 + (size_t)R * 1024 * 2;
constexpr size_t O_VTL2 = O_K2 + (size_t)R * 1024 * 2;
constexpr size_t O_VTC2 = O_VTL2 + (size_t)8 * 16 * 64 * 2048 * 2;
constexpr size_t O_G2 = O_VTC2 + (size_t)8 * 16 * 64 * 256 * 2;
constexpr size_t O_ACT2 = O_NBUF;
constexpr size_t O_SLOC = O_DYN;
constexpr size_t O_YG = O_DYN;
constexpr size_t O_ACT3 = O_YG + (size_t)RL * 1024 * 2;
constexpr size_t O_ACAT = O_DYN + (size_t)64 * NCH * 256 * 4;
constexpr size_t O_G3 = O_ACAT + (size_t)64 * NCH * 512 * 2;
constexpr size_t O_GT = O_G3 + (size_t)RL * 1024 * 2;
constexpr size_t O_MYT = O_GT + (size_t)64 * 256 * 256 * 2;
constexpr size_t O_BAR = O_MYT + (size_t)64 * 256 * 512 * 2;
constexpr size_t WS_END = O_BAR + 16384;

struct Params {
  const float* in[44];
  float* out;
  char* ws;
};

typedef __bf16 bf16n2 __attribute__((ext_vector_type(2)));
DI bf16_t f2bf(float x) { const __bf16 b = (__bf16)x; return __builtin_bit_cast(unsigned short, b); }
DI float bf2f(bf16_t b) { return __uint_as_float(((unsigned)b) << 16); }
DI unsigned pack2(float lo, float hi) { bf16n2 v; v[0] = (__bf16)lo; v[1] = (__bf16)hi; return __builtin_bit_cast(unsigned, v); }
DI float bflo(unsigned u) { return __uint_as_float(u << 16); }
DI float bfhi(unsigned u) { return __uint_as_float(u & 0xffff0000u); }
DI float frcp(float x) { return __builtin_amdgcn_rcpf(x); }
DI float sigm(float x) { return frcp(1.f + __expf(-x)); }
DI float silu(float x) { return x * frcp(1.f + __expf(-x)); }
DI float gelu_tanh(float x) {
  float z = 0.7978845608028654f * (x + 0.044715f * x * x * x);
  float e = __expf(2.f * z);
  float t = 1.f - 2.f * frcp(e + 1.f);
  return 0.5f * x * (1.f + t);
}
DI int crow(int i, int h) { return (i & 3) + 8 * (i >> 2) + 4 * h; }
DI f32x16 zero16() { f32x16 z; _Pragma("unroll") for (int i = 0; i < 16; ++i) z[i] = 0.f; return z; }
DI void sincos_rev(float rev, float& s, float& c) { rev = rev - rintf(rev); s = __builtin_amdgcn_sinf(rev); c = __builtin_amdgcn_cosf(rev); }

DI int lds_off(int row, int chunk) { return row * 128 + ((chunk ^ ((row >> 1) & 7)) << 4); }

template <bool DUAL, int PMODE, class Epi>
DI void gemm_tile(const bf16_t* A, const bf16_t* A2, int lda, const bf16_t* Bt, int ldb, int K, int row0, int col0, int bz,
                  const Epi& epi, char* smem) {
  const int tid = threadIdx.x, lane = tid & 63, wave = tid >> 6, wm = wave >> 1, wn = wave & 1, r = lane & 31, h = lane >> 5;
  char* As = smem;
  char* Bs = smem + 32768;
  f32x16 acc[2][2];
  _Pragma("unroll") for (int mi = 0; mi < 2; ++mi) _Pragma("unroll") for (int ni = 0; ni < 2; ++ni) acc[mi][ni] = zero16();
  const int nk = K >> 6;
  const int lrow = tid >> 3, lch = tid & 7;
  const bf16_t* ap = A + (size_t)(row0 + lrow) * lda + lch * 8;
  const bf16_t* ap2 = DUAL ? (A2 + (size_t)(row0 + lrow) * lda + lch * 8) : nullptr;
  const bf16_t* bp = Bt + (size_t)(col0 + lrow) * ldb + lch * 8;
  u32x4 ra0[4], rb0[4], ra1[4], rb1[4];
#define GLOAD(RA, RB, kt) do { \
    _Pragma("unroll") for (int i = 0; i < 4; ++i) { \
      RA[i] = *(const u32x4*)(ap + (size_t)(32 * i) * lda + (kt) * 64); \
      if (DUAL) { \
        const u32x4 t2 = *(const u32x4*)(ap2 + (size_t)(32 * i) * lda + (kt) * 64); \
        _Pragma("unroll") for (int e = 0; e < 4; ++e) RA[i][e] = pack2(bflo(RA[i][e]) + bflo(t2[e]), bfhi(RA[i][e]) + bfhi(t2[e])); \
      } \
      RB[i] = *(const u32x4*)(bp + (size_t)(32 * i) * ldb + (kt) * 64); \
    } } while (0)
#define SSTORE(RA, RB, buf) do { \
    _Pragma("unroll") for (int i = 0; i < 4; ++i) { \
      *(u32x4*)(As + (buf) * 16384 + lds_off(lrow + 32 * i, lch)) = RA[i]; \
      *(u32x4*)(Bs + (buf) * 16384 + lds_off(lrow + 32 * i, lch)) = RB[i]; \
    } } while (0)
#define COMPUTE(buf) do { \
    const char* a_ = As + (buf) * 16384; \
    const char* b_ = Bs + (buf) * 16384; \
    _Pragma("unroll") for (int ks = 0; ks < 4; ++ks) { \
      bf16x8 af[2], bfr[2]; \
      _Pragma("unroll") for (int mi = 0; mi < 2; ++mi) af[mi] = *(const bf16x8*)(a_ + lds_off(64 * wm + 32 * mi + r, 2 * ks + h)); \
      _Pragma("unroll") for (int ni = 0; ni < 2; ++ni) bfr[ni] = *(const bf16x8*)(b_ + lds_off(64 * wn + 32 * ni + r, 2 * ks + h)); \
      _Pragma("unroll") for (int mi = 0; mi < 2; ++mi) _Pragma("unroll") for (int ni = 0; ni < 2; ++ni) acc[mi][ni] = MFMA32(af[mi], bfr[ni], acc[mi][ni]); \
    } } while (0)
  if (PMODE == 1) { _Pragma("unroll") for (int i = 0; i < 4; ++i) { ra0[i] = rb0[i] = ra1[i] = rb1[i] = (u32x4){0u, 0u, 0u, 0u}; } }
  if (PMODE != 1) { GLOAD(ra0, rb0, 0); GLOAD(ra1, rb1, 1); }
  SSTORE(ra0, rb0, 0);
  __syncthreads();
  for (int kt = 0; kt < nk; kt += 2) {
    if (PMODE != 1) { if (kt + 2 < nk) GLOAD(ra0, rb0, kt + 2); }
    if (PMODE != 2) COMPUTE(0);
    if (PMODE != 1) SSTORE(ra1, rb1, 1);
    __syncthreads();
    if (PMODE != 1) { if (kt + 3 < nk) GLOAD(ra1, rb1, kt + 3); }
    if (PMODE != 2) COMPUTE(1);
    if (PMODE != 1) { if (kt + 2 < nk) SSTORE(ra0, rb0, 0); }
    __syncthreads();
  }
  if (PMODE != 0) { _Pragma("unroll") for (int mi = 0; mi < 2; ++mi) _Pragma("unroll") for (int ni = 0; ni < 2; ++ni) asm volatile("" :: "v"(acc[mi][ni])); return; }
#undef GLOAD
#undef SSTORE
#undef COMPUTE
  epi(acc, row0 + 64 * wm, col0 + 64 * wn, r, h, bz);
}

template <bool DUAL, class Epi, int PMODE = 0>
DI void gemm_phase(const bf16_t* A, const bf16_t* A2, int lda, size_t strideA, const bf16_t* Bt, int ldb, size_t strideB, int M, int N, int K,
                   int nbatch, const Epi& epi, char* smem) {
  const int tm = M >> 7, tn = N >> 7, per = tm * tn, total = per * nbatch;
  const int G = gridDim.x;
  const int vb = (G % 8 == 0) ? (blockIdx.x & 7) * (G >> 3) + (blockIdx.x >> 3) : blockIdx.x;
  for (int t = vb; t < total; t += G) {
    const int bz = t / per, rem = t - bz * per;
    const int grp = rem / (8 * tn), rr = rem - grp * 8 * tn, gsz = min(8, tm - grp * 8);
    const int im = grp * 8 + rr % gsz, in_ = rr / gsz;
    gemm_tile<DUAL, PMODE>(A + bz * strideA, DUAL ? A2 + bz * strideA : nullptr, lda, Bt + bz * strideB, ldb, K, im * 128, in_ * 128, bz, epi, smem);
  }
}

#define FOR_ACC _Pragma("unroll") for (int mi = 0; mi < 2; ++mi) _Pragma("unroll") for (int ni = 0; ni < 2; ++ni) _Pragma("unroll") for (int i = 0; i < 16; ++i)

struct EpiL0In {
  bf16_t* U0; bf16_t* G0;
  DI void operator()(const f32x16 (&acc)[2][2], int rb, int cb, int r, int h, int) const {
    bf16_t* dst; int c0;
    if (cb < LW) { dst = U0; c0 = cb; } else { dst = G0; c0 = cb - LW; }
    FOR_ACC dst[(size_t)(rb + 32 * mi + crow(i, h)) * LW + c0 + 32 * ni + r] = f2bf(acc[mi][ni][i]);
  }
};

struct EpiOut {
  const float* in_lat; const float* in_ctx; float* out_lat; float* out_ctx; const float* gate;
  DI void operator()(const f32x16 (&acc)[2][2], int rb, int cb, int r, int h, int) const {
    const float* src; float* dst; const float* g; int rr;
    if (rb < RL) { src = in_lat; dst = out_lat; rr = rb; g = gate + (size_t)(rb >> 11) * 3072; }
    else { src = in_ctx; dst = out_ctx; rr = rb - RL; g = gate + (size_t)8 * 3072; }
    FOR_ACC {
      const size_t idx = (size_t)(rr + 32 * mi + crow(i, h)) * 1024 + cb + 32 * ni + r;
      dst[idx] = src[idx] + g[cb + 32 * ni + r] * acc[mi][ni][i];
    }
  }
};

DI size_t k_off(int t, int d) { return (size_t)(t >> 5) * 2048 + (((d >> 4) * 64 + ((d >> 3) & 1) * 32 + (t & 31)) << 3) + (d & 7); }
DI void store_vfrag(const f32x16 (&acc)[2][2], bf16_t* vhead  , int t0  , int r, int h) {
  _Pragma("unroll") for (int mi = 0; mi < 2; ++mi) _Pragma("unroll") for (int ni = 0; ni < 2; ++ni) _Pragma("unroll") for (int q = 0; q < 4; ++q) {
    u32x2 v;
    v[0] = pack2(acc[mi][ni][4 * q + 0], acc[mi][ni][4 * q + 1]);
    v[1] = pack2(acc[mi][ni][4 * q + 2], acc[mi][ni][4 * q + 3]);
    const size_t off = (size_t)((t0 >> 5) + mi) * 2048 + ((((ni * 2 + (q >> 1)) * 64 + h * 32 + r) << 3) + (q & 1) * 4);
    *(u32x2*)(vhead + off) = v;
  }
}

struct EpiL1In {
  bf16_t *Q, *QR, *Kb, *VtL, *VtC, *G; const float *rc, *rs;
  DI void operator()(const f32x16 (&acc)[2][2], int rb, int cb, int r, int h, int) const {
    const bool lat = rb < RL;
    if (cb < 1024) {
      _Pragma("unroll") for (int mi = 0; mi < 2; ++mi) _Pragma("unroll") for (int i = 0; i < 16; ++i) {
        const int row = rb + 32 * mi + crow(i, h);
        const float a1 = acc[mi][0][i] * 0.125f, a2 = acc[mi][1][i] * 0.125f;
        Q[(size_t)row * 1024 + cb + r] = f2bf(a1);
        Q[(size_t)row * 1024 + cb + 32 + r] = f2bf(a2);
        if (lat) {
          const int t = row & 2047;
          const float c = rc[t * 32 + r], s = rs[t * 32 + r];
          QR[(size_t)row * 1024 + cb + r] = f2bf(a1 * c - a2 * s);
          QR[(size_t)row * 1024 + cb + 32 + r] = f2bf(a2 * c + a1 * s);
        }
      }
    } else if (cb < 1280) {
      const int kvh = (cb - 1024) >> 6;
      bf16_t* kh; int tb;
      if (lat) { kh = Kb + (size_t)((rb >> 11) * 4 + kvh) * 64 * 2048; tb = rb & 2047; }
      else { const int rr = rb - RL; kh = Kb + (size_t)RL * 256 + (size_t)((rr >> 8) * 4 + kvh) * 8 * 2048; tb = rr & 255; }
      _Pragma("unroll") for (int mi = 0; mi < 2; ++mi) _Pragma("unroll") for (int i = 0; i < 16; ++i) {
        const int t = tb + 32 * mi + crow(i, h);
        float a1 = acc[mi][0][i], a2 = acc[mi][1][i];
        if (lat) {
          const float c = rc[t * 32 + r], s = rs[t * 32 + r];
          const float b1 = a1 * c - a2 * s, b2 = a2 * c + a1 * s;
          a1 = b1; a2 = b2;
        }
        kh[k_off(t, r)] = f2bf(a1);
        kh[k_off(t, r + 32)] = f2bf(a2);
      }
    } else if (cb < 1536) {
      const int kvh = (cb - 1280) >> 6;
      if (lat) store_vfrag(acc, VtL + (size_t)((rb >> 11) * 4 + kvh) * 64 * 2048, rb & 2047, r, h);
      else { const int rr = rb - RL; store_vfrag(acc, VtC + (size_t)((rr >> 8) * 4 + kvh) * 8 * 2048, rr & 255, r, h); }
    } else {
      const int c0 = cb - 1536;
      FOR_ACC G[(size_t)(rb + 32 * mi + crow(i, h)) * 1024 + c0 + 32 * ni + r] = f2bf(acc[mi][ni][i]);
    }
  }
};

struct EpiL2In {
  bf16_t *Q, *Kb, *VtL, *VtC, *G;
  DI void operator()(const f32x16 (&acc)[2][2], int rb, int cb, int r, int h, int) const {
    if (cb < 1024) {
      FOR_ACC Q[(size_t)(rb + 32 * mi + crow(i, h)) * 1024 + cb + 32 * ni + r] = f2bf(acc[mi][ni][i] * 0.125f);
    } else if (cb < 2048) {
      const int hd = (cb - 1024) >> 6;
      bf16_t* kh; int tb;
      if (rb < RL) { kh = Kb + (size_t)((rb >> 11) * 16 + hd) * 64 * 2048; tb = rb & 2047; }
      else { const int rr = rb - RL; kh = Kb + (size_t)RL * 1024 + (size_t)((rr >> 8) * 16 + hd) * 8 * 2048; tb = rr & 255; }
      FOR_ACC kh[k_off(tb + 32 * mi + crow(i, h), 32 * ni + r)] = f2bf(acc[mi][ni][i]);
    } else if (cb < 3072) {
      const int hd = (cb - 2048) >> 6;
      if (rb < RL) store_vfrag(acc, VtL + (size_t)((rb >> 11) * 16 + hd) * 64 * 2048, rb & 2047, r, h);
      else { const int rr = rb - RL; store_vfrag(acc, VtC + (size_t)((rr >> 8) * 16 + hd) * 8 * 2048, rr & 255, r, h); }
    } else {
      FOR_ACC G[(size_t)(rb + 32 * mi + crow(i, h)) * 1024 + cb - 3072 + 32 * ni + r] = f2bf(acc[mi][ni][i]);
    }
  }
};

struct EpiL3In {
  bf16_t *ACAT, *G;
  DI void operator()(const f32x16 (&acc)[2][2], int rb, int cb, int r, int h, int) const {
    if (cb < 1024) {
      FOR_ACC {
        const int row = rb + 32 * mi + crow(i, h), col = cb + 32 * ni + r;
        ACAT[((size_t)(col >> 4) * NCH + (row >> 4)) * 512 + (row & 15) * 16 + (col & 15)] = f2bf(acc[mi][ni][i]);
      }
    } else if (rb < RL) {
      FOR_ACC G[(size_t)(rb + 32 * mi + crow(i, h)) * 1024 + cb - 1024 + 32 * ni + r] = f2bf(acc[mi][ni][i]);
    }
  }
};

struct EpiS5State {
  float* S;
  DI void operator()(const f32x16 (&acc)[2][2], int rb, int cb, int r, int h, int bz) const {
    FOR_ACC S[((size_t)bz * NCH + rb + 32 * mi + crow(i, h)) * 256 + cb + 32 * ni + r] = acc[mi][ni][i];
  }
};

struct EpiS5Y {
  bf16_t* YG;
  DI void operator()(const f32x16 (&acc)[2][2], int rb, int cb, int r, int h, int bz) const {
    FOR_ACC {
      const int chunk = rb + 32 * mi + crow(i, h), n = cb + 32 * ni + r;
      YG[((size_t)chunk * 16 + (n >> 4)) * 1024 + bz * 16 + (n & 15)] = f2bf(gelu_tanh(acc[mi][ni][i]));
    }
  }
};

struct EpiGlu {
  const bf16_t *YG, *G; const float* gb; bf16_t* ACT;
  DI void operator()(const f32x16 (&acc)[2][2], int rb, int cb, int r, int h, int) const {
    FOR_ACC {
      const int col = cb + 32 * ni + r;
      const size_t idx = (size_t)(rb + 32 * mi + crow(i, h)) * 1024 + col;
      ACT[idx] = f2bf(bf2f(YG[idx]) * sigm(acc[mi][ni][i] + gb[col]) * silu(bf2f(G[idx])));
    }
  }
};

DI void transpose_tile(const float* W, int K, int N, bf16_t* WT, int tile, float* sm) {
  const int tn = N >> 6, tk_i = tile / tn, tn_i = tile - tk_i * tn, k0 = tk_i * 64, n0 = tn_i * 64;
  const int c = threadIdx.x & 63, rr = threadIdx.x >> 6;
  _Pragma("unroll 4") for (int i = 0; i < 16; ++i) { const int k = i * 4 + rr; sm[k * 65 + c] = W[(size_t)(k0 + k) * N + n0 + c]; }
  __syncthreads();
  _Pragma("unroll 4") for (int i = 0; i < 16; ++i) { const int n = i * 4 + rr; WT[(size_t)(n0 + n) * K + k0 + c] = f2bf(sm[c * 65 + n]); }
  __syncthreads();
}

DI void phase0(const Params& p, char* smem) {
  char* ws = p.ws;
  float* smf = (float*)smem;
  for (int job = blockIdx.x; job < 192; job += gridDim.x) {
    const int l = job / 48, n0 = (job % 48) * 64;
    const float* aw = l == 0 ? p.in[4] : l == 1 ? p.in[16] : l == 2 ? p.in[22] : p.in[28];
    const float* ab = l == 0 ? p.in[5] : l == 1 ? p.in[17] : l == 2 ? p.in[23] : p.in[29];
    float* sv = smf;
    float* red = smf + 9 * 1024;
    for (int idx = threadIdx.x; idx < 9 * 1024; idx += 256) {
      const int v = idx >> 10, k = idx & 1023;
      const float x = v < 8 ? p.in[1][v * 1024 + k] : p.in[3][k];
      sv[idx] = silu(x);
    }
    __syncthreads();
    const int col = threadIdx.x & 63, ks = threadIdx.x >> 6;
    float a[9];
    _Pragma("unroll") for (int v = 0; v < 9; ++v) a[v] = 0.f;
    _Pragma("unroll 8") for (int k = ks * 256; k < ks * 256 + 256; ++k) {
      const float w = aw[(size_t)k * 3072 + n0 + col];
      _Pragma("unroll") for (int v = 0; v < 9; ++v) a[v] += sv[v * 1024 + k] * w;
    }
    _Pragma("unroll") for (int v = 0; v < 9; ++v) red[(ks * 9 + v) * 64 + col] = a[v];
    __syncthreads();
    float* MOD = (float*)(ws + O_MOD);
    for (int idx = threadIdx.x; idx < 9 * 64; idx += 256) {
      const int v = idx >> 6, cc = idx & 63;
      const float s = red[(0 * 9 + v) * 64 + cc] + red[(1 * 9 + v) * 64 + cc] + red[(2 * 9 + v) * 64 + cc] + red[(3 * 9 + v) * 64 + cc] + ab[n0 + cc];
      MOD[(size_t)(l * 9 + v) * 3072 + n0 + cc] = s;
    }
    __syncthreads();
  }
  {
    constexpr int T0 = 16 * 44, T1 = T0 + 22 * 16, T2 = T1 + 16 * 40, T3 = T2 + 256, T4 = T3 + 16 * 64, T5 = T4 + 256, T6 = T5 + 16 * 32, T7 = T6 + 256, T8 = T7 + 256;
    for (int j = blockIdx.x; j < T8; j += gridDim.x) {
      if (j < T0) transpose_tile(p.in[7], 1024, 2816, (bf16_t*)(ws + O_WT_IN0), j, smf);
      else if (j < T1) transpose_tile(p.in[15], 1408, 1024, (bf16_t*)(ws + O_WT_OUT0), j - T0, smf);
      else if (j < T2) transpose_tile(p.in[19], 1024, 2560, (bf16_t*)(ws + O_WT_IN1), j - T1, smf);
      else if (j < T3) transpose_tile(p.in[21], 1024, 1024, (bf16_t*)(ws + O_WT_OUT1), j - T2, smf);
      else if (j < T4) transpose_tile(p.in[25], 1024, 4096, (bf16_t*)(ws + O_WT_IN2), j - T3, smf);
      else if (j < T5) transpose_tile(p.in[27], 1024, 1024, (bf16_t*)(ws + O_WT_OUT2), j - T4, smf);
      else if (j < T6) transpose_tile(p.in[31], 1024, 2048, (bf16_t*)(ws + O_WT_IN3), j - T5, smf);
      else if (j < T7) transpose_tile(p.in[40], 1024, 1024, (bf16_t*)(ws + O_WT_GLU), j - T6, smf);
      else transpose_tile(p.in[42], 1024, 1024, (bf16_t*)(ws + O_WT_OUT3), j - T7, smf);
    }
  }
  const int gt = blockIdx.x * 256 + threadIdx.x, gn = gridDim.x * 256;
  {
    bf16_t* WG = (bf16_t*)(ws + O_WG);
    for (int idx = gt; idx < 16 * 2 * 192 * 96; idx += gn) {
      const int kk = idx % 96; int t = idx / 96; const int n = t % 192; t /= 192; const int d = t & 1, k = t >> 1;
      const int c = n >> 5, gate = (n >> 4) & 1, ch = c * 16 + (n & 15);
      float v = 0.f;
      if (ch < 88 && kk < 88) { const float* w = gate ? p.in[12] : p.in[10]; v = w[((size_t)(d * 16 + k) * 88 + kk) * 88 + ch]; }
      WG[idx] = f2bf(v);
    }
  }
  {
    float* RCt = (float*)(ws + O_ROPEC); float* RSt = (float*)(ws + O_ROPES);
    for (int idx = gt; idx < 2048 * 32; idx += gn) {
      const int t = idx >> 5, j = idx & 31;
      const float pos = (float)(j < 16 ? (t >> 6) : (t & 63));
      const float freq = exp2f(-(float)(j & 15) * (13.287712379549449f / 16.f));
      float s, c; sincos_rev(pos * freq * 0.15915494309189535f, s, c);
      RCt[idx] = c; RSt[idx] = s;
    }
  }
  {
    float2* POW = (float2*)(ws + O_POW); float2* BB = (float2*)(ws + O_BBAR);
    for (int idx = gt; idx < 2 * 64 * 17 * 64; idx += gn) {
      const int pp = idx & 63; int t = idx >> 6; const int n = t % 17; t /= 17;
      const float are = p.in[32][t * 64 + pp], aim = p.in[33][t * 64 + pp], dt = expf(p.in[34][t]);
      const float mag = expf((float)n * are * dt);
      const double rev = (double)n * (double)aim * (double)dt * 0.15915494309189535;
      float s, c; sincos_rev((float)(rev - rint(rev)), s, c);
      POW[idx] = make_float2(mag * c, mag * s);
    }
    for (int idx = gt; idx < 2 * 64 * 64 * 16; idx += gn) {
      const int t = idx >> 4;
      const int dg = t >> 6;
      const float are = p.in[32][t], aim = p.in[33][t], dt = expf(p.in[34][dg]);
      const float mag = expf(are * dt);
      const double rev = (double)aim * (double)dt * 0.15915494309189535;
      float s, c; sincos_rev((float)(rev - rint(rev)), s, c);
      const float nr = mag * c - 1.f, ni = mag * s;
      const float den = 1.f / (are * are + aim * aim);
      const float cr = (nr * are + ni * aim) * den, ci = (ni * are - nr * aim) * den;
      const float br = p.in[35][idx], bi = p.in[36][idx];
      BB[idx] = make_float2(cr * br - ci * bi, cr * bi + ci * br);
    }
  }
}

DI void norm_phase(const float* lat, const float* ctx, const float* gn, const float* mod  , bf16_t* NB_) {
  const int lane = threadIdx.x & 63;
  const int w0 = blockIdx.x * 4 + (threadIdx.x >> 6), nw = gridDim.x * 4;
  for (int row = w0; row < R; row += nw) {
    const float* src; const float* m;
    if (row < RL) { src = lat + (size_t)row * 1024; m = mod + (size_t)(row >> 11) * 3072; }
    else { src = ctx + (size_t)(row - RL) * 1024; m = mod + (size_t)8 * 3072; }
    f32x4 v[4]; float ss = 0.f;
    _Pragma("unroll") for (int i = 0; i < 4; ++i) { v[i] = *(const f32x4*)(src + (i * 64 + lane) * 4); ss += v[i][0] * v[i][0] + v[i][1] * v[i][1] + v[i][2] * v[i][2] + v[i][3] * v[i][3]; }
    _Pragma("unroll") for (int o = 32; o >= 1; o >>= 1) ss += __shfl_xor(ss, o);
    const float rstd = rsqrtf(ss * (1.f / 1024.f) + 1e-6f);
    _Pragma("unroll") for (int i = 0; i < 4; ++i) {
      const int k = (i * 64 + lane) * 4;
      const f32x4 g = *(const f32x4*)(gn + k), sh = *(const f32x4*)(m + k), sc = *(const f32x4*)(m + 1024 + k);
      u32x2 o;
      o[0] = pack2(v[i][0] * rstd * g[0] * (1.f + sc[0]) + sh[0], v[i][1] * rstd * g[1] * (1.f + sc[1]) + sh[1]);
      o[1] = pack2(v[i][2] * rstd * g[2] * (1.f + sc[2]) + sh[2], v[i][3] * rstd * g[3] * (1.f + sc[3]) + sh[3]);
      *(u32x2*)(NB_ + (size_t)row * 1024 + k) = o;
    }
  }
}

DI void final_norm_phase(float* H, const float* gn) {
  const int lane = threadIdx.x & 63;
  const int w0 = blockIdx.x * 4 + (threadIdx.x >> 6), nw = gridDim.x * 4;
  for (int row = w0; row < RL; row += nw) {
    float* src = H + (size_t)row * 1024;
    f32x4 v[4]; float ss = 0.f;
    _Pragma("unroll") for (int i = 0; i < 4; ++i) { v[i] = *(const f32x4*)(src + (i * 64 + lane) * 4); ss += v[i][0] * v[i][0] + v[i][1] * v[i][1] + v[i][2] * v[i][2] + v[i][3] * v[i][3]; }
    _Pragma("unroll") for (int o = 32; o >= 1; o >>= 1) ss += __shfl_xor(ss, o);
    const float rstd = rsqrtf(ss * (1.f / 1024.f) + 1e-6f);
    _Pragma("unroll") for (int i = 0; i < 4; ++i) {
      const int k = (i * 64 + lane) * 4;
      const f32x4 g = *(const f32x4*)(gn + k);
      f32x4 o; o[0] = v[i][0] * rstd * g[0]; o[1] = v[i][1] * rstd * g[1]; o[2] = v[i][2] * rstd * g[2]; o[3] = v[i][3] * rstd * g[3];
      *(f32x4*)(src + k) = o;
    }
  }
}

DI void lru_phase(const Params& p, char* smem) {
  char* ws = p.ws;
  bf16_t* Wl = (bf16_t*)smem;
  bf16_t* Uc = Wl + 96 * 96;
  float* aggA = (float*)(Uc + 64 * 96);
  float* aggH = aggA + 16 * 48;
  const bf16_t* U0 = (const bf16_t*)(ws + O_U0);
  const bf16_t* G0 = (const bf16_t*)(ws + O_G0);
  const int tid = threadIdx.x, lane = tid & 63, w = tid >> 6, col = lane & 15, quad = lane >> 4;
  for (int item = blockIdx.x; item < 512; item += gridDim.x) {
    const int half = item & 1, dir = (item >> 1) & 1, k = (item >> 2) & 15, b = item >> 6;
    bf16_t* ACT = (bf16_t*)(ws + O_ACT0) + (size_t)dir * R * LW;
    __syncthreads();
    {
      const u32x4* src = (const u32x4*)((const bf16_t*)(ws + O_WG) + ((size_t)(k * 2 + dir) * 192 + half * 96) * 96);
      u32x4* dst = (u32x4*)Wl;
      for (int i = tid; i < 96 * 96 / 8; i += 256) dst[i] = src[i];
      if (tid < 64) { u32x4 z; z[0] = z[1] = z[2] = z[3] = 0u; *(u32x4*)(Uc + tid * 96 + 88) = z; }
    }
    float ba[3], bx[3], sp8[3];
    _Pragma("unroll") for (int c = 0; c < 3; ++c) {
      const int ch = 48 * half + 16 * c + col;
      if (ch < 88) {
        ba[c] = p.in[11][dir * LW + k * 88 + ch]; bx[c] = p.in[13][dir * LW + k * 88 + ch];
        sp8[c] = 8.f * log1pf(expf(-p.in[14][dir * LW + k * 88 + ch]));
      } else { ba[c] = 0.f; bx[c] = 0.f; sp8[c] = 0.f; }
    }
    const int cp = tid % 44, run = tid / 44;
    float cw[4][2], cb2[2];
    _Pragma("unroll") for (int t = 0; t < 4; ++t) { cw[t][0] = p.in[8][t * LW + k * 88 + 2 * cp]; cw[t][1] = p.in[8][t * LW + k * 88 + 2 * cp + 1]; }
    cb2[0] = p.in[9][k * 88 + 2 * cp]; cb2[1] = p.in[9][k * 88 + 2 * cp + 1];
    float carry = 0.f;
    unsigned un[19];
    auto tile_info = [&](int ti, int& rowbase, int& L, int& t0) {
      if (ti < 4) { rowbase = RL + b * 256; L = 256; t0 = (dir ? 3 - ti : ti) * 64; }
      else { rowbase = b * 2048; L = 2048; t0 = (dir ? 31 - (ti - 4) : (ti - 4)) * 64; }
    };
    auto prefetch = [&](int ti) {
      int rowbase, L, t0; tile_info(ti, rowbase, L, t0);
      _Pragma("unroll") for (int i = 0; i < 19; ++i) {
        const int tt = t0 + 16 * run - 2 + i;
        unsigned v = 0u;
        if (tid < 176 && tt >= 0 && tt < L) v = *(const unsigned*)(U0 + (size_t)(rowbase + tt) * LW + k * 88 + 2 * cp);
        un[i] = v;
      }
    };
    prefetch(0);
    for (int ti = 0; ti < 36; ++ti) {
      int rowbase, L, t0; tile_info(ti, rowbase, L, t0);
      if (tid < 176) {
        _Pragma("unroll") for (int t = 0; t < 16; ++t) {
          const float y0 = cb2[0] + cw[0][0] * bflo(un[t]) + cw[1][0] * bflo(un[t + 1]) + cw[2][0] * bflo(un[t + 2]) + cw[3][0] * bflo(un[t + 3]);
          const float y1 = cb2[1] + cw[0][1] * bfhi(un[t]) + cw[1][1] * bfhi(un[t + 1]) + cw[2][1] * bfhi(un[t + 2]) + cw[3][1] * bfhi(un[t + 3]);
          *(unsigned*)(Uc + (16 * run + t) * 96 + 2 * cp) = pack2(y0, y1);
        }
      }
      if (ti + 1 < 36) prefetch(ti + 1);
      bf16_t gv[3][4];
      _Pragma("unroll") for (int c = 0; c < 3; ++c) {
        const int ch = 48 * half + 16 * c + col;
        _Pragma("unroll") for (int j = 0; j < 4; ++j)
          gv[c][j] = ch < 88 ? G0[(size_t)(rowbase + t0 + 16 * w + 4 * quad + j) * LW + k * 88 + ch] : (bf16_t)0;
      }
      __syncthreads();
      bf16x8 af[3];
      _Pragma("unroll") for (int ks = 0; ks < 3; ++ks) af[ks] = *(const bf16x8*)(Uc + (16 * w + col) * 96 + ks * 32 + quad * 8);
      float hl[3][4], ac[3][4];
      _Pragma("unroll") for (int c = 0; c < 3; ++c) {
        f32x4 gA = {0.f, 0.f, 0.f, 0.f}, gX = {0.f, 0.f, 0.f, 0.f};
        _Pragma("unroll") for (int ks = 0; ks < 3; ++ks) {
          const bf16x8 bA = *(const bf16x8*)(Wl + ((c * 2 + 0) * 16 + col) * 96 + ks * 32 + quad * 8);
          const bf16x8 bX = *(const bf16x8*)(Wl + ((c * 2 + 1) * 16 + col) * 96 + ks * 32 + quad * 8);
          gA = MFMA16(af[ks], bA, gA);
          gX = MFMA16(af[ks], bX, gX);
        }
        float a[4], bb[4];
        _Pragma("unroll") for (int j = 0; j < 4; ++j) {
          const float uval = bf2f(Uc[(16 * w + 4 * quad + j) * 96 + 48 * half + 16 * c + col]);
          const float rg = sigm(gA[j] + ba[c]), ig = sigm(gX[j] + bx[c]);
          a[j] = __expf(-sp8[c] * rg);
          bb[j] = __builtin_amdgcn_sqrtf(fmaxf(1.f - a[j] * a[j], 0.f)) * ig * uval;
        }
        if (dir == 0) {
          hl[c][0] = bb[0]; ac[c][0] = a[0];
          _Pragma("unroll") for (int j = 1; j < 4; ++j) { hl[c][j] = a[j] * hl[c][j - 1] + bb[j]; ac[c][j] = a[j] * ac[c][j - 1]; }
          aggA[(4 * w + quad) * 48 + 16 * c + col] = ac[c][3]; aggH[(4 * w + quad) * 48 + 16 * c + col] = hl[c][3];
        } else {
          hl[c][3] = bb[3]; ac[c][3] = a[3];
          _Pragma("unroll") for (int j = 2; j >= 0; --j) { hl[c][j] = a[j] * hl[c][j + 1] + bb[j]; ac[c][j] = a[j] * ac[c][j + 1]; }
          aggA[(4 * w + quad) * 48 + 16 * c + col] = ac[c][0]; aggH[(4 * w + quad) * 48 + 16 * c + col] = hl[c][0];
        }
      }
      __syncthreads();
      if (tid < 48) {
        float A_[16], H_[16];
        _Pragma("unroll") for (int s_ = 0; s_ < 16; ++s_) { A_[s_] = aggA[s_ * 48 + tid]; H_[s_] = aggH[s_ * 48 + tid]; }
        float cin = carry;
        if (dir == 0) { _Pragma("unroll") for (int s_ = 0; s_ < 16; ++s_) { aggA[s_ * 48 + tid] = cin; cin = A_[s_] * cin + H_[s_]; } }
        else { _Pragma("unroll") for (int s_ = 15; s_ >= 0; --s_) { aggA[s_ * 48 + tid] = cin; cin = A_[s_] * cin + H_[s_]; } }
        carry = cin;
      }
      __syncthreads();
      _Pragma("unroll") for (int c = 0; c < 3; ++c) {
        const int ch = 48 * half + 16 * c + col;
        if (ch < 88) {
          const float cin = aggA[(4 * w + quad) * 48 + 16 * c + col];
          _Pragma("unroll") for (int j = 0; j < 4; ++j) {
            const size_t idx = (size_t)(rowbase + t0 + 16 * w + 4 * quad + j) * LW + k * 88 + ch;
            const float hv = hl[c][j] + ac[c][j] * cin;
            ACT[idx] = f2bf(hv * silu(bf2f(gv[c][j])));
          }
        }
      }
    }
  }
}

struct AttnSt { f32x16 O0, O1; float m, l; };
DI bf16x8 ld16(const bf16_t* p) { return *(const bf16x8*)p; }
DI bf16x8 ld8x2(const bf16_t* p0) { const s16x4 a = *(const s16x4*)p0; const s16x4 b = *(const s16x4*)(p0 + 8); return __builtin_shufflevector(a, b, 0, 1, 2, 3, 4, 5, 6, 7); }
DI bf16x8 pack8(const f32x16& P, int s) {
  u32x4 u;
  _Pragma("unroll") for (int j = 0; j < 4; ++j) u[j] = pack2(P[8 * s + 2 * j], P[8 * s + 2 * j + 1]);
  return __builtin_bit_cast(bf16x8, u);
}

struct KVt { bf16x8 k0, k1, k2, k3, v00, v01, v10, v11; };
DI void attn_load(KVt& t, const bf16_t* kt_, const bf16_t* vt_) {
  t.k0 = ld16(kt_); t.k1 = ld16(kt_ + 512); t.k2 = ld16(kt_ + 1024); t.k3 = ld16(kt_ + 1536);
  t.v00 = ld16(vt_); t.v01 = ld16(vt_ + 512); t.v10 = ld16(vt_ + 1024); t.v11 = ld16(vt_ + 1536);
}
template <class F>
DI void attn_compute(AttnSt& st, const bf16x8 (&qf)[4], const KVt& t, F fmod) {
  f32x16 S = zero16();
  S = MFMA32(t.k0, qf[0], S); S = MFMA32(t.k1, qf[1], S); S = MFMA32(t.k2, qf[2], S); S = MFMA32(t.k3, qf[3], S);
  float mx = -3.0e38f;
  _Pragma("unroll") for (int i = 0; i < 16; ++i) { S[i] = fmod(i, S[i]); mx = fmaxf(mx, S[i]); }
  mx = fmaxf(mx, __shfl_xor(mx, 32));
  const float mn = fmaxf(st.m, mx);
  const float alpha = __expf(st.m - mn);
  st.m = mn;
  float ls = 0.f;
  f32x16 P;
  _Pragma("unroll") for (int i = 0; i < 16; ++i) { P[i] = __expf(S[i] - mn); ls += P[i]; }
  st.l = st.l * alpha + ls;
  _Pragma("unroll") for (int i = 0; i < 16; ++i) { st.O0[i] *= alpha; st.O1[i] *= alpha; }
  const bf16x8 p0 = pack8(P, 0), p1 = pack8(P, 1);
  st.O0 = MFMA32(t.v00, p0, st.O0); st.O0 = MFMA32(t.v01, p1, st.O0);
  st.O1 = MFMA32(t.v10, p0, st.O1); st.O1 = MFMA32(t.v11, p1, st.O1);
}

DI void attn_finish(AttnSt& st, const bf16_t* Grow  , bf16_t* Arow  , int h) {
  const float lt = st.l + __shfl_xor(st.l, 32);
  const float inv = frcp(lt);
  _Pragma("unroll") for (int q = 0; q < 4; ++q) {
    const int d0 = 8 * q + 4 * h;
    {
      const u32x2 g = *(const u32x2*)(Grow + d0);
      u32x2 o;
      o[0] = pack2(st.O0[4 * q + 0] * inv * silu(bflo(g[0])), st.O0[4 * q + 1] * inv * silu(bfhi(g[0])));
      o[1] = pack2(st.O0[4 * q + 2] * inv * silu(bflo(g[1])), st.O0[4 * q + 3] * inv * silu(bfhi(g[1])));
      *(u32x2*)(Arow + d0) = o;
    }
    {
      const u32x2 g = *(const u32x2*)(Grow + 32 + d0);
      u32x2 o;
      o[0] = pack2(st.O1[4 * q + 0] * inv * silu(bflo(g[0])), st.O1[4 * q + 1] * inv * silu(bfhi(g[0])));
      o[1] = pack2(st.O1[4 * q + 2] * inv * silu(bflo(g[1])), st.O1[4 * q + 3] * inv * silu(bfhi(g[1])));
      *(u32x2*)(Arow + 32 + d0) = o;
    }
  }
}

DI void swa_phase(const Params& p) {
  char* ws = p.ws;
  const bf16_t* Q = (const bf16_t*)(ws + O_Q1); const bf16_t* QR = (const bf16_t*)(ws + O_QR1); const bf16_t* Kb = (const bf16_t*)(ws + O_K1);
  const bf16_t* VtL = (const bf16_t*)(ws + O_VTL1); const bf16_t* VtC = (const bf16_t*)(ws + O_VTC1);
  const bf16_t* G = (const bf16_t*)(ws + O_G1); bf16_t* ACT = (bf16_t*)(ws + O_ACT1);
  const float* sink = p.in[20];
  const int lane = threadIdx.x & 63, r = lane & 31, h = lane >> 5;
  const int vb_ = (gridDim.x % 8 == 0) ? (blockIdx.x & 7) * (gridDim.x >> 3) + (blockIdx.x >> 3) : blockIdx.x;
  const int wid = vb_ * 4 + (threadIdx.x >> 6), nw = gridDim.x * 4;
  auto ident = [](int, float s) { return s; };
  for (int it = wid; it < 8192 + 1024; it += nw) {
    int b, kvh, g4, qt; const bool lat = it < 8192;
    if (lat) { g4 = it & 3; qt = (it >> 2) & 63; kvh = (it >> 8) & 3; b = it >> 10; }
    else { const int j = it - 8192; g4 = j & 3; qt = (j >> 2) & 7; kvh = (j >> 5) & 3; b = j >> 7; }
    const int head = kvh * 4 + g4;
    const size_t qrow = lat ? (size_t)b * 2048 + qt * 32 + r : (size_t)RL + b * 256 + qt * 32 + r;
    AttnSt st; st.O0 = zero16(); st.O1 = zero16(); st.m = sink[head]; st.l = h == 0 ? 1.f : 0.f;
    bf16x8 qf[4], qfr[4];
    _Pragma("unroll") for (int ks = 0; ks < 4; ++ks) qf[ks] = ld16(Q + qrow * 1024 + head * 64 + ks * 16 + 8 * h);
    if (lat) { _Pragma("unroll") for (int ks = 0; ks < 4; ++ks) qfr[ks] = ld16(QR + qrow * 1024 + head * 64 + ks * 16 + 8 * h); }
    else { _Pragma("unroll") for (int ks = 0; ks < 4; ++ks) qfr[ks] = qf[ks]; }
    const bf16_t* kc = Kb + (size_t)RL * 256 + (size_t)(b * 4 + kvh) * 8 * 2048 + lane * 8;
    const bf16_t* vc = VtC + (size_t)(b * 4 + kvh) * 8 * 2048 + lane * 8;
    const bf16_t* kl = Kb + (size_t)(b * 4 + kvh) * 64 * 2048 + lane * 8;
    const bf16_t* vl = VtL + (size_t)(b * 4 + kvh) * 64 * 2048 + lane * 8;
    const int kt_lo = max(qt - 4, 0), kt_hi = min(qt + 4, 63);
    const int nt = lat ? 8 + (kt_hi - kt_lo + 1) : 8;
    auto load_tile = [&](int j, KVt& t) {
      if (j < 8) attn_load(t, kc + (size_t)j * 2048, vc + (size_t)j * 2048);
      else { const int kt = kt_lo + j - 8; attn_load(t, kl + (size_t)kt * 2048, vl + (size_t)kt * 2048); }
    };
    KVt cur, nxt;
    load_tile(0, cur);
    for (int j = 0; j < 8; ++j) {
      nxt = cur;
      if (j + 1 < nt) load_tile(j + 1, nxt);
      attn_compute(st, qf, cur, ident);
      cur = nxt;
    }
    for (int j = 8; j < nt; ++j) {
      nxt = cur;
      if (j + 1 < nt) load_tile(j + 1, nxt);
      const int dq = qt * 32 + r - (kt_lo + j - 8) * 32;
      attn_compute(st, qfr, cur, [&](int i, float s) { const int d = dq - crow(i, h); return (d <= 128 && d >= -128) ? s : -1.0e30f; });
      cur = nxt;
    }
    attn_finish(st, G + qrow * 1024 + head * 64, ACT + qrow * 1024 + head * 64, h);
  }
}

DI void na_phase(const Params& p, char* smem) {
  char* ws = p.ws;
  const bf16_t* Q = (const bf16_t*)(ws + O_Q2); const bf16_t* Kb = (const bf16_t*)(ws + O_K2);
  const bf16_t* VtL = (const bf16_t*)(ws + O_VTL2); const bf16_t* VtC = (const bf16_t*)(ws + O_VTC2);
  const bf16_t* G = (const bf16_t*)(ws + O_G2); bf16_t* ACT = (bf16_t*)(ws + O_ACT2);
  float* rpbs = (float*)smem;
  __syncthreads();
  for (int i = threadIdx.x; i < 16 * 15 * 31; i += 256) rpbs[i] = p.in[26][i];
  __syncthreads();
  const int lane = threadIdx.x & 63, r = lane & 31, h = lane >> 5;
  const int vb_ = (gridDim.x % 8 == 0) ? (blockIdx.x & 7) * (gridDim.x >> 3) + (blockIdx.x >> 3) : blockIdx.x;
  const int wid = vb_ * 4 + (threadIdx.x >> 6), nw = gridDim.x * 4;
  auto ident = [](int, float s) { return s; };
  for (int it = wid; it < 8192 + 1024; it += nw) {
    int b, head, half, gr; const bool lat = it < 8192;
    if (lat) { half = it & 1; head = (it >> 1) & 15; gr = (it >> 5) & 31; b = it >> 10; }
    else { const int j = it - 8192; half = 0; head = j & 15; gr = (j >> 4) & 7; b = j >> 7; }
    const size_t qrow = lat ? (size_t)b * 2048 + gr * 64 + half * 32 + r : (size_t)RL + b * 256 + gr * 32 + r;
    AttnSt st; st.O0 = zero16(); st.O1 = zero16(); st.m = -1.0e30f; st.l = 0.f;
    bf16x8 qf[4];
    _Pragma("unroll") for (int ks = 0; ks < 4; ++ks) qf[ks] = ld16(Q + qrow * 1024 + head * 64 + ks * 16 + 8 * h);
    const bf16_t* kc = Kb + (size_t)RL * 1024 + (size_t)(b * 16 + head) * 8 * 2048 + lane * 8;
    const bf16_t* vc = VtC + (size_t)(b * 16 + head) * 8 * 2048 + lane * 8;
    const bf16_t* kl = Kb + (size_t)(b * 16 + head) * 64 * 2048 + lane * 8;
    const bf16_t* vl = VtL + (size_t)(b * 16 + head) * 64 * 2048 + lane * 8;
    const int cq = half * 32 + r;
    const int cs = min(max(cq - 8, 0), 48);
    const int rs_ = min(max(gr - 4, 0), 24);
    const int nt = lat ? 24 : 8;
    auto load_tile = [&](int j, KVt& t) {
      if (j < 8) attn_load(t, kc + (size_t)j * 2048, vc + (size_t)j * 2048);
      else { const int kt = (rs_ + ((j - 8) >> 1)) * 2 + ((j - 8) & 1); attn_load(t, kl + (size_t)kt * 2048, vl + (size_t)kt * 2048); }
    };
    KVt cur, nxt;
    load_tile(0, cur);
    for (int j = 0; j < 8; ++j) {
      nxt = cur;
      if (j + 1 < nt) load_tile(j + 1, nxt);
      attn_compute(st, qf, cur, ident);
      cur = nxt;
    }
    for (int j = 8; j < nt; ++j) {
      nxt = cur;
      if (j + 1 < nt) load_tile(j + 1, nxt);
      const int krow = rs_ + ((j - 8) >> 1), ct = (j - 8) & 1;
      const float* rp = rpbs + (head * 15 + (krow - gr + 7)) * 31;
      attn_compute(st, qf, cur, [&](int i, float s) {
        const int ck = ct * 32 + crow(i, h);
        const bool ok = (ck >= cs) && (ck < cs + 16);
        const int dx = min(max(ck - cq + 15, 0), 30);
        return ok ? s + rp[dx] : -1.0e30f;
      });
      cur = nxt;
    }
    attn_finish(st, G + qrow * 1024 + head * 64, ACT + qrow * 1024 + head * 64, h);
  }
}

DI void s5_mats_phase(const Params& p) {
  char* ws = p.ws;
  const float2* POW = (const float2*)(ws + O_POW); const float2* BB = (const float2*)(ws + O_BBAR);
  bf16_t* GT = (bf16_t*)(ws + O_GT); bf16_t* MYT = (bf16_t*)(ws + O_MYT);
  const float* cre = p.in[37]; const float* cim = p.in[38]; const float* dsk = p.in[39];
  const int gt = blockIdx.x * 256 + threadIdx.x, gn = gridDim.x * 256;
  for (int idx = gt; idx < 64 * 256 * 256; idx += gn) {
    const int g = idx >> 16, n = (idx >> 8) & 255, k = idx & 255;
    {
      const int dir = n >> 7, pp = (n >> 1) & 63, ri = n & 1, i = k >> 4, c = k & 15;
      const int e = dir ? i : 15 - i;
      const float2 pw = POW[((size_t)(dir * 64 + g) * 17 + e) * 64 + pp];
      const float2 bb = BB[((size_t)(dir * 64 + g) * 64 + pp) * 16 + c];
      const float zr = pw.x * bb.x - pw.y * bb.y, zi = pw.x * bb.y + pw.y * bb.x;
      GT[idx] = f2bf(ri ? zi : zr);
    }
    {
      const int j = n >> 4, o = n & 15, dir = k >> 7, pp = (k >> 1) & 63, ri = k & 1;
      const int e = dir ? 16 - j : j + 1;
      const float2 pw = POW[((size_t)(dir * 64 + g) * 17 + e) * 64 + pp];
      const size_t ci = ((size_t)(dir * 64 + g) * 16 + o) * 64 + pp;
      const float cr = cre[ci], cm = cim[ci];
      const float zr = cr * pw.x - cm * pw.y, zi = cr * pw.y + cm * pw.x;
      MYT[((size_t)g * 256 + n) * 512 + 256 + k] = f2bf(ri ? -zi : zr);
    }
  }
  for (int idx = gt; idx < 64 * 16 * 256; idx += gn) {
    const int g = idx >> 12, lag = (idx >> 8) & 15, o = (idx >> 4) & 15, c = idx & 15;
    float kf = 0.f, kb = 0.f;
    for (int pp = 0; pp < 64; ++pp) {
      {
        const float2 pw = POW[((size_t)(0 * 64 + g) * 17 + lag) * 64 + pp];
        const float2 bb = BB[((size_t)(0 * 64 + g) * 64 + pp) * 16 + c];
        const size_t ci = ((size_t)(0 * 64 + g) * 16 + o) * 64 + pp;
        const float zr = pw.x * bb.x - pw.y * bb.y, zi = pw.x * bb.y + pw.y * bb.x;
        kf += cre[ci] * zr - cim[ci] * zi;
      }
      {
        const float2 pw = POW[((size_t)(1 * 64 + g) * 17 + lag) * 64 + pp];
        const float2 bb = BB[((size_t)(1 * 64 + g) * 64 + pp) * 16 + c];
        const size_t ci = ((size_t)(1 * 64 + g) * 16 + o) * 64 + pp;
        const float zr = pw.x * bb.x - pw.y * bb.y, zi = pw.x * bb.y + pw.y * bb.x;
        kb += cre[ci] * zr - cim[ci] * zi;
      }
    }
    bf16_t* Mg = MYT + (size_t)g * 256 * 512;
    if (lag == 0) {
      const bf16_t v = f2bf(kf + kb + (o == c ? dsk[g * 16 + o] : 0.f));
      for (int j = 0; j < 16; ++j) Mg[(size_t)(j * 16 + o) * 512 + j * 16 + c] = v;
    } else {
      const bf16_t vf = f2bf(kf), vb = f2bf(kb);
      for (int i = 0; i + lag < 16; ++i) {
        Mg[(size_t)((i + lag) * 16 + o) * 512 + i * 16 + c] = vf;
        Mg[(size_t)(i * 16 + o) * 512 + (i + lag) * 16 + c] = vb;
      }
    }
  }
}

DI void s5_scan_phase(const Params& p) {
  char* ws = p.ws;
  const float2* POW = (const float2*)(ws + O_POW);
  const float* SL = (const float*)(ws + O_SLOC);
  bf16_t* ACAT = (bf16_t*)(ws + O_ACAT);
  for (int gid = blockIdx.x * 256 + threadIdx.x; gid < 65536; gid += gridDim.x * 256) {
    const int pp = gid & 63, g = (gid >> 6) & 63, dir = (gid >> 12) & 1, b = gid >> 13;
    const float2 lam = POW[((size_t)(dir * 64 + g) * 17 + 16) * 64 + pp];
    float hr = 0.f, hi = 0.f;
    for (int q0 = 0; q0 < 144; q0 += 16) {
      float2 s[16];
      _Pragma("unroll") for (int j = 0; j < 16; ++j) {
        const int q = q0 + j;
        const int chunk = q < 16 ? (1024 + b * 16 + (dir ? 15 - q : q)) : (b * 128 + (dir ? 127 - (q - 16) : (q - 16)));
        s[j] = *(const float2*)(SL + ((size_t)g * NCH + chunk) * 256 + dir * 128 + 2 * pp);
      }
      _Pragma("unroll") for (int j = 0; j < 16; ++j) {
        const int q = q0 + j;
        const int chunk = q < 16 ? (1024 + b * 16 + (dir ? 15 - q : q)) : (b * 128 + (dir ? 127 - (q - 16) : (q - 16)));
        *(unsigned*)(ACAT + ((size_t)g * NCH + chunk) * 512 + 256 + dir * 128 + 2 * pp) = pack2(hr, hi);
        const float nr = lam.x * hr - lam.y * hi + s[j].x, ni = lam.x * hi + lam.y * hr + s[j].y;
        hr = nr; hi = ni;
      }
    }
  }
}


#define XB_TMO      128
#define XB_XCNT(j)  (256  + 64 * (j))
#define XB_XSUB(j)  (1280 + 64 * (j))
#define XB_XGEN(j)  (2304 + 64 * (j))
#define XB_TOP      3328
#define XB_TOPGEN   3392
#define XCD_BAR_WORDS 3456
#define XB_SPIN_CAP (1u << 18)
#define LAS __attribute__((address_space(3)))
DI unsigned xb_ld(unsigned* p)              { return __hip_atomic_load(p, __ATOMIC_RELAXED, __HIP_MEMORY_SCOPE_AGENT); }
DI unsigned xb_add(unsigned* p, unsigned v) { return __hip_atomic_fetch_add(p, v, __ATOMIC_RELAXED, __HIP_MEMORY_SCOPE_AGENT); }
DI unsigned xb_xcc_id() { return (unsigned)__builtin_amdgcn_s_getreg((3 << 11) | 20) & 0xFu; }
#define XB_SPIN(cond, bar) do { unsigned _sp = 0; while (cond) { __builtin_amdgcn_s_sleep(1); \
    if ((++_sp & 255u) == 0u) { if (xb_ld(&(bar)[XB_TMO])) break; if (_sp > XB_SPIN_CAP) { atomicAdd(&(bar)[XB_TMO], 1u); break; } } } } while (0)
struct XcdBarrier { unsigned* bar; unsigned x; unsigned nloc, nx; };
DI XcdBarrier xcd_barrier_post(unsigned* bar) {
    XcdBarrier b; b.bar = bar; b.x = xb_xcc_id(); b.nloc = 0u; b.nx = 0u;
    if (threadIdx.x == 0) (void)xb_add(&bar[XB_XCNT(b.x)], 1u);
    return b;
}
DI void xcd_barrier_complete(unsigned* bar, unsigned x, unsigned& nloc, unsigned& nx) {
    const unsigned G = gridDim.x * gridDim.y * gridDim.z;
    unsigned sum, cnt, mine, sp = 0u;
    for (;;) {
        sum = 0u; cnt = 0u; mine = 0u;
#pragma unroll
        for (unsigned j = 0; j < 16; ++j) { const unsigned c = xb_ld(&bar[XB_XCNT(j)]); sum += c; cnt += (c > 0u) ? 1u : 0u; mine = (j == x) ? c : mine; }
        if (sum == G) break;
        __builtin_amdgcn_s_sleep(1);
        if ((++sp & 255u) == 0u) { if (xb_ld(&bar[XB_TMO])) break; if (sp > XB_SPIN_CAP) { atomicAdd(&bar[XB_TMO], 1u); break; } }
    }
    nloc = mine > 0u ? mine : 1u; nx = cnt > 0u ? cnt : 1u;
}
DI void xcd_barrier(XcdBarrier& b) {
    asm volatile("s_waitcnt vmcnt(0)" ::: "memory");
    __syncthreads();
    if (threadIdx.x == 0) {
        unsigned* bar = b.bar;
        __builtin_amdgcn_s_waitcnt(0);
        unsigned nloc = b.nloc, nx = b.nx;
        if (nloc == 0u) { xcd_barrier_complete(bar, b.x, nloc, nx); b.nloc = nloc; b.nx = nx; }
        const unsigned old = xb_add(&bar[XB_XSUB(b.x)], 1u);
        const unsigned gen = old / nloc;
        if (old + 1u == (gen + 1u) * nloc) {
            __builtin_amdgcn_fence(__ATOMIC_RELEASE, "agent");
            asm volatile("s_waitcnt vmcnt(0)" ::: "memory");
            const unsigned og = xb_add(&bar[XB_TOP], 1u);
            const unsigned tg = og / nx;
            if (og + 1u == (tg + 1u) * nx) xb_add(&bar[XB_TOPGEN], 1u);
            else XB_SPIN(xb_ld(&bar[XB_TOPGEN]) == tg, bar);
            __builtin_amdgcn_fence(__ATOMIC_ACQUIRE, "agent");
            xb_add(&bar[XB_XGEN(b.x)], 1u);
            asm volatile("s_waitcnt vmcnt(0)" ::: "memory");
        } else {
            XB_SPIN(xb_ld(&bar[XB_XGEN(b.x)]) == gen, bar);
            __builtin_amdgcn_fence(__ATOMIC_ACQUIRE, "agent");
            asm volatile("s_waitcnt vmcnt(0)" ::: "memory");
        }
    }
    __syncthreads();
}

#define REP_P0 1
#define REP_NORM 1
#define REP_GIN 1
#define REP_LRU 1
#define REP_SWA 1
#define REP_NA 1
#define REP_S5 1
#define REP_SYNC 0
#define PROBE_MODE 0
__global__ void __launch_bounds__(256, 2) fwd_megakernel(Params p) {
  __shared__ __attribute__((aligned(16))) char smem[65536];
  cg::grid_group grid = cg::this_grid();
  char* ws = p.ws;
  XcdBarrier xb = xcd_barrier_post((unsigned*)(ws + O_BAR));
#define GSYNC() xcd_barrier(xb)
  float* MOD = (float*)(ws + O_MOD);
  float* HCTX = (float*)(ws + O_HCTX);
  const bf16_t* NBUF = (const bf16_t*)(ws + O_NBUF);

  for (int rep = 0; rep < REP_P0; ++rep) { phase0(p, smem); grid.sync(); }
  for (int rep = 0; rep < REP_SYNC; ++rep) GSYNC();
  for (int rep = 0; rep < REP_NORM; ++rep) { norm_phase(p.in[0], p.in[2], p.in[6], MOD, (bf16_t*)(ws + O_NBUF0)); GSYNC(); }
  for (int rep = 0; rep < REP_GIN; ++rep) {
    EpiL0In e{(bf16_t*)(ws + O_U0), (bf16_t*)(ws + O_G0)};
    gemm_phase<false>((const bf16_t*)(ws + O_NBUF0), nullptr, 1024, 0, (const bf16_t*)(ws + O_WT_IN0), 1024, 0, R, 2816, 1024, 1, e, smem);
    if (0) gemm_phase<false, EpiL0In, PROBE_MODE>((const bf16_t*)(ws + O_NBUF0), nullptr, 1024, 0, (const bf16_t*)(ws + O_WT_IN0), 1024, 0, R, 2816, 1024, 1, e, smem);
    GSYNC();
  }
  for (int rep = 0; rep < REP_LRU; ++rep) { lru_phase(p, smem); GSYNC(); }
  {
    EpiOut e{p.in[0], p.in[2], p.out, HCTX, MOD + 2048};
    gemm_phase<true>((const bf16_t*)(ws + O_ACT0), (const bf16_t*)(ws + O_ACT0) + (size_t)R * LW, LW, 0, (const bf16_t*)(ws + O_WT_OUT0), LW, 0, R, 1024, LW, 1, e, smem);
  }
  GSYNC();
  for (int rep = 0; rep < REP_NORM; ++rep) { norm_phase(p.out, HCTX, p.in[18], MOD + 9 * 3072, (bf16_t*)(ws + O_NBUF)); GSYNC(); }
  for (int rep = 0; rep < REP_GIN; ++rep) {
    EpiL1In e{(bf16_t*)(ws + O_Q1), (bf16_t*)(ws + O_QR1), (bf16_t*)(ws + O_K1), (bf16_t*)(ws + O_VTL1), (bf16_t*)(ws + O_VTC1), (bf16_t*)(ws + O_G1),
              (const float*)(ws + O_ROPEC), (const float*)(ws + O_ROPES)};
    gemm_phase<false>(NBUF, nullptr, 1024, 0, (const bf16_t*)(ws + O_WT_IN1), 1024, 0, R, 2560, 1024, 1, e, smem);
    if (0) gemm_phase<false, EpiL1In, PROBE_MODE>(NBUF, nullptr, 1024, 0, (const bf16_t*)(ws + O_WT_IN1), 1024, 0, R, 2560, 1024, 1, e, smem);
    GSYNC();
  }
  for (int rep = 0; rep < REP_SWA; ++rep) { swa_phase(p); GSYNC(); }
  {
    EpiOut e{p.out, HCTX, p.out, HCTX, MOD + 9 * 3072 + 2048};
    gemm_phase<false>((const bf16_t*)(ws + O_ACT1), nullptr, 1024, 0, (const bf16_t*)(ws + O_WT_OUT1), 1024, 0, R, 1024, 1024, 1, e, smem);
  }
  GSYNC();
  for (int rep = 0; rep < REP_NORM; ++rep) { norm_phase(p.out, HCTX, p.in[24], MOD + 2 * 9 * 3072, (bf16_t*)(ws + O_NBUF)); GSYNC(); }
  for (int rep = 0; rep < REP_GIN; ++rep) {
    EpiL2In e{(bf16_t*)(ws + O_Q2), (bf16_t*)(ws + O_K2), (bf16_t*)(ws + O_VTL2), (bf16_t*)(ws + O_VTC2), (bf16_t*)(ws + O_G2)};
    gemm_phase<false>(NBUF, nullptr, 1024, 0, (const bf16_t*)(ws + O_WT_IN2), 1024, 0, R, 4096, 1024, 1, e, smem);
    if (PROBE_MODE) gemm_phase<false, EpiL2In, PROBE_MODE>(NBUF, nullptr, 1024, 0, (const bf16_t*)(ws + O_WT_IN2), 1024, 0, R, 4096, 1024, 1, e, smem);
    GSYNC();
  }
  for (int rep = 0; rep < REP_NA; ++rep) { na_phase(p, smem); GSYNC(); }
  {
    EpiOut e{p.out, HCTX, p.out, HCTX, MOD + 2 * 9 * 3072 + 2048};
    gemm_phase<false>((const bf16_t*)(ws + O_ACT2), nullptr, 1024, 0, (const bf16_t*)(ws + O_WT_OUT2), 1024, 0, R, 1024, 1024, 1, e, smem);
  }
  GSYNC();
  for (int rep = 0; rep < REP_NORM; ++rep) { norm_phase(p.out, HCTX, p.in[30], MOD + 3 * 9 * 3072, (bf16_t*)(ws + O_NBUF)); GSYNC(); }
  for (int rep = 0; rep < REP_S5; ++rep) { s5_mats_phase(p); GSYNC(); }
  for (int rep = 0; rep < REP_GIN; ++rep) {
    EpiL3In e{(bf16_t*)(ws + O_ACAT), (bf16_t*)(ws + O_G3)};
    gemm_phase<false>(NBUF, nullptr, 1024, 0, (const bf16_t*)(ws + O_WT_IN3), 1024, 0, R, 2048, 1024, 1, e, smem);
    if (0) gemm_phase<false, EpiL3In, PROBE_MODE>(NBUF, nullptr, 1024, 0, (const bf16_t*)(ws + O_WT_IN3), 1024, 0, R, 2048, 1024, 1, e, smem);
    GSYNC();
  }
  for (int rep = 0; rep < REP_S5; ++rep) {
    EpiS5State e{(float*)(ws + O_SLOC)};
    gemm_phase<false>((const bf16_t*)(ws + O_ACAT), nullptr, 512, (size_t)NCH * 512, (const bf16_t*)(ws + O_GT), 256, (size_t)256 * 256, NCH, 256, 256, 64, e, smem);
    GSYNC();
  }
  for (int rep = 0; rep < REP_S5; ++rep) { s5_scan_phase(p); GSYNC(); }
  for (int rep = 0; rep < REP_S5; ++rep) {
    EpiS5Y e{(bf16_t*)(ws + O_YG)};
    gemm_phase<false>((const bf16_t*)(ws + O_ACAT), nullptr, 512, (size_t)NCH * 512, (const bf16_t*)(ws + O_MYT), 512, (size_t)256 * 512, 1024, 256, 512, 64, e, smem);
    GSYNC();
  }
  {
    EpiGlu e{(const bf16_t*)(ws + O_YG), (const bf16_t*)(ws + O_G3), p.in[41], (bf16_t*)(ws + O_ACT3)};
    gemm_phase<false>((const bf16_t*)(ws + O_YG), nullptr, 1024, 0, (const bf16_t*)(ws + O_WT_GLU), 1024, 0, RL, 1024, 1024, 1, e, smem);
  }
  GSYNC();
  {
    EpiOut e{p.out, HCTX, p.out, HCTX, MOD + 3 * 9 * 3072 + 2048};
    gemm_phase<false>((const bf16_t*)(ws + O_ACT3), nullptr, 1024, 0, (const bf16_t*)(ws + O_WT_OUT3), 1024, 0, RL, 1024, 1024, 1, e, smem);
  }
  GSYNC();
  final_norm_phase(p.out, p.in[43]);
}

extern "C" void kernel_launch(void* const* d_in, const int* in_sizes, int n_in, void* d_out, int out_size, void* d_ws, size_t ws_size,
                              hipStream_t stream) {
  static int grid_blocks = 0;
  if (!grid_blocks) {
    int dev = 0, cus = 0, per_cu = 0;
    hipGetDevice(&dev);
    hipDeviceGetAttribute(&cus, hipDeviceAttributeMultiprocessorCount, dev);
    hipOccupancyMaxActiveBlocksPerMultiprocessor(&per_cu, fwd_megakernel, 256, 0);
    if (per_cu > 2) per_cu = 2;
    if (per_cu < 1) per_cu = 1;
    grid_blocks = cus * per_cu;
  }
  if (n_in != 44 || ws_size < WS_END) { fprintf(stderr, "kernel_launch: unexpected n_in %d or ws_size %zu < %zu\n", n_in, ws_size, (size_t)WS_END); return; }
  Params p{};
  for (int i = 0; i < 44; ++i) p.in[i] = (const float*)d_in[i];
  p.out = (float*)d_out;
  p.ws = (char*)d_ws;
  if (hipMemsetAsync((char*)d_ws + O_BAR, 0, 16384, stream) != hipSuccess) { fprintf(stderr, "memset failed\n"); return; }
  void* args[] = {&p};
  hipError_t e = hipLaunchCooperativeKernel((void*)fwd_megakernel, dim3(grid_blocks), dim3(256), args, 0, stream);
  if (e != hipSuccess) fprintf(stderr, "cooperative launch failed: %s (grid %d)\n", hipGetErrorString(e), grid_blocks);
}
```

```cpp
#include <hip/hip_runtime.h>
#include <hip/hip_cooperative_groups.h>
#include <cstdio>
namespace cg = cooperative_groups;

#define DI __device__ __forceinline__
typedef unsigned short bf16_t;
typedef short bf16x8 __attribute__((ext_vector_type(8)));
typedef short s16x4 __attribute__((ext_vector_type(4)));
typedef float f32x16 __attribute__((ext_vector_type(16)));
typedef float f32x4 __attribute__((ext_vector_type(4)));
typedef unsigned u32x2 __attribute__((ext_vector_type(2)));
typedef unsigned u32x4 __attribute__((ext_vector_type(4)));

#define MFMA32(a, b, c) __builtin_amdgcn_mfma_f32_32x32x16_bf16((a), (b), (c), 0, 0, 0)
#define MFMA16(a, b, c) __builtin_amdgcn_mfma_f32_16x16x32_bf16((a), (b), (c), 0, 0, 0)

constexpr int D = 1024, NB = 8, SEQ = 2048, CTXL = 256;
constexpr int RL = NB * SEQ;
constexpr int RC = NB * CTXL;
constexpr int R = RL + RC;
constexpr int LW = 1408;
constexpr int NCH = R / 16;
constexpr int NCHP = 1280;

constexpr size_t O_WT_IN0 = 0;
constexpr size_t O_WT_OUT0 = O_WT_IN0 + (size_t)2816 * 1024 * 2;
constexpr size_t O_WT_IN1 = O_WT_OUT0 + (size_t)1024 * 2816 * 2;
constexpr size_t O_WT_OUT1 = O_WT_IN1 + (size_t)2560 * 1024 * 2;
constexpr size_t O_WT_IN2 = O_WT_OUT1 + (size_t)1024 * 1024 * 2;
constexpr size_t O_WT_OUT2 = O_WT_IN2 + (size_t)4096 * 1024 * 2;
constexpr size_t O_WT_IN3 = O_WT_OUT2 + (size_t)1024 * 1024 * 2;
constexpr size_t O_WT_GLU = O_WT_IN3 + (size_t)2048 * 1024 * 2;
constexpr size_t O_WT_OUT3 = O_WT_GLU + (size_t)1024 * 1024 * 2;
constexpr size_t O_WG = O_WT_OUT3 + (size_t)1024 * 1024 * 2;
constexpr size_t O_MOD = O_WG + (size_t)16 * 2 * 192 * 96 * 2;
constexpr size_t O_ROPEC = O_MOD + (size_t)4 * 9 * 3072 * 4;
constexpr size_t O_ROPES = O_ROPEC + (size_t)2048 * 32 * 4;
constexpr size_t O_POW = O_ROPES + (size_t)2048 * 32 * 4;
constexpr size_t O_BBAR = O_POW + (size_t)2 * 64 * 17 * 64 * 8;
constexpr size_t O_HCTX = O_BBAR + (size_t)2 * 64 * 64 * 16 * 8;
constexpr size_t O_BAR = O_HCTX + (size_t)RC * 1024 * 4;
constexpr size_t O_DYN = O_BAR + 16384;
constexpr size_t O_U0 = O_DYN;
constexpr size_t O_G0 = O_U0 + (size_t)R * LW * 2;
constexpr size_t O_ACT0 = O_G0 + (size_t)R * LW * 2;
constexpr size_t O_NBUF0 = O_ACT0;
constexpr size_t O_NBUF = O_DYN;
constexpr size_t O_Q1 = O_NBUF + (size_t)R * 1024 * 2;
constexpr size_t O_QR1 = O_Q1 + (size_t)R * 1024 * 2;
constexpr size_t O_K1 = O_QR1 + (size_t)RL * 1024 * 2;
constexpr size_t O_VTL1 = O_K1 + (size_t)R * 256 * 2;
constexpr size_t O_VTC1 = O_VTL1 + (size_t)8 * 4 * 64 * 2048 * 2;
constexpr size_t O_G1 = O_VTC1 + (size_t)8 * 4 * 64 * 256 * 2;
constexpr size_t O_ACT1 = O_G1 + (size_t)R * 1024 * 2;
constexpr size_t O_Q2 = O_NBUF + (size_t)R * 1024 * 2;
constexpr size_t O_K2 = O_Q2 + (size_t)R * 1024 * 2;
constexpr size_t O_VTL2 = O_K2 + (size_t)R * 1024 * 2;
constexpr size_t O_VTC2 = O_VTL2 + (size_t)8 * 16 * 64 * 2048 * 2;
constexpr size_t O_G2 = O_VTC2 + (size_t)8 * 16 * 64 * 256 * 2;
constexpr size_t O_ACT2 = O_NBUF;
constexpr size_t O_SLOC = O_DYN;
constexpr size_t O_YG = O_DYN;
constexpr size_t O_ACT3 = O_YG + (size_t)RL * 1024 * 2;
constexpr size_t O_ACAT = O_DYN + (size_t)64 * NCHP * 256 * 4;
constexpr size_t O_G3 = O_ACAT + (size_t)64 * NCH * 512 * 2;
constexpr size_t O_GT = O_WT_IN2;
constexpr size_t O_MYT = O_WT_IN0;
static_assert(O_WT_OUT1 - O_WT_IN0 == (size_t)64 * 256 * 512 * 2 && O_WT_OUT2 - O_WT_IN2 == (size_t)64 * 256 * 256 * 2, "S5 matrix aliases");
constexpr size_t WS_END = O_ACT0 + (size_t)R * LW * 2 * 2;
static_assert(O_G3 + (size_t)RL * 1024 * 2 <= WS_END && O_ACT1 + (size_t)R * 1024 * 2 <= WS_END && O_G2 + (size_t)R * 1024 * 2 <= WS_END, "workspace map");
static_assert(WS_END <= (size_t)256 * 1024 * 1024, "workspace budget");

struct Params {
  const float* in[44];
  float* out;
  char* ws;
};

typedef __bf16 bf16n2 __attribute__((ext_vector_type(2)));
DI bf16_t f2bf(float x) { const __bf16 b = (__bf16)x; return __builtin_bit_cast(unsigned short, b); }
DI float bf2f(bf16_t b) { return __uint_as_float(((unsigned)b) << 16); }
DI unsigned pack2(float lo, float hi) { bf16n2 v; v[0] = (__bf16)lo; v[1] = (__bf16)hi; return __builtin_bit_cast(unsigned, v); }
DI float bflo(unsigned u) { return __uint_as_float(u << 16); }
DI float bfhi(unsigned u) { return __uint_as_float(u & 0xffff0000u); }
DI float frcp(float x) { return __builtin_amdgcn_rcpf(x); }
DI float sigm(float x) { return frcp(1.f + __expf(-x)); }
DI float silu(float x) { return x * frcp(1.f + __expf(-x)); }
DI float gelu_tanh(float x) {
  float z = 0.7978845608028654f * (x + 0.044715f * x * x * x);
  float e = __expf(2.f * z);
  float t = 1.f - 2.f * frcp(e + 1.f);
  return 0.5f * x * (1.f + t);
}
DI int opaque_tid() { int t = threadIdx.x; asm volatile("" : "+v"(t)); return t; }
DI int crow(int i, int h) { return (i & 3) + 8 * (i >> 2) + 4 * h; }
DI f32x16 zero16() { f32x16 z; _Pragma("unroll") for (int i = 0; i < 16; ++i) z[i] = 0.f; return z; }
DI void sincos_rev(float rev, float& s, float& c) { rev = rev - rintf(rev); s = __builtin_amdgcn_sinf(rev); c = __builtin_amdgcn_cosf(rev); }

#define LAS __attribute__((address_space(3)))
namespace pg8 {
constexpr int BM = 256, BK = 64, HALF = 128, HTB = HALF * BK * 2, STAGE_BYTES = 8 * HTB;
DI int lds_byte(int r, int c) { const int st = (r >> 4) * 2 + (c >> 5), rr = r & 15, cc = c & 31, ob = rr * 64 + cc * 2; return st * 1024 + (ob ^ (((ob >> 9) & 1) << 5)); }
DI void stage_rc(int b, int& R_, int& C_) { const int st = b / 1024, sb = b % 1024, swz = sb ^ (((sb >> 9) & 1) << 5); R_ = (st >> 1) * 16 + swz / 64; C_ = (st & 1) * 32 + (swz % 64) / 2; }
DI int perm32(int rho) { const int n = rho >> 4, i = rho & 15; return 8 * (i >> 2) + 4 * n + (i & 3); }
struct Unit { int pm, pn, pb; };
struct Gemm { const bf16_t* A; const bf16_t* Bt; int lda, ldb, K, nM, nN, nB; int strideA, strideB; int rot; };
DI bool next_unit(const Gemm& g, int i, Unit& u) {
  const int G = gridDim.x, per = g.nM * g.nN, nwg = per * g.nB;
  const int c = (blockIdx.x + g.rot) % G;
  const long L = (long)i * G + c;
  if (L >= nwg) return false;
  int wgid = (int)L;
  { const int q = nwg / 8, r = nwg % 8, xcd = wgid % 8, off = wgid / 8; wgid = (xcd < r ? xcd * (q + 1) : r * (q + 1) + (xcd - r) * q) + off; }
  const int pb = wgid / per, w = wgid - pb * per;
  const int nig = 8 * g.nN, gid = w / nig, fm = gid * 8, gsz = (g.nM - fm) < 8 ? (g.nM - fm) : 8;
  u.pb = pb; u.pm = fm + ((w % nig) % gsz); u.pn = (w % nig) / gsz;
  return true;
}

template <class Epi>
DI void gemm_phase(LAS unsigned char* lds, const Gemm g, const Epi& E) {
  const int tid = opaque_tid(), wid = __builtin_amdgcn_readfirstlane(tid >> 6), lane = tid & 63, wr = wid >> 2, wc = wid & 3, fr = lane & 15, fq = lane >> 4;
  const int K = g.K, nt = K / BK;
  unsigned voffA[2], voffB[2];
#pragma unroll
  for (int i = 0; i < 2; ++i) { int R_, C_; stage_rc(tid * 16 + i * 8192, R_, C_); const int Rb = Epi::PERM ? ((R_ & ~31) + perm32(R_ & 31)) : R_;
    voffA[i] = (unsigned)(R_ * g.lda + C_) * 2u; voffB[i] = (unsigned)(Rb * g.ldb + C_) * 2u; }
  const size_t kstep = (size_t)(BK * 2);
  const size_t hstepA = (size_t)HALF * g.lda * 2, hstepB = (size_t)HALF * g.ldb * 2;
  const size_t tstepA = 2 * hstepA, tstepB = 2 * hstepB;
  const unsigned ldsw = (unsigned)wid * 1024u;
  const int aoff = lds_byte(wr * 64 + fr, fq * 8), boff = lds_byte(wc * 32 + fr, fq * 8);
#define PG8_SA(b, h) (((b) * 2 + (h)) * HTB)
#define PG8_SB(b, h) ((4 + (b) * 2 + (h)) * HTB)
#define PG8_STAGE(bufoff, gbase, voff) do { _Pragma("unroll") for (int _i = 0; _i < 2; ++_i) \
        __builtin_amdgcn_global_load_lds((const unsigned*)((const char*)(gbase) + (voff)[_i]), (LAS unsigned*)(lds + (bufoff) + ldsw + _i * 8192), 16, 0, 0); } while (0)
#define PG8_LDA(dst, b, h) do { _Pragma("unroll") for (int m = 0; m < 4; ++m) _Pragma("unroll") for (int k = 0; k < 2; ++k) dst[m][k] = *(const LAS bf16x8*)(lds + PG8_SA(b, h) + aoff + m * 2048 + k * 1024); } while (0)
#define PG8_LDB(dst, b, h) do { _Pragma("unroll") for (int n = 0; n < 2; ++n) _Pragma("unroll") for (int k = 0; k < 2; ++k) dst[n][k] = *(const LAS bf16x8*)(lds + PG8_SB(b, h) + boff + n * 2048 + k * 1024); } while (0)
#define PG8_MMA(ai, bj, At, Bt) do { __builtin_amdgcn_s_setprio(1); _Pragma("unroll") for (int m = 0; m < 4; ++m) _Pragma("unroll") for (int n = 0; n < 2; ++n) _Pragma("unroll") for (int k = 0; k < 2; ++k) \
        acc[ai][bj][m][n] = __builtin_amdgcn_mfma_f32_16x16x32_bf16(Bt[n][k], At[m][k], acc[ai][bj][m][n], 0, 0, 0); __builtin_amdgcn_s_setprio(0); } while (0)
#define PG8_WAIT_V(n) asm volatile("s_waitcnt vmcnt(" #n ")" ::: "memory")
#define PG8_WAIT_L(n) asm volatile("s_waitcnt lgkmcnt(" #n ")" ::: "memory")
#define PG8_BAR __builtin_amdgcn_s_barrier()
#define PG8_SCHED __builtin_amdgcn_sched_barrier(0)
  Unit cur, nxt; int ui = 0;
  if (!next_unit(g, 0, cur)) return;
  f32x4 acc[2][2][4][2];
#pragma unroll
  for (int a = 0; a < 2; ++a)
#pragma unroll
    for (int b = 0; b < 2; ++b)
#pragma unroll
      for (int m = 0; m < 4; ++m)
#pragma unroll
        for (int n = 0; n < 2; ++n) acc[a][b][m][n] = (f32x4){0.f, 0.f, 0.f, 0.f};
  bf16x8 At[4][2], B0[2][2], B1[2][2];
  const char* cA = (const char*)(g.A + (size_t)cur.pb * g.strideA) + (size_t)cur.pm * tstepA;
  const char* cB = (const char*)(g.Bt + (size_t)cur.pb * g.strideB) + (size_t)cur.pn * tstepB;
  PG8_STAGE(PG8_SB(0, 0), cB, voffB); PG8_STAGE(PG8_SA(0, 0), cA, voffA); PG8_STAGE(PG8_SB(0, 1), cB + hstepB, voffB); PG8_STAGE(PG8_SA(0, 1), cA + hstepA, voffA);
  if (wr == 1) PG8_BAR;
  PG8_WAIT_V(4); PG8_BAR;
  PG8_STAGE(PG8_SB(1, 0), cB + kstep, voffB); PG8_STAGE(PG8_SA(1, 0), cA + kstep, voffA); PG8_STAGE(PG8_SB(1, 1), cB + hstepB + kstep, voffB);
  PG8_WAIT_V(6); PG8_BAR;
  for (;;) {
    const bool has_next = next_unit(g, ui + 1, nxt);
    const char* nA = has_next ? (const char*)(g.A + (size_t)nxt.pb * g.strideA) + (size_t)nxt.pm * tstepA : cA;
    const char* nB = has_next ? (const char*)(g.Bt + (size_t)nxt.pb * g.strideB) + (size_t)nxt.pn * tstepB : cB;
    for (int t = 0; t < nt; t += 2) {
      const bool last = (t == nt - 2);
      const char* a1 = cA + (size_t)(t + 1) * kstep;
      const char* a2 = last ? nA : cA + (size_t)(t + 2) * kstep; const char* b2 = last ? nB : cB + (size_t)(t + 2) * kstep;
      const char* a3 = a2 + kstep; const char* b3 = b2 + kstep;
      PG8_LDB(B0, 0, 0); PG8_SCHED; PG8_LDA(At, 0, 0); PG8_STAGE(PG8_SA(1, 1), a1 + hstepA, voffA);
      PG8_WAIT_L(8); PG8_BAR; PG8_WAIT_L(0); PG8_MMA(0, 0, At, B0); PG8_BAR; PG8_SCHED;
      PG8_LDB(B1, 0, 1); PG8_STAGE(PG8_SB(0, 0), b2, voffB);
      PG8_BAR; PG8_WAIT_L(0); PG8_MMA(0, 1, At, B1); PG8_BAR;
      PG8_LDA(At, 0, 1); PG8_STAGE(PG8_SA(0, 0), a2, voffA);
      PG8_BAR; PG8_WAIT_L(0); PG8_MMA(1, 0, At, B0); PG8_BAR; PG8_SCHED;
      PG8_STAGE(PG8_SB(0, 1), b2 + hstepB, voffB);
      PG8_WAIT_V(6); PG8_BAR; PG8_MMA(1, 1, At, B1); PG8_BAR;
      PG8_LDB(B0, 1, 0); PG8_SCHED; PG8_LDA(At, 1, 0); PG8_STAGE(PG8_SA(0, 1), a2 + hstepA, voffA);
      PG8_WAIT_L(8); PG8_BAR; PG8_WAIT_L(0); PG8_MMA(0, 0, At, B0); PG8_BAR; PG8_SCHED;
      PG8_LDB(B1, 1, 1); PG8_STAGE(PG8_SB(1, 0), b3, voffB);
      PG8_BAR; PG8_WAIT_L(0); PG8_MMA(0, 1, At, B1); PG8_BAR;
      PG8_LDA(At, 1, 1); PG8_STAGE(PG8_SA(1, 0), a3, voffA);
      PG8_BAR; PG8_WAIT_L(0); PG8_MMA(1, 0, At, B0); PG8_BAR; PG8_SCHED;
      PG8_STAGE(PG8_SB(1, 1), b3 + hstepB, voffB);
      PG8_WAIT_V(6); PG8_BAR; PG8_MMA(1, 1, At, B1); PG8_BAR;
    }
    E(acc, cur, wr, wc, fr, fq);
    if (!has_next) break;
#pragma unroll
    for (int a = 0; a < 2; ++a)
#pragma unroll
      for (int b = 0; b < 2; ++b)
#pragma unroll
        for (int m = 0; m < 4; ++m)
#pragma unroll
          for (int n = 0; n < 2; ++n) acc[a][b][m][n] = (f32x4){0.f, 0.f, 0.f, 0.f};
    cur = nxt; cA = nA; cB = nB; ++ui;
  }
  PG8_WAIT_V(0);
  if (wr == 0) PG8_BAR;
  PG8_BAR;
#undef PG8_SA
#undef PG8_SB
#undef PG8_STAGE
#undef PG8_LDA
#undef PG8_LDB
#undef PG8_MMA
#undef PG8_WAIT_V
#undef PG8_WAIT_L
#undef PG8_BAR
#undef PG8_SCHED
}
}
using pg8::Unit;
typedef f32x4 AccT[2][2][4][2];

DI void asm_fence() { asm volatile("" ::: "memory"); }
#define EPI_ROWS _Pragma("unroll") for (int ai = 0; ai < 2; ++ai) _Pragma("unroll") for (int m = 0; m < 4; ++m) if ((asm_fence(), true))
DI u32x4 pack8f(const f32x4& a, const f32x4& b) { u32x4 w; w[0] = pack2(a[0], a[1]); w[1] = pack2(a[2], a[3]); w[2] = pack2(b[0], b[1]); w[3] = pack2(b[2], b[3]); return w; }
DI size_t k_off(int t, int d) { return (size_t)(t >> 5) * 2048 + (((d >> 4) * 64 + ((d >> 3) & 1) * 32 + (t & 31)) << 3) + (d & 7); }

struct EpiL0In {
  static constexpr bool PERM = true;
  bf16_t* U0; bf16_t* G0;
  DI void operator()(const AccT& acc, const Unit& u, int wr, int wc, int fr, int fq) const {
    EPI_ROWS { const int row = u.pm * 256 + ai * 128 + wr * 64 + m * 16 + fr;
      _Pragma("unroll") for (int bj = 0; bj < 2; ++bj) { const int c0 = u.pn * 256 + bj * 128 + wc * 32 + 8 * fq;
        bf16_t* dst = c0 < LW ? U0 + (size_t)row * LW + c0 : G0 + (size_t)row * LW + (c0 - LW);
        *(u32x4*)dst = pack8f(acc[ai][bj][m][0], acc[ai][bj][m][1]); } }
  }
};

struct EpiOut {
  static constexpr bool PERM = false;
  const float* in_lat; const float* in_ctx; float* out_lat; float* out_ctx; const float* gate;
  DI void operator()(const AccT& acc, const Unit& u, int wr, int wc, int fr, int fq) const {
    const int rb = u.pm * 256;
    const float* src; float* dst; const float* g; int rr;
    if (rb < RL) { src = in_lat; dst = out_lat; rr = rb; g = gate + (size_t)(rb >> 11) * 3072; }
    else { src = in_ctx; dst = out_ctx; rr = rb - RL; g = gate + (size_t)8 * 3072; }
    EPI_ROWS { const int row = rr + ai * 128 + wr * 64 + m * 16 + fr;
      _Pragma("unroll") for (int bj = 0; bj < 2; ++bj) _Pragma("unroll") for (int n = 0; n < 2; ++n) {
        const int c = u.pn * 256 + bj * 128 + wc * 32 + 16 * n + 4 * fq;
        const f32x4 hv = *(const f32x4*)(src + (size_t)row * 1024 + c), gv = *(const f32x4*)(g + c);
        *(f32x4*)(dst + (size_t)row * 1024 + c) = hv + gv * acc[ai][bj][m][n]; } }
  }
};

struct EpiL1 {
  static constexpr bool PERM = true;
  bf16_t *Q, *QR, *Kb, *G; const float *rc, *rs;
  DI void operator()(const AccT& acc, const Unit& u, int wr, int wc, int fr, int fq) const {
    const int rb = u.pm * 256; const bool lat = rb < RL;
    EPI_ROWS { const int row = rb + ai * 128 + wr * 64 + m * 16 + fr;
      _Pragma("unroll") for (int bj = 0; bj < 2; ++bj) { const int c0 = u.pn * 256 + bj * 128 + wc * 32 + 8 * fq;
        const f32x4 v0 = acc[ai][bj][m][0], v1 = acc[ai][bj][m][1];
        if (c0 < 1280) {
          const int d0 = (c0 & 63) >> 1;
          float x1[4] = {v0[0], v0[2], v1[0], v1[2]}, x2[4] = {v0[1], v0[3], v1[1], v1[3]};
          float y1[4], y2[4];
          int t = 0;
          if (lat) {
            t = row & 2047;
            const f32x4 c4 = *(const f32x4*)(rc + t * 32 + d0), s4 = *(const f32x4*)(rs + t * 32 + d0);
            _Pragma("unroll") for (int j = 0; j < 4; ++j) { y1[j] = x1[j] * c4[j] - x2[j] * s4[j]; y2[j] = x2[j] * c4[j] + x1[j] * s4[j]; }
          } else { t = (row - RL) & 255; _Pragma("unroll") for (int j = 0; j < 4; ++j) { y1[j] = x1[j]; y2[j] = x2[j]; } }
          if (c0 < 1024) {
            const size_t o = (size_t)row * 1024 + (c0 & ~63) + d0;
            u32x2 a, b2; a[0] = pack2(x1[0] * 0.125f, x1[1] * 0.125f); a[1] = pack2(x1[2] * 0.125f, x1[3] * 0.125f);
            b2[0] = pack2(x2[0] * 0.125f, x2[1] * 0.125f); b2[1] = pack2(x2[2] * 0.125f, x2[3] * 0.125f);
            *(u32x2*)(Q + o) = a; *(u32x2*)(Q + o + 32) = b2;
            if (lat) {
              a[0] = pack2(y1[0] * 0.125f, y1[1] * 0.125f); a[1] = pack2(y1[2] * 0.125f, y1[3] * 0.125f);
              b2[0] = pack2(y2[0] * 0.125f, y2[1] * 0.125f); b2[1] = pack2(y2[2] * 0.125f, y2[3] * 0.125f);
              *(u32x2*)(QR + o) = a; *(u32x2*)(QR + o + 32) = b2;
            }
          } else {
            const int kvh = (c0 - 1024) >> 6;
            bf16_t* kh = lat ? Kb + (size_t)((row >> 11) * 4 + kvh) * 64 * 2048 : Kb + (size_t)RL * 256 + (size_t)(((row - RL) >> 8) * 4 + kvh) * 8 * 2048;
            u32x2 a, b2; a[0] = pack2(y1[0], y1[1]); a[1] = pack2(y1[2], y1[3]); b2[0] = pack2(y2[0], y2[1]); b2[1] = pack2(y2[2], y2[3]);
            *(u32x2*)(kh + k_off(t, d0)) = a; *(u32x2*)(kh + k_off(t, d0 + 32)) = b2;
          }
        } else {
          *(u32x4*)(G + (size_t)row * 1024 + (c0 - 1280)) = pack8f(v0, v1);
        } } }
  }
};

template <int H>
struct EpiV {
  static constexpr bool PERM = true;
  bf16_t *VtL, *VtC;
  DI void operator()(const AccT& acc, const Unit& u, int wr, int wc, int fr, int fq) const {
    const bool latn = u.pn * 256 < RL;
    bf16_t* basep = latn ? VtL : VtC;
    const int tsh = latn ? 11 : 8, tiles = latn ? 64 : 8;
    const int nb = (latn ? u.pn * 256 : u.pn * 256 - RL) + wc * 32 + 8 * fq;
    EPI_ROWS { const int rowd = u.pm * 256 + ai * 128 + wr * 64 + m * 16 + fr, head = rowd >> 6, d = rowd & 63;
      const unsigned rowoff = (unsigned)(((d >> 5) * 128 + (d & 31)) << 3);
      _Pragma("unroll") for (int bj = 0; bj < 2; ++bj) { const int nn = nb + bj * 128;
        const int bidx = nn >> tsh, t = nn & ((1 << tsh) - 1);
        const unsigned off = (unsigned)(((bidx * H + head) * tiles + (t >> 5)) * 2048) + rowoff + (unsigned)((((t & 31) >> 4) * 64) << 3) + (unsigned)(((t >> 3) & 1) * 4);
        const f32x4 v0 = acc[ai][bj][m][0], v1 = acc[ai][bj][m][1];
        u32x2 a, b2; a[0] = pack2(v0[0], v0[1]); a[1] = pack2(v0[2], v0[3]); b2[0] = pack2(v1[0], v1[1]); b2[1] = pack2(v1[2], v1[3]);
        *(u32x2*)(basep + off) = a; *(u32x2*)(basep + off + 256) = b2; } }
  }
};

struct EpiL2 {
  static constexpr bool PERM = true;
  bf16_t *Q, *Kb, *G;
  DI void operator()(const AccT& acc, const Unit& u, int wr, int wc, int fr, int fq) const {
    const int rb = u.pm * 256; const bool lat = rb < RL;
    EPI_ROWS { const int row = rb + ai * 128 + wr * 64 + m * 16 + fr;
      _Pragma("unroll") for (int bj = 0; bj < 2; ++bj) { const int c0 = u.pn * 256 + bj * 128 + wc * 32 + 8 * fq;
        const f32x4 v0 = acc[ai][bj][m][0], v1 = acc[ai][bj][m][1];
        if (c0 < 1024) *(u32x4*)(Q + (size_t)row * 1024 + c0) = pack8f(v0 * 0.125f, v1 * 0.125f);
        else if (c0 < 2048) {
          const int hd = (c0 - 1024) >> 6, d0 = c0 & 63;
          bf16_t* kh; int t;
          if (lat) { kh = Kb + (size_t)((row >> 11) * 16 + hd) * 64 * 2048; t = row & 2047; }
          else { const int rr = row - RL; kh = Kb + (size_t)RL * 1024 + (size_t)((rr >> 8) * 16 + hd) * 8 * 2048; t = rr & 255; }
          *(u32x4*)(kh + k_off(t, d0)) = pack8f(v0, v1);
        } else *(u32x4*)(G + (size_t)row * 1024 + (c0 - 2048)) = pack8f(v0, v1); } }
  }
};

struct EpiL3In {
  static constexpr bool PERM = true;
  bf16_t *ACAT, *G;
  DI void operator()(const AccT& acc, const Unit& u, int wr, int wc, int fr, int fq) const {
    EPI_ROWS { const int row = u.pm * 256 + ai * 128 + wr * 64 + m * 16 + fr;
      _Pragma("unroll") for (int bj = 0; bj < 2; ++bj) { const int c0 = u.pn * 256 + bj * 128 + wc * 32 + 8 * fq;
        const u32x4 w = pack8f(acc[ai][bj][m][0], acc[ai][bj][m][1]);
        if (c0 < 1024) *(u32x4*)(ACAT + ((size_t)(c0 >> 4) * NCH + (row >> 4)) * 512 + (row & 15) * 16 + (c0 & 15)) = w;
        else if (row < RL) *(u32x4*)(G + (size_t)row * 1024 + (c0 - 1024)) = w; } }
  }
};

struct EpiS5State {
  static constexpr bool PERM = false;
  float* S;
  DI void operator()(const AccT& acc, const Unit& u, int wr, int wc, int fr, int fq) const {
    float* sp = S + ((size_t)u.pb * NCHP + u.pm * 256) * 256 + wc * 32 + 4 * fq;
    EPI_ROWS { const unsigned o = (unsigned)(ai * 128 + wr * 64 + m * 16 + fr) * 256u;
      *(f32x4*)(sp + o) = acc[ai][0][m][0]; *(f32x4*)(sp + o + 16) = acc[ai][0][m][1];
      *(f32x4*)(sp + o + 128) = acc[ai][1][m][0]; *(f32x4*)(sp + o + 144) = acc[ai][1][m][1]; }
  }
};

struct EpiS5Y {
  static constexpr bool PERM = true;
  bf16_t* YG;
  DI void operator()(const AccT& acc, const Unit& u, int wr, int wc, int fr, int fq) const {
    EPI_ROWS { const int chunk = u.pm * 256 + ai * 128 + wr * 64 + m * 16 + fr;
      _Pragma("unroll") for (int bj = 0; bj < 2; ++bj) { const int n0 = bj * 128 + wc * 32 + 8 * fq;
        f32x4 v0 = acc[ai][bj][m][0], v1 = acc[ai][bj][m][1];
        _Pragma("unroll") for (int j = 0; j < 4; ++j) { v0[j] = gelu_tanh(v0[j]); v1[j] = gelu_tanh(v1[j]); }
        *(u32x4*)(YG + ((size_t)chunk * 16 + (n0 >> 4)) * 1024 + u.pb * 16 + (n0 & 15)) = pack8f(v0, v1); } }
  }
};

struct EpiGlu {
  static constexpr bool PERM = true;
  const bf16_t *YG, *G; const float* gb; bf16_t* ACT;
  DI void operator()(const AccT& acc, const Unit& u, int wr, int wc, int fr, int fq) const {
    EPI_ROWS { const int row = u.pm * 256 + ai * 128 + wr * 64 + m * 16 + fr;
      _Pragma("unroll") for (int bj = 0; bj < 2; ++bj) { const int c0 = u.pn * 256 + bj * 128 + wc * 32 + 8 * fq;
        const size_t idx = (size_t)row * 1024 + c0;
        const u32x4 y = *(const u32x4*)(YG + idx), gg = *(const u32x4*)(G + idx);
        const f32x4 b0 = *(const f32x4*)(gb + c0), b1 = *(const f32x4*)(gb + c0 + 4);
        const f32x4 v0 = acc[ai][bj][m][0], v1 = acc[ai][bj][m][1];
        u32x4 w;
        w[0] = pack2(bflo(y[0]) * sigm(v0[0] + b0[0]) * silu(bflo(gg[0])), bfhi(y[0]) * sigm(v0[1] + b0[1]) * silu(bfhi(gg[0])));
        w[1] = pack2(bflo(y[1]) * sigm(v0[2] + b0[2]) * silu(bflo(gg[1])), bfhi(y[1]) * sigm(v0[3] + b0[3]) * silu(bfhi(gg[1])));
        w[2] = pack2(bflo(y[2]) * sigm(v1[0] + b1[0]) * silu(bflo(gg[2])), bfhi(y[2]) * sigm(v1[1] + b1[1]) * silu(bfhi(gg[2])));
        w[3] = pack2(bflo(y[3]) * sigm(v1[2] + b1[2]) * silu(bflo(gg[3])), bfhi(y[3]) * sigm(v1[3] + b1[3]) * silu(bfhi(gg[3])));
        *(u32x4*)(ACT + idx) = w; } }
  }
};

struct TrJob { const float* W; bf16_t* dst; int N, ldd, k0, n0, perm, dup; };
DI TrJob tr_job(const Params& p, int j) {
  constexpr int T0 = 16 * 44, T1 = T0 + 22 * 16, T2 = T1 + 16 * 40, T3 = T2 + 256, T4 = T3 + 16 * 64, T5 = T4 + 256, T6 = T5 + 16 * 32, T7 = T6 + 256;
  char* ws = p.ws;
  TrJob t; int tile, K; t.perm = 0; t.dup = 0;
  bf16_t* base;
  if (j < T0) { t.W = p.in[7]; K = 1024; t.N = 2816; base = (bf16_t*)(ws + O_WT_IN0); tile = j; }
  else if (j < T1) { t.W = p.in[15]; K = 1408; t.N = 1024; base = (bf16_t*)(ws + O_WT_OUT0); tile = j - T0; }
  else if (j < T2) { t.W = p.in[19]; K = 1024; t.N = 2560; base = (bf16_t*)(ws + O_WT_IN1); tile = j - T1; }
  else if (j < T3) { t.W = p.in[21]; K = 1024; t.N = 1024; base = (bf16_t*)(ws + O_WT_OUT1); tile = j - T2; }
  else if (j < T4) { t.W = p.in[25]; K = 1024; t.N = 4096; base = (bf16_t*)(ws + O_WT_IN2); tile = j - T3; }
  else if (j < T5) { t.W = p.in[27]; K = 1024; t.N = 1024; base = (bf16_t*)(ws + O_WT_OUT2); tile = j - T4; }
  else if (j < T6) { t.W = p.in[31]; K = 1024; t.N = 2048; base = (bf16_t*)(ws + O_WT_IN3); tile = j - T5; }
  else if (j < T7) { t.W = p.in[40]; K = 1024; t.N = 1024; base = (bf16_t*)(ws + O_WT_GLU); tile = j - T6; }
  else { t.W = p.in[42]; K = 1024; t.N = 1024; base = (bf16_t*)(ws + O_WT_OUT3); tile = j - T7; }
  const int tn = t.N >> 6, tk_i = tile / tn;
  t.k0 = tk_i * 64; t.n0 = (tile - tk_i * tn) * 64;
  t.ldd = K;
  int drow = t.n0;
  if (j >= T0 && j < T1) { t.ldd = 2816; t.dup = 1; }
  else if (j >= T1 && j < T2) {
    if (t.n0 < 1280) t.perm = 1;
    else if (t.n0 < 1536) drow = 2304 + (t.n0 - 1280);
    else drow = t.n0 - 256;
  } else if (j >= T3 && j < T4) {
    if (t.n0 >= 3072) drow = t.n0 - 1024;
    else if (t.n0 >= 2048) drow = 3072 + (t.n0 - 2048);
  }
  t.dst = base + (size_t)drow * t.ldd + t.k0;
  return t;
}

DI void phase0(const Params& p, char* smem) {
  char* ws = p.ws;
  float* smf = (float*)smem;
  const int NT_ = blockDim.x;
  for (int job = blockIdx.x; job < 384; job += gridDim.x) {
    const int l = job / 96, n0 = (job % 96) * 32;
    const float* aw = l == 0 ? p.in[4] : l == 1 ? p.in[16] : l == 2 ? p.in[22] : p.in[28];
    const float* ab = l == 0 ? p.in[5] : l == 1 ? p.in[17] : l == 2 ? p.in[23] : p.in[29];
    float* sv = smf;
    float* red = smf + 9 * 1024;
    for (int idx = threadIdx.x; idx < 9 * 1024; idx += NT_) {
      const int v = idx >> 10, k = idx & 1023;
      const float x = v < 8 ? p.in[1][v * 1024 + k] : p.in[3][k];
      sv[idx] = silu(x);
    }
    __syncthreads();
    const int col = threadIdx.x & 31, ks = threadIdx.x >> 5;
    float a[9];
    _Pragma("unroll") for (int v = 0; v < 9; ++v) a[v] = 0.f;
    for (int kb = ks * 64; kb < ks * 64 + 64; kb += 16) {
      float wv[16];
      _Pragma("unroll") for (int u = 0; u < 16; ++u) wv[u] = aw[(size_t)(kb + u) * 3072 + n0 + col];
      _Pragma("unroll") for (int u = 0; u < 16; ++u) _Pragma("unroll") for (int v = 0; v < 9; ++v) a[v] += sv[v * 1024 + kb + u] * wv[u];
    }
    _Pragma("unroll") for (int v = 0; v < 9; ++v) red[(ks * 9 + v) * 32 + col] = a[v];
    __syncthreads();
    float* MOD = (float*)(ws + O_MOD);
    for (int idx = threadIdx.x; idx < 9 * 32; idx += NT_) {
      const int v = idx >> 5, cc = idx & 31;
      float sum = ab[n0 + cc];
      _Pragma("unroll") for (int q = 0; q < 16; ++q) sum += red[(q * 9 + v) * 32 + cc];
      MOD[(size_t)(l * 9 + v) * 3072 + n0 + cc] = sum;
    }
    __syncthreads();
  }
  {
    constexpr int NTL = 16 * 44 + 22 * 16 + 16 * 40 + 256 + 16 * 64 + 256 + 16 * 32 + 256 + 256;
    const int G = gridDim.x;
    const int c = threadIdx.x & 63, rr = threadIdx.x >> 6, kp = threadIdx.x & 31, nb = threadIdx.x >> 5;
    int j = (blockIdx.x + G - (384 % G)) % G;
    float v[8];
    TrJob cur{};
    if (j < NTL) { cur = tr_job(p, j); _Pragma("unroll") for (int i = 0; i < 8; ++i) v[i] = cur.W[(size_t)(cur.k0 + i * 8 + rr) * cur.N + cur.n0 + c]; }
    for (; j < NTL; j += G) {
      _Pragma("unroll") for (int i = 0; i < 8; ++i) smf[(i * 8 + rr) * 65 + c] = v[i];
      const TrJob me = cur;
      if (j + G < NTL) { cur = tr_job(p, j + G); _Pragma("unroll") for (int i = 0; i < 8; ++i) v[i] = cur.W[(size_t)(cur.k0 + i * 8 + rr) * cur.N + cur.n0 + c]; }
      __syncthreads();
      _Pragma("unroll") for (int i = 0; i < 4; ++i) {
        const int n = nb + 16 * i;
        const int dr = me.perm ? (((n & 31) << 1) | (n >> 5)) : n;
        const unsigned w = pack2(smf[(2 * kp) * 65 + n], smf[(2 * kp + 1) * 65 + n]);
        bf16_t* d = me.dst + (size_t)dr * me.ldd + 2 * kp;
        *(unsigned*)d = w;
        if (me.dup) *(unsigned*)(d + 1408) = w;
      }
      __syncthreads();
    }
  }
  const int gt = blockIdx.x * blockDim.x + threadIdx.x, gn = gridDim.x * blockDim.x;
  {
    bf16_t* WG = (bf16_t*)(ws + O_WG);
    for (int idx = gt; idx < 16 * 2 * 192 * 96; idx += gn) {
      const int kk = idx % 96; int t = idx / 96; const int n = t % 192; t /= 192; const int d = t & 1, k = t >> 1;
      const int c = n >> 5, gate = (n >> 4) & 1, ch = c * 16 + (n & 15);
      float v = 0.f;
      if (ch < 88 && kk < 88) { const float* w = gate ? p.in[12] : p.in[10]; v = w[((size_t)(d * 16 + k) * 88 + kk) * 88 + ch]; }
      WG[idx] = f2bf(v);
    }
  }
  {
    float* RCt = (float*)(ws + O_ROPEC); float* RSt = (float*)(ws + O_ROPES);
    for (int idx = gt; idx < 2048 * 32; idx += gn) {
      const int t = idx >> 5, j = idx & 31;
      const float pos = (float)(j < 16 ? (t >> 6) : (t & 63));
      const float freq = exp2f(-(float)(j & 15) * (13.287712379549449f / 16.f));
      float s, c; sincos_rev(pos * freq * 0.15915494309189535f, s, c);
      RCt[idx] = c; RSt[idx] = s;
    }
  }
  {
    float2* POW = (float2*)(ws + O_POW); float2* BB = (float2*)(ws + O_BBAR);
    for (int idx = gt; idx < 2 * 64 * 17 * 64; idx += gn) {
      const int pp = idx & 63; int t = idx >> 6; const int n = t % 17; t /= 17;
      const float are = p.in[32][t * 64 + pp], aim = p.in[33][t * 64 + pp], dt = expf(p.in[34][t]);
      const float mag = expf((float)n * are * dt);
      const double rev = (double)n * (double)aim * (double)dt * 0.15915494309189535;
      float s, c; sincos_rev((float)(rev - rint(rev)), s, c);
      POW[idx] = make_float2(mag * c, mag * s);
    }
    for (int idx = gt; idx < 2 * 64 * 64 * 16; idx += gn) {
      const int t = idx >> 4;
      const int dg = t >> 6;
      const float are = p.in[32][t], aim = p.in[33][t], dt = expf(p.in[34][dg]);
      const float mag = expf(are * dt);
      const double rev = (double)aim * (double)dt * 0.15915494309189535;
      float s, c; sincos_rev((float)(rev - rint(rev)), s, c);
      const float nr = mag * c - 1.f, ni = mag * s;
      const float den = 1.f / (are * are + aim * aim);
      const float cr = (nr * are + ni * aim) * den, ci = (ni * are - nr * aim) * den;
      const float br = p.in[35][idx], bi = p.in[36][idx];
      BB[idx] = make_float2(cr * br - ci * bi, cr * bi + ci * br);
    }
  }
}

DI void norm_phase(const float* lat, const float* ctx, const float* gn, const float* mod  , bf16_t* NB_) {
  const int tid_ = opaque_tid();
  const int lane = tid_ & 63;
  const int w0 = blockIdx.x * 8 + (tid_ >> 6), nw = gridDim.x * 8;
  for (int row = w0; row < R; row += nw) {
    const float* src; const float* m;
    if (row < RL) { src = lat + (size_t)row * 1024; m = mod + (size_t)(row >> 11) * 3072; }
    else { src = ctx + (size_t)(row - RL) * 1024; m = mod + (size_t)8 * 3072; }
    f32x4 v[4]; float ss = 0.f;
    _Pragma("unroll") for (int i = 0; i < 4; ++i) { v[i] = *(const f32x4*)(src + (i * 64 + lane) * 4); ss += v[i][0] * v[i][0] + v[i][1] * v[i][1] + v[i][2] * v[i][2] + v[i][3] * v[i][3]; }
    _Pragma("unroll") for (int o = 32; o >= 1; o >>= 1) ss += __shfl_xor(ss, o);
    const float rstd = rsqrtf(ss * (1.f / 1024.f) + 1e-6f);
    _Pragma("unroll") for (int i = 0; i < 4; ++i) {
      const int k = (i * 64 + lane) * 4;
      const f32x4 g = *(const f32x4*)(gn + k), sh = *(const f32x4*)(m + k), sc = *(const f32x4*)(m + 1024 + k);
      u32x2 o;
      o[0] = pack2(v[i][0] * rstd * g[0] * (1.f + sc[0]) + sh[0], v[i][1] * rstd * g[1] * (1.f + sc[1]) + sh[1]);
      o[1] = pack2(v[i][2] * rstd * g[2] * (1.f + sc[2]) + sh[2], v[i][3] * rstd * g[3] * (1.f + sc[3]) + sh[3]);
      *(u32x2*)(NB_ + (size_t)row * 1024 + k) = o;
    }
  }
}

DI void final_norm_phase(float* H, const float* gn) {
  const int tid_ = opaque_tid();
  const int lane = tid_ & 63;
  const int w0 = blockIdx.x * 8 + (tid_ >> 6), nw = gridDim.x * 8;
  for (int row = w0; row < RL; row += nw) {
    float* src = H + (size_t)row * 1024;
    f32x4 v[4]; float ss = 0.f;
    _Pragma("unroll") for (int i = 0; i < 4; ++i) { v[i] = *(const f32x4*)(src + (i * 64 + lane) * 4); ss += v[i][0] * v[i][0] + v[i][1] * v[i][1] + v[i][2] * v[i][2] + v[i][3] * v[i][3]; }
    _Pragma("unroll") for (int o = 32; o >= 1; o >>= 1) ss += __shfl_xor(ss, o);
    const float rstd = rsqrtf(ss * (1.f / 1024.f) + 1e-6f);
    _Pragma("unroll") for (int i = 0; i < 4; ++i) {
      const int k = (i * 64 + lane) * 4;
      const f32x4 g = *(const f32x4*)(gn + k);
      f32x4 o; o[0] = v[i][0] * rstd * g[0]; o[1] = v[i][1] * rstd * g[1]; o[2] = v[i][2] * rstd * g[2]; o[3] = v[i][3] * rstd * g[3];
      *(f32x4*)(src + k) = o;
    }
  }
}

DI void lru_phase(const Params& p, char* smem) {
  char* ws = p.ws;
  const int tid_ = opaque_tid();
  const int sub = tid_ >> 8;
  smem += sub * 36864;
  bf16_t* Wl = (bf16_t*)smem;
  bf16_t* Uc = Wl + 96 * 96;
  float* aggA = (float*)(Uc + 64 * 96);
  float* aggH = aggA + 16 * 48;
  const bf16_t* U0 = (const bf16_t*)(ws + O_U0);
  const bf16_t* G0 = (const bf16_t*)(ws + O_G0);
  const int tid = tid_ & 255, lane = tid & 63, w = tid >> 6, col = lane & 15, quad = lane >> 4;
  for (int item = blockIdx.x * 2 + sub; item < 512; item += gridDim.x * 2) {
    const int half = item & 1, dir = (item >> 1) & 1, k = (item >> 2) & 15, b = item >> 6;
    bf16_t* ACT = (bf16_t*)(ws + O_ACT0) + dir * LW;
    __syncthreads();
    {
      const u32x4* src = (const u32x4*)((const bf16_t*)(ws + O_WG) + ((size_t)(k * 2 + dir) * 192 + half * 96) * 96);
      u32x4* dst = (u32x4*)Wl;
      for (int i = tid; i < 96 * 96 / 8; i += 256) dst[i] = src[i];
      if (tid < 64) { u32x4 z; z[0] = z[1] = z[2] = z[3] = 0u; *(u32x4*)(Uc + tid * 96 + 88) = z; }
    }
    float ba[3], bx[3], sp8[3];
    _Pragma("unroll") for (int c = 0; c < 3; ++c) {
      const int ch = 48 * half + 16 * c + col;
      if (ch < 88) {
        ba[c] = p.in[11][dir * LW + k * 88 + ch]; bx[c] = p.in[13][dir * LW + k * 88 + ch];
        sp8[c] = 8.f * log1pf(expf(-p.in[14][dir * LW + k * 88 + ch]));
      } else { ba[c] = 0.f; bx[c] = 0.f; sp8[c] = 0.f; }
    }
    const int cp = tid % 44, run = tid / 44;
    float cw[4][2], cb2[2];
    _Pragma("unroll") for (int t = 0; t < 4; ++t) { cw[t][0] = p.in[8][t * LW + k * 88 + 2 * cp]; cw[t][1] = p.in[8][t * LW + k * 88 + 2 * cp + 1]; }
    cb2[0] = p.in[9][k * 88 + 2 * cp]; cb2[1] = p.in[9][k * 88 + 2 * cp + 1];
    float carry = 0.f;
    unsigned un[19];
    auto tile_info = [&](int ti, int& rowbase, int& L, int& t0) {
      if (ti < 4) { rowbase = RL + b * 256; L = 256; t0 = (dir ? 3 - ti : ti) * 64; }
      else { rowbase = b * 2048; L = 2048; t0 = (dir ? 31 - (ti - 4) : (ti - 4)) * 64; }
    };
    auto prefetch = [&](int ti) {
      int rowbase, L, t0; tile_info(ti, rowbase, L, t0);
      _Pragma("unroll") for (int i = 0; i < 19; ++i) {
        const int tt = t0 + 16 * run - 2 + i;
        unsigned v = 0u;
        if (tid < 176 && tt >= 0 && tt < L) v = *(const unsigned*)(U0 + (size_t)(rowbase + tt) * LW + k * 88 + 2 * cp);
        un[i] = v;
      }
    };
    prefetch(0);
    for (int ti = 0; ti < 36; ++ti) {
      int rowbase, L, t0; tile_info(ti, rowbase, L, t0);
      if (tid < 176) {
        _Pragma("unroll") for (int t = 0; t < 16; ++t) {
          const float y0 = cb2[0] + cw[0][0] * bflo(un[t]) + cw[1][0] * bflo(un[t + 1]) + cw[2][0] * bflo(un[t + 2]) + cw[3][0] * bflo(un[t + 3]);
          const float y1 = cb2[1] + cw[0][1] * bfhi(un[t]) + cw[1][1] * bfhi(un[t + 1]) + cw[2][1] * bfhi(un[t + 2]) + cw[3][1] * bfhi(un[t + 3]);
          *(unsigned*)(Uc + (16 * run + t) * 96 + 2 * cp) = pack2(y0, y1);
        }
      }
      if (ti + 1 < 36) prefetch(ti + 1);
      bf16_t gv[3][4];
      _Pragma("unroll") for (int c = 0; c < 3; ++c) {
        const int ch = 48 * half + 16 * c + col;
        _Pragma("unroll") for (int j = 0; j < 4; ++j)
          gv[c][j] = ch < 88 ? G0[(size_t)(rowbase + t0 + 16 * w + 4 * quad + j) * LW + k * 88 + ch] : (bf16_t)0;
      }
      __syncthreads();
      bf16x8 af[3];
      _Pragma("unroll") for (int ks = 0; ks < 3; ++ks) af[ks] = *(const bf16x8*)(Uc + (16 * w + col) * 96 + ks * 32 + quad * 8);
      float hl[3][4], ac[3][4];
      _Pragma("unroll") for (int c = 0; c < 3; ++c) {
        f32x4 gA = {0.f, 0.f, 0.f, 0.f}, gX = {0.f, 0.f, 0.f, 0.f};
        _Pragma("unroll") for (int ks = 0; ks < 3; ++ks) {
          const bf16x8 bA = *(const bf16x8*)(Wl + ((c * 2 + 0) * 16 + col) * 96 + ks * 32 + quad * 8);
          const bf16x8 bX = *(const bf16x8*)(Wl + ((c * 2 + 1) * 16 + col) * 96 + ks * 32 + quad * 8);
          gA = MFMA16(af[ks], bA, gA);
          gX = MFMA16(af[ks], bX, gX);
        }
        float a[4], bb[4];
        _Pragma("unroll") for (int j = 0; j < 4; ++j) {
          const float uval = bf2f(Uc[(16 * w + 4 * quad + j) * 96 + 48 * half + 16 * c + col]);
          const float rg = sigm(gA[j] + ba[c]), ig = sigm(gX[j] + bx[c]);
          a[j] = __expf(-sp8[c] * rg);
          bb[j] = __builtin_amdgcn_sqrtf(fmaxf(1.f - a[j] * a[j], 0.f)) * ig * uval;
        }
        if (dir == 0) {
          hl[c][0] = bb[0]; ac[c][0] = a[0];
          _Pragma("unroll") for (int j = 1; j < 4; ++j) { hl[c][j] = a[j] * hl[c][j - 1] + bb[j]; ac[c][j] = a[j] * ac[c][j - 1]; }
          aggA[(4 * w + quad) * 48 + 16 * c + col] = ac[c][3]; aggH[(4 * w + quad) * 48 + 16 * c + col] = hl[c][3];
        } else {
          hl[c][3] = bb[3]; ac[c][3] = a[3];
          _Pragma("unroll") for (int j = 2; j >= 0; --j) { hl[c][j] = a[j] * hl[c][j + 1] + bb[j]; ac[c][j] = a[j] * ac[c][j + 1]; }
          aggA[(4 * w + quad) * 48 + 16 * c + col] = ac[c][0]; aggH[(4 * w + quad) * 48 + 16 * c + col] = hl[c][0];
        }
      }
      __syncthreads();
      if (tid < 48) {
        float A_[16], H_[16];
        _Pragma("unroll") for (int s_ = 0; s_ < 16; ++s_) { A_[s_] = aggA[s_ * 48 + tid]; H_[s_] = aggH[s_ * 48 + tid]; }
        float cin = carry;
        if (dir == 0) { _Pragma("unroll") for (int s_ = 0; s_ < 16; ++s_) { aggA[s_ * 48 + tid] = cin; cin = A_[s_] * cin + H_[s_]; } }
        else { _Pragma("unroll") for (int s_ = 15; s_ >= 0; --s_) { aggA[s_ * 48 + tid] = cin; cin = A_[s_] * cin + H_[s_]; } }
        carry = cin;
      }
      __syncthreads();
      _Pragma("unroll") for (int c = 0; c < 3; ++c) {
        const int ch = 48 * half + 16 * c + col;
        if (ch < 88) {
          const float cin = aggA[(4 * w + quad) * 48 + 16 * c + col];
          _Pragma("unroll") for (int j = 0; j < 4; ++j) {
            const size_t idx = (size_t)(rowbase + t0 + 16 * w + 4 * quad + j) * (2 * LW) + k * 88 + ch;
            const float hv = hl[c][j] + ac[c][j] * cin;
            ACT[idx] = f2bf(hv * silu(bf2f(gv[c][j])));
          }
        }
      }
    }
  }
}

struct AttnSt { f32x16 O0, O1; float m, l; };
DI bf16x8 ld16(const bf16_t* p) { return *(const bf16x8*)p; }
DI bf16x8 ld8x2(const bf16_t* p0) { const s16x4 a = *(const s16x4*)p0; const s16x4 b = *(const s16x4*)(p0 + 8); return __builtin_shufflevector(a, b, 0, 1, 2, 3, 4, 5, 6, 7); }
DI bf16x8 pack8(const f32x16& P, int s) {
  u32x4 u;
  _Pragma("unroll") for (int j = 0; j < 4; ++j) u[j] = pack2(P[8 * s + 2 * j], P[8 * s + 2 * j + 1]);
  return __builtin_bit_cast(bf16x8, u);
}

struct KVt { bf16x8 k0, k1, k2, k3, v00, v01, v10, v11; };
DI void attn_load(KVt& t, const bf16_t* kt_, const bf16_t* vt_) {
  t.k0 = ld16(kt_); t.k1 = ld16(kt_ + 512); t.k2 = ld16(kt_ + 1024); t.k3 = ld16(kt_ + 1536);
  t.v00 = ld16(vt_); t.v01 = ld16(vt_ + 512); t.v10 = ld16(vt_ + 1024); t.v11 = ld16(vt_ + 1536);
}
template <class F>
DI void attn_compute(AttnSt& st, const bf16x8 (&qf)[4], const KVt& t, F fmod) {
  f32x16 S = zero16();
  S = MFMA32(t.k0, qf[0], S); S = MFMA32(t.k1, qf[1], S); S = MFMA32(t.k2, qf[2], S); S = MFMA32(t.k3, qf[3], S);
  float mx = -3.0e38f;
  _Pragma("unroll") for (int i = 0; i < 16; ++i) { S[i] = fmod(i, S[i]); mx = fmaxf(mx, S[i]); }
  mx = fmaxf(mx, __shfl_xor(mx, 32));
  const float mn = fmaxf(st.m, mx);
  const float alpha = __expf(st.m - mn);
  st.m = mn;
  float ls = 0.f;
  f32x16 P;
  _Pragma("unroll") for (int i = 0; i < 16; ++i) { P[i] = __expf(S[i] - mn); ls += P[i]; }
  st.l = st.l * alpha + ls;
  _Pragma("unroll") for (int i = 0; i < 16; ++i) { st.O0[i] *= alpha; st.O1[i] *= alpha; }
  const bf16x8 p0 = pack8(P, 0), p1 = pack8(P, 1);
  st.O0 = MFMA32(t.v00, p0, st.O0); st.O0 = MFMA32(t.v01, p1, st.O0);
  st.O1 = MFMA32(t.v10, p0, st.O1); st.O1 = MFMA32(t.v11, p1, st.O1);
}

DI void attn_finish(AttnSt& st, const bf16_t* Grow  , bf16_t* Arow  , int h) {
  const float lt = st.l + __shfl_xor(st.l, 32);
  const float inv = frcp(lt);
  _Pragma("unroll") for (int q = 0; q < 4; ++q) {
    const int d0 = 8 * q + 4 * h;
    {
      const u32x2 g = *(const u32x2*)(Grow + d0);
      u32x2 o;
      o[0] = pack2(st.O0[4 * q + 0] * inv * silu(bflo(g[0])), st.O0[4 * q + 1] * inv * silu(bfhi(g[0])));
      o[1] = pack2(st.O0[4 * q + 2] * inv * silu(bflo(g[1])), st.O0[4 * q + 3] * inv * silu(bfhi(g[1])));
      *(u32x2*)(Arow + d0) = o;
    }
    {
      const u32x2 g = *(const u32x2*)(Grow + 32 + d0);
      u32x2 o;
      o[0] = pack2(st.O1[4 * q + 0] * inv * silu(bflo(g[0])), st.O1[4 * q + 1] * inv * silu(bfhi(g[0])));
      o[1] = pack2(st.O1[4 * q + 2] * inv * silu(bflo(g[1])), st.O1[4 * q + 3] * inv * silu(bfhi(g[1])));
      *(u32x2*)(Arow + 32 + d0) = o;
    }
  }
}

DI void swa_phase(const Params& p) {
  char* ws = p.ws;
  const bf16_t* Q = (const bf16_t*)(ws + O_Q1); const bf16_t* QR = (const bf16_t*)(ws + O_QR1); const bf16_t* Kb = (const bf16_t*)(ws + O_K1);
  const bf16_t* VtL = (const bf16_t*)(ws + O_VTL1); const bf16_t* VtC = (const bf16_t*)(ws + O_VTC1);
  const bf16_t* G = (const bf16_t*)(ws + O_G1); bf16_t* ACT = (bf16_t*)(ws + O_ACT1);
  const float* sink = p.in[20];
  const int tid_ = opaque_tid();
  const int lane = tid_ & 63, r = lane & 31, h = lane >> 5;
  const int vb_ = (gridDim.x % 8 == 0) ? (blockIdx.x & 7) * (gridDim.x >> 3) + (blockIdx.x >> 3) : blockIdx.x;
  const int wid = vb_ * 8 + (tid_ >> 6), nw = gridDim.x * 8;
  auto ident = [](int, float s) { return s; };
  for (int it = wid; it < 8192 + 1024; it += nw) {
    int b, kvh, g4, qt; const bool lat = it < 8192;
    if (lat) { g4 = it & 3; qt = (it >> 2) & 63; kvh = (it >> 8) & 3; b = it >> 10; }
    else { const int j = it - 8192; g4 = j & 3; qt = (j >> 2) & 7; kvh = (j >> 5) & 3; b = j >> 7; }
    const int head = kvh * 4 + g4;
    const size_t qrow = lat ? (size_t)b * 2048 + qt * 32 + r : (size_t)RL + b * 256 + qt * 32 + r;
    AttnSt st; st.O0 = zero16(); st.O1 = zero16(); st.m = sink[head]; st.l = h == 0 ? 1.f : 0.f;
    bf16x8 qf[4], qfr[4];
    _Pragma("unroll") for (int ks = 0; ks < 4; ++ks) qf[ks] = ld16(Q + qrow * 1024 + head * 64 + ks * 16 + 8 * h);
    if (lat) { _Pragma("unroll") for (int ks = 0; ks < 4; ++ks) qfr[ks] = ld16(QR + qrow * 1024 + head * 64 + ks * 16 + 8 * h); }
    else { _Pragma("unroll") for (int ks = 0; ks < 4; ++ks) qfr[ks] = qf[ks]; }
    const bf16_t* kc = Kb + (size_t)RL * 256 + (size_t)(b * 4 + kvh) * 8 * 2048 + lane * 8;
    const bf16_t* vc = VtC + (size_t)(b * 4 + kvh) * 8 * 2048 + lane * 8;
    const bf16_t* kl = Kb + (size_t)(b * 4 + kvh) * 64 * 2048 + lane * 8;
    const bf16_t* vl = VtL + (size_t)(b * 4 + kvh) * 64 * 2048 + lane * 8;
    const int kt_lo = max(qt - 4, 0), kt_hi = min(qt + 4, 63);
    const int nt = lat ? 8 + (kt_hi - kt_lo + 1) : 8;
    auto load_tile = [&](int j, KVt& t) {
      if (j < 8) attn_load(t, kc + (size_t)j * 2048, vc + (size_t)j * 2048);
      else { const int kt = kt_lo + j - 8; attn_load(t, kl + (size_t)kt * 2048, vl + (size_t)kt * 2048); }
    };
    KVt cur, nxt;
    load_tile(0, cur);
    for (int j = 0; j < 8; ++j) {
      nxt = cur;
      if (j + 1 < nt) load_tile(j + 1, nxt);
      attn_compute(st, qf, cur, ident);
      cur = nxt;
    }
    for (int j = 8; j < nt; ++j) {
      nxt = cur;
      if (j + 1 < nt) load_tile(j + 1, nxt);
      const int dq = qt * 32 + r - (kt_lo + j - 8) * 32;
      attn_compute(st, qfr, cur, [&](int i, float s) { const int d = dq - crow(i, h); return (d <= 128 && d >= -128) ? s : -1.0e30f; });
      cur = nxt;
    }
    attn_finish(st, G + qrow * 1024 + head * 64, ACT + qrow * 1024 + head * 64, h);
  }
}

DI void na_phase(const Params& p, char* smem) {
  char* ws = p.ws;
  const bf16_t* Q = (const bf16_t*)(ws + O_Q2); const bf16_t* Kb = (const bf16_t*)(ws + O_K2);
  const bf16_t* VtL = (const bf16_t*)(ws + O_VTL2); const bf16_t* VtC = (const bf16_t*)(ws + O_VTC2);
  const bf16_t* G = (const bf16_t*)(ws + O_G2); bf16_t* ACT = (bf16_t*)(ws + O_ACT2);
  float* rpbs = (float*)smem;
  __syncthreads();
  for (int i = threadIdx.x; i < 16 * 15 * 31; i += blockDim.x) rpbs[i] = p.in[26][i];
  __syncthreads();
  const int tid_ = opaque_tid();
  const int lane = tid_ & 63, r = lane & 31, h = lane >> 5;
  const int vb_ = (gridDim.x % 8 == 0) ? (blockIdx.x & 7) * (gridDim.x >> 3) + (blockIdx.x >> 3) : blockIdx.x;
  const int wid = vb_ * 8 + (tid_ >> 6), nw = gridDim.x * 8;
  auto ident = [](int, float s) { return s; };
  for (int it = wid; it < 8192 + 1024; it += nw) {
    int b, head, half, gr; const bool lat = it < 8192;
    if (lat) { half = it & 1; head = (it >> 1) & 15; gr = (it >> 5) & 31; b = it >> 10; }
    else { const int j = it - 8192; half = 0; head = j & 15; gr = (j >> 4) & 7; b = j >> 7; }
    const size_t qrow = lat ? (size_t)b * 2048 + gr * 64 + half * 32 + r : (size_t)RL + b * 256 + gr * 32 + r;
    AttnSt st; st.O0 = zero16(); st.O1 = zero16(); st.m = -1.0e30f; st.l = 0.f;
    bf16x8 qf[4];
    _Pragma("unroll") for (int ks = 0; ks < 4; ++ks) qf[ks] = ld16(Q + qrow * 1024 + head * 64 + ks * 16 + 8 * h);
    const bf16_t* kc = Kb + (size_t)RL * 1024 + (size_t)(b * 16 + head) * 8 * 2048 + lane * 8;
    const bf16_t* vc = VtC + (size_t)(b * 16 + head) * 8 * 2048 + lane * 8;
    const bf16_t* kl = Kb + (size_t)(b * 16 + head) * 64 * 2048 + lane * 8;
    const bf16_t* vl = VtL + (size_t)(b * 16 + head) * 64 * 2048 + lane * 8;
    const int cq = half * 32 + r;
    const int cs = min(max(cq - 8, 0), 48);
    const int rs_ = min(max(gr - 4, 0), 24);
    const int nt = lat ? 24 : 8;
    auto load_tile = [&](int j, KVt& t) {
      if (j < 8) attn_load(t, kc + (size_t)j * 2048, vc + (size_t)j * 2048);
      else { const int kt = (rs_ + ((j - 8) >> 1)) * 2 + ((j - 8) & 1); attn_load(t, kl + (size_t)kt * 2048, vl + (size_t)kt * 2048); }
    };
    KVt cur, nxt;
    load_tile(0, cur);
    for (int j = 0; j < 8; ++j) {
      nxt = cur;
      if (j + 1 < nt) load_tile(j + 1, nxt);
      attn_compute(st, qf, cur, ident);
      cur = nxt;
    }
    for (int j = 8; j < nt; ++j) {
      nxt = cur;
      if (j + 1 < nt) load_tile(j + 1, nxt);
      const int krow = rs_ + ((j - 8) >> 1), ct = (j - 8) & 1;
      const float* rp = rpbs + (head * 15 + (krow - gr + 7)) * 31;
      attn_compute(st, qf, cur, [&](int i, float s) {
        const int ck = ct * 32 + crow(i, h);
        const bool ok = (ck >= cs) && (ck < cs + 16);
        const int dx = min(max(ck - cq + 15, 0), 30);
        return ok ? s + rp[dx] : -1.0e30f;
      });
      cur = nxt;
    }
    attn_finish(st, G + qrow * 1024 + head * 64, ACT + qrow * 1024 + head * 64, h);
  }
}

DI void s5_mats_phase(const Params& p) {
  char* ws = p.ws;
  const float2* POW = (const float2*)(ws + O_POW); const float2* BB = (const float2*)(ws + O_BBAR);
  bf16_t* GT = (bf16_t*)(ws + O_GT); bf16_t* MYT = (bf16_t*)(ws + O_MYT);
  const float* cre = p.in[37]; const float* cim = p.in[38]; const float* dsk = p.in[39];
  const int gt = blockIdx.x * blockDim.x + threadIdx.x, gn = gridDim.x * blockDim.x;
  for (int idx = gt; idx < 64 * 256 * 256; idx += gn) {
    const int g = idx >> 16, n = (idx >> 8) & 255, k = idx & 255;
    {
      const int dir = n >> 7, pp = (n >> 1) & 63, ri = n & 1, i = k >> 4, c = k & 15;
      const int e = dir ? i : 15 - i;
      const float2 pw = POW[((size_t)(dir * 64 + g) * 17 + e) * 64 + pp];
      const float2 bb = BB[((size_t)(dir * 64 + g) * 64 + pp) * 16 + c];
      const float zr = pw.x * bb.x - pw.y * bb.y, zi = pw.x * bb.y + pw.y * bb.x;
      GT[idx] = f2bf(ri ? zi : zr);
    }
    {
      const int j = n >> 4, o = n & 15, dir = k >> 7, pp = (k >> 1) & 63, ri = k & 1;
      const int e = dir ? 16 - j : j + 1;
      const float2 pw = POW[((size_t)(dir * 64 + g) * 17 + e) * 64 + pp];
      const size_t ci = ((size_t)(dir * 64 + g) * 16 + o) * 64 + pp;
      const float cr = cre[ci], cm = cim[ci];
      const float zr = cr * pw.x - cm * pw.y, zi = cr * pw.y + cm * pw.x;
      MYT[((size_t)g * 256 + n) * 512 + 256 + k] = f2bf(ri ? -zi : zr);
    }
  }
  for (int idx = gt; idx < 64 * 16 * 256; idx += gn) {
    const int g = idx >> 12, lag = (idx >> 8) & 15, o = (idx >> 4) & 15, c = idx & 15;
    float kf = 0.f, kb = 0.f;
    _Pragma("unroll 8") for (int pp = 0; pp < 64; ++pp) {
      {
        const float2 pw = POW[((size_t)(0 * 64 + g) * 17 + lag) * 64 + pp];
        const float2 bb = BB[((size_t)(0 * 64 + g) * 64 + pp) * 16 + c];
        const size_t ci = ((size_t)(0 * 64 + g) * 16 + o) * 64 + pp;
        const float zr = pw.x * bb.x - pw.y * bb.y, zi = pw.x * bb.y + pw.y * bb.x;
        kf += cre[ci] * zr - cim[ci] * zi;
      }
      {
        const float2 pw = POW[((size_t)(1 * 64 + g) * 17 + lag) * 64 + pp];
        const float2 bb = BB[((size_t)(1 * 64 + g) * 64 + pp) * 16 + c];
        const size_t ci = ((size_t)(1 * 64 + g) * 16 + o) * 64 + pp;
        const float zr = pw.x * bb.x - pw.y * bb.y, zi = pw.x * bb.y + pw.y * bb.x;
        kb += cre[ci] * zr - cim[ci] * zi;
      }
    }
    bf16_t* Mg = MYT + (size_t)g * 256 * 512;
    if (lag == 0) {
      const bf16_t v = f2bf(kf + kb + (o == c ? dsk[g * 16 + o] : 0.f));
      for (int j = 0; j < 16; ++j) Mg[(size_t)(j * 16 + o) * 512 + j * 16 + c] = v;
    } else {
      const bf16_t vf = f2bf(kf), vb = f2bf(kb);
      for (int i = 0; i + lag < 16; ++i) {
        Mg[(size_t)((i + lag) * 16 + o) * 512 + i * 16 + c] = vf;
        Mg[(size_t)(i * 16 + o) * 512 + (i + lag) * 16 + c] = vb;
      }
    }
  }
}

DI void s5_scan_phase(const Params& p) {
  char* ws = p.ws;
  const float2* POW = (const float2*)(ws + O_POW);
  const float* SL = (const float*)(ws + O_SLOC);
  bf16_t* ACAT = (bf16_t*)(ws + O_ACAT);
  for (int gid = blockIdx.x * blockDim.x + threadIdx.x; gid < 65536; gid += gridDim.x * blockDim.x) {
    const int pp = gid & 63, g = (gid >> 6) & 63, dir = (gid >> 12) & 1, b = gid >> 13;
    const float2 lam = POW[((size_t)(dir * 64 + g) * 17 + 16) * 64 + pp];
    float hr = 0.f, hi = 0.f;
    for (int q0 = 0; q0 < 144; q0 += 16) {
      float2 s[16];
      _Pragma("unroll") for (int j = 0; j < 16; ++j) {
        const int q = q0 + j;
        const int chunk = q < 16 ? (1024 + b * 16 + (dir ? 15 - q : q)) : (b * 128 + (dir ? 127 - (q - 16) : (q - 16)));
        s[j] = *(const float2*)(SL + ((size_t)g * NCHP + chunk) * 256 + dir * 128 + 2 * pp);
      }
      _Pragma("unroll") for (int j = 0; j < 16; ++j) {
        const int q = q0 + j;
        const int chunk = q < 16 ? (1024 + b * 16 + (dir ? 15 - q : q)) : (b * 128 + (dir ? 127 - (q - 16) : (q - 16)));
        *(unsigned*)(ACAT + ((size_t)g * NCH + chunk) * 512 + 256 + dir * 128 + 2 * pp) = pack2(hr, hi);
        const float nr = lam.x * hr - lam.y * hi + s[j].x, ni = lam.x * hi + lam.y * hr + s[j].y;
        hr = nr; hi = ni;
      }
    }
  }
}


#define XB_TMO      128
#define XB_XCNT(j)  (256  + 64 * (j))
#define XB_XSUB(j)  (1280 + 64 * (j))
#define XB_XGEN(j)  (2304 + 64 * (j))
#define XB_TOP      3328
#define XB_TOPGEN   3392
#define XCD_BAR_WORDS 3456
#define XB_SPIN_CAP (1u << 18)
#define LAS __attribute__((address_space(3)))
DI unsigned xb_ld(unsigned* p)              { return __hip_atomic_load(p, __ATOMIC_RELAXED, __HIP_MEMORY_SCOPE_AGENT); }
DI unsigned xb_add(unsigned* p, unsigned v) { return __hip_atomic_fetch_add(p, v, __ATOMIC_RELAXED, __HIP_MEMORY_SCOPE_AGENT); }
DI unsigned xb_xcc_id() { return (unsigned)__builtin_amdgcn_s_getreg((3 << 11) | 20) & 0xFu; }
#define XB_SPIN(cond, bar) do { unsigned _sp = 0; while (cond) { __builtin_amdgcn_s_sleep(1); \
    if ((++_sp & 255u) == 0u) { if (xb_ld(&(bar)[XB_TMO])) break; if (_sp > XB_SPIN_CAP) { atomicAdd(&(bar)[XB_TMO], 1u); break; } } } } while (0)
struct XcdBarrier { unsigned* bar; unsigned x; volatile LAS unsigned* st; };
DI XcdBarrier xcd_barrier_post(unsigned* bar, volatile LAS unsigned* st) {
    XcdBarrier b; b.bar = bar; b.x = xb_xcc_id(); b.st = st;
    if (threadIdx.x == 0) (void)xb_add(&bar[XB_XCNT(b.x)], 1u);
    return b;
}
DI void xcd_barrier_complete(unsigned* bar, unsigned x, unsigned& nloc, unsigned& nx) {
    const unsigned G = gridDim.x * gridDim.y * gridDim.z;
    unsigned sum, cnt, mine, sp = 0u;
    for (;;) {
        sum = 0u; cnt = 0u; mine = 0u;
#pragma unroll
        for (unsigned j = 0; j < 16; ++j) { const unsigned c = xb_ld(&bar[XB_XCNT(j)]); sum += c; cnt += (c > 0u) ? 1u : 0u; mine = (j == x) ? c : mine; }
        if (sum == G) break;
        __builtin_amdgcn_s_sleep(1);
        if ((++sp & 255u) == 0u) { if (xb_ld(&bar[XB_TMO])) break; if (sp > XB_SPIN_CAP) { atomicAdd(&bar[XB_TMO], 1u); break; } }
    }
    nloc = mine > 0u ? mine : 1u; nx = cnt > 0u ? cnt : 1u;
}
DI void xcd_barrier(const XcdBarrier& b) {
    asm volatile("s_waitcnt vmcnt(0)" ::: "memory");
    __syncthreads();
    if (threadIdx.x == 0) {
        unsigned* bar = b.bar;
        __builtin_amdgcn_s_waitcnt(0);
        unsigned nloc = b.st[0], nx = b.st[1];
        if (nloc == 0u) { xcd_barrier_complete(bar, b.x, nloc, nx); b.st[0] = nloc; b.st[1] = nx; }
        const unsigned old = xb_add(&bar[XB_XSUB(b.x)], 1u);
        const unsigned gen = old / nloc;
        if (old + 1u == (gen + 1u) * nloc) {
            __builtin_amdgcn_fence(__ATOMIC_RELEASE, "agent");
            asm volatile("s_waitcnt vmcnt(0)" ::: "memory");
            const unsigned og = xb_add(&bar[XB_TOP], 1u);
            const unsigned tg = og / nx;
            if (og + 1u == (tg + 1u) * nx) xb_add(&bar[XB_TOPGEN], 1u);
            else XB_SPIN(xb_ld(&bar[XB_TOPGEN]) == tg, bar);
            __builtin_amdgcn_fence(__ATOMIC_ACQUIRE, "agent");
            xb_add(&bar[XB_XGEN(b.x)], 1u);
            asm volatile("s_waitcnt vmcnt(0)" ::: "memory");
        } else {
            XB_SPIN(xb_ld(&bar[XB_XGEN(b.x)]) == gen, bar);
            __builtin_amdgcn_fence(__ATOMIC_ACQUIRE, "agent");
            asm volatile("s_waitcnt vmcnt(0)" ::: "memory");
        }
    }
    __syncthreads();
}

constexpr int LDS_BYTES = 147456;

__global__ void __launch_bounds__(512, 2) fwd_megakernel(Params p) {
  extern __shared__ __attribute__((aligned(16))) unsigned char lds_raw[];
  LAS unsigned char* lds = (LAS unsigned char*)lds_raw;
  char* smem = (char*)lds_raw;
  cg::grid_group grid = cg::this_grid();
  char* ws = p.ws;
  volatile LAS unsigned* xst = (volatile LAS unsigned*)(lds + 131072 + 256);
  if (threadIdx.x == 0) { xst[0] = 0u; xst[1] = 0u; }
  __syncthreads();
  XcdBarrier xb = xcd_barrier_post((unsigned*)(ws + O_BAR), xst);
#define GSYNC() xcd_barrier(xb)
  float* MOD = (float*)(ws + O_MOD);
  float* HCTX = (float*)(ws + O_HCTX);
  const bf16_t* NBUF = (const bf16_t*)(ws + O_NBUF);
  using pg8::Gemm;

  phase0(p, smem);
  grid.sync();
  norm_phase(p.in[0], p.in[2], p.in[6], MOD, (bf16_t*)(ws + O_NBUF0));
  GSYNC();
  {
    EpiL0In e{(bf16_t*)(ws + O_U0), (bf16_t*)(ws + O_G0)};
    Gemm g{(const bf16_t*)(ws + O_NBUF0), (const bf16_t*)(ws + O_WT_IN0), 1024, 1024, 1024, 72, 11, 1, 0, 0, 0};
    pg8::gemm_phase(lds, g, e);
  }
  GSYNC();
  lru_phase(p, smem);
  GSYNC();
  {
    EpiOut e{p.in[0], p.in[2], p.out, HCTX, MOD + 2048};
    Gemm g{(const bf16_t*)(ws + O_ACT0), (const bf16_t*)(ws + O_WT_OUT0), 2816, 2816, 2816, 72, 4, 1, 0, 0, 0};
    pg8::gemm_phase(lds, g, e);
  }
  GSYNC();
  norm_phase(p.out, HCTX, p.in[18], MOD + 9 * 3072, (bf16_t*)(ws + O_NBUF));
  GSYNC();
  {
    EpiL1 e{(bf16_t*)(ws + O_Q1), (bf16_t*)(ws + O_QR1), (bf16_t*)(ws + O_K1), (bf16_t*)(ws + O_G1), (const float*)(ws + O_ROPEC), (const float*)(ws + O_ROPES)};
    Gemm g{NBUF, (const bf16_t*)(ws + O_WT_IN1), 1024, 1024, 1024, 72, 9, 1, 0, 0, 0};
    pg8::gemm_phase(lds, g, e);
    EpiV<4> ev{(bf16_t*)(ws + O_VTL1), (bf16_t*)(ws + O_VTC1)};
    Gemm gv{(const bf16_t*)(ws + O_WT_IN1) + (size_t)2304 * 1024, NBUF, 1024, 1024, 1024, 1, 72, 1, 0, 0, 256 - 136};
    pg8::gemm_phase(lds, gv, ev);
  }
  GSYNC();
  swa_phase(p);
  GSYNC();
  {
    EpiOut e{p.out, HCTX, p.out, HCTX, MOD + 9 * 3072 + 2048};
    Gemm g{(const bf16_t*)(ws + O_ACT1), (const bf16_t*)(ws + O_WT_OUT1), 1024, 1024, 1024, 72, 4, 1, 0, 0, 0};
    pg8::gemm_phase(lds, g, e);
  }
  GSYNC();
  norm_phase(p.out, HCTX, p.in[24], MOD + 2 * 9 * 3072, (bf16_t*)(ws + O_NBUF));
  GSYNC();
  {
    EpiL2 e{(bf16_t*)(ws + O_Q2), (bf16_t*)(ws + O_K2), (bf16_t*)(ws + O_G2)};
    Gemm g{NBUF, (const bf16_t*)(ws + O_WT_IN2), 1024, 1024, 1024, 72, 12, 1, 0, 0, 0};
    pg8::gemm_phase(lds, g, e);
    EpiV<16> ev{(bf16_t*)(ws + O_VTL2), (bf16_t*)(ws + O_VTC2)};
    Gemm gv{(const bf16_t*)(ws + O_WT_IN2) + (size_t)3072 * 1024, NBUF, 1024, 1024, 1024, 4, 72, 1, 0, 0, 256 - 96};
    pg8::gemm_phase(lds, gv, ev);
  }
  GSYNC();
  na_phase(p, smem);
  GSYNC();
  {
    EpiOut e{p.out, HCTX, p.out, HCTX, MOD + 2 * 9 * 3072 + 2048};
    Gemm g{(const bf16_t*)(ws + O_ACT2), (const bf16_t*)(ws + O_WT_OUT2), 1024, 1024, 1024, 72, 4, 1, 0, 0, 0};
    pg8::gemm_phase(lds, g, e);
  }
  GSYNC();
  norm_phase(p.out, HCTX, p.in[30], MOD + 3 * 9 * 3072, (bf16_t*)(ws + O_NBUF));
  s5_mats_phase(p);
  GSYNC();
  {
    EpiL3In e{(bf16_t*)(ws + O_ACAT), (bf16_t*)(ws + O_G3)};
    Gemm g{NBUF, (const bf16_t*)(ws + O_WT_IN3), 1024, 1024, 1024, 72, 8, 1, 0, 0, 0};
    pg8::gemm_phase(lds, g, e);
  }
  GSYNC();
  {
    EpiS5State e{(float*)(ws + O_SLOC)};
    Gemm g{(const bf16_t*)(ws + O_ACAT), (const bf16_t*)(ws + O_GT), 512, 256, 256, 5, 1, 64, NCH * 512, 256 * 256, 0};
    pg8::gemm_phase(lds, g, e);
  }
  GSYNC();
  s5_scan_phase(p);
  GSYNC();
  {
    EpiS5Y e{(bf16_t*)(ws + O_YG)};
    Gemm g{(const bf16_t*)(ws + O_ACAT), (const bf16_t*)(ws + O_MYT), 512, 512, 512, 4, 1, 64, NCH * 512, 256 * 512, 0};
    pg8::gemm_phase(lds, g, e);
  }
  GSYNC();
  {
    EpiGlu e{(const bf16_t*)(ws + O_YG), (const bf16_t*)(ws + O_G3), p.in[41], (bf16_t*)(ws + O_ACT3)};
    Gemm g{(const bf16_t*)(ws + O_YG), (const bf16_t*)(ws + O_WT_GLU), 1024, 1024, 1024, 64, 4, 1, 0, 0, 0};
    pg8::gemm_phase(lds, g, e);
  }
  GSYNC();
  {
    EpiOut e{p.out, HCTX, p.out, HCTX, MOD + 3 * 9 * 3072 + 2048};
    Gemm g{(const bf16_t*)(ws + O_ACT3), (const bf16_t*)(ws + O_WT_OUT3), 1024, 1024, 1024, 64, 4, 1, 0, 0, 0};
    pg8::gemm_phase(lds, g, e);
  }
  GSYNC();
  final_norm_phase(p.out, p.in[43]);
}

extern "C" void kernel_launch(void* const* d_in, const int* in_sizes, int n_in, void* d_out, int out_size, void* d_ws, size_t ws_size,
                              hipStream_t stream) {
  static int grid_blocks = 0;
  if (!grid_blocks) {
    int dev = 0, cus = 0, per_cu = 0;
    (void)hipGetDevice(&dev);
    (void)hipDeviceGetAttribute(&cus, hipDeviceAttributeMultiprocessorCount, dev);
    if (hipFuncSetAttribute((const void*)fwd_megakernel, hipFuncAttributeMaxDynamicSharedMemorySize, LDS_BYTES) != hipSuccess) { fprintf(stderr, "kernel_launch: hipFuncSetAttribute failed\n"); grid_blocks = -1; return; }
    (void)hipOccupancyMaxActiveBlocksPerMultiprocessor(&per_cu, (const void*)fwd_megakernel, 512, LDS_BYTES);
    (void)hipGetLastError();
    grid_blocks = cus;
  }
  if (grid_blocks < 0) return;
  if (n_in != 44 || ws_size < WS_END) { fprintf(stderr, "kernel_launch: unexpected n_in %d or ws_size %zu < %zu\n", n_in, ws_size, (size_t)WS_END); return; }
  Params p{};
  for (int i = 0; i < 44; ++i) p.in[i] = (const float*)d_in[i];
  p.out = (float*)d_out;
  p.ws = (char*)d_ws;
  if (hipMemsetAsync((char*)d_ws + O_BAR, 0, 16384, stream) != hipSuccess) { fprintf(stderr, "memset failed\n"); return; }
  void* args[] = {&p};
  hipError_t e = hipLaunchCooperativeKernel((void*)fwd_megakernel, dim3(grid_blocks), dim3(512), args, LDS_BYTES, stream);
  if (e != hipSuccess) fprintf(stderr, "cooperative launch failed: %s (grid %d)\n", hipGetErrorString(e), grid_blocks);
}
```

```cpp
#include <hip/hip_runtime.h>
#include <hip/hip_cooperative_groups.h>
#include <cstdio>
namespace cg = cooperative_groups;

#define DI __device__ __forceinline__
typedef unsigned short bf16_t;
typedef short bf16x8 __attribute__((ext_vector_type(8)));
typedef short s16x4 __attribute__((ext_vector_type(4)));
typedef float f32x16 __attribute__((ext_vector_type(16)));
typedef float f32x4 __attribute__((ext_vector_type(4)));
typedef unsigned u32x2 __attribute__((ext_vector_type(2)));
typedef unsigned u32x4 __attribute__((ext_vector_type(4)));

#define MFMA32(a, b, c) __builtin_amdgcn_mfma_f32_32x32x16_bf16((a), (b), (c), 0, 0, 0)
#define MFMA16(a, b, c) __builtin_amdgcn_mfma_f32_16x16x32_bf16((a), (b), (c), 0, 0, 0)

constexpr int D = 1024, NB = 8, SEQ = 2048, CTXL = 256;
constexpr int RL = NB * SEQ;
constexpr int RC = NB * CTXL;
constexpr int R = RL + RC;
constexpr int LW = 1408;
constexpr int NCH = R / 16;
constexpr int NCHP = 1280;

constexpr size_t O_WT_IN0 = 0;
constexpr size_t O_WT_OUT0 = O_WT_IN0 + (size_t)2816 * 1024 * 2;
constexpr size_t O_WT_IN1 = O_WT_OUT0 + (size_t)1024 * 2816 * 2;
constexpr size_t O_WT_OUT1 = O_WT_IN1 + (size_t)2560 * 1024 * 2;
constexpr size_t O_WT_IN2 = O_WT_OUT1 + (size_t)1024 * 1024 * 2;
constexpr size_t O_WT_OUT2 = O_WT_IN2 + (size_t)4096 * 1024 * 2;
constexpr size_t O_WT_IN3 = O_WT_OUT2 + (size_t)1024 * 1024 * 2;
constexpr size_t O_WT_GLU = O_WT_IN3 + (size_t)2048 * 1024 * 2;
constexpr size_t O_WT_OUT3 = O_WT_GLU + (size_t)1024 * 1024 * 2;
constexpr size_t O_WG = O_WT_OUT3 + (size_t)1024 * 1024 * 2;
constexpr size_t O_MOD = O_WG + (size_t)16 * 2 * 192 * 96 * 2;
constexpr size_t O_ROPEC = O_MOD + (size_t)4 * 9 * 3072 * 4;
constexpr size_t O_ROPES = O_ROPEC + (size_t)2048 * 32 * 4;
constexpr size_t O_POW = O_ROPES + (size_t)2048 * 32 * 4;
constexpr size_t O_BBAR = O_POW + (size_t)2 * 64 * 17 * 64 * 8;
constexpr size_t O_HCTX = O_BBAR + (size_t)2 * 64 * 64 * 16 * 8;
constexpr size_t O_SS = O_HCTX + (size_t)RC * 1024 * 4;
constexpr size_t O_GS = O_SS + (size_t)3 * R * 4;
constexpr size_t O_SHW = O_GS + (size_t)3 * 9 * 1024 * 4;
constexpr size_t O_BAR = O_SHW + (size_t)3 * 9 * 4096 * 4;
constexpr size_t O_DYN = O_BAR + 16384;
constexpr size_t O_U0 = O_DYN;
constexpr size_t O_G0 = O_U0 + (size_t)R * LW * 2;
constexpr size_t O_ACT0 = O_G0 + (size_t)R * LW * 2;
constexpr size_t O_NBUF0 = O_ACT0;
constexpr size_t O_NBUF = O_DYN;
constexpr size_t O_Q1 = O_NBUF + (size_t)R * 1024 * 2;
constexpr size_t O_QR1 = O_Q1 + (size_t)R * 1024 * 2;
constexpr size_t O_K1 = O_QR1 + (size_t)RL * 1024 * 2;
constexpr size_t O_VTL1 = O_K1 + (size_t)R * 256 * 2;
constexpr size_t O_VTC1 = O_VTL1 + (size_t)8 * 4 * 64 * 2048 * 2;
constexpr size_t O_G1 = O_VTC1 + (size_t)8 * 4 * 64 * 256 * 2;
constexpr size_t O_ACT1 = O_G1 + (size_t)R * 1024 * 2;
constexpr size_t O_Q2 = O_NBUF + (size_t)R * 1024 * 2;
constexpr size_t O_K2 = O_Q2 + (size_t)R * 1024 * 2;
constexpr size_t O_VTL2 = O_K2 + (size_t)R * 1024 * 2;
constexpr size_t O_VTC2 = O_VTL2 + (size_t)8 * 16 * 64 * 2048 * 2;
constexpr size_t O_G2 = O_VTC2 + (size_t)8 * 16 * 64 * 256 * 2;
constexpr size_t O_ACT2 = O_Q2;
constexpr size_t O_SLOC = O_DYN;
constexpr size_t O_YG = O_DYN;
constexpr size_t O_ACT3 = O_YG + (size_t)RL * 1024 * 2;
constexpr size_t O_ACAT = O_DYN + (size_t)64 * NCHP * 256 * 4;
constexpr size_t O_G3 = O_ACAT + (size_t)64 * NCH * 512 * 2;
constexpr size_t O_GT = O_WT_IN2;
constexpr size_t O_MYT = O_WT_IN0;
static_assert(O_WT_OUT1 - O_WT_IN0 == (size_t)64 * 256 * 512 * 2 && O_WT_OUT2 - O_WT_IN2 == (size_t)64 * 256 * 256 * 2, "S5 matrix aliases");
constexpr size_t WS_END = O_ACT0 + (size_t)R * LW * 2 * 2;
static_assert(O_G3 + (size_t)RL * 1024 * 2 <= WS_END && O_ACT1 + (size_t)R * 1024 * 2 <= WS_END && O_G2 + (size_t)R * 1024 * 2 <= WS_END, "workspace map");
static_assert(WS_END <= (size_t)256 * 1024 * 1024, "workspace budget");

struct Params {
  const float* in[44];
  float* out;
  char* ws;
};

typedef __bf16 bf16n2 __attribute__((ext_vector_type(2)));
DI bf16_t f2bf(float x) { const __bf16 b = (__bf16)x; return __builtin_bit_cast(unsigned short, b); }
DI float bf2f(bf16_t b) { return __uint_as_float(((unsigned)b) << 16); }
DI unsigned pack2(float lo, float hi) { bf16n2 v; v[0] = (__bf16)lo; v[1] = (__bf16)hi; return __builtin_bit_cast(unsigned, v); }
DI float bflo(unsigned u) { return __uint_as_float(u << 16); }
DI float bfhi(unsigned u) { return __uint_as_float(u & 0xffff0000u); }
DI float frcp(float x) { return __builtin_amdgcn_rcpf(x); }
DI float sigm(float x) { return frcp(1.f + __expf(-x)); }
DI float silu(float x) { return x * frcp(1.f + __expf(-x)); }
DI float gelu_tanh(float x) {
  float z = 0.7978845608028654f * (x + 0.044715f * x * x * x);
  float e = __expf(2.f * z);
  float t = 1.f - 2.f * frcp(e + 1.f);
  return 0.5f * x * (1.f + t);
}
DI int opaque_tid() { int t = threadIdx.x; asm volatile("" : "+v"(t)); return t; }
constexpr float QSCALE = 0.125f * 1.4426950408889634f;
DI int crow(int i, int h) { return (i & 3) + 8 * (i >> 2) + 4 * h; }
DI f32x16 zero16() { f32x16 z; _Pragma("unroll") for (int i = 0; i < 16; ++i) z[i] = 0.f; return z; }
DI void sincos_rev(float rev, float& s, float& c) { rev = rev - rintf(rev); s = __builtin_amdgcn_sinf(rev); c = __builtin_amdgcn_cosf(rev); }

#define LAS __attribute__((address_space(3)))
namespace pg8 {
constexpr int BM = 256, BK = 64, HALF = 128, HTB = HALF * BK * 2, STAGE_BYTES = 8 * HTB;
DI int lds_byte(int r, int c) { const int st = (r >> 4) * 2 + (c >> 5), rr = r & 15, cc = c & 31, ob = rr * 64 + cc * 2; return st * 1024 + (ob ^ (((ob >> 9) & 1) << 5)); }
DI void stage_rc(int b, int& R_, int& C_) { const int st = b / 1024, sb = b % 1024, swz = sb ^ (((sb >> 9) & 1) << 5); R_ = (st >> 1) * 16 + swz / 64; C_ = (st & 1) * 32 + (swz % 64) / 2; }
DI int perm32(int rho) { const int n = rho >> 4, i = rho & 15; return 8 * (i >> 2) + 4 * n + (i & 3); }
struct Unit { int pm, pn, pb; };
struct Gemm { const bf16_t* A; const bf16_t* Bt; int lda, ldb, K, nM, nN, nB; int strideA, strideB; int rot; };
DI bool next_unit(const Gemm& g, int i, Unit& u) {
  const int G = gridDim.x, per = g.nM * g.nN, nwg = per * g.nB;
  const int c = (blockIdx.x + g.rot) % G;
  const long L = (long)i * G + c;
  if (L >= nwg) return false;
  int wgid = (int)L;
  { const int q = nwg / 8, r = nwg % 8, xcd = wgid % 8, off = wgid / 8; wgid = (xcd < r ? xcd * (q + 1) : r * (q + 1) + (xcd - r) * q) + off; }
  const int pb = wgid / per, w = wgid - pb * per;
  const int nig = 8 * g.nN, gid = w / nig, fm = gid * 8, gsz = (g.nM - fm) < 8 ? (g.nM - fm) : 8;
  u.pb = pb; u.pm = fm + ((w % nig) % gsz); u.pn = (w % nig) / gsz;
  return true;
}

template <class Epi>
DI void gemm_phase(LAS unsigned char* lds, const Gemm g, const Epi& E) {
  const int tid = opaque_tid(), wid = __builtin_amdgcn_readfirstlane(tid >> 6), lane = tid & 63, wr = wid >> 2, wc = wid & 3, fr = lane & 15, fq = lane >> 4;
  const int K = g.K, nt = K / BK;
  unsigned voffA[2], voffB[2];
#pragma unroll
  for (int i = 0; i < 2; ++i) { int R_, C_; stage_rc(tid * 16 + i * 8192, R_, C_); const int Rb = Epi::PERM ? ((R_ & ~31) + perm32(R_ & 31)) : R_;
    voffA[i] = (unsigned)(R_ * g.lda + C_) * 2u; voffB[i] = (unsigned)(Rb * g.ldb + C_) * 2u; }
  const size_t kstep = (size_t)(BK * 2);
  const size_t hstepA = (size_t)HALF * g.lda * 2, hstepB = (size_t)HALF * g.ldb * 2;
  const size_t tstepA = 2 * hstepA, tstepB = 2 * hstepB;
  const unsigned ldsw = (unsigned)wid * 1024u;
  const int aoff = lds_byte(wr * 64 + fr, fq * 8), boff = lds_byte(wc * 32 + fr, fq * 8);
#define PG8_SA(b, h) (((b) * 2 + (h)) * HTB)
#define PG8_SB(b, h) ((4 + (b) * 2 + (h)) * HTB)
#define PG8_STAGE(bufoff, gbase, voff) do { _Pragma("unroll") for (int _i = 0; _i < 2; ++_i) \
        __builtin_amdgcn_global_load_lds((const unsigned*)((const char*)(gbase) + (voff)[_i]), (LAS unsigned*)(lds + (bufoff) + ldsw + _i * 8192), 16, 0, 0); } while (0)
#define PG8_LDA(dst, b, h) do { _Pragma("unroll") for (int m = 0; m < 4; ++m) _Pragma("unroll") for (int k = 0; k < 2; ++k) dst[m][k] = *(const LAS bf16x8*)(lds + PG8_SA(b, h) + aoff + m * 2048 + k * 1024); } while (0)
#define PG8_LDB(dst, b, h) do { _Pragma("unroll") for (int n = 0; n < 2; ++n) _Pragma("unroll") for (int k = 0; k < 2; ++k) dst[n][k] = *(const LAS bf16x8*)(lds + PG8_SB(b, h) + boff + n * 2048 + k * 1024); } while (0)
#define PG8_MMA(ai, bj, At, Bt) do { __builtin_amdgcn_s_setprio(1); _Pragma("unroll") for (int m = 0; m < 4; ++m) _Pragma("unroll") for (int n = 0; n < 2; ++n) _Pragma("unroll") for (int k = 0; k < 2; ++k) \
        acc[ai][bj][m][n] = __builtin_amdgcn_mfma_f32_16x16x32_bf16(Bt[n][k], At[m][k], acc[ai][bj][m][n], 0, 0, 0); __builtin_amdgcn_s_setprio(0); } while (0)
#define PG8_WAIT_V(n) asm volatile("s_waitcnt vmcnt(" #n ")" ::: "memory")
#define PG8_WAIT_L(n) asm volatile("s_waitcnt lgkmcnt(" #n ")" ::: "memory")
#define PG8_BAR __builtin_amdgcn_s_barrier()
#define PG8_SCHED __builtin_amdgcn_sched_barrier(0)
  Unit cur, nxt; int ui = 0;
  if (!next_unit(g, 0, cur)) return;
  f32x4 acc[2][2][4][2];
#pragma unroll
  for (int a = 0; a < 2; ++a)
#pragma unroll
    for (int b = 0; b < 2; ++b)
#pragma unroll
      for (int m = 0; m < 4; ++m)
#pragma unroll
        for (int n = 0; n < 2; ++n) acc[a][b][m][n] = (f32x4){0.f, 0.f, 0.f, 0.f};
  bf16x8 At[4][2], B0[2][2], B1[2][2];
  const char* cA = (const char*)(g.A + (size_t)cur.pb * g.strideA) + (size_t)cur.pm * tstepA;
  const char* cB = (const char*)(g.Bt + (size_t)cur.pb * g.strideB) + (size_t)cur.pn * tstepB;
  PG8_STAGE(PG8_SB(0, 0), cB, voffB); PG8_STAGE(PG8_SA(0, 0), cA, voffA); PG8_STAGE(PG8_SB(0, 1), cB + hstepB, voffB); PG8_STAGE(PG8_SA(0, 1), cA + hstepA, voffA);
  if (wr == 1) PG8_BAR;
  PG8_WAIT_V(4); PG8_BAR;
  PG8_STAGE(PG8_SB(1, 0), cB + kstep, voffB); PG8_STAGE(PG8_SA(1, 0), cA + kstep, voffA); PG8_STAGE(PG8_SB(1, 1), cB + hstepB + kstep, voffB);
  PG8_WAIT_V(6); PG8_BAR;
  for (;;) {
    const bool has_next = next_unit(g, ui + 1, nxt);
    const char* nA = has_next ? (const char*)(g.A + (size_t)nxt.pb * g.strideA) + (size_t)nxt.pm * tstepA : cA;
    const char* nB = has_next ? (const char*)(g.Bt + (size_t)nxt.pb * g.strideB) + (size_t)nxt.pn * tstepB : cB;
    for (int t = 0; t < nt; t += 2) {
      const bool last = (t == nt - 2);
      const char* a1 = cA + (size_t)(t + 1) * kstep;
      const char* a2 = last ? nA : cA + (size_t)(t + 2) * kstep; const char* b2 = last ? nB : cB + (size_t)(t + 2) * kstep;
      const char* a3 = a2 + kstep; const char* b3 = b2 + kstep;
      PG8_LDB(B0, 0, 0); PG8_SCHED; PG8_LDA(At, 0, 0); PG8_STAGE(PG8_SA(1, 1), a1 + hstepA, voffA);
      PG8_WAIT_L(8); PG8_BAR; PG8_WAIT_L(0); PG8_MMA(0, 0, At, B0); PG8_BAR; PG8_SCHED;
      PG8_LDB(B1, 0, 1); PG8_STAGE(PG8_SB(0, 0), b2, voffB);
      PG8_BAR; PG8_WAIT_L(0); PG8_MMA(0, 1, At, B1); PG8_BAR;
      PG8_LDA(At, 0, 1); PG8_STAGE(PG8_SA(0, 0), a2, voffA);
      PG8_BAR; PG8_WAIT_L(0); PG8_MMA(1, 0, At, B0); PG8_BAR; PG8_SCHED;
      PG8_STAGE(PG8_SB(0, 1), b2 + hstepB, voffB);
      PG8_WAIT_V(6); PG8_BAR; PG8_MMA(1, 1, At, B1); PG8_BAR;
      PG8_LDB(B0, 1, 0); PG8_SCHED; PG8_LDA(At, 1, 0); PG8_STAGE(PG8_SA(0, 1), a2 + hstepA, voffA);
      PG8_WAIT_L(8); PG8_BAR; PG8_WAIT_L(0); PG8_MMA(0, 0, At, B0); PG8_BAR; PG8_SCHED;
      PG8_LDB(B1, 1, 1); PG8_STAGE(PG8_SB(1, 0), b3, voffB);
      PG8_BAR; PG8_WAIT_L(0); PG8_MMA(0, 1, At, B1); PG8_BAR;
      PG8_LDA(At, 1, 1); PG8_STAGE(PG8_SA(1, 0), a3, voffA);
      PG8_BAR; PG8_WAIT_L(0); PG8_MMA(1, 0, At, B0); PG8_BAR; PG8_SCHED;
      PG8_STAGE(PG8_SB(1, 1), b3 + hstepB, voffB);
      PG8_WAIT_V(6); PG8_BAR; PG8_MMA(1, 1, At, B1); PG8_BAR;
    }
    E(acc, cur, wr, wc, fr, fq);
    if (!has_next) break;
#pragma unroll
    for (int a = 0; a < 2; ++a)
#pragma unroll
      for (int b = 0; b < 2; ++b)
#pragma unroll
        for (int m = 0; m < 4; ++m)
#pragma unroll
          for (int n = 0; n < 2; ++n) acc[a][b][m][n] = (f32x4){0.f, 0.f, 0.f, 0.f};
    cur = nxt; cA = nA; cB = nB; ++ui;
  }
  PG8_WAIT_V(0);
  if (wr == 0) PG8_BAR;
  PG8_BAR;
#undef PG8_SA
#undef PG8_SB
#undef PG8_STAGE
#undef PG8_LDA
#undef PG8_LDB
#undef PG8_MMA
#undef PG8_WAIT_V
#undef PG8_WAIT_L
#undef PG8_BAR
#undef PG8_SCHED
}
}
using pg8::Unit;
typedef f32x4 AccT[2][2][4][2];

DI void asm_fence() { asm volatile("" ::: "memory"); }
#define EPI_ROWS4 _Pragma("unroll") for (int ai = 0; ai < 2; ++ai) if ((asm_fence(), true)) _Pragma("unroll") for (int m = 0; m < 4; ++m)
#define EPI_ROWS _Pragma("unroll") for (int ai = 0; ai < 2; ++ai) _Pragma("unroll") for (int m = 0; m < 4; ++m) if ((asm_fence(), true))
DI u32x4 pack8f(const f32x4& a, const f32x4& b) { u32x4 w; w[0] = pack2(a[0], a[1]); w[1] = pack2(a[2], a[3]); w[2] = pack2(b[0], b[1]); w[3] = pack2(b[2], b[3]); return w; }
DI size_t k_off(int t, int d) { return (size_t)(t >> 5) * 2048 + (((d >> 4) * 64 + ((d >> 3) & 1) * 32 + (t & 31)) << 3) + (d & 7); }

struct EpiL0In {
  static constexpr bool PERM = true;
  bf16_t* U0; bf16_t* G0;
  DI void operator()(const AccT& acc, const Unit& u, int wr, int wc, int fr, int fq) const {
    EPI_ROWS { const int row = u.pm * 256 + ai * 128 + wr * 64 + m * 16 + fr;
      _Pragma("unroll") for (int bj = 0; bj < 2; ++bj) { const int c0 = u.pn * 256 + bj * 128 + wc * 32 + 8 * fq;
        const bool isu = u.pn * 256 + bj * 128 < LW;
        bf16_t* dst = isu ? U0 + (size_t)row * LW + c0 : G0 + (size_t)row * LW + (c0 - LW);
        *(u32x4*)dst = pack8f(acc[ai][bj][m][0], acc[ai][bj][m][1]); } }
  }
};

template <bool NEXT>
struct EpiOut {
  static constexpr bool PERM = false;
  const float* in_lat; const float* in_ctx; float* out_lat; float* out_ctx; const float* gate;
  const float* gs; bf16_t* NB_; float* ss;
  DI void operator()(const AccT& acc, const Unit& u, int wr, int wc, int fr, int fq) const {
    const int rb = u.pm * 256;
    const float* src; float* dst; const float* g; const float* gsv; int rr;
    if (rb < RL) { src = in_lat; dst = out_lat; rr = rb; g = gate + (size_t)(rb >> 11) * 3072; gsv = gs + (size_t)(rb >> 11) * 1024; }
    else { src = in_ctx; dst = out_ctx; rr = rb - RL; g = gate + (size_t)8 * 3072; gsv = gs + (size_t)8 * 1024; }
    const int cb = u.pn * 256 + wc * 32 + 4 * fq;
    f32x4 gv[4], sv[4];
    _Pragma("unroll") for (int q = 0; q < 4; ++q) { gv[q] = *(const f32x4*)(g + cb + (q >> 1) * 128 + (q & 1) * 16); if (NEXT) sv[q] = *(const f32x4*)(gsv + cb + (q >> 1) * 128 + (q & 1) * 16); }
    const int r0 = rr + wr * 64 + fr;
    f32x4 hc[4], hn[4];
    _Pragma("unroll") for (int q = 0; q < 4; ++q) hc[q] = *(const f32x4*)(src + (size_t)r0 * 1024 + cb + (q >> 1) * 128 + (q & 1) * 16);
    _Pragma("unroll") for (int r_ = 0; r_ < 8; ++r_) {
      const int ai = r_ >> 2, m = r_ & 3, row = r0 + 128 * ai + 16 * m;
      if (r_ + 1 < 8) { const int rown = r0 + 128 * ((r_ + 1) >> 2) + 16 * ((r_ + 1) & 3);
        _Pragma("unroll") for (int q = 0; q < 4; ++q) hn[q] = *(const f32x4*)(src + (size_t)rown * 1024 + cb + (q >> 1) * 128 + (q & 1) * 16); }
      float sq = 0.f;
      _Pragma("unroll") for (int q = 0; q < 4; ++q) {
        const int c = cb + (q >> 1) * 128 + (q & 1) * 16;
        const f32x4 o = hc[q] + gv[q] * acc[ai][q >> 1][m][q & 1];
        *(f32x4*)(dst + (size_t)row * 1024 + c) = o;
        if (NEXT) {
          u32x2 w; w[0] = pack2(o[0] * sv[q][0], o[1] * sv[q][1]); w[1] = pack2(o[2] * sv[q][2], o[3] * sv[q][3]);
          *(u32x2*)(NB_ + (size_t)(row - rr + rb) * 1024 + c) = w;
          sq += o[0] * o[0] + o[1] * o[1] + o[2] * o[2] + o[3] * o[3];
        }
      }
      if (NEXT) {
        sq += __shfl_xor(sq, 16); sq += __shfl_xor(sq, 32);
        if (fq == 0) atomicAdd(ss + (row - rr + rb), sq);
      }
      asm_fence();
      _Pragma("unroll") for (int q = 0; q < 4; ++q) hc[q] = hn[q];
    }
  }
};

struct EpiL1 {
  static constexpr bool PERM = true;
  bf16_t *Q, *QR, *Kb, *G; const float *rc, *rs; const float* ss; const float* shw;
  DI void operator()(const AccT& acc, const Unit& u, int wr, int wc, int fr, int fq) const {
    const int rb = u.pm * 256; const bool lat = rb < RL;
    const float* sh = shw + (size_t)(lat ? (rb >> 11) : 8) * 4096;
    const int r0 = rb + wr * 64 + fr;
    float rstd[8];
    _Pragma("unroll") for (int r_ = 0; r_ < 8; ++r_) rstd[r_] = ss[r0 + 128 * (r_ >> 2) + 16 * (r_ & 3)];
    _Pragma("unroll") for (int r_ = 0; r_ < 8; ++r_) rstd[r_] = rsqrtf(rstd[r_] * (1.f / 1024.f) + 1e-6f);
    const bool qk = u.pn * 256 < 1280;
    f32x4 b1[2], b2v[2];
    int c0s[2], d0s[2];
    _Pragma("unroll") for (int bj = 0; bj < 2; ++bj) {
      const int c0 = u.pn * 256 + bj * 128 + wc * 32 + 8 * fq; c0s[bj] = c0; d0s[bj] = (c0 & 63) >> 1;
      if (qk) { const int oc = (c0 & ~63) + d0s[bj]; b1[bj] = *(const f32x4*)(sh + oc); b2v[bj] = *(const f32x4*)(sh + oc + 32); }
      else { b1[bj] = *(const f32x4*)(sh + c0 + 256); b2v[bj] = *(const f32x4*)(sh + c0 + 260); }
    }
    f32x4 cc, sc, cn, sn;
    if (qk && lat) { const int t = r0 & 2047; cc = *(const f32x4*)(rc + t * 32 + d0s[0]); sc = *(const f32x4*)(rs + t * 32 + d0s[0]); }
    _Pragma("unroll") for (int r_ = 0; r_ < 8; ++r_) {
      const int ai = r_ >> 2, m = r_ & 3, row = r0 + 128 * ai + 16 * m;
      if (qk && lat && r_ + 1 < 8) { const int tn = (r0 + 128 * ((r_ + 1) >> 2) + 16 * ((r_ + 1) & 3)) & 2047;
        cn = *(const f32x4*)(rc + tn * 32 + d0s[0]); sn = *(const f32x4*)(rs + tn * 32 + d0s[0]); }
      _Pragma("unroll") for (int bj = 0; bj < 2; ++bj) { const int c0 = c0s[bj], d0 = d0s[bj];
        const f32x4 v0 = acc[ai][bj][m][0] * rstd[r_], v1 = acc[ai][bj][m][1] * rstd[r_];
        if (qk) {
          float x1[4] = {v0[0] + b1[bj][0], v0[2] + b1[bj][1], v1[0] + b1[bj][2], v1[2] + b1[bj][3]}, x2[4] = {v0[1] + b2v[bj][0], v0[3] + b2v[bj][1], v1[1] + b2v[bj][2], v1[3] + b2v[bj][3]};
          float y1[4], y2[4];
          int t;
          if (lat) { t = row & 2047; _Pragma("unroll") for (int j = 0; j < 4; ++j) { y1[j] = x1[j] * cc[j] - x2[j] * sc[j]; y2[j] = x2[j] * cc[j] + x1[j] * sc[j]; } }
          else { t = (row - RL) & 255; _Pragma("unroll") for (int j = 0; j < 4; ++j) { y1[j] = x1[j]; y2[j] = x2[j]; } }
          if (u.pn < 4) {
            const size_t o = (size_t)row * 1024 + (c0 & ~63) + d0;
            u32x2 a, b2; a[0] = pack2(x1[0] * QSCALE, x1[1] * QSCALE); a[1] = pack2(x1[2] * QSCALE, x1[3] * QSCALE);
            b2[0] = pack2(x2[0] * QSCALE, x2[1] * QSCALE); b2[1] = pack2(x2[2] * QSCALE, x2[3] * QSCALE);
            *(u32x2*)(Q + o) = a; *(u32x2*)(Q + o + 32) = b2;
            if (lat) {
              a[0] = pack2(y1[0] * QSCALE, y1[1] * QSCALE); a[1] = pack2(y1[2] * QSCALE, y1[3] * QSCALE);
              b2[0] = pack2(y2[0] * QSCALE, y2[1] * QSCALE); b2[1] = pack2(y2[2] * QSCALE, y2[3] * QSCALE);
              *(u32x2*)(QR + o) = a; *(u32x2*)(QR + o + 32) = b2;
            }
          } else {
            const int kvh = (c0 - 1024) >> 6;
            bf16_t* kh = lat ? Kb + (size_t)((row >> 11) * 4 + kvh) * 64 * 2048 : Kb + (size_t)RL * 256 + (size_t)(((row - RL) >> 8) * 4 + kvh) * 8 * 2048;
            u32x2 a, b2; a[0] = pack2(y1[0], y1[1]); a[1] = pack2(y1[2], y1[3]); b2[0] = pack2(y2[0], y2[1]); b2[1] = pack2(y2[2], y2[3]);
            *(u32x2*)(kh + k_off(t, d0)) = a; *(u32x2*)(kh + k_off(t, d0 + 32)) = b2;
          }
        } else {
          *(u32x4*)(G + (size_t)row * 1024 + (c0 - 1280)) = pack8f(v0 + b1[bj], v1 + b2v[bj]);
        } }
      asm_fence();
      cc = cn; sc = sn;
    }
  }
};

template <int H, int VCOL0  >
struct EpiV {
  static constexpr bool PERM = true;
  bf16_t *VtL, *VtC; const float* ss; const float* shw;
  DI void operator()(const AccT& acc, const Unit& u, int wr, int wc, int fr, int fq) const {
    const bool latn = u.pn * 256 < RL;
    bf16_t* basep = latn ? VtL : VtC;
    const int tsh = latn ? 11 : 8, tiles = latn ? 64 : 8;
    const int nb = (latn ? u.pn * 256 : u.pn * 256 - RL) + wc * 32 + 8 * fq;
    f32x4 r0[2], r1[2];
    _Pragma("unroll") for (int bj = 0; bj < 2; ++bj) {
      const float* sp = ss + u.pn * 256 + bj * 128 + wc * 32 + 8 * fq;
      const f32x4 a = *(const f32x4*)sp, b2 = *(const f32x4*)(sp + 4);
      _Pragma("unroll") for (int j = 0; j < 4; ++j) { r0[bj][j] = rsqrtf(a[j] * (1.f / 1024.f) + 1e-6f); r1[bj][j] = rsqrtf(b2[j] * (1.f / 1024.f) + 1e-6f); }
    }
    const int vb0 = latn ? (nb >> tsh) : 8;
    float biasr[8];
    _Pragma("unroll") for (int r_ = 0; r_ < 8; ++r_) biasr[r_] = shw[(size_t)vb0 * 4096 + VCOL0 + u.pm * 256 + (r_ >> 2) * 128 + wr * 64 + (r_ & 3) * 16 + fr];
    EPI_ROWS { const int rowd = u.pm * 256 + ai * 128 + wr * 64 + m * 16 + fr, head = rowd >> 6, d = rowd & 63;
      const unsigned rowoff = (unsigned)(((d >> 5) * 128 + (d & 31)) << 3);
      _Pragma("unroll") for (int bj = 0; bj < 2; ++bj) { const int nn = nb + bj * 128;
        const int bidx = nn >> tsh, t = nn & ((1 << tsh) - 1);
        const float bias = biasr[ai * 4 + m];
        const unsigned off = (unsigned)(((bidx * H + head) * tiles + (t >> 5)) * 2048) + rowoff + (unsigned)((((t & 31) >> 4) * 64) << 3) + (unsigned)(((t >> 3) & 1) * 4);
        const f32x4 v0 = acc[ai][bj][m][0] * r0[bj] + bias, v1 = acc[ai][bj][m][1] * r1[bj] + bias;
        u32x2 a, b2; a[0] = pack2(v0[0], v0[1]); a[1] = pack2(v0[2], v0[3]); b2[0] = pack2(v1[0], v1[1]); b2[1] = pack2(v1[2], v1[3]);
        *(u32x2*)(basep + off) = a; *(u32x2*)(basep + off + 256) = b2; } }
  }
};

struct EpiL2 {
  static constexpr bool PERM = true;
  bf16_t *Q, *Kb, *G; const float* ss; const float* shw;
  DI void operator()(const AccT& acc, const Unit& u, int wr, int wc, int fr, int fq) const {
    const int rb = u.pm * 256; const bool lat = rb < RL;
    const float* sh = shw + (size_t)(lat ? (rb >> 11) : 8) * 4096;
    const int r0 = rb + wr * 64 + fr;
    float rstd[8];
    _Pragma("unroll") for (int r_ = 0; r_ < 8; ++r_) rstd[r_] = ss[r0 + 128 * (r_ >> 2) + 16 * (r_ & 3)];
    _Pragma("unroll") for (int r_ = 0; r_ < 8; ++r_) rstd[r_] = rsqrtf(rstd[r_] * (1.f / 1024.f) + 1e-6f);
    f32x4 b1[2], b2v[2];
    _Pragma("unroll") for (int bj = 0; bj < 2; ++bj) { const int c0 = u.pn * 256 + bj * 128 + wc * 32 + 8 * fq, oc = u.pn < 8 ? c0 : c0 + 1024;
      b1[bj] = *(const f32x4*)(sh + oc); b2v[bj] = *(const f32x4*)(sh + oc + 4); }
    _Pragma("unroll") for (int r_ = 0; r_ < 8; ++r_) { const int ai = r_ >> 2, m = r_ & 3, row = r0 + 128 * ai + 16 * m;
      _Pragma("unroll") for (int bj = 0; bj < 2; ++bj) { const int c0 = u.pn * 256 + bj * 128 + wc * 32 + 8 * fq;
        const f32x4 v0 = acc[ai][bj][m][0] * rstd[r_] + b1[bj], v1 = acc[ai][bj][m][1] * rstd[r_] + b2v[bj];
        if (u.pn < 4) *(u32x4*)(Q + (size_t)row * 1024 + c0) = pack8f(v0 * QSCALE, v1 * QSCALE);
        else if (u.pn < 8) {
          const int hd = (c0 - 1024) >> 6, d0 = c0 & 63;
          bf16_t* kh; int t;
          if (lat) { kh = Kb + (size_t)((row >> 11) * 16 + hd) * 64 * 2048; t = row & 2047; }
          else { const int rr = row - RL; kh = Kb + (size_t)RL * 1024 + (size_t)((rr >> 8) * 16 + hd) * 8 * 2048; t = rr & 255; }
          *(u32x4*)(kh + k_off(t, d0)) = pack8f(v0, v1);
        } else *(u32x4*)(G + (size_t)row * 1024 + (c0 - 2048)) = pack8f(v0, v1); }
      asm_fence(); }
  }
};

struct EpiL3In {
  static constexpr bool PERM = true;
  bf16_t *ACAT, *G; const float* ss; const float* shw;
  DI void operator()(const AccT& acc, const Unit& u, int wr, int wc, int fr, int fq) const {
    const int rb = u.pm * 256;
    const float* sh = shw + (size_t)(rb < RL ? (rb >> 11) : 8) * 4096;
    const int r0 = rb + wr * 64 + fr;
    float rstd[8];
    _Pragma("unroll") for (int r_ = 0; r_ < 8; ++r_) rstd[r_] = ss[r0 + 128 * (r_ >> 2) + 16 * (r_ & 3)];
    _Pragma("unroll") for (int r_ = 0; r_ < 8; ++r_) rstd[r_] = rsqrtf(rstd[r_] * (1.f / 1024.f) + 1e-6f);
    f32x4 b1[2], b2v[2];
    _Pragma("unroll") for (int bj = 0; bj < 2; ++bj) { const int c0 = u.pn * 256 + bj * 128 + wc * 32 + 8 * fq; b1[bj] = *(const f32x4*)(sh + c0); b2v[bj] = *(const f32x4*)(sh + c0 + 4); }
    _Pragma("unroll") for (int r_ = 0; r_ < 8; ++r_) { const int ai = r_ >> 2, m = r_ & 3, row = r0 + 128 * ai + 16 * m;
      _Pragma("unroll") for (int bj = 0; bj < 2; ++bj) { const int c0 = u.pn * 256 + bj * 128 + wc * 32 + 8 * fq;
        const u32x4 w = pack8f(acc[ai][bj][m][0] * rstd[r_] + b1[bj], acc[ai][bj][m][1] * rstd[r_] + b2v[bj]);
        if (u.pn < 4) *(u32x4*)(ACAT + ((size_t)(c0 >> 4) * NCH + (row >> 4)) * 512 + (row & 15) * 16 + (c0 & 15)) = w;
        else if (rb < RL) *(u32x4*)(G + (size_t)row * 1024 + (c0 - 1024)) = w; }
      asm_fence(); }
  }
};

struct EpiS5State {
  static constexpr bool PERM = false;
  float* S;
  DI void operator()(const AccT& acc, const Unit& u, int wr, int wc, int fr, int fq) const {
    float* sp = S + ((size_t)u.pb * NCHP + u.pm * 256) * 256 + wc * 32 + 4 * fq;
    EPI_ROWS { const unsigned o = (unsigned)(ai * 128 + wr * 64 + m * 16 + fr) * 256u;
      *(f32x4*)(sp + o) = acc[ai][0][m][0]; *(f32x4*)(sp + o + 16) = acc[ai][0][m][1];
      *(f32x4*)(sp + o + 128) = acc[ai][1][m][0]; *(f32x4*)(sp + o + 144) = acc[ai][1][m][1]; }
  }
};

struct EpiS5Y {
  static constexpr bool PERM = true;
  bf16_t* YG;
  DI void operator()(const AccT& acc, const Unit& u, int wr, int wc, int fr, int fq) const {
    EPI_ROWS { const int chunk = u.pm * 256 + ai * 128 + wr * 64 + m * 16 + fr;
      _Pragma("unroll") for (int bj = 0; bj < 2; ++bj) { const int n0 = bj * 128 + wc * 32 + 8 * fq;
        f32x4 v0 = acc[ai][bj][m][0], v1 = acc[ai][bj][m][1];
        _Pragma("unroll") for (int j = 0; j < 4; ++j) { v0[j] = gelu_tanh(v0[j]); v1[j] = gelu_tanh(v1[j]); }
        *(u32x4*)(YG + ((size_t)chunk * 16 + (n0 >> 4)) * 1024 + u.pb * 16 + (n0 & 15)) = pack8f(v0, v1); } }
  }
};

struct EpiGlu {
  static constexpr bool PERM = true;
  const bf16_t *YG, *G; const float* gb; bf16_t* ACT;
  DI void operator()(const AccT& acc, const Unit& u, int wr, int wc, int fr, int fq) const {
    const int r0 = u.pm * 256 + wr * 64 + fr, cb = u.pn * 256 + wc * 32 + 8 * fq;
    f32x4 b0[2], b1[2];
    _Pragma("unroll") for (int bj = 0; bj < 2; ++bj) { b0[bj] = *(const f32x4*)(gb + cb + bj * 128); b1[bj] = *(const f32x4*)(gb + cb + bj * 128 + 4); }
    u32x4 yc[2], gc[2], yn[2], gn_[2];
    _Pragma("unroll") for (int bj = 0; bj < 2; ++bj) { yc[bj] = *(const u32x4*)(YG + (size_t)r0 * 1024 + cb + bj * 128); gc[bj] = *(const u32x4*)(G + (size_t)r0 * 1024 + cb + bj * 128); }
    _Pragma("unroll") for (int r_ = 0; r_ < 8; ++r_) {
      const int ai = r_ >> 2, m = r_ & 3, row = r0 + 128 * ai + 16 * m;
      if (r_ + 1 < 8) { const int rown = r0 + 128 * ((r_ + 1) >> 2) + 16 * ((r_ + 1) & 3);
        _Pragma("unroll") for (int bj = 0; bj < 2; ++bj) { yn[bj] = *(const u32x4*)(YG + (size_t)rown * 1024 + cb + bj * 128); gn_[bj] = *(const u32x4*)(G + (size_t)rown * 1024 + cb + bj * 128); } }
      _Pragma("unroll") for (int bj = 0; bj < 2; ++bj) {
        const u32x4 y = yc[bj], gg = gc[bj];
        const f32x4 v0 = acc[ai][bj][m][0], v1 = acc[ai][bj][m][1];
        u32x4 w;
        w[0] = pack2(bflo(y[0]) * sigm(v0[0] + b0[bj][0]) * silu(bflo(gg[0])), bfhi(y[0]) * sigm(v0[1] + b0[bj][1]) * silu(bfhi(gg[0])));
        w[1] = pack2(bflo(y[1]) * sigm(v0[2] + b0[bj][2]) * silu(bflo(gg[1])), bfhi(y[1]) * sigm(v0[3] + b0[bj][3]) * silu(bfhi(gg[1])));
        w[2] = pack2(bflo(y[2]) * sigm(v1[0] + b1[bj][0]) * silu(bflo(gg[2])), bfhi(y[2]) * sigm(v1[1] + b1[bj][1]) * silu(bfhi(gg[2])));
        w[3] = pack2(bflo(y[3]) * sigm(v1[2] + b1[bj][2]) * silu(bflo(gg[3])), bfhi(y[3]) * sigm(v1[3] + b1[bj][3]) * silu(bfhi(gg[3])));
        *(u32x4*)(ACT + (size_t)row * 1024 + cb + bj * 128) = w;
      }
      asm_fence();
      _Pragma("unroll") for (int bj = 0; bj < 2; ++bj) { yc[bj] = yn[bj]; gc[bj] = gn_[bj]; }
    }
  }
};

struct TrJob { const float* W; bf16_t* dst; int N, ldd, k0, n0, perm, dup; };
DI TrJob tr_job(const Params& p, int j) {
  constexpr int T0 = 16 * 44, T1 = T0 + 22 * 16, T2 = T1 + 16 * 40, T3 = T2 + 256, T4 = T3 + 16 * 64, T5 = T4 + 256, T6 = T5 + 16 * 32, T7 = T6 + 256;
  char* ws = p.ws;
  TrJob t; int tile, K; t.perm = 0; t.dup = 0;
  bf16_t* base;
  if (j < T0) { t.W = p.in[7]; K = 1024; t.N = 2816; base = (bf16_t*)(ws + O_WT_IN0); tile = j; }
  else if (j < T1) { t.W = p.in[15]; K = 1408; t.N = 1024; base = (bf16_t*)(ws + O_WT_OUT0); tile = j - T0; }
  else if (j < T2) { t.W = p.in[19]; K = 1024; t.N = 2560; base = (bf16_t*)(ws + O_WT_IN1); tile = j - T1; }
  else if (j < T3) { t.W = p.in[21]; K = 1024; t.N = 1024; base = (bf16_t*)(ws + O_WT_OUT1); tile = j - T2; }
  else if (j < T4) { t.W = p.in[25]; K = 1024; t.N = 4096; base = (bf16_t*)(ws + O_WT_IN2); tile = j - T3; }
  else if (j < T5) { t.W = p.in[27]; K = 1024; t.N = 1024; base = (bf16_t*)(ws + O_WT_OUT2); tile = j - T4; }
  else if (j < T6) { t.W = p.in[31]; K = 1024; t.N = 2048; base = (bf16_t*)(ws + O_WT_IN3); tile = j - T5; }
  else if (j < T7) { t.W = p.in[40]; K = 1024; t.N = 1024; base = (bf16_t*)(ws + O_WT_GLU); tile = j - T6; }
  else { t.W = p.in[42]; K = 1024; t.N = 1024; base = (bf16_t*)(ws + O_WT_OUT3); tile = j - T7; }
  const int tn = t.N >> 6, tk_i = tile / tn;
  t.k0 = tk_i * 64; t.n0 = (tile - tk_i * tn) * 64;
  t.ldd = K;
  int drow = t.n0;
  if (j >= T1 && j < T2) {
    if (t.n0 < 1280) t.perm = 1;
    else if (t.n0 < 1536) drow = 2304 + (t.n0 - 1280);
    else drow = t.n0 - 256;
  } else if (j >= T3 && j < T4) {
    if (t.n0 >= 3072) drow = t.n0 - 1024;
    else if (t.n0 >= 2048) drow = 3072 + (t.n0 - 2048);
  }
  t.dst = base + (size_t)drow * t.ldd + t.k0;
  return t;
}

DI void transpose_range(const Params& p, char* smem, int j0, int j1, int first_blk, int skew) {
  if ((int)blockIdx.x < first_blk) return;
  float* smf = (float*)smem;
  const int G = (int)gridDim.x - first_blk;
  const int c = threadIdx.x & 63, rr = threadIdx.x >> 6, kp = threadIdx.x & 31, nb = threadIdx.x >> 5;
  int j = j0 + ((int)blockIdx.x - first_blk + G - (skew % G)) % G;
  float v[8];
  TrJob cur{};
  __syncthreads();
  if (j < j1) { cur = tr_job(p, j); _Pragma("unroll") for (int i = 0; i < 8; ++i) v[i] = cur.W[(size_t)(cur.k0 + i * 8 + rr) * cur.N + cur.n0 + c]; }
  for (; j < j1; j += G) {
    _Pragma("unroll") for (int i = 0; i < 8; ++i) smf[(i * 8 + rr) * 65 + c] = v[i];
    const TrJob me = cur;
    if (j + G < j1) { cur = tr_job(p, j + G); _Pragma("unroll") for (int i = 0; i < 8; ++i) v[i] = cur.W[(size_t)(cur.k0 + i * 8 + rr) * cur.N + cur.n0 + c]; }
    __syncthreads();
    _Pragma("unroll") for (int i = 0; i < 4; ++i) {
      const int n = nb + 16 * i;
      const int dr = me.perm ? (((n & 31) << 1) | (n >> 5)) : n;
      const unsigned w = pack2(smf[(2 * kp) * 65 + n], smf[(2 * kp + 1) * 65 + n]);
      bf16_t* d = me.dst + (size_t)dr * me.ldd + 2 * kp;
      *(unsigned*)d = w;
      if (me.dup) *(unsigned*)(d + 1408) = w;
    }
    __syncthreads();
  }
}

DI void phase0(const Params& p, char* smem) {
  char* ws = p.ws;
  float* smf = (float*)smem;
  const int NT_ = blockDim.x;
  for (int job = blockIdx.x; job < 384; job += gridDim.x) {
    const int l = job / 96, n0 = (job % 96) * 32;
    const float* aw = l == 0 ? p.in[4] : l == 1 ? p.in[16] : l == 2 ? p.in[22] : p.in[28];
    const float* ab = l == 0 ? p.in[5] : l == 1 ? p.in[17] : l == 2 ? p.in[23] : p.in[29];
    float* sv = smf;
    float* red = smf + 9 * 1024;
    for (int idx = threadIdx.x; idx < 9 * 1024; idx += NT_) {
      const int v = idx >> 10, k = idx & 1023;
      const float x = v < 8 ? p.in[1][v * 1024 + k] : p.in[3][k];
      sv[idx] = silu(x);
    }
    __syncthreads();
    const int col = threadIdx.x & 31, ks = threadIdx.x >> 5;
    float a[9];
    _Pragma("unroll") for (int v = 0; v < 9; ++v) a[v] = 0.f;
    for (int kb = ks * 64; kb < ks * 64 + 64; kb += 16) {
      float wv[16];
      _Pragma("unroll") for (int u = 0; u < 16; ++u) wv[u] = aw[(size_t)(kb + u) * 3072 + n0 + col];
      _Pragma("unroll") for (int u = 0; u < 16; ++u) _Pragma("unroll") for (int v = 0; v < 9; ++v) a[v] += sv[v * 1024 + kb + u] * wv[u];
    }
    _Pragma("unroll") for (int v = 0; v < 9; ++v) red[(ks * 9 + v) * 32 + col] = a[v];
    __syncthreads();
    float* MOD = (float*)(ws + O_MOD);
    for (int idx = threadIdx.x; idx < 9 * 32; idx += NT_) {
      const int v = idx >> 5, cc = idx & 31;
      float sum = ab[n0 + cc];
      _Pragma("unroll") for (int q = 0; q < 16; ++q) sum += red[(q * 9 + v) * 32 + cc];
      MOD[(size_t)(l * 9 + v) * 3072 + n0 + cc] = sum;
    }
    __syncthreads();
  }
  transpose_range(p, smem, 0, 16 * 44, gridDim.x == 256 ? 128 : 0, 0);
}

DI void tables_phase(const Params& p, int first_blk) {
  if ((int)blockIdx.x < first_blk) return;
  char* ws = p.ws;
  const int gt = ((int)blockIdx.x - first_blk) * blockDim.x + threadIdx.x, gn = ((int)gridDim.x - first_blk) * blockDim.x;
  {
    bf16_t* WG = (bf16_t*)(ws + O_WG);
    for (int idx = gt; idx < 16 * 2 * 192 * 96; idx += gn) {
      const int kk = idx % 96; int t = idx / 96; const int n = t % 192; t /= 192; const int d = t & 1, k = t >> 1;
      const int c = n >> 5, gate = (n >> 4) & 1, ch = c * 16 + (n & 15);
      float v = 0.f;
      if (ch < 88 && kk < 88) { const float* w = gate ? p.in[12] : p.in[10]; v = w[((size_t)(d * 16 + k) * 88 + kk) * 88 + ch]; }
      WG[idx] = f2bf(v);
    }
  }
  { float* SS = (float*)(ws + O_SS); for (int idx = gt; idx < 3 * R; idx += gn) SS[idx] = 0.f; }
  {
    float* RCt = (float*)(ws + O_ROPEC); float* RSt = (float*)(ws + O_ROPES);
    for (int idx = gt; idx < 2048 * 32; idx += gn) {
      const int t = idx >> 5, j = idx & 31;
      const float pos = (float)(j < 16 ? (t >> 6) : (t & 63));
      const float freq = exp2f(-(float)(j & 15) * (13.287712379549449f / 16.f));
      float s, c; sincos_rev(pos * freq * 0.15915494309189535f, s, c);
      RCt[idx] = c; RSt[idx] = s;
    }
  }
  {
    float2* POW = (float2*)(ws + O_POW); float2* BB = (float2*)(ws + O_BBAR);
    for (int idx = gt; idx < 2 * 64 * 17 * 64; idx += gn) {
      const int pp = idx & 63; int t = idx >> 6; const int n = t % 17; t /= 17;
      const float are = p.in[32][t * 64 + pp], aim = p.in[33][t * 64 + pp], dt = expf(p.in[34][t]);
      const float mag = expf((float)n * are * dt);
      const double rev = (double)n * (double)aim * (double)dt * 0.15915494309189535;
      float s, c; sincos_rev((float)(rev - rint(rev)), s, c);
      POW[idx] = make_float2(mag * c, mag * s);
    }
    for (int idx = gt; idx < 2 * 64 * 64 * 16; idx += gn) {
      const int t = idx >> 4;
      const int dg = t >> 6;
      const float are = p.in[32][t], aim = p.in[33][t], dt = expf(p.in[34][dg]);
      const float mag = expf(are * dt);
      const double rev = (double)aim * (double)dt * 0.15915494309189535;
      float s, c; sincos_rev((float)(rev - rint(rev)), s, c);
      const float nr = mag * c - 1.f, ni = mag * s;
      const float den = 1.f / (are * are + aim * aim);
      const float cr = (nr * are + ni * aim) * den, ci = (ni * are - nr * aim) * den;
      const float br = p.in[35][idx], bi = p.in[36][idx];
      BB[idx] = make_float2(cr * br - ci * bi, cr * bi + ci * br);
    }
  }
}

DI void modfold_phase(const Params& p, char* smem) {
  char* ws = p.ws;
  const float* MOD = (const float*)(ws + O_MOD);
  float* GS = (float*)(ws + O_GS);
  float* SHW = (float*)(ws + O_SHW);
  const int NT_ = blockDim.x;
  for (int idx = blockIdx.x * NT_ + threadIdx.x; idx < 3 * 9 * 1024; idx += gridDim.x * NT_) {
    const int k = idx & 1023, lv = idx >> 10, l = lv / 9 + 1, v = lv - (l - 1) * 9;
    const float* gn = l == 1 ? p.in[18] : l == 2 ? p.in[24] : p.in[30];
    GS[idx] = gn[k] * (1.f + MOD[(size_t)(l * 9 + v) * 3072 + 1024 + k]);
  }
  float* smf = (float*)smem;
  float* sv = smf;
  float* red = smf + 9 * 1024;
  for (int job = (int)gridDim.x - 1 - (int)blockIdx.x; job < 80 + 128 + 64; job += gridDim.x) {
    int l, n0; const float* W; int N;
    if (job < 80) { l = 1; n0 = job * 32; W = p.in[19]; N = 2560; }
    else if (job < 208) { l = 2; n0 = (job - 80) * 32; W = p.in[25]; N = 4096; }
    else { l = 3; n0 = (job - 208) * 32; W = p.in[31]; N = 2048; }
    __syncthreads();
    for (int idx = threadIdx.x; idx < 9 * 1024; idx += NT_) sv[idx] = MOD[(size_t)(l * 9 + (idx >> 10)) * 3072 + (idx & 1023)];
    __syncthreads();
    const int col = threadIdx.x & 31, ks = threadIdx.x >> 5;
    float a[9];
    _Pragma("unroll") for (int v = 0; v < 9; ++v) a[v] = 0.f;
    for (int kb = ks * 64; kb < ks * 64 + 64; kb += 16) {
      float wv[16];
      _Pragma("unroll") for (int u = 0; u < 16; ++u) wv[u] = W[(size_t)(kb + u) * N + n0 + col];
      _Pragma("unroll") for (int u = 0; u < 16; ++u) _Pragma("unroll") for (int v = 0; v < 9; ++v) a[v] += sv[v * 1024 + kb + u] * wv[u];
    }
    _Pragma("unroll") for (int v = 0; v < 9; ++v) red[(ks * 9 + v) * 32 + col] = a[v];
    __syncthreads();
    for (int idx = threadIdx.x; idx < 9 * 32; idx += NT_) {
      const int v = idx >> 5, cc = idx & 31;
      float sum = 0.f;
      _Pragma("unroll") for (int q = 0; q < 16; ++q) sum += red[(q * 9 + v) * 32 + cc];
      SHW[(size_t)((l - 1) * 9 + v) * 4096 + n0 + cc] = sum;
    }
  }
  __syncthreads();
}

DI void norm_phase(const float* lat, const float* ctx, const float* gn, const float* mod  , bf16_t* NB_) {
  const int tid_ = opaque_tid();
  const int lane = tid_ & 63;
  const int w0 = blockIdx.x * 8 + (tid_ >> 6), nw = gridDim.x * 8;
  for (int row0 = w0 * 2; row0 < R; row0 += nw * 2) {
    f32x4 v[2][4]; float ss[2] = {0.f, 0.f};
    const float* m[2];
    _Pragma("unroll") for (int q = 0; q < 2; ++q) {
      const int row = row0 + q;
      const float* src;
      if (row < RL) { src = lat + (size_t)row * 1024; m[q] = mod + (size_t)(row >> 11) * 3072; }
      else { src = ctx + (size_t)(row - RL) * 1024; m[q] = mod + (size_t)8 * 3072; }
      _Pragma("unroll") for (int i = 0; i < 4; ++i) v[q][i] = *(const f32x4*)(src + (i * 64 + lane) * 4);
    }
    _Pragma("unroll") for (int q = 0; q < 2; ++q) {
      _Pragma("unroll") for (int i = 0; i < 4; ++i) ss[q] += v[q][i][0] * v[q][i][0] + v[q][i][1] * v[q][i][1] + v[q][i][2] * v[q][i][2] + v[q][i][3] * v[q][i][3];
      _Pragma("unroll") for (int o = 32; o >= 1; o >>= 1) ss[q] += __shfl_xor(ss[q], o);
    }
    _Pragma("unroll") for (int q = 0; q < 2; ++q) {
      const float rstd = rsqrtf(ss[q] * (1.f / 1024.f) + 1e-6f);
      _Pragma("unroll") for (int i = 0; i < 4; ++i) {
        const int k = (i * 64 + lane) * 4;
        const f32x4 g = *(const f32x4*)(gn + k), sh = *(const f32x4*)(m[q] + k), sc = *(const f32x4*)(m[q] + 1024 + k);
        u32x2 o;
        o[0] = pack2(v[q][i][0] * rstd * g[0] * (1.f + sc[0]) + sh[0], v[q][i][1] * rstd * g[1] * (1.f + sc[1]) + sh[1]);
        o[1] = pack2(v[q][i][2] * rstd * g[2] * (1.f + sc[2]) + sh[2], v[q][i][3] * rstd * g[3] * (1.f + sc[3]) + sh[3]);
        *(u32x2*)(NB_ + (size_t)(row0 + q) * 1024 + k) = o;
      }
    }
  }
}

DI void final_norm_phase(float* H, const float* gn) {
  const int tid_ = opaque_tid();
  const int lane = tid_ & 63;
  const int w0 = blockIdx.x * 8 + (tid_ >> 6), nw = gridDim.x * 8;
  for (int row0 = w0 * 2; row0 < RL; row0 += nw * 2) {
    f32x4 v[2][4]; float ss[2] = {0.f, 0.f};
    _Pragma("unroll") for (int q = 0; q < 2; ++q) _Pragma("unroll") for (int i = 0; i < 4; ++i) v[q][i] = *(const f32x4*)(H + (size_t)(row0 + q) * 1024 + (i * 64 + lane) * 4);
    _Pragma("unroll") for (int q = 0; q < 2; ++q) {
      _Pragma("unroll") for (int i = 0; i < 4; ++i) ss[q] += v[q][i][0] * v[q][i][0] + v[q][i][1] * v[q][i][1] + v[q][i][2] * v[q][i][2] + v[q][i][3] * v[q][i][3];
      _Pragma("unroll") for (int o = 32; o >= 1; o >>= 1) ss[q] += __shfl_xor(ss[q], o);
    }
    _Pragma("unroll") for (int q = 0; q < 2; ++q) {
      const float rstd = rsqrtf(ss[q] * (1.f / 1024.f) + 1e-6f);
      _Pragma("unroll") for (int i = 0; i < 4; ++i) {
        const int k = (i * 64 + lane) * 4;
        const f32x4 g = *(const f32x4*)(gn + k);
        f32x4 o; o[0] = v[q][i][0] * rstd * g[0]; o[1] = v[q][i][1] * rstd * g[1]; o[2] = v[q][i][2] * rstd * g[2]; o[3] = v[q][i][3] * rstd * g[3];
        *(f32x4*)(H + (size_t)(row0 + q) * 1024 + k) = o;
      }
    }
  }
}

DI void lru_phase(const Params& p, char* smem) {
  char* ws = p.ws;
  const int tid_ = opaque_tid();
  const int sub = tid_ >> 8;
  smem += sub * 36864;
  bf16_t* Wl = (bf16_t*)smem;
  bf16_t* Uc = Wl + 96 * 96;
  float* aggA = (float*)(Uc + 64 * 96);
  float* aggH = aggA + 16 * 48;
  const bf16_t* U0 = (const bf16_t*)(ws + O_U0);
  const bf16_t* G0 = (const bf16_t*)(ws + O_G0);
  const int tid = tid_ & 255, lane = tid & 63, w = tid >> 6, col = lane & 15, quad = lane >> 4;
  for (int item = blockIdx.x; item < 256; item += gridDim.x) {
    const int half = item & 1, dir = sub, k = (item >> 1) & 15, b = item >> 5;
    bf16_t* ACT = (bf16_t*)(ws + O_ACT0);
    __syncthreads();
    {
      const u32x4* src = (const u32x4*)((const bf16_t*)(ws + O_WG) + ((size_t)(k * 2 + dir) * 192 + half * 96) * 96);
      u32x4* dst = (u32x4*)Wl;
      for (int i = tid; i < 96 * 96 / 8; i += 256) dst[i] = src[i];
      if (tid < 64) { u32x4 z; z[0] = z[1] = z[2] = z[3] = 0u; *(u32x4*)(Uc + tid * 96 + 88) = z; }
    }
    float ba[3], bx[3], sp8[3];
    _Pragma("unroll") for (int c = 0; c < 3; ++c) {
      const int ch = 48 * half + 16 * c + col;
      if (ch < 88) {
        ba[c] = p.in[11][dir * LW + k * 88 + ch]; bx[c] = p.in[13][dir * LW + k * 88 + ch];
        sp8[c] = 8.f * log1pf(expf(-p.in[14][dir * LW + k * 88 + ch]));
      } else { ba[c] = 0.f; bx[c] = 0.f; sp8[c] = 0.f; }
    }
    const int cp = tid % 44, run = tid / 44;
    float cw[4][2], cb2[2];
    _Pragma("unroll") for (int t = 0; t < 4; ++t) { cw[t][0] = p.in[8][t * LW + k * 88 + 2 * cp]; cw[t][1] = p.in[8][t * LW + k * 88 + 2 * cp + 1]; }
    cb2[0] = p.in[9][k * 88 + 2 * cp]; cb2[1] = p.in[9][k * 88 + 2 * cp + 1];
    float carry = 0.f;
    unsigned un[19]; unsigned unmask = 0u;
    auto tile_info = [&](int ti, int& rowbase, int& L, int& t0) {
      if (ti < 4) { rowbase = RL + b * 256; L = 256; t0 = (dir ? 3 - ti : ti) * 64; }
      else { rowbase = b * 2048; L = 2048; t0 = (dir ? 31 - (ti - 4) : (ti - 4)) * 64; }
    };
    auto prefetch = [&](int ti) {
      int rowbase, L, t0; tile_info(ti, rowbase, L, t0);
      const unsigned* ub = (const unsigned*)(U0 + (size_t)rowbase * LW + k * 88 + 2 * cp);
      const int tb = t0 + 16 * (run < 4 ? run : 3) - 2;
      unsigned vm = 0u;
      _Pragma("unroll") for (int i = 0; i < 19; ++i) {
        const int tt = tb + i;
        un[i] = ub[(unsigned)min(max(tt, 0), L - 1) * (unsigned)(LW / 2)];
        vm |= (tt >= 0 && tt < L) ? (1u << i) : 0u;
      }
      unmask = vm;
    };
    prefetch(0);
    for (int ti = 0; ti < 36; ++ti) {
      int rowbase, L, t0; tile_info(ti, rowbase, L, t0);
      if (tid < 176) {
        if (unmask != 0x7ffffu) { _Pragma("unroll") for (int i = 0; i < 19; ++i) un[i] = ((unmask >> i) & 1u) ? un[i] : 0u; }
        _Pragma("unroll") for (int t = 0; t < 16; ++t) {
          const float y0 = cb2[0] + cw[0][0] * bflo(un[t]) + cw[1][0] * bflo(un[t + 1]) + cw[2][0] * bflo(un[t + 2]) + cw[3][0] * bflo(un[t + 3]);
          const float y1 = cb2[1] + cw[0][1] * bfhi(un[t]) + cw[1][1] * bfhi(un[t + 1]) + cw[2][1] * bfhi(un[t + 2]) + cw[3][1] * bfhi(un[t + 3]);
          *(unsigned*)(Uc + (16 * run + t) * 96 + 2 * cp) = pack2(y0, y1);
        }
      }
      if (ti + 1 < 36) prefetch(ti + 1);
      bf16_t gv[3][4];
      _Pragma("unroll") for (int c = 0; c < 3; ++c) {
        const int ch = 48 * half + 16 * c + col;
        _Pragma("unroll") for (int j = 0; j < 4; ++j)
          gv[c][j] = G0[(unsigned)(rowbase + t0 + 16 * w + 4 * quad) * (unsigned)LW + (unsigned)(j * LW + k * 88 + min(ch, 87))];
      }
      const bool second = ti < 4 ? (ti >= 2) : (ti >= 20);
      const bool adjacent = (ti == 2) || (ti == 20);
      bf16_t pv[3][4];
      if (second && !adjacent) {
        _Pragma("unroll") for (int c = 0; c < 3; ++c) {
          const int ch = 48 * half + 16 * c + col;
          _Pragma("unroll") for (int j = 0; j < 4; ++j) pv[c][j] = ACT[(unsigned)(rowbase + t0 + 16 * w + 4 * quad) * (unsigned)LW + (unsigned)(j * LW + k * 88 + min(ch, 87))];
        }
      } else { _Pragma("unroll") for (int c = 0; c < 3; ++c) _Pragma("unroll") for (int j = 0; j < 4; ++j) pv[c][j] = (bf16_t)0; }
      __syncthreads();
      bf16x8 af[3];
      _Pragma("unroll") for (int ks = 0; ks < 3; ++ks) af[ks] = *(const bf16x8*)(Uc + (16 * w + col) * 96 + ks * 32 + quad * 8);
      float hl[3][4], ac[3][4];
      _Pragma("unroll") for (int c = 0; c < 3; ++c) {
        f32x4 gA = {0.f, 0.f, 0.f, 0.f}, gX = {0.f, 0.f, 0.f, 0.f};
        _Pragma("unroll") for (int ks = 0; ks < 3; ++ks) {
          const bf16x8 bA = *(const bf16x8*)(Wl + ((c * 2 + 0) * 16 + col) * 96 + ks * 32 + quad * 8);
          const bf16x8 bX = *(const bf16x8*)(Wl + ((c * 2 + 1) * 16 + col) * 96 + ks * 32 + quad * 8);
          gA = MFMA16(af[ks], bA, gA);
          gX = MFMA16(af[ks], bX, gX);
        }
        float a[4], bb[4];
        _Pragma("unroll") for (int j = 0; j < 4; ++j) {
          const float uval = bf2f(Uc[(16 * w + 4 * quad + j) * 96 + 48 * half + 16 * c + col]);
          const float rg = sigm(gA[j] + ba[c]), ig = sigm(gX[j] + bx[c]);
          a[j] = __expf(-sp8[c] * rg);
          bb[j] = __builtin_amdgcn_sqrtf(fmaxf(1.f - a[j] * a[j], 0.f)) * ig * uval;
        }
        if (dir == 0) {
          hl[c][0] = bb[0]; ac[c][0] = a[0];
          _Pragma("unroll") for (int j = 1; j < 4; ++j) { hl[c][j] = a[j] * hl[c][j - 1] + bb[j]; ac[c][j] = a[j] * ac[c][j - 1]; }
          aggA[(4 * w + quad) * 48 + 16 * c + col] = ac[c][3]; aggH[(4 * w + quad) * 48 + 16 * c + col] = hl[c][3];
        } else {
          hl[c][3] = bb[3]; ac[c][3] = a[3];
          _Pragma("unroll") for (int j = 2; j >= 0; --j) { hl[c][j] = a[j] * hl[c][j + 1] + bb[j]; ac[c][j] = a[j] * ac[c][j + 1]; }
          aggA[(4 * w + quad) * 48 + 16 * c + col] = ac[c][0]; aggH[(4 * w + quad) * 48 + 16 * c + col] = hl[c][0];
        }
      }
      asm volatile("s_waitcnt vmcnt(0)" ::: "memory");
      __syncthreads();
      if (adjacent) {
        _Pragma("unroll") for (int c = 0; c < 3; ++c) {
          const int ch = 48 * half + 16 * c + col;
          _Pragma("unroll") for (int j = 0; j < 4; ++j)
            pv[c][j] = ACT[(unsigned)(rowbase + t0 + 16 * w + 4 * quad) * (unsigned)LW + (unsigned)(j * LW + k * 88 + min(ch, 87))];
        }
      }
      if (tid < 48) {
        float A_[16], H_[16];
        _Pragma("unroll") for (int s_ = 0; s_ < 16; ++s_) { A_[s_] = aggA[s_ * 48 + tid]; H_[s_] = aggH[s_ * 48 + tid]; }
        float cin = carry;
        if (dir == 0) { _Pragma("unroll") for (int s_ = 0; s_ < 16; ++s_) { aggA[s_ * 48 + tid] = cin; cin = A_[s_] * cin + H_[s_]; } }
        else { _Pragma("unroll") for (int s_ = 15; s_ >= 0; --s_) { aggA[s_ * 48 + tid] = cin; cin = A_[s_] * cin + H_[s_]; } }
        carry = cin;
      }
      __syncthreads();
      _Pragma("unroll") for (int c = 0; c < 3; ++c) {
        const int ch = 48 * half + 16 * c + col;
        if (ch < 88) {
          const float cin = aggA[(4 * w + quad) * 48 + 16 * c + col];
          _Pragma("unroll") for (int j = 0; j < 4; ++j) {
            const unsigned idx = (unsigned)(rowbase + t0 + 16 * w + 4 * quad) * (unsigned)LW + (unsigned)(j * LW + k * 88 + ch);
            const float hv = hl[c][j] + ac[c][j] * cin;
            ACT[idx] = f2bf(hv * silu(bf2f(gv[c][j])) + bf2f(pv[c][j]));
          }
        }
      }

    }
  }
}

struct AttnSt { f32x16 O0, O1; float m, l; };
DI bf16x8 ld16(const bf16_t* p) { return *(const bf16x8*)p; }
DI bf16x8 ld8x2(const bf16_t* p0) { const s16x4 a = *(const s16x4*)p0; const s16x4 b = *(const s16x4*)(p0 + 8); return __builtin_shufflevector(a, b, 0, 1, 2, 3, 4, 5, 6, 7); }
DI bf16x8 pack8(const f32x16& P, int s) {
  u32x4 u;
  _Pragma("unroll") for (int j = 0; j < 4; ++j) u[j] = pack2(P[8 * s + 2 * j], P[8 * s + 2 * j + 1]);
  return __builtin_bit_cast(bf16x8, u);
}

struct KVt { bf16x8 k0, k1, k2, k3, v00, v01, v10, v11; };
DI void attn_load(KVt& t, const bf16_t* kt_, const bf16_t* vt_) {
  t.k0 = ld16(kt_); t.k1 = ld16(kt_ + 512); t.k2 = ld16(kt_ + 1024); t.k3 = ld16(kt_ + 1536);
  t.v00 = ld16(vt_); t.v01 = ld16(vt_ + 512); t.v10 = ld16(vt_ + 1024); t.v11 = ld16(vt_ + 1536);
}
template <class F>
DI void attn_compute(AttnSt& st, const bf16x8 (&qf)[4], const KVt& t, F fmod) {
  f32x16 S = zero16();
  S = MFMA32(t.k0, qf[0], S); S = MFMA32(t.k1, qf[1], S); S = MFMA32(t.k2, qf[2], S); S = MFMA32(t.k3, qf[3], S);
  float mx = -3.0e38f;
  _Pragma("unroll") for (int i = 0; i < 16; ++i) { S[i] = fmod(i, S[i]); mx = fmaxf(mx, S[i]); }
  mx = fmaxf(mx, __shfl_xor(mx, 32));
  const float mn = fmaxf(st.m, mx);
  float ls = 0.f;
  f32x16 P;
  _Pragma("unroll") for (int i = 0; i < 16; ++i) { P[i] = __builtin_amdgcn_exp2f(S[i] - mn); ls += P[i]; }
  if (__builtin_amdgcn_ballot_w64(mn > st.m) != 0ull) {
    const float alpha = __builtin_amdgcn_exp2f(st.m - mn);
    st.m = mn;
    st.l *= alpha;
    _Pragma("unroll") for (int i = 0; i < 16; ++i) { st.O0[i] *= alpha; st.O1[i] *= alpha; }
  }
  st.l += ls;
  const bf16x8 p0 = pack8(P, 0), p1 = pack8(P, 1);
  st.O0 = MFMA32(t.v00, p0, st.O0); st.O0 = MFMA32(t.v01, p1, st.O0);
  st.O1 = MFMA32(t.v10, p0, st.O1); st.O1 = MFMA32(t.v11, p1, st.O1);
}

struct GPre { u32x2 g0[4], g1[4]; };
DI void attn_gload(GPre& gp, const bf16_t* Grow  , int h) {
  _Pragma("unroll") for (int q = 0; q < 4; ++q) { gp.g0[q] = *(const u32x2*)(Grow + 8 * q + 4 * h); gp.g1[q] = *(const u32x2*)(Grow + 32 + 8 * q + 4 * h); }
}
DI void attn_finish(AttnSt& st, const GPre& gp, bf16_t* Arow  , int h) {
  const float lt = st.l + __shfl_xor(st.l, 32);
  const float inv = frcp(lt);
  unsigned w0[4][2], w1[4][2];
  _Pragma("unroll") for (int q = 0; q < 4; ++q) {
    const u32x2 g0 = gp.g0[q], g1 = gp.g1[q];
    w0[q][0] = pack2(st.O0[4 * q + 0] * inv * silu(bflo(g0[0])), st.O0[4 * q + 1] * inv * silu(bfhi(g0[0])));
    w0[q][1] = pack2(st.O0[4 * q + 2] * inv * silu(bflo(g0[1])), st.O0[4 * q + 3] * inv * silu(bfhi(g0[1])));
    w1[q][0] = pack2(st.O1[4 * q + 0] * inv * silu(bflo(g1[0])), st.O1[4 * q + 1] * inv * silu(bfhi(g1[0])));
    w1[q][1] = pack2(st.O1[4 * q + 2] * inv * silu(bflo(g1[1])), st.O1[4 * q + 3] * inv * silu(bfhi(g1[1])));
  }
  _Pragma("unroll") for (int qp = 0; qp < 2; ++qp) {
    const int q = 2 * qp;
    {
      const auto s0 = __builtin_amdgcn_permlane32_swap(w0[q][0], w0[q + 1][0], false, false);
      const auto s1 = __builtin_amdgcn_permlane32_swap(w0[q][1], w0[q + 1][1], false, false);
      u32x4 o; o[0] = s0[0]; o[1] = s1[0]; o[2] = s0[1]; o[3] = s1[1];
      *(u32x4*)(Arow + 8 * q + 8 * h) = o;
    }
    {
      const auto s0 = __builtin_amdgcn_permlane32_swap(w1[q][0], w1[q + 1][0], false, false);
      const auto s1 = __builtin_amdgcn_permlane32_swap(w1[q][1], w1[q + 1][1], false, false);
      u32x4 o; o[0] = s0[0]; o[1] = s1[0]; o[2] = s0[1]; o[3] = s1[1];
      *(u32x4*)(Arow + 32 + 8 * q + 8 * h) = o;
    }
  }
}

DI void swa_phase(const Params& p) {
  char* ws = p.ws;
  const bf16_t* Q = (const bf16_t*)(ws + O_Q1); const bf16_t* QR = (const bf16_t*)(ws + O_QR1); const bf16_t* Kb = (const bf16_t*)(ws + O_K1);
  const bf16_t* VtL = (const bf16_t*)(ws + O_VTL1); const bf16_t* VtC = (const bf16_t*)(ws + O_VTC1);
  const bf16_t* G = (const bf16_t*)(ws + O_G1); bf16_t* ACT = (bf16_t*)(ws + O_ACT1);
  const float* sink = p.in[20];
  const int tid_ = opaque_tid();
  const int lane = tid_ & 63, r = lane & 31, h = lane >> 5;
  const int vb_ = (gridDim.x % 8 == 0) ? (blockIdx.x & 7) * (gridDim.x >> 3) + (blockIdx.x >> 3) : blockIdx.x;
  const int wid = vb_ * 8 + (tid_ >> 6), nw = gridDim.x * 8;
  auto ident = [](int, float s) { return s; };
  for (int it = wid; it < 8192 + 1024; it += nw) {
    int b, kvh, g4, qt; const bool lat = it < 8192;
    if (lat) { g4 = it & 3; qt = (it >> 2) & 63; kvh = (it >> 8) & 3; b = it >> 10; }
    else { const int j = it - 8192; g4 = j & 3; qt = (j >> 2) & 7; kvh = (j >> 5) & 3; b = j >> 7; }
    const int head = kvh * 4 + g4;
    const size_t qrow = lat ? (size_t)b * 2048 + qt * 32 + r : (size_t)RL + b * 256 + qt * 32 + r;
    AttnSt st; st.O0 = zero16(); st.O1 = zero16(); st.m = sink[head] * 1.4426950408889634f; st.l = h == 0 ? 1.f : 0.f;
    bf16x8 qf[4], qfr[4];
    _Pragma("unroll") for (int ks = 0; ks < 4; ++ks) qf[ks] = ld16(Q + qrow * 1024 + head * 64 + ks * 16 + 8 * h);
    GPre gp; attn_gload(gp, G + qrow * 1024 + head * 64, h);
    if (lat) { _Pragma("unroll") for (int ks = 0; ks < 4; ++ks) qfr[ks] = ld16(QR + qrow * 1024 + head * 64 + ks * 16 + 8 * h); }
    else { _Pragma("unroll") for (int ks = 0; ks < 4; ++ks) qfr[ks] = qf[ks]; }
    const bf16_t* kc = Kb + (size_t)RL * 256 + (size_t)(b * 4 + kvh) * 8 * 2048 + lane * 8;
    const bf16_t* vc = VtC + (size_t)(b * 4 + kvh) * 8 * 2048 + lane * 8;
    const bf16_t* kl = Kb + (size_t)(b * 4 + kvh) * 64 * 2048 + lane * 8;
    const bf16_t* vl = VtL + (size_t)(b * 4 + kvh) * 64 * 2048 + lane * 8;
    const int kt_lo = max(qt - 4, 0), kt_hi = min(qt + 4, 63);
    const int nt = lat ? 8 + (kt_hi - kt_lo + 1) : 8;
    auto load_tile = [&](int j, KVt& t) {
      if (j < 8) attn_load(t, kc + (size_t)j * 2048, vc + (size_t)j * 2048);
      else { const int kt = kt_lo + j - 8; attn_load(t, kl + (size_t)kt * 2048, vl + (size_t)kt * 2048); }
    };
    KVt cur, nxt;
    load_tile(0, cur);
    for (int j = 0; j < 8; ++j) {
      nxt = cur;
      if (j + 1 < nt) load_tile(j + 1, nxt);
      attn_compute(st, qf, cur, ident);
      cur = nxt;
    }
    for (int j = 8; j < nt; ++j) {
      nxt = cur;
      if (j + 1 < nt) load_tile(j + 1, nxt);
      const int kt = kt_lo + j - 8;
      if (kt == qt - 4 || kt == qt + 4) {
        const int dq = qt * 32 + r - kt * 32;
        attn_compute(st, qfr, cur, [&](int i, float s) { const int d = dq - crow(i, h); return (d <= 128 && d >= -128) ? s : -1.0e30f; });
      } else attn_compute(st, qfr, cur, ident);
      cur = nxt;
    }
    attn_finish(st, gp, ACT + qrow * 1024 + head * 64, h);
  }
}

DI void na_phase(const Params& p, char* smem) {
  char* ws = p.ws;
  const bf16_t* Q = (const bf16_t*)(ws + O_Q2); const bf16_t* Kb = (const bf16_t*)(ws + O_K2);
  const bf16_t* VtL = (const bf16_t*)(ws + O_VTL2); const bf16_t* VtC = (const bf16_t*)(ws + O_VTC2);
  const bf16_t* G = (const bf16_t*)(ws + O_G2); bf16_t* ACT = (bf16_t*)(ws + O_ACT2);
  float* rpbs = (float*)smem + 64;
  __syncthreads();
  for (int i = threadIdx.x; i < 16 * 15 * 31; i += blockDim.x) rpbs[i] = p.in[26][i] * 1.4426950408889634f;
  __syncthreads();
  const int tid_ = opaque_tid();
  const int lane = tid_ & 63, r = lane & 31, h = lane >> 5;
  const int vb_ = (gridDim.x % 8 == 0) ? (blockIdx.x & 7) * (gridDim.x >> 3) + (blockIdx.x >> 3) : blockIdx.x;
  const int wid = vb_ * 8 + (tid_ >> 6), nw = gridDim.x * 8;
  auto ident = [](int, float s) { return s; };
  for (int it = wid; it < 8192 + 1024; it += nw) {
    int b, head, half, gr; const bool lat = it < 8192;
    if (lat) { half = it & 1; head = (it >> 1) & 15; gr = (it >> 5) & 31; b = it >> 10; }
    else { const int j = it - 8192; half = 0; head = j & 15; gr = (j >> 4) & 7; b = j >> 7; }
    const size_t qrow = lat ? (size_t)b * 2048 + gr * 64 + half * 32 + r : (size_t)RL + b * 256 + gr * 32 + r;
    AttnSt st; st.O0 = zero16(); st.O1 = zero16(); st.m = -1.0e30f; st.l = 0.f;
    bf16x8 qf[4];
    _Pragma("unroll") for (int ks = 0; ks < 4; ++ks) qf[ks] = ld16(Q + qrow * 1024 + head * 64 + ks * 16 + 8 * h);
    GPre gp; attn_gload(gp, G + qrow * 1024 + head * 64, h);
    const bf16_t* kc = Kb + (size_t)RL * 1024 + (size_t)(b * 16 + head) * 8 * 2048 + lane * 8;
    const bf16_t* vc = VtC + (size_t)(b * 16 + head) * 8 * 2048 + lane * 8;
    const bf16_t* kl = Kb + (size_t)(b * 16 + head) * 64 * 2048 + lane * 8;
    const bf16_t* vl = VtL + (size_t)(b * 16 + head) * 64 * 2048 + lane * 8;
    const int cq = half * 32 + r;
    const int cs = min(max(cq - 8, 0), 48);
    const int rs_ = min(max(gr - 4, 0), 24);
    const int nt = lat ? 24 : 8;
    auto load_tile = [&](int j, KVt& t) {
      if (j < 8) attn_load(t, kc + (size_t)j * 2048, vc + (size_t)j * 2048);
      else { const int kt = (rs_ + ((j - 8) >> 1)) * 2 + ((j - 8) & 1); attn_load(t, kl + (size_t)kt * 2048, vl + (size_t)kt * 2048); }
    };
    KVt cur, nxt;
    load_tile(0, cur);
    for (int j = 0; j < 8; ++j) {
      nxt = cur;
      if (j + 1 < nt) load_tile(j + 1, nxt);
      attn_compute(st, qf, cur, ident);
      cur = nxt;
    }
    unsigned okm[2] = {0u, 0u};
    _Pragma("unroll") for (int ct = 0; ct < 2; ++ct) _Pragma("unroll") for (int i = 0; i < 16; ++i) {
      const int ck = ct * 32 + crow(i, h);
      okm[ct] |= ((ck >= cs) && (ck < cs + 16)) ? (1u << i) : 0u;
    }
    const int dxb = 4 * h - cq + 15;
    for (int j = 8; j < nt; j += 2) {
      const int krow = rs_ + ((j - 8) >> 1);
      const float* rp = rpbs + (head * 15 + (krow - gr + 7)) * 31 + dxb;
      nxt = cur;
      load_tile(j + 1, nxt);
      attn_compute(st, qf, cur, [&](int i, float s) { const float sb = s + rp[(i & 3) + 8 * (i >> 2)]; return ((okm[0] >> i) & 1u) ? sb : -1.0e30f; });
      cur = nxt;
      if (j + 2 < nt) load_tile(j + 2, nxt);
      attn_compute(st, qf, cur, [&](int i, float s) { const float sb = s + rp[32 + (i & 3) + 8 * (i >> 2)]; return ((okm[1] >> i) & 1u) ? sb : -1.0e30f; });
      cur = nxt;
    }
    attn_finish(st, gp, ACT + qrow * 1024 + head * 64, h);
  }
}

DI void s5_mats_phase(const Params& p, int which, int first_blk) {
  if ((int)blockIdx.x < first_blk) return;
  char* ws = p.ws;
  const float2* POW = (const float2*)(ws + O_POW); const float2* BB = (const float2*)(ws + O_BBAR);
  bf16_t* GT = (bf16_t*)(ws + O_GT); bf16_t* MYT = (bf16_t*)(ws + O_MYT);
  const float* cre = p.in[37]; const float* cim = p.in[38]; const float* dsk = p.in[39];
  const int gt = ((int)blockIdx.x - first_blk) * blockDim.x + threadIdx.x, gn = ((int)gridDim.x - first_blk) * blockDim.x;
  if (which == 2) {
    for (int idx0 = gt; idx0 < 64 * 256 * 256; idx0 += 4 * gn) {
      float2 pw1[4], bb1[4];
      _Pragma("unroll") for (int u = 0; u < 4; ++u) {
        const int idx = min(idx0 + u * gn, 64 * 256 * 256 - 1);
        const int g = idx >> 16, n = (idx >> 8) & 255, k = idx & 255;
        const int dir = n >> 7, pp = (n >> 1) & 63, i = k >> 4, c = k & 15, e = dir ? i : 15 - i;
        pw1[u] = POW[((size_t)(dir * 64 + g) * 17 + e) * 64 + pp]; bb1[u] = BB[((size_t)(dir * 64 + g) * 64 + pp) * 16 + c];
      }
      _Pragma("unroll") for (int u = 0; u < 4; ++u) {
        const int idx = idx0 + u * gn;
        if (idx < 64 * 256 * 256) {
          const float zr = pw1[u].x * bb1[u].x - pw1[u].y * bb1[u].y, zi = pw1[u].x * bb1[u].y + pw1[u].y * bb1[u].x;
          GT[idx] = f2bf(((idx >> 8) & 1) ? zi : zr);
        }
      }
    }
    return;
  }
  for (int idx0 = gt; idx0 < 64 * 256 * 256; idx0 += 4 * gn) {
    float2 pw2[4]; float cr[4], cm[4];
    _Pragma("unroll") for (int u = 0; u < 4; ++u) {
      const int idx = min(idx0 + u * gn, 64 * 256 * 256 - 1);
      const int g = idx >> 16, n = (idx >> 8) & 255, k = idx & 255;
      const int j = n >> 4, o = n & 15, dir = k >> 7, pp = (k >> 1) & 63, e = dir ? 16 - j : j + 1;
      pw2[u] = POW[((size_t)(dir * 64 + g) * 17 + e) * 64 + pp];
      const size_t ci = ((size_t)(dir * 64 + g) * 16 + o) * 64 + pp; cr[u] = cre[ci]; cm[u] = cim[ci];
    }
    _Pragma("unroll") for (int u = 0; u < 4; ++u) {
      const int idx = idx0 + u * gn;
      if (idx < 64 * 256 * 256) {
        const int g = idx >> 16, n = (idx >> 8) & 255, k = idx & 255;
        const float zr = cr[u] * pw2[u].x - cm[u] * pw2[u].y, zi = cr[u] * pw2[u].y + cm[u] * pw2[u].x;
        MYT[((size_t)g * 256 + n) * 512 + 256 + k] = f2bf((k & 1) ? -zi : zr);
      }
    }
  }
  for (int idx = gt; idx < 64 * 16 * 256; idx += gn) {
    const int g = idx >> 12, lag = (idx >> 8) & 15, o = (idx >> 4) & 15, c = idx & 15;
    float kf = 0.f, kb = 0.f;
    _Pragma("unroll 8") for (int pp = 0; pp < 64; ++pp) {
      {
        const float2 pw = POW[((size_t)(0 * 64 + g) * 17 + lag) * 64 + pp];
        const float2 bb = BB[((size_t)(0 * 64 + g) * 64 + pp) * 16 + c];
        const size_t ci = ((size_t)(0 * 64 + g) * 16 + o) * 64 + pp;
        const float zr = pw.x * bb.x - pw.y * bb.y, zi = pw.x * bb.y + pw.y * bb.x;
        kf += cre[ci] * zr - cim[ci] * zi;
      }
      {
        const float2 pw = POW[((size_t)(1 * 64 + g) * 17 + lag) * 64 + pp];
        const float2 bb = BB[((size_t)(1 * 64 + g) * 64 + pp) * 16 + c];
        const size_t ci = ((size_t)(1 * 64 + g) * 16 + o) * 64 + pp;
        const float zr = pw.x * bb.x - pw.y * bb.y, zi = pw.x * bb.y + pw.y * bb.x;
        kb += cre[ci] * zr - cim[ci] * zi;
      }
    }
    bf16_t* Mg = MYT + (size_t)g * 256 * 512;
    if (lag == 0) {
      const bf16_t v = f2bf(kf + kb + (o == c ? dsk[g * 16 + o] : 0.f));
      for (int j = 0; j < 16; ++j) Mg[(size_t)(j * 16 + o) * 512 + j * 16 + c] = v;
    } else {
      const bf16_t vf = f2bf(kf), vb = f2bf(kb);
      for (int i = 0; i + lag < 16; ++i) {
        Mg[(size_t)((i + lag) * 16 + o) * 512 + i * 16 + c] = vf;
        Mg[(size_t)(i * 16 + o) * 512 + (i + lag) * 16 + c] = vb;
      }
    }
  }
}

DI void s5_scan_one(const Params& p, int b, int g, int dir, int pp) {
  char* ws = p.ws;
  const float2* POW = (const float2*)(ws + O_POW);
  const float* SL = (const float*)(ws + O_SLOC);
  bf16_t* ACAT = (bf16_t*)(ws + O_ACAT);
  const float2 lam = POW[((size_t)(dir * 64 + g) * 17 + 16) * 64 + pp];
  float hr = 0.f, hi = 0.f;
  auto chunk_of = [&](int q) { return q < 16 ? (1024 + b * 16 + (dir ? 15 - q : q)) : (b * 128 + (dir ? 127 - (q - 16) : (q - 16))); };
  auto loadb = [&](int q0, float2 (&sx)[16]) {
    _Pragma("unroll") for (int j = 0; j < 16; ++j) sx[j] = *(const float2*)(SL + ((size_t)g * NCHP + chunk_of(q0 + j)) * 256 + dir * 128 + 2 * pp);
  };
  auto procb = [&](int q0, const float2 (&sx)[16]) {
    _Pragma("unroll") for (int j = 0; j < 16; ++j) {
      *(unsigned*)(ACAT + ((size_t)g * NCH + chunk_of(q0 + j)) * 512 + 256 + dir * 128 + 2 * pp) = pack2(hr, hi);
      const float nr = lam.x * hr - lam.y * hi + sx[j].x, ni = lam.x * hi + lam.y * hr + sx[j].y;
      hr = nr; hi = ni;
    }
  };
  float2 sA[16], sB[16];
  loadb(0, sA);
  for (int q0 = 0; q0 < 144; q0 += 32) {
    if (q0 + 16 < 144) loadb(q0 + 16, sB);
    procb(q0, sA);
    if (q0 + 16 >= 144) break;
    if (q0 + 32 < 144) loadb(q0 + 32, sA);
    procb(q0 + 16, sB);
  }
}
DI void s5_scan_phase(const Params& p) {
  for (int gid = blockIdx.x * blockDim.x + threadIdx.x; gid < 65536; gid += gridDim.x * blockDim.x)
    s5_scan_one(p, gid >> 13, (gid >> 6) & 63, (gid >> 12) & 1, gid & 63);
}

#define XB_TMO      128
#define XB_XCNT(j)  (256  + 64 * (j))
#define XB_XSUB(j)  (1280 + 64 * (j))
#define XB_XGEN(j)  (2304 + 64 * (j))
#define XB_TOP      3328
#define XB_TOPGEN   3392
#define XCD_BAR_WORDS 3456
#define XB_SPIN_CAP (1u << 18)
#define LAS __attribute__((address_space(3)))
DI unsigned xb_ld(unsigned* p)              { return __hip_atomic_load(p, __ATOMIC_RELAXED, __HIP_MEMORY_SCOPE_AGENT); }
DI unsigned xb_add(unsigned* p, unsigned v) { return __hip_atomic_fetch_add(p, v, __ATOMIC_RELAXED, __HIP_MEMORY_SCOPE_AGENT); }
DI unsigned xb_xcc_id() { return (unsigned)__builtin_amdgcn_s_getreg((3 << 11) | 20) & 0xFu; }
#define XB_SPIN(cond, bar) do { unsigned _sp = 0; while (cond) { __builtin_amdgcn_s_sleep(1); \
    if ((++_sp & 255u) == 0u) { if (xb_ld(&(bar)[XB_TMO])) break; if (_sp > XB_SPIN_CAP) { atomicAdd(&(bar)[XB_TMO], 1u); break; } } } } while (0)
struct XcdBarrier { unsigned* bar; unsigned x; volatile LAS unsigned* st; };
DI XcdBarrier xcd_barrier_post(unsigned* bar, volatile LAS unsigned* st) {
    XcdBarrier b; b.bar = bar; b.x = xb_xcc_id(); b.st = st;
    if (threadIdx.x == 0) (void)xb_add(&bar[XB_XCNT(b.x)], 1u);
    return b;
}
DI void xcd_barrier_complete(unsigned* bar, unsigned x, unsigned& nloc, unsigned& nx) {
    const unsigned G = gridDim.x * gridDim.y * gridDim.z;
    unsigned sum, cnt, mine, sp = 0u;
    for (;;) {
        sum = 0u; cnt = 0u; mine = 0u;
#pragma unroll
        for (unsigned j = 0; j < 16; ++j) { const unsigned c = xb_ld(&bar[XB_XCNT(j)]); sum += c; cnt += (c > 0u) ? 1u : 0u; mine = (j == x) ? c : mine; }
        if (sum == G) break;
        __builtin_amdgcn_s_sleep(1);
        if ((++sp & 255u) == 0u) { if (xb_ld(&bar[XB_TMO])) break; if (sp > XB_SPIN_CAP) { atomicAdd(&bar[XB_TMO], 1u); break; } }
    }
    nloc = mine > 0u ? mine : 1u; nx = cnt > 0u ? cnt : 1u;
}
DI void xcd_barrier(const XcdBarrier& b) {
    asm volatile("s_waitcnt vmcnt(0)" ::: "memory");
    __syncthreads();
    if (threadIdx.x == 0) {
        unsigned* bar = b.bar;
        __builtin_amdgcn_s_waitcnt(0);
        unsigned nloc = b.st[0], nx = b.st[1];
        if (nloc == 0u) { xcd_barrier_complete(bar, b.x, nloc, nx); b.st[0] = nloc; b.st[1] = nx; }
        const unsigned old = xb_add(&bar[XB_XSUB(b.x)], 1u);
        const unsigned gen = old / nloc;
        if (old + 1u == (gen + 1u) * nloc) {
            __builtin_amdgcn_fence(__ATOMIC_RELEASE, "agent");
            asm volatile("s_waitcnt vmcnt(0)" ::: "memory");
            const unsigned og = xb_add(&bar[XB_TOP], 1u);
            const unsigned tg = og / nx;
            if (og + 1u == (tg + 1u) * nx) xb_add(&bar[XB_TOPGEN], 1u);
            else XB_SPIN(xb_ld(&bar[XB_TOPGEN]) == tg, bar);
            __builtin_amdgcn_fence(__ATOMIC_ACQUIRE, "agent");
            xb_add(&bar[XB_XGEN(b.x)], 1u);
            asm volatile("s_waitcnt vmcnt(0)" ::: "memory");
        } else {
            XB_SPIN(xb_ld(&bar[XB_XGEN(b.x)]) == gen, bar);
            __builtin_amdgcn_fence(__ATOMIC_ACQUIRE, "agent");
            asm volatile("s_waitcnt vmcnt(0)" ::: "memory");
        }
    }
    __syncthreads();
}

#define RP_GIN 1
#define RP_OUT0 1
#define RP_LRU 1
#define RP_SWA 1
#define RP_NA 1
#define RP_S5 1
#define RP_NORM 1
#define RP_GLU 1
#define RP_SYNC 0
#define REPEAT(n) for (int rep_ = 0; rep_ < (n); ++rep_)
constexpr int LDS_BYTES = 147456;

__global__ void __launch_bounds__(512, 2) fwd_megakernel(Params p) {
  extern __shared__ __attribute__((aligned(16))) unsigned char lds_raw[];
  LAS unsigned char* lds = (LAS unsigned char*)lds_raw;
  char* smem = (char*)lds_raw;
  cg::grid_group grid = cg::this_grid();
  char* ws = p.ws;
  volatile LAS unsigned* xst = (volatile LAS unsigned*)(lds + 131072 + 256);
  if (threadIdx.x == 0) { xst[0] = 0u; xst[1] = 0u; }
  __syncthreads();
  XcdBarrier xb = xcd_barrier_post((unsigned*)(ws + O_BAR), xst);
#define GSYNC() xcd_barrier(xb)
  float* MOD = (float*)(ws + O_MOD);
  float* HCTX = (float*)(ws + O_HCTX);
  const bf16_t* NBUF = (const bf16_t*)(ws + O_NBUF);
  using pg8::Gemm;

  phase0(p, smem);
  GSYNC();
  if (p.out == nullptr) grid.sync();
  float* SS = (float*)(ws + O_SS);
  const float* GS = (const float*)(ws + O_GS);
  const float* SHW = (const float*)(ws + O_SHW);
  bf16_t* NBW = (bf16_t*)(ws + O_NBUF);
  norm_phase(p.in[0], p.in[2], p.in[6], MOD, (bf16_t*)(ws + O_NBUF0));
  GSYNC();
  {
    EpiL0In e{(bf16_t*)(ws + O_U0), (bf16_t*)(ws + O_G0)};
    Gemm g{(const bf16_t*)(ws + O_NBUF0), (const bf16_t*)(ws + O_WT_IN0), 1024, 1024, 1024, 72, 11, 1, 0, 0, 0};
    pg8::gemm_phase(lds, g, e);
  }
  modfold_phase(p, smem);
  tables_phase(p, gridDim.x == 256 ? 24 : 0);
  if (gridDim.x == 256) transpose_range(p, smem, 16 * 44, 16 * 44 + 22 * 16 + 16 * 40 + 256, 24, 0);
  else transpose_range(p, smem, 16 * 44, 16 * 44 + 22 * 16 + 16 * 40 + 256, 0, 0);
  GSYNC();
  lru_phase(p, smem);
  GSYNC();
  {
    EpiOut<true> e{p.in[0], p.in[2], p.out, HCTX, MOD + 2048, GS, NBW, SS};
    Gemm g{(const bf16_t*)(ws + O_ACT0), (const bf16_t*)(ws + O_WT_OUT0), LW, LW, LW, 72, 4, 1, 0, 0, 0};
    pg8::gemm_phase(lds, g, e);
  }
  {
    constexpr int J0 = 16 * 44 + 22 * 16 + 16 * 40 + 256, J1 = J0 + 16 * 64 + 256 + 16 * 32 + 256 + 256;
    transpose_range(p, smem, J0, J1, gridDim.x == 256 ? 32 : 0, 0);
  }
  GSYNC();
  {
    EpiL1 e{(bf16_t*)(ws + O_Q1), (bf16_t*)(ws + O_QR1), (bf16_t*)(ws + O_K1), (bf16_t*)(ws + O_G1), (const float*)(ws + O_ROPEC), (const float*)(ws + O_ROPES), SS, SHW};
    Gemm g{NBUF, (const bf16_t*)(ws + O_WT_IN1), 1024, 1024, 1024, 72, 9, 1, 0, 0, 0};
    pg8::gemm_phase(lds, g, e);
    EpiV<4, 1280> ev{(bf16_t*)(ws + O_VTL1), (bf16_t*)(ws + O_VTC1), SS, SHW};
    Gemm gv{(const bf16_t*)(ws + O_WT_IN1) + (size_t)2304 * 1024, NBUF, 1024, 1024, 1024, 1, 72, 1, 0, 0, 256 - 136};
    pg8::gemm_phase(lds, gv, ev);
  }
  GSYNC();
  swa_phase(p);
  GSYNC();
  {
    EpiOut<true> e{p.out, HCTX, p.out, HCTX, MOD + 9 * 3072 + 2048, GS + 9 * 1024, NBW, SS + R};
    Gemm g{(const bf16_t*)(ws + O_ACT1), (const bf16_t*)(ws + O_WT_OUT1), 1024, 1024, 1024, 72, 4, 1, 0, 0, 0};
    pg8::gemm_phase(lds, g, e);
  }
  s5_mats_phase(p, 1, gridDim.x == 256 ? 32 : 0);
  GSYNC();
  {
    EpiL2 e{(bf16_t*)(ws + O_Q2), (bf16_t*)(ws + O_K2), (bf16_t*)(ws + O_G2), SS + R, SHW + 9 * 4096};
    Gemm g{NBUF, (const bf16_t*)(ws + O_WT_IN2), 1024, 1024, 1024, 72, 12, 1, 0, 0, 0};
    pg8::gemm_phase(lds, g, e);
    EpiV<16, 2048> ev{(bf16_t*)(ws + O_VTL2), (bf16_t*)(ws + O_VTC2), SS + R, SHW + 9 * 4096};
    Gemm gv{(const bf16_t*)(ws + O_WT_IN2) + (size_t)3072 * 1024, NBUF, 1024, 1024, 1024, 4, 72, 1, 0, 0, 256 - 96};
    pg8::gemm_phase(lds, gv, ev);
  }
  GSYNC();
  na_phase(p, smem);
  GSYNC();
  {
    EpiOut<true> e{p.out, HCTX, p.out, HCTX, MOD + 2 * 9 * 3072 + 2048, GS + 2 * 9 * 1024, NBW, SS + 2 * R};
    Gemm g{(const bf16_t*)(ws + O_ACT2), (const bf16_t*)(ws + O_WT_OUT2), 1024, 1024, 1024, 72, 4, 1, 0, 0, 0};
    pg8::gemm_phase(lds, g, e);
  }
  s5_mats_phase(p, 2, gridDim.x == 256 ? 32 : 0);
  GSYNC();
  {
    EpiL3In e{(bf16_t*)(ws + O_ACAT), (bf16_t*)(ws + O_G3), SS + 2 * R, SHW + 2 * 9 * 4096};
    Gemm g{NBUF, (const bf16_t*)(ws + O_WT_IN3), 1024, 1024, 1024, 72, 8, 1, 0, 0, 0};
    pg8::gemm_phase(lds, g, e);
  }
  GSYNC();
  {
    EpiS5State e{(float*)(ws + O_SLOC)};
    Gemm g{(const bf16_t*)(ws + O_ACAT), (const bf16_t*)(ws + O_GT), 512, 256, 256, 5, 1, 64, NCH * 512, 256 * 256, 0};
    pg8::gemm_phase(lds, g, e);
  }
  GSYNC();
  {
    EpiS5Y e{(bf16_t*)(ws + O_YG)};
    Gemm g{(const bf16_t*)(ws + O_ACAT), (const bf16_t*)(ws + O_MYT), 512, 512, 512, 4, 1, 64, NCH * 512, 256 * 512, 0};
    if (gridDim.x == 256) {
      pg8::Unit u;
      if (pg8::next_unit(g, 0, u)) {
        const int t_ = opaque_tid();
        if (t_ < 256) s5_scan_one(p, 2 * u.pm + (t_ >> 7), u.pb, (t_ >> 6) & 1, t_ & 63);
      }
      asm volatile("s_waitcnt vmcnt(0)" ::: "memory");
      __syncthreads();
    } else {
      s5_scan_phase(p);
      GSYNC();
    }
    pg8::gemm_phase(lds, g, e);
  }
  GSYNC();
  {
    EpiGlu e{(const bf16_t*)(ws + O_YG), (const bf16_t*)(ws + O_G3), p.in[41], (bf16_t*)(ws + O_ACT3)};
    Gemm g{(const bf16_t*)(ws + O_YG), (const bf16_t*)(ws + O_WT_GLU), 1024, 1024, 1024, 64, 4, 1, 0, 0, 0};
    pg8::gemm_phase(lds, g, e);
  }
  GSYNC();
  {
    EpiOut<false> e{p.out, HCTX, p.out, HCTX, MOD + 3 * 9 * 3072 + 2048, nullptr, nullptr, nullptr};
    Gemm g{(const bf16_t*)(ws + O_ACT3), (const bf16_t*)(ws + O_WT_OUT3), 1024, 1024, 1024, 64, 4, 1, 0, 0, 0};
    pg8::gemm_phase(lds, g, e);
  }
  GSYNC();
  final_norm_phase(p.out, p.in[43]);
}

extern "C" void kernel_launch(void* const* d_in, const int* in_sizes, int n_in, void* d_out, int out_size, void* d_ws, size_t ws_size,
                              hipStream_t stream) {
  static int grid_blocks = 0;
  if (!grid_blocks) {
    int dev = 0, cus = 0, per_cu = 0;
    (void)hipGetDevice(&dev);
    (void)hipDeviceGetAttribute(&cus, hipDeviceAttributeMultiprocessorCount, dev);
    if (hipFuncSetAttribute((const void*)fwd_megakernel, hipFuncAttributeMaxDynamicSharedMemorySize, LDS_BYTES) != hipSuccess) { fprintf(stderr, "kernel_launch: hipFuncSetAttribute failed\n"); grid_blocks = -1; return; }
    (void)hipOccupancyMaxActiveBlocksPerMultiprocessor(&per_cu, (const void*)fwd_megakernel, 512, LDS_BYTES);
    (void)hipGetLastError();
    grid_blocks = cus;
  }
  if (grid_blocks < 0) return;
  if (n_in != 44 || ws_size < WS_END) { fprintf(stderr, "kernel_launch: unexpected n_in %d or ws_size %zu < %zu\n", n_in, ws_size, (size_t)WS_END); return; }
  Params p{};
  for (int i = 0; i < 44; ++i) p.in[i] = (const float*)d_in[i];
  p.out = (float*)d_out;
  p.ws = (char*)d_ws;
  if (hipMemsetAsync((char*)d_ws + O_BAR, 0, 16384, stream) != hipSuccess) { fprintf(stderr, "memset failed\n"); return; }
  void* args[] = {&p};
  hipError_t e = hipLaunchCooperativeKernel((void*)fwd_megakernel, dim3(grid_blocks), dim3(512), args, LDS_BYTES, stream);
  if (e != hipSuccess) fprintf(stderr, "cooperative launch failed: %s (grid %d)\n", hipGetErrorString(e), grid_blocks);
}
```

```cpp
#include <hip/hip_runtime.h>
#include <hip/hip_cooperative_groups.h>
#include <cstdio>
namespace cg = cooperative_groups;

#define DI __device__ __forceinline__
typedef unsigned short bf16_t;
typedef short bf16x8 __attribute__((ext_vector_type(8)));
typedef short s16x4 __attribute__((ext_vector_type(4)));
typedef float f32x16 __attribute__((ext_vector_type(16)));
typedef float f32x4 __attribute__((ext_vector_type(4)));
typedef unsigned u32x2 __attribute__((ext_vector_type(2)));
typedef unsigned u32x4 __attribute__((ext_vector_type(4)));

#define MFMA32(a, b, c) __builtin_amdgcn_mfma_f32_32x32x16_bf16((a), (b), (c), 0, 0, 0)
#define MFMA16(a, b, c) __builtin_amdgcn_mfma_f32_16x16x32_bf16((a), (b), (c), 0, 0, 0)

constexpr int D = 1024, NB = 8, SEQ = 2048, CTXL = 256;
constexpr int RL = NB * SEQ;
constexpr int RC = NB * CTXL;
constexpr int R = RL + RC;
constexpr int LW = 1408;
constexpr int NCH = R / 16;
constexpr int NCHP = 1280;

constexpr size_t O_WT_IN0 = 0;
constexpr size_t O_WT_OUT0 = O_WT_IN0 + (size_t)2816 * 1024 * 2;
constexpr size_t O_WT_IN1 = O_WT_OUT0 + (size_t)1024 * 2816 * 2;
constexpr size_t O_WT_OUT1 = O_WT_IN1 + (size_t)2560 * 1024 * 2;
constexpr size_t O_WT_IN2 = O_WT_OUT1 + (size_t)1024 * 1024 * 2;
constexpr size_t O_WT_OUT2 = O_WT_IN2 + (size_t)4096 * 1024 * 2;
constexpr size_t O_WT_IN3 = O_WT_OUT2 + (size_t)1024 * 1024 * 2;
constexpr size_t O_WT_GLU = O_WT_IN3 + (size_t)2048 * 1024 * 2;
constexpr size_t O_WT_OUT3 = O_WT_GLU + (size_t)1024 * 1024 * 2;
constexpr size_t O_WG = O_WT_OUT3 + (size_t)1024 * 1024 * 2;
constexpr size_t O_MOD = O_WG + (size_t)16 * 2 * 192 * 96 * 2;
constexpr size_t O_ROPEC = O_MOD + (size_t)4 * 9 * 3072 * 4;
constexpr size_t O_ROPES = O_ROPEC + (size_t)2048 * 32 * 4;
constexpr size_t O_POW = O_ROPES + (size_t)2048 * 32 * 4;
constexpr size_t O_BBAR = O_POW + (size_t)2 * 64 * 17 * 64 * 8;
constexpr size_t O_HCTX = O_BBAR + (size_t)2 * 64 * 64 * 16 * 8;
constexpr size_t O_SS = O_HCTX + (size_t)RC * 1024 * 4;
constexpr size_t O_GS = O_SS + (size_t)3 * R * 4;
constexpr size_t O_SHW = O_GS + (size_t)3 * 9 * 1024 * 4;
constexpr size_t O_BAR = O_SHW + (size_t)3 * 9 * 4096 * 4;
constexpr size_t O_DYN = O_BAR + 16384;
constexpr size_t O_U0 = O_DYN;
constexpr size_t O_G0 = O_U0 + (size_t)R * LW * 2;
constexpr size_t O_ACT0 = O_G0 + (size_t)R * LW * 2;
constexpr size_t O_NBUF0 = O_ACT0;
constexpr size_t O_NBUF = O_DYN;
constexpr size_t O_Q1 = O_NBUF + (size_t)R * 1024 * 2;
constexpr size_t O_QR1 = O_Q1 + (size_t)R * 1024 * 2;
constexpr size_t O_K1 = O_QR1 + (size_t)RL * 1024 * 2;
constexpr size_t O_VTL1 = O_K1 + (size_t)R * 256 * 2;
constexpr size_t O_VTC1 = O_VTL1 + (size_t)8 * 4 * 64 * 2048 * 2;
constexpr size_t O_G1 = O_VTC1 + (size_t)8 * 4 * 64 * 256 * 2;
constexpr size_t O_ACT1 = O_G1 + (size_t)R * 1024 * 2;
constexpr size_t O_Q2 = O_NBUF + (size_t)R * 1024 * 2;
constexpr size_t O_K2 = O_Q2 + (size_t)R * 1024 * 2;
constexpr size_t O_VTL2 = O_K2 + (size_t)R * 1024 * 2;
constexpr size_t O_VTC2 = O_VTL2 + (size_t)8 * 16 * 64 * 2048 * 2;
constexpr size_t O_G2 = O_VTC2 + (size_t)8 * 16 * 64 * 256 * 2;
constexpr size_t O_ACT2 = O_Q2;
constexpr size_t O_SLOC = O_DYN;
constexpr size_t O_YG = O_DYN;
constexpr size_t O_ACT3 = O_YG + (size_t)RL * 1024 * 2;
constexpr size_t O_ACAT = O_DYN + (size_t)64 * NCHP * 256 * 4;
constexpr size_t O_G3 = O_ACAT + (size_t)64 * NCH * 512 * 2;
constexpr size_t O_GT = O_WT_IN2;
constexpr size_t O_MYT = O_WT_IN0;
static_assert(O_WT_OUT1 - O_WT_IN0 == (size_t)64 * 256 * 512 * 2 && O_WT_OUT2 - O_WT_IN2 == (size_t)64 * 256 * 256 * 2, "S5 matrix aliases");
constexpr size_t WS_END = O_ACT0 + (size_t)R * LW * 2 * 2;
static_assert(O_G3 + (size_t)RL * 1024 * 2 <= WS_END && O_ACT1 + (size_t)R * 1024 * 2 <= WS_END && O_G2 + (size_t)R * 1024 * 2 <= WS_END, "workspace map");
static_assert(WS_END <= (size_t)256 * 1024 * 1024, "workspace budget");

struct Params {
  const float* in[44];
  float* out;
  char* ws;
};

typedef __bf16 bf16n2 __attribute__((ext_vector_type(2)));
DI bf16_t f2bf(float x) { const __bf16 b = (__bf16)x; return __builtin_bit_cast(unsigned short, b); }
DI float bf2f(bf16_t b) { return __uint_as_float(((unsigned)b) << 16); }
DI unsigned pack2(float lo, float hi) { bf16n2 v; v[0] = (__bf16)lo; v[1] = (__bf16)hi; return __builtin_bit_cast(unsigned, v); }
DI float bflo(unsigned u) { return __uint_as_float(u << 16); }
DI float bfhi(unsigned u) { return __uint_as_float(u & 0xffff0000u); }
DI float frcp(float x) { return __builtin_amdgcn_rcpf(x); }
DI float sigm(float x) { return frcp(1.f + __expf(-x)); }
DI float silu(float x) { return x * frcp(1.f + __expf(-x)); }
DI float gelu_tanh(float x) {
  float z = 0.7978845608028654f * (x + 0.044715f * x * x * x);
  float e = __expf(2.f * z);
  float t = 1.f - 2.f * frcp(e + 1.f);
  return 0.5f * x * (1.f + t);
}
DI int opaque_tid() { int t = threadIdx.x; asm volatile("" : "+v"(t)); return t; }
constexpr float QSCALE = 0.125f * 1.4426950408889634f;
DI int crow(int i, int h) { return (i & 3) + 8 * (i >> 2) + 4 * h; }
DI f32x16 zero16() { f32x16 z; _Pragma("unroll") for (int i = 0; i < 16; ++i) z[i] = 0.f; return z; }
DI void sincos_rev(float rev, float& s, float& c) { rev = rev - rintf(rev); s = __builtin_amdgcn_sinf(rev); c = __builtin_amdgcn_cosf(rev); }

#define LAS __attribute__((address_space(3)))
namespace pg8 {
constexpr int BM = 256, BK = 64, HALF = 128, HTB = HALF * BK * 2, STAGE_BYTES = 8 * HTB;
DI int lds_byte(int r, int c) { const int st = (r >> 4) * 2 + (c >> 5), rr = r & 15, cc = c & 31, ob = rr * 64 + cc * 2; return st * 1024 + (ob ^ (((ob >> 9) & 1) << 5)); }
DI void stage_rc(int b, int& R_, int& C_) { const int st = b / 1024, sb = b % 1024, swz = sb ^ (((sb >> 9) & 1) << 5); R_ = (st >> 1) * 16 + swz / 64; C_ = (st & 1) * 32 + (swz % 64) / 2; }
DI int perm32(int rho) { const int n = rho >> 4, i = rho & 15; return 8 * (i >> 2) + 4 * n + (i & 3); }
struct Unit { int pm, pn, pb; };
struct Gemm { const bf16_t* A; const bf16_t* Bt; int lda, ldb, K, nM, nN, nB; int strideA, strideB; int rot; };
DI bool next_unit(const Gemm& g, int i, Unit& u) {
  const int G = gridDim.x, per = g.nM * g.nN, nwg = per * g.nB;
  const int c = (blockIdx.x + g.rot) % G;
  const long L = (long)i * G + c;
  if (L >= nwg) return false;
  int wgid = (int)L;
  { const int q = nwg / 8, r = nwg % 8, xcd = wgid % 8, off = wgid / 8; wgid = (xcd < r ? xcd * (q + 1) : r * (q + 1) + (xcd - r) * q) + off; }
  const int pb = wgid / per, w = wgid - pb * per;
  const int nig = 8 * g.nN, gid = w / nig, fm = gid * 8, gsz = (g.nM - fm) < 8 ? (g.nM - fm) : 8;
  u.pb = pb; u.pm = fm + ((w % nig) % gsz); u.pn = (w % nig) / gsz;
  return true;
}

template <class Epi>
DI void gemm_phase(LAS unsigned char* lds, const Gemm g, const Epi& E) {
  const int tid = opaque_tid(), wid = __builtin_amdgcn_readfirstlane(tid >> 6), lane = tid & 63, wr = wid >> 2, wc = wid & 3, fr = lane & 15, fq = lane >> 4;
  const int K = g.K, nt = K / BK;
  unsigned voffA[2], voffB[2];
#pragma unroll
  for (int i = 0; i < 2; ++i) { int R_, C_; stage_rc(tid * 16 + i * 8192, R_, C_); const int Rb = Epi::PERM ? ((R_ & ~31) + perm32(R_ & 31)) : R_;
    voffA[i] = (unsigned)(R_ * g.lda + C_) * 2u; voffB[i] = (unsigned)(Rb * g.ldb + C_) * 2u; }
  const size_t kstep = (size_t)(BK * 2);
  const size_t hstepA = (size_t)HALF * g.lda * 2, hstepB = (size_t)HALF * g.ldb * 2;
  const size_t tstepA = 2 * hstepA, tstepB = 2 * hstepB;
  const unsigned ldsw = (unsigned)wid * 1024u;
  const int aoff = lds_byte(wr * 64 + fr, fq * 8), boff = lds_byte(wc * 32 + fr, fq * 8);
#define PG8_SA(b, h) (((b) * 2 + (h)) * HTB)
#define PG8_SB(b, h) ((4 + (b) * 2 + (h)) * HTB)
#define PG8_STAGE(bufoff, gbase, voff) do { _Pragma("unroll") for (int _i = 0; _i < 2; ++_i) \
        __builtin_amdgcn_global_load_lds((const unsigned*)((const char*)(gbase) + (voff)[_i]), (LAS unsigned*)(lds + (bufoff) + ldsw + _i * 8192), 16, 0, 0); } while (0)
#define PG8_LDA(dst, b, h) do { _Pragma("unroll") for (int m = 0; m < 4; ++m) _Pragma("unroll") for (int k = 0; k < 2; ++k) dst[m][k] = *(const LAS bf16x8*)(lds + PG8_SA(b, h) + aoff + m * 2048 + k * 1024); } while (0)
#define PG8_LDB(dst, b, h) do { _Pragma("unroll") for (int n = 0; n < 2; ++n) _Pragma("unroll") for (int k = 0; k < 2; ++k) dst[n][k] = *(const LAS bf16x8*)(lds + PG8_SB(b, h) + boff + n * 2048 + k * 1024); } while (0)
#define PG8_MMA(ai, bj, At, Bt) do { __builtin_amdgcn_s_setprio(1); _Pragma("unroll") for (int m = 0; m < 4; ++m) _Pragma("unroll") for (int n = 0; n < 2; ++n) _Pragma("unroll") for (int k = 0; k < 2; ++k) \
        acc[ai][bj][m][n] = __builtin_amdgcn_mfma_f32_16x16x32_bf16(Bt[n][k], At[m][k], acc[ai][bj][m][n], 0, 0, 0); __builtin_amdgcn_s_setprio(0); } while (0)
#define PG8_WAIT_V(n) asm volatile("s_waitcnt vmcnt(" #n ")" ::: "memory")
#define PG8_WAIT_L(n) asm volatile("s_waitcnt lgkmcnt(" #n ")" ::: "memory")
#define PG8_BAR __builtin_amdgcn_s_barrier()
#define PG8_SCHED __builtin_amdgcn_sched_barrier(0)
  Unit cur, nxt; int ui = 0;
  if (!next_unit(g, 0, cur)) return;
  f32x4 acc[2][2][4][2];
#pragma unroll
  for (int a = 0; a < 2; ++a)
#pragma unroll
    for (int b = 0; b < 2; ++b)
#pragma unroll
      for (int m = 0; m < 4; ++m)
#pragma unroll
        for (int n = 0; n < 2; ++n) acc[a][b][m][n] = (f32x4){0.f, 0.f, 0.f, 0.f};
  bf16x8 At[4][2], B0[2][2], B1[2][2];
  const char* cA = (const char*)(g.A + (size_t)cur.pb * g.strideA) + (size_t)cur.pm * tstepA;
  const char* cB = (const char*)(g.Bt + (size_t)cur.pb * g.strideB) + (size_t)cur.pn * tstepB;
  PG8_STAGE(PG8_SB(0, 0), cB, voffB); PG8_STAGE(PG8_SA(0, 0), cA, voffA); PG8_STAGE(PG8_SB(0, 1), cB + hstepB, voffB); PG8_STAGE(PG8_SA(0, 1), cA + hstepA, voffA);
  if (wr == 1) PG8_BAR;
  PG8_WAIT_V(4); PG8_BAR;
  PG8_STAGE(PG8_SB(1, 0), cB + kstep, voffB); PG8_STAGE(PG8_SA(1, 0), cA + kstep, voffA); PG8_STAGE(PG8_SB(1, 1), cB + hstepB + kstep, voffB);
  PG8_WAIT_V(6); PG8_BAR;
  for (;;) {
    const bool has_next = next_unit(g, ui + 1, nxt);
    const char* nA = has_next ? (const char*)(g.A + (size_t)nxt.pb * g.strideA) + (size_t)nxt.pm * tstepA : cA;
    const char* nB = has_next ? (const char*)(g.Bt + (size_t)nxt.pb * g.strideB) + (size_t)nxt.pn * tstepB : cB;
    for (int t = 0; t < nt; t += 2) {
      const bool last = (t == nt - 2);
      const char* a1 = cA + (size_t)(t + 1) * kstep;
      const char* a2 = last ? nA : cA + (size_t)(t + 2) * kstep; const char* b2 = last ? nB : cB + (size_t)(t + 2) * kstep;
      const char* a3 = a2 + kstep; const char* b3 = b2 + kstep;
      PG8_LDB(B0, 0, 0); PG8_SCHED; PG8_LDA(At, 0, 0); PG8_STAGE(PG8_SA(1, 1), a1 + hstepA, voffA);
      PG8_WAIT_L(8); PG8_BAR; PG8_WAIT_L(0); PG8_MMA(0, 0, At, B0); PG8_BAR; PG8_SCHED;
      PG8_LDB(B1, 0, 1); PG8_STAGE(PG8_SB(0, 0), b2, voffB);
      PG8_BAR; PG8_WAIT_L(0); PG8_MMA(0, 1, At, B1); PG8_BAR;
      PG8_LDA(At, 0, 1); PG8_STAGE(PG8_SA(0, 0), a2, voffA);
      PG8_BAR; PG8_WAIT_L(0); PG8_MMA(1, 0, At, B0); PG8_BAR; PG8_SCHED;
      PG8_STAGE(PG8_SB(0, 1), b2 + hstepB, voffB);
      PG8_WAIT_V(6); PG8_BAR; PG8_MMA(1, 1, At, B1); PG8_BAR;
      PG8_LDB(B0, 1, 0); PG8_SCHED; PG8_LDA(At, 1, 0); PG8_STAGE(PG8_SA(0, 1), a2 + hstepA, voffA);
      PG8_WAIT_L(8); PG8_BAR; PG8_WAIT_L(0); PG8_MMA(0, 0, At, B0); PG8_BAR; PG8_SCHED;
      PG8_LDB(B1, 1, 1); PG8_STAGE(PG8_SB(1, 0), b3, voffB);
      PG8_BAR; PG8_WAIT_L(0); PG8_MMA(0, 1, At, B1); PG8_BAR;
      PG8_LDA(At, 1, 1); PG8_STAGE(PG8_SA(1, 0), a3, voffA);
      PG8_BAR; PG8_WAIT_L(0); PG8_MMA(1, 0, At, B0); PG8_BAR; PG8_SCHED;
      PG8_STAGE(PG8_SB(1, 1), b3 + hstepB, voffB);
      PG8_WAIT_V(6); PG8_BAR; PG8_MMA(1, 1, At, B1); PG8_BAR;
    }
    E(acc, cur, wr, wc, fr, fq);
    if (!has_next) break;
#pragma unroll
    for (int a = 0; a < 2; ++a)
#pragma unroll
      for (int b = 0; b < 2; ++b)
#pragma unroll
        for (int m = 0; m < 4; ++m)
#pragma unroll
          for (int n = 0; n < 2; ++n) acc[a][b][m][n] = (f32x4){0.f, 0.f, 0.f, 0.f};
    cur = nxt; cA = nA; cB = nB; ++ui;
  }
  PG8_WAIT_V(0);
  if (wr == 0) PG8_BAR;
  PG8_BAR;
#undef PG8_SA
#undef PG8_SB
#undef PG8_STAGE
#undef PG8_LDA
#undef PG8_LDB
#undef PG8_MMA
#undef PG8_WAIT_V
#undef PG8_WAIT_L
#undef PG8_BAR
#undef PG8_SCHED
}
}
using pg8::Unit;
typedef f32x4 AccT[2][2][4][2];

DI void asm_fence() { asm volatile("" ::: "memory"); }
#define EPI_ROWS4 _Pragma("unroll") for (int ai = 0; ai < 2; ++ai) if ((asm_fence(), true)) _Pragma("unroll") for (int m = 0; m < 4; ++m)
#define EPI_ROWS _Pragma("unroll") for (int ai = 0; ai < 2; ++ai) _Pragma("unroll") for (int m = 0; m < 4; ++m) if ((asm_fence(), true))
DI u32x4 pack8f(const f32x4& a, const f32x4& b) { u32x4 w; w[0] = pack2(a[0], a[1]); w[1] = pack2(a[2], a[3]); w[2] = pack2(b[0], b[1]); w[3] = pack2(b[2], b[3]); return w; }
DI size_t k_off(int t, int d) { return (size_t)(t >> 5) * 2048 + (((d >> 4) * 64 + ((d >> 3) & 1) * 32 + (t & 31)) << 3) + (d & 7); }

struct EpiL0In {
  static constexpr bool PERM = true;
  bf16_t* U0; bf16_t* G0;
  DI void operator()(const AccT& acc, const Unit& u, int wr, int wc, int fr, int fq) const {
    EPI_ROWS { const int row = u.pm * 256 + ai * 128 + wr * 64 + m * 16 + fr;
      _Pragma("unroll") for (int bj = 0; bj < 2; ++bj) { const int c0 = u.pn * 256 + bj * 128 + wc * 32 + 8 * fq;
        const bool isu = u.pn * 256 + bj * 128 < LW;
        bf16_t* dst = isu ? U0 + (size_t)row * LW + c0 : G0 + (size_t)row * LW + (c0 - LW);
        *(u32x4*)dst = pack8f(acc[ai][bj][m][0], acc[ai][bj][m][1]); } }
  }
};

template <bool NEXT>
struct EpiOut {
  static constexpr bool PERM = false;
  const float* in_lat; const float* in_ctx; float* out_lat; float* out_ctx; const float* gate;
  const float* gs; bf16_t* NB_; float* ss;
  DI void operator()(const AccT& acc, const Unit& u, int wr, int wc, int fr, int fq) const {
    const int rb = u.pm * 256;
    const float* src; float* dst; const float* g; const float* gsv; int rr;
    if (rb < RL) { src = in_lat; dst = out_lat; rr = rb; g = gate + (size_t)(rb >> 11) * 3072; gsv = gs + (size_t)(rb >> 11) * 1024; }
    else { src = in_ctx; dst = out_ctx; rr = rb - RL; g = gate + (size_t)8 * 3072; gsv = gs + (size_t)8 * 1024; }
    const int cb = u.pn * 256 + wc * 32 + 4 * fq;
    f32x4 gv[4], sv[4];
    _Pragma("unroll") for (int q = 0; q < 4; ++q) { gv[q] = *(const f32x4*)(g + cb + (q >> 1) * 128 + (q & 1) * 16); if (NEXT) sv[q] = *(const f32x4*)(gsv + cb + (q >> 1) * 128 + (q & 1) * 16); }
    const int r0 = rr + wr * 64 + fr;
    f32x4 hc[4], hn[4];
    _Pragma("unroll") for (int q = 0; q < 4; ++q) hc[q] = *(const f32x4*)(src + (size_t)r0 * 1024 + cb + (q >> 1) * 128 + (q & 1) * 16);
    _Pragma("unroll") for (int r_ = 0; r_ < 8; ++r_) {
      const int ai = r_ >> 2, m = r_ & 3, row = r0 + 128 * ai + 16 * m;
      if (r_ + 1 < 8) { const int rown = r0 + 128 * ((r_ + 1) >> 2) + 16 * ((r_ + 1) & 3);
        _Pragma("unroll") for (int q = 0; q < 4; ++q) hn[q] = *(const f32x4*)(src + (size_t)rown * 1024 + cb + (q >> 1) * 128 + (q & 1) * 16); }
      float sq = 0.f;
      _Pragma("unroll") for (int q = 0; q < 4; ++q) {
        const int c = cb + (q >> 1) * 128 + (q & 1) * 16;
        const f32x4 o = hc[q] + gv[q] * acc[ai][q >> 1][m][q & 1];
        *(f32x4*)(dst + (size_t)row * 1024 + c) = o;
        if (NEXT) {
          u32x2 w; w[0] = pack2(o[0] * sv[q][0], o[1] * sv[q][1]); w[1] = pack2(o[2] * sv[q][2], o[3] * sv[q][3]);
          *(u32x2*)(NB_ + (size_t)(row - rr + rb) * 1024 + c) = w;
          sq += o[0] * o[0] + o[1] * o[1] + o[2] * o[2] + o[3] * o[3];
        }
      }
      if (NEXT) {
        sq += __shfl_xor(sq, 16); sq += __shfl_xor(sq, 32);
        if (fq == 0) atomicAdd(ss + (row - rr + rb), sq);
      }
      asm_fence();
      _Pragma("unroll") for (int q = 0; q < 4; ++q) hc[q] = hn[q];
    }
  }
};

struct EpiL1 {
  static constexpr bool PERM = true;
  bf16_t *Q, *QR, *Kb, *G; const float *rc, *rs; const float* ss; const float* shw;
  DI void operator()(const AccT& acc, const Unit& u, int wr, int wc, int fr, int fq) const {
    const int rb = u.pm * 256; const bool lat = rb < RL;
    const float* sh = shw + (size_t)(lat ? (rb >> 11) : 8) * 4096;
    const int r0 = rb + wr * 64 + fr;
    float rstd[8];
    _Pragma("unroll") for (int r_ = 0; r_ < 8; ++r_) rstd[r_] = ss[r0 + 128 * (r_ >> 2) + 16 * (r_ & 3)];
    _Pragma("unroll") for (int r_ = 0; r_ < 8; ++r_) rstd[r_] = rsqrtf(rstd[r_] * (1.f / 1024.f) + 1e-6f);
    const bool qk = u.pn * 256 < 1280;
    f32x4 b1[2], b2v[2];
    int c0s[2], d0s[2];
    _Pragma("unroll") for (int bj = 0; bj < 2; ++bj) {
      const int c0 = u.pn * 256 + bj * 128 + wc * 32 + 8 * fq; c0s[bj] = c0; d0s[bj] = (c0 & 63) >> 1;
      if (qk) { const int oc = (c0 & ~63) + d0s[bj]; b1[bj] = *(const f32x4*)(sh + oc); b2v[bj] = *(const f32x4*)(sh + oc + 32); }
      else { b1[bj] = *(const f32x4*)(sh + c0 + 256); b2v[bj] = *(const f32x4*)(sh + c0 + 260); }
    }
    f32x4 cc, sc, cn, sn;
    if (qk && lat) { const int t = r0 & 2047; cc = *(const f32x4*)(rc + t * 32 + d0s[0]); sc = *(const f32x4*)(rs + t * 32 + d0s[0]); }
    _Pragma("unroll") for (int r_ = 0; r_ < 8; ++r_) {
      const int ai = r_ >> 2, m = r_ & 3, row = r0 + 128 * ai + 16 * m;
      if (qk && lat && r_ + 1 < 8) { const int tn = (r0 + 128 * ((r_ + 1) >> 2) + 16 * ((r_ + 1) & 3)) & 2047;
        cn = *(const f32x4*)(rc + tn * 32 + d0s[0]); sn = *(const f32x4*)(rs + tn * 32 + d0s[0]); }
      _Pragma("unroll") for (int bj = 0; bj < 2; ++bj) { const int c0 = c0s[bj], d0 = d0s[bj];
        const f32x4 v0 = acc[ai][bj][m][0] * rstd[r_], v1 = acc[ai][bj][m][1] * rstd[r_];
        if (qk) {
          float x1[4] = {v0[0] + b1[bj][0], v0[2] + b1[bj][1], v1[0] + b1[bj][2], v1[2] + b1[bj][3]}, x2[4] = {v0[1] + b2v[bj][0], v0[3] + b2v[bj][1], v1[1] + b2v[bj][2], v1[3] + b2v[bj][3]};
          float y1[4], y2[4];
          int t;
          if (lat) { t = row & 2047; _Pragma("unroll") for (int j = 0; j < 4; ++j) { y1[j] = x1[j] * cc[j] - x2[j] * sc[j]; y2[j] = x2[j] * cc[j] + x1[j] * sc[j]; } }
          else { t = (row - RL) & 255; _Pragma("unroll") for (int j = 0; j < 4; ++j) { y1[j] = x1[j]; y2[j] = x2[j]; } }
          if (u.pn < 4) {
            const size_t o = (size_t)row * 1024 + (c0 & ~63) + d0;
            u32x2 a, b2; a[0] = pack2(x1[0] * QSCALE, x1[1] * QSCALE); a[1] = pack2(x1[2] * QSCALE, x1[3] * QSCALE);
            b2[0] = pack2(x2[0] * QSCALE, x2[1] * QSCALE); b2[1] = pack2(x2[2] * QSCALE, x2[3] * QSCALE);
            *(u32x2*)(Q + o) = a; *(u32x2*)(Q + o + 32) = b2;
            if (lat) {
              a[0] = pack2(y1[0] * QSCALE, y1[1] * QSCALE); a[1] = pack2(y1[2] * QSCALE, y1[3] * QSCALE);
              b2[0] = pack2(y2[0] * QSCALE, y2[1] * QSCALE); b2[1] = pack2(y2[2] * QSCALE, y2[3] * QSCALE);
              *(u32x2*)(QR + o) = a; *(u32x2*)(QR + o + 32) = b2;
            }
          } else {
            const int kvh = (c0 - 1024) >> 6;
            bf16_t* kh = lat ? Kb + (size_t)((row >> 11) * 4 + kvh) * 64 * 2048 : Kb + (size_t)RL * 256 + (size_t)(((row - RL) >> 8) * 4 + kvh) * 8 * 2048;
            u32x2 a, b2; a[0] = pack2(y1[0], y1[1]); a[1] = pack2(y1[2], y1[3]); b2[0] = pack2(y2[0], y2[1]); b2[1] = pack2(y2[2], y2[3]);
            *(u32x2*)(kh + k_off(t, d0)) = a; *(u32x2*)(kh + k_off(t, d0 + 32)) = b2;
          }
        } else {
          *(u32x4*)(G + (size_t)row * 1024 + (c0 - 1280)) = pack8f(v0 + b1[bj], v1 + b2v[bj]);
        } }
      asm_fence();
      cc = cn; sc = sn;
    }
  }
};

template <int H, int VCOL0  >
struct EpiV {
  static constexpr bool PERM = true;
  bf16_t *VtL, *VtC; const float* ss; const float* shw;
  DI void operator()(const AccT& acc, const Unit& u, int wr, int wc, int fr, int fq) const {
    const bool latn = u.pn * 256 < RL;
    bf16_t* basep = latn ? VtL : VtC;
    const int tsh = latn ? 11 : 8, tiles = latn ? 64 : 8;
    const int nb = (latn ? u.pn * 256 : u.pn * 256 - RL) + wc * 32 + 8 * fq;
    f32x4 r0[2], r1[2];
    _Pragma("unroll") for (int bj = 0; bj < 2; ++bj) {
      const float* sp = ss + u.pn * 256 + bj * 128 + wc * 32 + 8 * fq;
      const f32x4 a = *(const f32x4*)sp, b2 = *(const f32x4*)(sp + 4);
      _Pragma("unroll") for (int j = 0; j < 4; ++j) { r0[bj][j] = rsqrtf(a[j] * (1.f / 1024.f) + 1e-6f); r1[bj][j] = rsqrtf(b2[j] * (1.f / 1024.f) + 1e-6f); }
    }
    const int vb0 = latn ? (nb >> tsh) : 8;
    float biasr[8];
    _Pragma("unroll") for (int r_ = 0; r_ < 8; ++r_) biasr[r_] = shw[(size_t)vb0 * 4096 + VCOL0 + u.pm * 256 + (r_ >> 2) * 128 + wr * 64 + (r_ & 3) * 16 + fr];
    EPI_ROWS { const int rowd = u.pm * 256 + ai * 128 + wr * 64 + m * 16 + fr, head = rowd >> 6, d = rowd & 63;
      const unsigned rowoff = (unsigned)(((d >> 5) * 128 + (d & 31)) << 3);
      _Pragma("unroll") for (int bj = 0; bj < 2; ++bj) { const int nn = nb + bj * 128;
        const int bidx = nn >> tsh, t = nn & ((1 << tsh) - 1);
        const float bias = biasr[ai * 4 + m];
        const unsigned off = (unsigned)(((bidx * H + head) * tiles + (t >> 5)) * 2048) + rowoff + (unsigned)((((t & 31) >> 4) * 64) << 3) + (unsigned)(((t >> 3) & 1) * 4);
        const f32x4 v0 = acc[ai][bj][m][0] * r0[bj] + bias, v1 = acc[ai][bj][m][1] * r1[bj] + bias;
        u32x2 a, b2; a[0] = pack2(v0[0], v0[1]); a[1] = pack2(v0[2], v0[3]); b2[0] = pack2(v1[0], v1[1]); b2[1] = pack2(v1[2], v1[3]);
        *(u32x2*)(basep + off) = a; *(u32x2*)(basep + off + 256) = b2; } }
  }
};

struct EpiL2 {
  static constexpr bool PERM = true;
  bf16_t *Q, *Kb, *G; const float* ss; const float* shw;
  DI void operator()(const AccT& acc, const Unit& u, int wr, int wc, int fr, int fq) const {
    const int rb = u.pm * 256; const bool lat = rb < RL;
    const float* sh = shw + (size_t)(lat ? (rb >> 11) : 8) * 4096;
    const int r0 = rb + wr * 64 + fr;
    float rstd[8];
    _Pragma("unroll") for (int r_ = 0; r_ < 8; ++r_) rstd[r_] = ss[r0 + 128 * (r_ >> 2) + 16 * (r_ & 3)];
    _Pragma("unroll") for (int r_ = 0; r_ < 8; ++r_) rstd[r_] = rsqrtf(rstd[r_] * (1.f / 1024.f) + 1e-6f);
    f32x4 b1[2], b2v[2];
    _Pragma("unroll") for (int bj = 0; bj < 2; ++bj) { const int c0 = u.pn * 256 + bj * 128 + wc * 32 + 8 * fq, oc = u.pn < 8 ? c0 : c0 + 1024;
      b1[bj] = *(const f32x4*)(sh + oc); b2v[bj] = *(const f32x4*)(sh + oc + 4); }
    _Pragma("unroll") for (int r_ = 0; r_ < 8; ++r_) { const int ai = r_ >> 2, m = r_ & 3, row = r0 + 128 * ai + 16 * m;
      _Pragma("unroll") for (int bj = 0; bj < 2; ++bj) { const int c0 = u.pn * 256 + bj * 128 + wc * 32 + 8 * fq;
        const f32x4 v0 = acc[ai][bj][m][0] * rstd[r_] + b1[bj], v1 = acc[ai][bj][m][1] * rstd[r_] + b2v[bj];
        if (u.pn < 4) *(u32x4*)(Q + (size_t)row * 1024 + c0) = pack8f(v0 * QSCALE, v1 * QSCALE);
        else if (u.pn < 8) {
          const int hd = (c0 - 1024) >> 6, d0 = c0 & 63;
          bf16_t* kh; int t;
          if (lat) { kh = Kb + (size_t)((row >> 11) * 16 + hd) * 64 * 2048; t = row & 2047; }
          else { const int rr = row - RL; kh = Kb + (size_t)RL * 1024 + (size_t)((rr >> 8) * 16 + hd) * 8 * 2048; t = rr & 255; }
          *(u32x4*)(kh + k_off(t, d0)) = pack8f(v0, v1);
        } else *(u32x4*)(G + (size_t)row * 1024 + (c0 - 2048)) = pack8f(v0, v1); }
      asm_fence(); }
  }
};

struct EpiL3In {
  static constexpr bool PERM = true;
  bf16_t *ACAT, *G; const float* ss; const float* shw;
  DI void operator()(const AccT& acc, const Unit& u, int wr, int wc, int fr, int fq) const {
    const int rb = u.pm * 256;
    const float* sh = shw + (size_t)(rb < RL ? (rb >> 11) : 8) * 4096;
    const int r0 = rb + wr * 64 + fr;
    float rstd[8];
    _Pragma("unroll") for (int r_ = 0; r_ < 8; ++r_) rstd[r_] = ss[r0 + 128 * (r_ >> 2) + 16 * (r_ & 3)];
    _Pragma("unroll") for (int r_ = 0; r_ < 8; ++r_) rstd[r_] = rsqrtf(rstd[r_] * (1.f / 1024.f) + 1e-6f);
    f32x4 b1[2], b2v[2];
    _Pragma("unroll") for (int bj = 0; bj < 2; ++bj) { const int c0 = u.pn * 256 + bj * 128 + wc * 32 + 8 * fq; b1[bj] = *(const f32x4*)(sh + c0); b2v[bj] = *(const f32x4*)(sh + c0 + 4); }
    _Pragma("unroll") for (int r_ = 0; r_ < 8; ++r_) { const int ai = r_ >> 2, m = r_ & 3, row = r0 + 128 * ai + 16 * m;
      _Pragma("unroll") for (int bj = 0; bj < 2; ++bj) { const int c0 = u.pn * 256 + bj * 128 + wc * 32 + 8 * fq;
        const u32x4 w = pack8f(acc[ai][bj][m][0] * rstd[r_] + b1[bj], acc[ai][bj][m][1] * rstd[r_] + b2v[bj]);
        if (u.pn < 4) *(u32x4*)(ACAT + ((size_t)(c0 >> 4) * NCH + (row >> 4)) * 512 + (row & 15) * 16 + (c0 & 15)) = w;
        else if (rb < RL) *(u32x4*)(G + (size_t)row * 1024 + (c0 - 1024)) = w; }
      asm_fence(); }
  }
};

struct EpiS5State {
  static constexpr bool PERM = false;
  float* S;
  DI void operator()(const AccT& acc, const Unit& u, int wr, int wc, int fr, int fq) const {
    float* sp = S + ((size_t)u.pb * NCHP + u.pm * 256) * 256 + wc * 32 + 4 * fq;
    EPI_ROWS { const unsigned o = (unsigned)(ai * 128 + wr * 64 + m * 16 + fr) * 256u;
      *(f32x4*)(sp + o) = acc[ai][0][m][0]; *(f32x4*)(sp + o + 16) = acc[ai][0][m][1];
      *(f32x4*)(sp + o + 128) = acc[ai][1][m][0]; *(f32x4*)(sp + o + 144) = acc[ai][1][m][1]; }
  }
};

struct EpiS5Y {
  static constexpr bool PERM = true;
  bf16_t* YG;
  DI void operator()(const AccT& acc, const Unit& u, int wr, int wc, int fr, int fq) const {
    EPI_ROWS { const int chunk = u.pm * 256 + ai * 128 + wr * 64 + m * 16 + fr;
      _Pragma("unroll") for (int bj = 0; bj < 2; ++bj) { const int n0 = bj * 128 + wc * 32 + 8 * fq;
        f32x4 v0 = acc[ai][bj][m][0], v1 = acc[ai][bj][m][1];
        _Pragma("unroll") for (int j = 0; j < 4; ++j) { v0[j] = gelu_tanh(v0[j]); v1[j] = gelu_tanh(v1[j]); }
        *(u32x4*)(YG + ((size_t)chunk * 16 + (n0 >> 4)) * 1024 + u.pb * 16 + (n0 & 15)) = pack8f(v0, v1); } }
  }
};

struct EpiGlu {
  static constexpr bool PERM = true;
  const bf16_t *YG, *G; const float* gb; bf16_t* ACT;
  DI void operator()(const AccT& acc, const Unit& u, int wr, int wc, int fr, int fq) const {
    const int r0 = u.pm * 256 + wr * 64 + fr, cb = u.pn * 256 + wc * 32 + 8 * fq;
    f32x4 b0[2], b1[2];
    _Pragma("unroll") for (int bj = 0; bj < 2; ++bj) { b0[bj] = *(const f32x4*)(gb + cb + bj * 128); b1[bj] = *(const f32x4*)(gb + cb + bj * 128 + 4); }
    u32x4 yc[2], gc[2], yn[2], gn_[2];
    _Pragma("unroll") for (int bj = 0; bj < 2; ++bj) { yc[bj] = *(const u32x4*)(YG + (size_t)r0 * 1024 + cb + bj * 128); gc[bj] = *(const u32x4*)(G + (size_t)r0 * 1024 + cb + bj * 128); }
    _Pragma("unroll") for (int r_ = 0; r_ < 8; ++r_) {
      const int ai = r_ >> 2, m = r_ & 3, row = r0 + 128 * ai + 16 * m;
      if (r_ + 1 < 8) { const int rown = r0 + 128 * ((r_ + 1) >> 2) + 16 * ((r_ + 1) & 3);
        _Pragma("unroll") for (int bj = 0; bj < 2; ++bj) { yn[bj] = *(const u32x4*)(YG + (size_t)rown * 1024 + cb + bj * 128); gn_[bj] = *(const u32x4*)(G + (size_t)rown * 1024 + cb + bj * 128); } }
      _Pragma("unroll") for (int bj = 0; bj < 2; ++bj) {
        const u32x4 y = yc[bj], gg = gc[bj];
        const f32x4 v0 = acc[ai][bj][m][0], v1 = acc[ai][bj][m][1];
        u32x4 w;
        w[0] = pack2(bflo(y[0]) * sigm(v0[0] + b0[bj][0]) * silu(bflo(gg[0])), bfhi(y[0]) * sigm(v0[1] + b0[bj][1]) * silu(bfhi(gg[0])));
        w[1] = pack2(bflo(y[1]) * sigm(v0[2] + b0[bj][2]) * silu(bflo(gg[1])), bfhi(y[1]) * sigm(v0[3] + b0[bj][3]) * silu(bfhi(gg[1])));
        w[2] = pack2(bflo(y[2]) * sigm(v1[0] + b1[bj][0]) * silu(bflo(gg[2])), bfhi(y[2]) * sigm(v1[1] + b1[bj][1]) * silu(bfhi(gg[2])));
        w[3] = pack2(bflo(y[3]) * sigm(v1[2] + b1[bj][2]) * silu(bflo(gg[3])), bfhi(y[3]) * sigm(v1[3] + b1[bj][3]) * silu(bfhi(gg[3])));
        *(u32x4*)(ACT + (size_t)row * 1024 + cb + bj * 128) = w;
      }
      asm_fence();
      _Pragma("unroll") for (int bj = 0; bj < 2; ++bj) { yc[bj] = yn[bj]; gc[bj] = gn_[bj]; }
    }
  }
};

struct TrJob { const float* W; bf16_t* dst; int N, ldd, k0, n0, perm, dup; };
DI TrJob tr_job(const Params& p, int j) {
  constexpr int T0 = 16 * 44, T1 = T0 + 22 * 16, T2 = T1 + 16 * 40, T3 = T2 + 256, T4 = T3 + 16 * 64, T5 = T4 + 256, T6 = T5 + 16 * 32, T7 = T6 + 256;
  char* ws = p.ws;
  TrJob t; int tile, K; t.perm = 0; t.dup = 0;
  bf16_t* base;
  if (j < T0) { t.W = p.in[7]; K = 1024; t.N = 2816; base = (bf16_t*)(ws + O_WT_IN0); tile = j; }
  else if (j < T1) { t.W = p.in[15]; K = 1408; t.N = 1024; base = (bf16_t*)(ws + O_WT_OUT0); tile = j - T0; }
  else if (j < T2) { t.W = p.in[19]; K = 1024; t.N = 2560; base = (bf16_t*)(ws + O_WT_IN1); tile = j - T1; }
  else if (j < T3) { t.W = p.in[21]; K = 1024; t.N = 1024; base = (bf16_t*)(ws + O_WT_OUT1); tile = j - T2; }
  else if (j < T4) { t.W = p.in[25]; K = 1024; t.N = 4096; base = (bf16_t*)(ws + O_WT_IN2); tile = j - T3; }
  else if (j < T5) { t.W = p.in[27]; K = 1024; t.N = 1024; base = (bf16_t*)(ws + O_WT_OUT2); tile = j - T4; }
  else if (j < T6) { t.W = p.in[31]; K = 1024; t.N = 2048; base = (bf16_t*)(ws + O_WT_IN3); tile = j - T5; }
  else if (j < T7) { t.W = p.in[40]; K = 1024; t.N = 1024; base = (bf16_t*)(ws + O_WT_GLU); tile = j - T6; }
  else { t.W = p.in[42]; K = 1024; t.N = 1024; base = (bf16_t*)(ws + O_WT_OUT3); tile = j - T7; }
  const int tn = t.N >> 6, tk_i = tile / tn;
  t.k0 = tk_i * 64; t.n0 = (tile - tk_i * tn) * 64;
  t.ldd = K;
  int drow = t.n0;
  if (j >= T1 && j < T2) {
    if (t.n0 < 1280) t.perm = 1;
    else if (t.n0 < 1536) drow = 2304 + (t.n0 - 1280);
    else drow = t.n0 - 256;
  } else if (j >= T3 && j < T4) {
    if (t.n0 >= 3072) drow = t.n0 - 1024;
    else if (t.n0 >= 2048) drow = 3072 + (t.n0 - 2048);
  }
  t.dst = base + (size_t)drow * t.ldd + t.k0;
  return t;
}

DI void transpose_range(const Params& p, char* smem, int j0, int j1, int first_blk, int skew) {
  if ((int)blockIdx.x < first_blk) return;
  float* smf = (float*)smem;
  const int G = (int)gridDim.x - first_blk;
  const int c = threadIdx.x & 63, rr = threadIdx.x >> 6, kp = threadIdx.x & 31, nb = threadIdx.x >> 5;
  int j = j0 + ((int)blockIdx.x - first_blk + G - (skew % G)) % G;
  float v[8];
  TrJob cur{};
  __syncthreads();
  if (j < j1) { cur = tr_job(p, j); _Pragma("unroll") for (int i = 0; i < 8; ++i) v[i] = __builtin_nontemporal_load(cur.W + (size_t)(cur.k0 + i * 8 + rr) * cur.N + cur.n0 + c); }
  for (; j < j1; j += G) {
    _Pragma("unroll") for (int i = 0; i < 8; ++i) smf[(i * 8 + rr) * 65 + c] = v[i];
    const TrJob me = cur;
    if (j + G < j1) { cur = tr_job(p, j + G); _Pragma("unroll") for (int i = 0; i < 8; ++i) v[i] = __builtin_nontemporal_load(cur.W + (size_t)(cur.k0 + i * 8 + rr) * cur.N + cur.n0 + c); }
    __syncthreads();
    _Pragma("unroll") for (int i = 0; i < 4; ++i) {
      const int n = nb + 16 * i;
      const int dr = me.perm ? (((n & 31) << 1) | (n >> 5)) : n;
      const unsigned w = pack2(smf[(2 * kp) * 65 + n], smf[(2 * kp + 1) * 65 + n]);
      bf16_t* d = me.dst + (size_t)dr * me.ldd + 2 * kp;
      *(unsigned*)d = w;
      if (me.dup) *(unsigned*)(d + 1408) = w;
    }
    __syncthreads();
  }
}

DI void phase0(const Params& p, char* smem) {
  char* ws = p.ws;
  float* smf = (float*)smem;
  const int NT_ = blockDim.x;
  for (int job = blockIdx.x; job < 384; job += gridDim.x) {
    const int l = job / 96, n0 = (job % 96) * 32;
    const float* aw = l == 0 ? p.in[4] : l == 1 ? p.in[16] : l == 2 ? p.in[22] : p.in[28];
    const float* ab = l == 0 ? p.in[5] : l == 1 ? p.in[17] : l == 2 ? p.in[23] : p.in[29];
    float* sv = smf;
    float* red = smf + 9 * 1024;
    for (int idx = threadIdx.x; idx < 9 * 1024; idx += NT_) {
      const int v = idx >> 10, k = idx & 1023;
      const float x = v < 8 ? p.in[1][v * 1024 + k] : p.in[3][k];
      sv[idx] = silu(x);
    }
    __syncthreads();
    const int col = threadIdx.x & 31, ks = threadIdx.x >> 5;
    float a[9];
    _Pragma("unroll") for (int v = 0; v < 9; ++v) a[v] = 0.f;
    for (int kb = ks * 64; kb < ks * 64 + 64; kb += 16) {
      float wv[16];
      _Pragma("unroll") for (int u = 0; u < 16; ++u) wv[u] = aw[(size_t)(kb + u) * 3072 + n0 + col];
      _Pragma("unroll") for (int u = 0; u < 16; ++u) _Pragma("unroll") for (int v = 0; v < 9; ++v) a[v] += sv[v * 1024 + kb + u] * wv[u];
    }
    _Pragma("unroll") for (int v = 0; v < 9; ++v) red[(ks * 9 + v) * 32 + col] = a[v];
    __syncthreads();
    float* MOD = (float*)(ws + O_MOD);
    for (int idx = threadIdx.x; idx < 9 * 32; idx += NT_) {
      const int v = idx >> 5, cc = idx & 31;
      float sum = ab[n0 + cc];
      _Pragma("unroll") for (int q = 0; q < 16; ++q) sum += red[(q * 9 + v) * 32 + cc];
      MOD[(size_t)(l * 9 + v) * 3072 + n0 + cc] = sum;
    }
    __syncthreads();
  }
  transpose_range(p, smem, 0, 16 * 44, gridDim.x == 256 ? 128 : 0, 0);
}

DI void tables_phase(const Params& p, int first_blk) {
  if ((int)blockIdx.x < first_blk) return;
  char* ws = p.ws;
  const int gt = ((int)blockIdx.x - first_blk) * blockDim.x + threadIdx.x, gn = ((int)gridDim.x - first_blk) * blockDim.x;
  {
    bf16_t* WG = (bf16_t*)(ws + O_WG);
    for (int idx = gt; idx < 16 * 2 * 192 * 96; idx += gn) {
      const int kk = idx % 96; int t = idx / 96; const int n = t % 192; t /= 192; const int d = t & 1, k = t >> 1;
      const int c = n >> 5, gate = (n >> 4) & 1, ch = c * 16 + (n & 15);
      float v = 0.f;
      if (ch < 88 && kk < 88) { const float* w = gate ? p.in[12] : p.in[10]; v = w[((size_t)(d * 16 + k) * 88 + kk) * 88 + ch]; }
      WG[idx] = f2bf(v);
    }
  }
  { float* SS = (float*)(ws + O_SS); for (int idx = gt; idx < 3 * R; idx += gn) SS[idx] = 0.f; }
  {
    float* RCt = (float*)(ws + O_ROPEC); float* RSt = (float*)(ws + O_ROPES);
    for (int idx = gt; idx < 2048 * 32; idx += gn) {
      const int t = idx >> 5, j = idx & 31;
      const float pos = (float)(j < 16 ? (t >> 6) : (t & 63));
      const float freq = exp2f(-(float)(j & 15) * (13.287712379549449f / 16.f));
      float s, c; sincos_rev(pos * freq * 0.15915494309189535f, s, c);
      RCt[idx] = c; RSt[idx] = s;
    }
  }
  {
    float2* POW = (float2*)(ws + O_POW); float2* BB = (float2*)(ws + O_BBAR);
    for (int idx = gt; idx < 2 * 64 * 17 * 64; idx += gn) {
      const int pp = idx & 63; int t = idx >> 6; const int n = t % 17; t /= 17;
      const float are = p.in[32][t * 64 + pp], aim = p.in[33][t * 64 + pp], dt = expf(p.in[34][t]);
      const float mag = expf((float)n * are * dt);
      const double rev = (double)n * (double)aim * (double)dt * 0.15915494309189535;
      float s, c; sincos_rev((float)(rev - rint(rev)), s, c);
      POW[idx] = make_float2(mag * c, mag * s);
    }
    for (int idx = gt; idx < 2 * 64 * 64 * 16; idx += gn) {
      const int t = idx >> 4;
      const int dg = t >> 6;
      const float are = p.in[32][t], aim = p.in[33][t], dt = expf(p.in[34][dg]);
      const float mag = expf(are * dt);
      const double rev = (double)aim * (double)dt * 0.15915494309189535;
      float s, c; sincos_rev((float)(rev - rint(rev)), s, c);
      const float nr = mag * c - 1.f, ni = mag * s;
      const float den = 1.f / (are * are + aim * aim);
      const float cr = (nr * are + ni * aim) * den, ci = (ni * are - nr * aim) * den;
      const float br = p.in[35][idx], bi = p.in[36][idx];
      BB[idx] = make_float2(cr * br - ci * bi, cr * bi + ci * br);
    }
  }
}

DI void modfold_phase(const Params& p, char* smem) {
  char* ws = p.ws;
  const float* MOD = (const float*)(ws + O_MOD);
  float* GS = (float*)(ws + O_GS);
  float* SHW = (float*)(ws + O_SHW);
  const int NT_ = blockDim.x;
  for (int idx = blockIdx.x * NT_ + threadIdx.x; idx < 3 * 9 * 1024; idx += gridDim.x * NT_) {
    const int k = idx & 1023, lv = idx >> 10, l = lv / 9 + 1, v = lv - (l - 1) * 9;
    const float* gn = l == 1 ? p.in[18] : l == 2 ? p.in[24] : p.in[30];
    GS[idx] = gn[k] * (1.f + MOD[(size_t)(l * 9 + v) * 3072 + 1024 + k]);
  }
  float* smf = (float*)smem;
  float* sv = smf;
  float* red = smf + 9 * 1024;
  for (int job = (int)gridDim.x - 1 - (int)blockIdx.x; job < 80 + 128 + 64; job += gridDim.x) {
    int l, n0; const float* W; int N;
    if (job < 80) { l = 1; n0 = job * 32; W = p.in[19]; N = 2560; }
    else if (job < 208) { l = 2; n0 = (job - 80) * 32; W = p.in[25]; N = 4096; }
    else { l = 3; n0 = (job - 208) * 32; W = p.in[31]; N = 2048; }
    __syncthreads();
    for (int idx = threadIdx.x; idx < 9 * 1024; idx += NT_) sv[idx] = MOD[(size_t)(l * 9 + (idx >> 10)) * 3072 + (idx & 1023)];
    __syncthreads();
    const int col = threadIdx.x & 31, ks = threadIdx.x >> 5;
    float a[9];
    _Pragma("unroll") for (int v = 0; v < 9; ++v) a[v] = 0.f;
    for (int kb = ks * 64; kb < ks * 64 + 64; kb += 16) {
      float wv[16];
      _Pragma("unroll") for (int u = 0; u < 16; ++u) wv[u] = W[(size_t)(kb + u) * N + n0 + col];
      _Pragma("unroll") for (int u = 0; u < 16; ++u) _Pragma("unroll") for (int v = 0; v < 9; ++v) a[v] += sv[v * 1024 + kb + u] * wv[u];
    }
    _Pragma("unroll") for (int v = 0; v < 9; ++v) red[(ks * 9 + v) * 32 + col] = a[v];
    __syncthreads();
    for (int idx = threadIdx.x; idx < 9 * 32; idx += NT_) {
      const int v = idx >> 5, cc = idx & 31;
      float sum = 0.f;
      _Pragma("unroll") for (int q = 0; q < 16; ++q) sum += red[(q * 9 + v) * 32 + cc];
      SHW[(size_t)((l - 1) * 9 + v) * 4096 + n0 + cc] = sum;
    }
  }
  __syncthreads();
}

DI void norm_phase(const float* lat, const float* ctx, const float* gn, const float* mod  , bf16_t* NB_) {
  const int tid_ = opaque_tid();
  const int lane = tid_ & 63;
  const int w0 = blockIdx.x * 8 + (tid_ >> 6), nw = gridDim.x * 8;
  for (int row0 = w0 * 2; row0 < R; row0 += nw * 2) {
    f32x4 v[2][4]; float ss[2] = {0.f, 0.f};
    const float* m[2];
    _Pragma("unroll") for (int q = 0; q < 2; ++q) {
      const int row = row0 + q;
      const float* src;
      if (row < RL) { src = lat + (size_t)row * 1024; m[q] = mod + (size_t)(row >> 11) * 3072; }
      else { src = ctx + (size_t)(row - RL) * 1024; m[q] = mod + (size_t)8 * 3072; }
      _Pragma("unroll") for (int i = 0; i < 4; ++i) v[q][i] = __builtin_nontemporal_load((const f32x4*)(src + (i * 64 + lane) * 4));
    }
    _Pragma("unroll") for (int q = 0; q < 2; ++q) {
      _Pragma("unroll") for (int i = 0; i < 4; ++i) ss[q] += v[q][i][0] * v[q][i][0] + v[q][i][1] * v[q][i][1] + v[q][i][2] * v[q][i][2] + v[q][i][3] * v[q][i][3];
      _Pragma("unroll") for (int o = 32; o >= 1; o >>= 1) ss[q] += __shfl_xor(ss[q], o);
    }
    _Pragma("unroll") for (int q = 0; q < 2; ++q) {
      const float rstd = rsqrtf(ss[q] * (1.f / 1024.f) + 1e-6f);
      _Pragma("unroll") for (int i = 0; i < 4; ++i) {
        const int k = (i * 64 + lane) * 4;
        const f32x4 g = *(const f32x4*)(gn + k), sh = *(const f32x4*)(m[q] + k), sc = *(const f32x4*)(m[q] + 1024 + k);
        u32x2 o;
        o[0] = pack2(v[q][i][0] * rstd * g[0] * (1.f + sc[0]) + sh[0], v[q][i][1] * rstd * g[1] * (1.f + sc[1]) + sh[1]);
        o[1] = pack2(v[q][i][2] * rstd * g[2] * (1.f + sc[2]) + sh[2], v[q][i][3] * rstd * g[3] * (1.f + sc[3]) + sh[3]);
        *(u32x2*)(NB_ + (size_t)(row0 + q) * 1024 + k) = o;
      }
    }
  }
}

DI void final_norm_phase(float* H, const float* gn) {
  const int tid_ = opaque_tid();
  const int lane = tid_ & 63;
  const int w0 = blockIdx.x * 8 + (tid_ >> 6), nw = gridDim.x * 8;
  for (int row0 = w0 * 2; row0 < RL; row0 += nw * 2) {
    f32x4 v[2][4]; float ss[2] = {0.f, 0.f};
    _Pragma("unroll") for (int q = 0; q < 2; ++q) _Pragma("unroll") for (int i = 0; i < 4; ++i) v[q][i] = __builtin_nontemporal_load((const f32x4*)(H + (size_t)(row0 + q) * 1024 + (i * 64 + lane) * 4));
    _Pragma("unroll") for (int q = 0; q < 2; ++q) {
      _Pragma("unroll") for (int i = 0; i < 4; ++i) ss[q] += v[q][i][0] * v[q][i][0] + v[q][i][1] * v[q][i][1] + v[q][i][2] * v[q][i][2] + v[q][i][3] * v[q][i][3];
      _Pragma("unroll") for (int o = 32; o >= 1; o >>= 1) ss[q] += __shfl_xor(ss[q], o);
    }
    _Pragma("unroll") for (int q = 0; q < 2; ++q) {
      const float rstd = rsqrtf(ss[q] * (1.f / 1024.f) + 1e-6f);
      _Pragma("unroll") for (int i = 0; i < 4; ++i) {
        const int k = (i * 64 + lane) * 4;
        const f32x4 g = *(const f32x4*)(gn + k);
        f32x4 o; o[0] = v[q][i][0] * rstd * g[0]; o[1] = v[q][i][1] * rstd * g[1]; o[2] = v[q][i][2] * rstd * g[2]; o[3] = v[q][i][3] * rstd * g[3];
        __builtin_nontemporal_store(o, (f32x4*)(H + (size_t)(row0 + q) * 1024 + k));
      }
    }
  }
}

DI void lru_phase(const Params& p, char* smem) {
  char* ws = p.ws;
  const int tid_ = opaque_tid();
  const int sub = tid_ >> 8;
  smem += sub * 36864;
  bf16_t* Wl = (bf16_t*)smem;
  bf16_t* Uc = Wl + 96 * 96;
  float* aggA = (float*)(Uc + 64 * 96);
  float* aggH = aggA + 16 * 48;
  const bf16_t* U0 = (const bf16_t*)(ws + O_U0);
  const bf16_t* G0 = (const bf16_t*)(ws + O_G0);
  const int tid = tid_ & 255, lane = tid & 63, w = tid >> 6, col = lane & 15, quad = lane >> 4;
  const int vbl = (gridDim.x % 8 == 0) ? (blockIdx.x & 7) * (gridDim.x >> 3) + (blockIdx.x >> 3) : blockIdx.x;
  for (int item = vbl; item < 256; item += gridDim.x) {
    const int half = item & 1, dir = sub, k = (item >> 1) & 15, b = item >> 5;
    bf16_t* ACT = (bf16_t*)(ws + O_ACT0);
    __syncthreads();
    {
      const u32x4* src = (const u32x4*)((const bf16_t*)(ws + O_WG) + ((size_t)(k * 2 + dir) * 192 + half * 96) * 96);
      u32x4* dst = (u32x4*)Wl;
      for (int i = tid; i < 96 * 96 / 8; i += 256) dst[i] = src[i];
      if (tid < 64) { u32x4 z; z[0] = z[1] = z[2] = z[3] = 0u; *(u32x4*)(Uc + tid * 96 + 88) = z; }
    }
    float ba[3], bx[3], sp8[3];
    _Pragma("unroll") for (int c = 0; c < 3; ++c) {
      const int ch = 48 * half + 16 * c + col;
      if (ch < 88) {
        ba[c] = p.in[11][dir * LW + k * 88 + ch]; bx[c] = p.in[13][dir * LW + k * 88 + ch];
        sp8[c] = 8.f * log1pf(expf(-p.in[14][dir * LW + k * 88 + ch]));
      } else { ba[c] = 0.f; bx[c] = 0.f; sp8[c] = 0.f; }
    }
    const int cp = tid % 44, run = tid / 44;
    float cw[4][2], cb2[2];
    _Pragma("unroll") for (int t = 0; t < 4; ++t) { cw[t][0] = p.in[8][t * LW + k * 88 + 2 * cp]; cw[t][1] = p.in[8][t * LW + k * 88 + 2 * cp + 1]; }
    cb2[0] = p.in[9][k * 88 + 2 * cp]; cb2[1] = p.in[9][k * 88 + 2 * cp + 1];
    float carry = 0.f;
    unsigned un[19]; unsigned unmask = 0u;
    auto tile_info = [&](int ti, int& rowbase, int& L, int& t0) {
      if (ti < 4) { rowbase = RL + b * 256; L = 256; t0 = (dir ? 3 - ti : ti) * 64; }
      else { rowbase = b * 2048; L = 2048; t0 = (dir ? 31 - (ti - 4) : (ti - 4)) * 64; }
    };
    auto prefetch = [&](int ti) {
      int rowbase, L, t0; tile_info(ti, rowbase, L, t0);
      const unsigned* ub = (const unsigned*)(U0 + (size_t)rowbase * LW + k * 88 + 2 * cp);
      const int tb = t0 + 16 * (run < 4 ? run : 3) - 2;
      unsigned vm = 0u;
      _Pragma("unroll") for (int i = 0; i < 19; ++i) {
        const int tt = tb + i;
        un[i] = ub[(unsigned)min(max(tt, 0), L - 1) * (unsigned)(LW / 2)];
        vm |= (tt >= 0 && tt < L) ? (1u << i) : 0u;
      }
      unmask = vm;
    };
    prefetch(0);
    for (int ti = 0; ti < 36; ++ti) {
      int rowbase, L, t0; tile_info(ti, rowbase, L, t0);
      if (tid < 176) {
        if (unmask != 0x7ffffu) { _Pragma("unroll") for (int i = 0; i < 19; ++i) un[i] = ((unmask >> i) & 1u) ? un[i] : 0u; }
        _Pragma("unroll") for (int t = 0; t < 16; ++t) {
          const float y0 = cb2[0] + cw[0][0] * bflo(un[t]) + cw[1][0] * bflo(un[t + 1]) + cw[2][0] * bflo(un[t + 2]) + cw[3][0] * bflo(un[t + 3]);
          const float y1 = cb2[1] + cw[0][1] * bfhi(un[t]) + cw[1][1] * bfhi(un[t + 1]) + cw[2][1] * bfhi(un[t + 2]) + cw[3][1] * bfhi(un[t + 3]);
          *(unsigned*)(Uc + (16 * run + t) * 96 + 2 * cp) = pack2(y0, y1);
        }
      }
      if (ti + 1 < 36) prefetch(ti + 1);
      bf16_t gv[3][4];
      _Pragma("unroll") for (int c = 0; c < 3; ++c) {
        const int ch = 48 * half + 16 * c + col;
        _Pragma("unroll") for (int j = 0; j < 4; ++j)
          gv[c][j] = G0[(unsigned)(rowbase + t0 + 16 * w + 4 * quad) * (unsigned)LW + (unsigned)(j * LW + k * 88 + min(ch, 87))];
      }
      const bool second = ti < 4 ? (ti >= 2) : (ti >= 20);
      const bool adjacent = (ti == 2) || (ti == 20);
      bf16_t pv[3][4];
      if (second && !adjacent) {
        _Pragma("unroll") for (int c = 0; c < 3; ++c) {
          const int ch = 48 * half + 16 * c + col;
          _Pragma("unroll") for (int j = 0; j < 4; ++j) pv[c][j] = ACT[(unsigned)(rowbase + t0 + 16 * w + 4 * quad) * (unsigned)LW + (unsigned)(j * LW + k * 88 + min(ch, 87))];
        }
      } else { _Pragma("unroll") for (int c = 0; c < 3; ++c) _Pragma("unroll") for (int j = 0; j < 4; ++j) pv[c][j] = (bf16_t)0; }
      __syncthreads();
      bf16x8 af[3];
      _Pragma("unroll") for (int ks = 0; ks < 3; ++ks) af[ks] = *(const bf16x8*)(Uc + (16 * w + col) * 96 + ks * 32 + quad * 8);
      float hl[3][4], ac[3][4];
      _Pragma("unroll") for (int c = 0; c < 3; ++c) {
        f32x4 gA = {0.f, 0.f, 0.f, 0.f}, gX = {0.f, 0.f, 0.f, 0.f};
        _Pragma("unroll") for (int ks = 0; ks < 3; ++ks) {
          const bf16x8 bA = *(const bf16x8*)(Wl + ((c * 2 + 0) * 16 + col) * 96 + ks * 32 + quad * 8);
          const bf16x8 bX = *(const bf16x8*)(Wl + ((c * 2 + 1) * 16 + col) * 96 + ks * 32 + quad * 8);
          gA = MFMA16(af[ks], bA, gA);
          gX = MFMA16(af[ks], bX, gX);
        }
        float a[4], bb[4];
        _Pragma("unroll") for (int j = 0; j < 4; ++j) {
          const float uval = bf2f(Uc[(16 * w + 4 * quad + j) * 96 + 48 * half + 16 * c + col]);
          const float rg = sigm(gA[j] + ba[c]), ig = sigm(gX[j] + bx[c]);
          a[j] = __expf(-sp8[c] * rg);
          bb[j] = __builtin_amdgcn_sqrtf(fmaxf(1.f - a[j] * a[j], 0.f)) * ig * uval;
        }
        if (dir == 0) {
          hl[c][0] = bb[0]; ac[c][0] = a[0];
          _Pragma("unroll") for (int j = 1; j < 4; ++j) { hl[c][j] = a[j] * hl[c][j - 1] + bb[j]; ac[c][j] = a[j] * ac[c][j - 1]; }
          aggA[(4 * w + quad) * 48 + 16 * c + col] = ac[c][3]; aggH[(4 * w + quad) * 48 + 16 * c + col] = hl[c][3];
        } else {
          hl[c][3] = bb[3]; ac[c][3] = a[3];
          _Pragma("unroll") for (int j = 2; j >= 0; --j) { hl[c][j] = a[j] * hl[c][j + 1] + bb[j]; ac[c][j] = a[j] * ac[c][j + 1]; }
          aggA[(4 * w + quad) * 48 + 16 * c + col] = ac[c][0]; aggH[(4 * w + quad) * 48 + 16 * c + col] = hl[c][0];
        }
      }
      asm volatile("s_waitcnt vmcnt(0)" ::: "memory");
      __syncthreads();
      if (adjacent) {
        _Pragma("unroll") for (int c = 0; c < 3; ++c) {
          const int ch = 48 * half + 16 * c + col;
          _Pragma("unroll") for (int j = 0; j < 4; ++j)
            pv[c][j] = ACT[(unsigned)(rowbase + t0 + 16 * w + 4 * quad) * (unsigned)LW + (unsigned)(j * LW + k * 88 + min(ch, 87))];
        }
      }
      if (tid < 48) {
        float A_[16], H_[16];
        _Pragma("unroll") for (int s_ = 0; s_ < 16; ++s_) { A_[s_] = aggA[s_ * 48 + tid]; H_[s_] = aggH[s_ * 48 + tid]; }
        float cin = carry;
        if (dir == 0) { _Pragma("unroll") for (int s_ = 0; s_ < 16; ++s_) { aggA[s_ * 48 + tid] = cin; cin = A_[s_] * cin + H_[s_]; } }
        else { _Pragma("unroll") for (int s_ = 15; s_ >= 0; --s_) { aggA[s_ * 48 + tid] = cin; cin = A_[s_] * cin + H_[s_]; } }
        carry = cin;
      }
      __syncthreads();
      _Pragma("unroll") for (int c = 0; c < 3; ++c) {
        const int ch = 48 * half + 16 * c + col;
        if (ch < 88) {
          const float cin = aggA[(4 * w + quad) * 48 + 16 * c + col];
          _Pragma("unroll") for (int j = 0; j < 4; ++j) {
            const unsigned idx = (unsigned)(rowbase + t0 + 16 * w + 4 * quad) * (unsigned)LW + (unsigned)(j * LW + k * 88 + ch);
            const float hv = hl[c][j] + ac[c][j] * cin;
            ACT[idx] = f2bf(hv * silu(bf2f(gv[c][j])) + bf2f(pv[c][j]));
          }
        }
      }

    }
  }
}

struct AttnSt { f32x16 O0, O1; float m, l; };
DI bf16x8 ld16(const bf16_t* p) { return *(const bf16x8*)p; }
DI bf16x8 ld8x2(const bf16_t* p0) { const s16x4 a = *(const s16x4*)p0; const s16x4 b = *(const s16x4*)(p0 + 8); return __builtin_shufflevector(a, b, 0, 1, 2, 3, 4, 5, 6, 7); }
DI bf16x8 pack8(const f32x16& P, int s) {
  u32x4 u;
  _Pragma("unroll") for (int j = 0; j < 4; ++j) u[j] = pack2(P[8 * s + 2 * j], P[8 * s + 2 * j + 1]);
  return __builtin_bit_cast(bf16x8, u);
}

struct KVt { bf16x8 k0, k1, k2, k3, v00, v01, v10, v11; };
DI void attn_load(KVt& t, const bf16_t* kt_, const bf16_t* vt_) {
  t.k0 = ld16(kt_); t.k1 = ld16(kt_ + 512); t.k2 = ld16(kt_ + 1024); t.k3 = ld16(kt_ + 1536);
  t.v00 = ld16(vt_); t.v01 = ld16(vt_ + 512); t.v10 = ld16(vt_ + 1024); t.v11 = ld16(vt_ + 1536);
}
template <class F>
DI void attn_compute(AttnSt& st, const bf16x8 (&qf)[4], const KVt& t, F fmod) {
  f32x16 S = zero16();
  S = MFMA32(t.k0, qf[0], S); S = MFMA32(t.k1, qf[1], S); S = MFMA32(t.k2, qf[2], S); S = MFMA32(t.k3, qf[3], S);
  float mx = -3.0e38f;
  _Pragma("unroll") for (int i = 0; i < 16; ++i) { S[i] = fmod(i, S[i]); mx = fmaxf(mx, S[i]); }
  mx = fmaxf(mx, __shfl_xor(mx, 32));
  const float mn = fmaxf(st.m, mx);
  float ls = 0.f;
  f32x16 P;
  _Pragma("unroll") for (int i = 0; i < 16; ++i) { P[i] = __builtin_amdgcn_exp2f(S[i] - mn); ls += P[i]; }
  if (__builtin_amdgcn_ballot_w64(mn > st.m) != 0ull) {
    const float alpha = __builtin_amdgcn_exp2f(st.m - mn);
    st.m = mn;
    st.l *= alpha;
    _Pragma("unroll") for (int i = 0; i < 16; ++i) { st.O0[i] *= alpha; st.O1[i] *= alpha; }
  }
  st.l += ls;
  const bf16x8 p0 = pack8(P, 0), p1 = pack8(P, 1);
  st.O0 = MFMA32(t.v00, p0, st.O0); st.O0 = MFMA32(t.v01, p1, st.O0);
  st.O1 = MFMA32(t.v10, p0, st.O1); st.O1 = MFMA32(t.v11, p1, st.O1);
}

struct GPre { u32x2 g0[4], g1[4]; };
DI void attn_gload(GPre& gp, const bf16_t* Grow  , int h) {
  _Pragma("unroll") for (int q = 0; q < 4; ++q) { gp.g0[q] = *(const u32x2*)(Grow + 8 * q + 4 * h); gp.g1[q] = *(const u32x2*)(Grow + 32 + 8 * q + 4 * h); }
}
DI void attn_finish(AttnSt& st, const GPre& gp, bf16_t* Arow  , int h) {
  const float lt = st.l + __shfl_xor(st.l, 32);
  const float inv = frcp(lt);
  unsigned w0[4][2], w1[4][2];
  _Pragma("unroll") for (int q = 0; q < 4; ++q) {
    const u32x2 g0 = gp.g0[q], g1 = gp.g1[q];
    w0[q][0] = pack2(st.O0[4 * q + 0] * inv * silu(bflo(g0[0])), st.O0[4 * q + 1] * inv * silu(bfhi(g0[0])));
    w0[q][1] = pack2(st.O0[4 * q + 2] * inv * silu(bflo(g0[1])), st.O0[4 * q + 3] * inv * silu(bfhi(g0[1])));
    w1[q][0] = pack2(st.O1[4 * q + 0] * inv * silu(bflo(g1[0])), st.O1[4 * q + 1] * inv * silu(bfhi(g1[0])));
    w1[q][1] = pack2(st.O1[4 * q + 2] * inv * silu(bflo(g1[1])), st.O1[4 * q + 3] * inv * silu(bfhi(g1[1])));
  }
  _Pragma("unroll") for (int qp = 0; qp < 2; ++qp) {
    const int q = 2 * qp;
    {
      const auto s0 = __builtin_amdgcn_permlane32_swap(w0[q][0], w0[q + 1][0], false, false);
      const auto s1 = __builtin_amdgcn_permlane32_swap(w0[q][1], w0[q + 1][1], false, false);
      u32x4 o; o[0] = s0[0]; o[1] = s1[0]; o[2] = s0[1]; o[3] = s1[1];
      *(u32x4*)(Arow + 8 * q + 8 * h) = o;
    }
    {
      const auto s0 = __builtin_amdgcn_permlane32_swap(w1[q][0], w1[q + 1][0], false, false);
      const auto s1 = __builtin_amdgcn_permlane32_swap(w1[q][1], w1[q + 1][1], false, false);
      u32x4 o; o[0] = s0[0]; o[1] = s1[0]; o[2] = s0[1]; o[3] = s1[1];
      *(u32x4*)(Arow + 32 + 8 * q + 8 * h) = o;
    }
  }
}

DI void swa_phase(const Params& p) {
  char* ws = p.ws;
  const bf16_t* Q = (const bf16_t*)(ws + O_Q1); const bf16_t* QR = (const bf16_t*)(ws + O_QR1); const bf16_t* Kb = (const bf16_t*)(ws + O_K1);
  const bf16_t* VtL = (const bf16_t*)(ws + O_VTL1); const bf16_t* VtC = (const bf16_t*)(ws + O_VTC1);
  const bf16_t* G = (const bf16_t*)(ws + O_G1); bf16_t* ACT = (bf16_t*)(ws + O_ACT1);
  const float* sink = p.in[20];
  const int tid_ = opaque_tid();
  const int lane = tid_ & 63, r = lane & 31, h = lane >> 5;
  const int vb_ = (gridDim.x % 8 == 0) ? (blockIdx.x & 7) * (gridDim.x >> 3) + (blockIdx.x >> 3) : blockIdx.x;
  const int wid = vb_ * 8 + (tid_ >> 6), nw = gridDim.x * 8;
  auto ident = [](int, float s) { return s; };
  auto do_item = [&](int it) {
    int b, kvh, g4, qt; const bool lat = it < 8192;
    if (lat) { g4 = it & 3; qt = (it >> 2) & 63; kvh = (it >> 8) & 3; b = it >> 10; }
    else { const int j = it - 8192; g4 = j & 3; qt = (j >> 2) & 7; kvh = (j >> 5) & 3; b = j >> 7; }
    const int head = kvh * 4 + g4;
    const size_t qrow = lat ? (size_t)b * 2048 + qt * 32 + r : (size_t)RL + b * 256 + qt * 32 + r;
    AttnSt st; st.O0 = zero16(); st.O1 = zero16(); st.m = sink[head] * 1.4426950408889634f; st.l = h == 0 ? 1.f : 0.f;
    bf16x8 qf[4], qfr[4];
    _Pragma("unroll") for (int ks = 0; ks < 4; ++ks) qf[ks] = ld16(Q + qrow * 1024 + head * 64 + ks * 16 + 8 * h);
    GPre gp; attn_gload(gp, G + qrow * 1024 + head * 64, h);
    if (lat) { _Pragma("unroll") for (int ks = 0; ks < 4; ++ks) qfr[ks] = ld16(QR + qrow * 1024 + head * 64 + ks * 16 + 8 * h); }
    else { _Pragma("unroll") for (int ks = 0; ks < 4; ++ks) qfr[ks] = qf[ks]; }
    const bf16_t* kc = Kb + (size_t)RL * 256 + (size_t)(b * 4 + kvh) * 8 * 2048 + lane * 8;
    const bf16_t* vc = VtC + (size_t)(b * 4 + kvh) * 8 * 2048 + lane * 8;
    const bf16_t* kl = Kb + (size_t)(b * 4 + kvh) * 64 * 2048 + lane * 8;
    const bf16_t* vl = VtL + (size_t)(b * 4 + kvh) * 64 * 2048 + lane * 8;
    const int kt_lo = max(qt - 4, 0), kt_hi = min(qt + 4, 63);
    const int nt = lat ? 8 + (kt_hi - kt_lo + 1) : 8;
    auto load_tile = [&](int j, KVt& t) {
      if (j < 8) attn_load(t, kc + (size_t)j * 2048, vc + (size_t)j * 2048);
      else { const int kt = kt_lo + j - 8; attn_load(t, kl + (size_t)kt * 2048, vl + (size_t)kt * 2048); }
    };
    KVt cur, nxt;
    load_tile(0, cur);
    for (int j = 0; j < 8; ++j) {
      nxt = cur;
      if (j + 1 < nt) load_tile(j + 1, nxt);
      attn_compute(st, qf, cur, ident);
      cur = nxt;
    }
    for (int j = 8; j < nt; ++j) {
      nxt = cur;
      if (j + 1 < nt) load_tile(j + 1, nxt);
      const int kt = kt_lo + j - 8;
      if (kt == qt - 4 || kt == qt + 4) {
        const int dq = qt * 32 + r - kt * 32;
        attn_compute(st, qfr, cur, [&](int i, float s) { const int d = dq - crow(i, h); return (d <= 128 && d >= -128) ? s : -1.0e30f; });
      } else attn_compute(st, qfr, cur, ident);
      cur = nxt;
    }
    attn_finish(st, gp, ACT + qrow * 1024 + head * 64, h);
  };
  for (int it = wid; it < 8192; it += nw) do_item(it);
  if (nw == 2048) {
    if ((wid & 7) < 4) do_item(8192 + (wid >> 3) * 4 + (wid & 3));
  } else { for (int it = 8192 + wid; it < 8192 + 1024; it += nw) do_item(it); }
}

DI void na_phase(const Params& p, char* smem) {
  char* ws = p.ws;
  const bf16_t* Q = (const bf16_t*)(ws + O_Q2); const bf16_t* Kb = (const bf16_t*)(ws + O_K2);
  const bf16_t* VtL = (const bf16_t*)(ws + O_VTL2); const bf16_t* VtC = (const bf16_t*)(ws + O_VTC2);
  const bf16_t* G = (const bf16_t*)(ws + O_G2); bf16_t* ACT = (bf16_t*)(ws + O_ACT2);
  float* rpbs = (float*)smem + 64;
  __syncthreads();
  for (int i = threadIdx.x; i < 16 * 15 * 31; i += blockDim.x) rpbs[i] = p.in[26][i] * 1.4426950408889634f;
  __syncthreads();
  const int tid_ = opaque_tid();
  const int lane = tid_ & 63, r = lane & 31, h = lane >> 5;
  const int vb_ = (gridDim.x % 8 == 0) ? (blockIdx.x & 7) * (gridDim.x >> 3) + (blockIdx.x >> 3) : blockIdx.x;
  const int wid = vb_ * 8 + (tid_ >> 6), nw = gridDim.x * 8;
  auto ident = [](int, float s) { return s; };
  auto do_item = [&](int it) {
    int b, head, half, gr; const bool lat = it < 8192;
    if (lat) { half = it & 1; head = (it >> 1) & 15; gr = (it >> 5) & 31; b = it >> 10; }
    else { const int j = it - 8192; half = 0; head = j & 15; gr = (j >> 4) & 7; b = j >> 7; }
    const size_t qrow = lat ? (size_t)b * 2048 + gr * 64 + half * 32 + r : (size_t)RL + b * 256 + gr * 32 + r;
    AttnSt st; st.O0 = zero16(); st.O1 = zero16(); st.m = -1.0e30f; st.l = 0.f;
    bf16x8 qf[4];
    _Pragma("unroll") for (int ks = 0; ks < 4; ++ks) qf[ks] = ld16(Q + qrow * 1024 + head * 64 + ks * 16 + 8 * h);
    GPre gp; attn_gload(gp, G + qrow * 1024 + head * 64, h);
    const bf16_t* kc = Kb + (size_t)RL * 1024 + (size_t)(b * 16 + head) * 8 * 2048 + lane * 8;
    const bf16_t* vc = VtC + (size_t)(b * 16 + head) * 8 * 2048 + lane * 8;
    const bf16_t* kl = Kb + (size_t)(b * 16 + head) * 64 * 2048 + lane * 8;
    const bf16_t* vl = VtL + (size_t)(b * 16 + head) * 64 * 2048 + lane * 8;
    const int cq = half * 32 + r;
    const int cs = min(max(cq - 8, 0), 48);
    const int rs_ = min(max(gr - 4, 0), 24);
    const int nt = lat ? 24 : 8;
    auto load_tile = [&](int j, KVt& t) {
      if (j < 8) attn_load(t, kc + (size_t)j * 2048, vc + (size_t)j * 2048);
      else { const int kt = (rs_ + ((j - 8) >> 1)) * 2 + ((j - 8) & 1); attn_load(t, kl + (size_t)kt * 2048, vl + (size_t)kt * 2048); }
    };
    KVt cur, nxt;
    load_tile(0, cur);
    for (int j = 0; j < 8; ++j) {
      nxt = cur;
      if (j + 1 < nt) load_tile(j + 1, nxt);
      attn_compute(st, qf, cur, ident);
      cur = nxt;
    }
    unsigned okm[2] = {0u, 0u};
    _Pragma("unroll") for (int ct = 0; ct < 2; ++ct) _Pragma("unroll") for (int i = 0; i < 16; ++i) {
      const int ck = ct * 32 + crow(i, h);
      okm[ct] |= ((ck >= cs) && (ck < cs + 16)) ? (1u << i) : 0u;
    }
    const int dxb = 4 * h - cq + 15;
    for (int j = 8; j < nt; j += 2) {
      const int krow = rs_ + ((j - 8) >> 1);
      const float* rp = rpbs + (head * 15 + (krow - gr + 7)) * 31 + dxb;
      nxt = cur;
      load_tile(j + 1, nxt);
      attn_compute(st, qf, cur, [&](int i, float s) { const float sb = s + rp[(i & 3) + 8 * (i >> 2)]; return ((okm[0] >> i) & 1u) ? sb : -1.0e30f; });
      cur = nxt;
      if (j + 2 < nt) load_tile(j + 2, nxt);
      attn_compute(st, qf, cur, [&](int i, float s) { const float sb = s + rp[32 + (i & 3) + 8 * (i >> 2)]; return ((okm[1] >> i) & 1u) ? sb : -1.0e30f; });
      cur = nxt;
    }
    attn_finish(st, gp, ACT + qrow * 1024 + head * 64, h);
  };
  for (int it = wid; it < 8192; it += nw) do_item(it);
  if (nw == 2048) {
    if ((wid & 7) < 4) do_item(8192 + (wid >> 3) * 4 + (wid & 3));
  } else { for (int it = 8192 + wid; it < 8192 + 1024; it += nw) do_item(it); }
}

DI void s5_mats_phase(const Params& p, int which, int first_blk) {
  if ((int)blockIdx.x < first_blk) return;
  char* ws = p.ws;
  const float2* POW = (const float2*)(ws + O_POW); const float2* BB = (const float2*)(ws + O_BBAR);
  bf16_t* GT = (bf16_t*)(ws + O_GT); bf16_t* MYT = (bf16_t*)(ws + O_MYT);
  const float* cre = p.in[37]; const float* cim = p.in[38]; const float* dsk = p.in[39];
  const int gt = ((int)blockIdx.x - first_blk) * blockDim.x + threadIdx.x, gn = ((int)gridDim.x - first_blk) * blockDim.x;
  if (which == 2) {
    for (int idx0 = gt; idx0 < 64 * 256 * 256; idx0 += 4 * gn) {
      float2 pw1[4], bb1[4];
      _Pragma("unroll") for (int u = 0; u < 4; ++u) {
        const int idx = min(idx0 + u * gn, 64 * 256 * 256 - 1);
        const int g = idx >> 16, n = (idx >> 8) & 255, k = idx & 255;
        const int dir = n >> 7, pp = (n >> 1) & 63, i = k >> 4, c = k & 15, e = dir ? i : 15 - i;
        pw1[u] = POW[((size_t)(dir * 64 + g) * 17 + e) * 64 + pp]; bb1[u] = BB[((size_t)(dir * 64 + g) * 64 + pp) * 16 + c];
      }
      _Pragma("unroll") for (int u = 0; u < 4; ++u) {
        const int idx = idx0 + u * gn;
        if (idx < 64 * 256 * 256) {
          const float zr = pw1[u].x * bb1[u].x - pw1[u].y * bb1[u].y, zi = pw1[u].x * bb1[u].y + pw1[u].y * bb1[u].x;
          GT[idx] = f2bf(((idx >> 8) & 1) ? zi : zr);
        }
      }
    }
    return;
  }
  for (int idx0 = gt; idx0 < 64 * 256 * 256; idx0 += 4 * gn) {
    float2 pw2[4]; float cr[4], cm[4];
    _Pragma("unroll") for (int u = 0; u < 4; ++u) {
      const int idx = min(idx0 + u * gn, 64 * 256 * 256 - 1);
      const int g = idx >> 16, n = (idx >> 8) & 255, k = idx & 255;
      const int j = n >> 4, o = n & 15, dir = k >> 7, pp = (k >> 1) & 63, e = dir ? 16 - j : j + 1;
      pw2[u] = POW[((size_t)(dir * 64 + g) * 17 + e) * 64 + pp];
      const size_t ci = ((size_t)(dir * 64 + g) * 16 + o) * 64 + pp; cr[u] = cre[ci]; cm[u] = cim[ci];
    }
    _Pragma("unroll") for (int u = 0; u < 4; ++u) {
      const int idx = idx0 + u * gn;
      if (idx < 64 * 256 * 256) {
        const int g = idx >> 16, n = (idx >> 8) & 255, k = idx & 255;
        const float zr = cr[u] * pw2[u].x - cm[u] * pw2[u].y, zi = cr[u] * pw2[u].y + cm[u] * pw2[u].x;
        MYT[((size_t)g * 256 + n) * 512 + 256 + k] = f2bf((k & 1) ? -zi : zr);
      }
    }
  }
  for (int idx = gt; idx < 64 * 16 * 256; idx += gn) {
    const int g = idx >> 12, lag = (idx >> 8) & 15, o = (idx >> 4) & 15, c = idx & 15;
    float kf = 0.f, kb = 0.f;
    _Pragma("unroll 8") for (int pp = 0; pp < 64; ++pp) {
      {
        const float2 pw = POW[((size_t)(0 * 64 + g) * 17 + lag) * 64 + pp];
        const float2 bb = BB[((size_t)(0 * 64 + g) * 64 + pp) * 16 + c];
        const size_t ci = ((size_t)(0 * 64 + g) * 16 + o) * 64 + pp;
        const float zr = pw.x * bb.x - pw.y * bb.y, zi = pw.x * bb.y + pw.y * bb.x;
        kf += cre[ci] * zr - cim[ci] * zi;
      }
      {
        const float2 pw = POW[((size_t)(1 * 64 + g) * 17 + lag) * 64 + pp];
        const float2 bb = BB[((size_t)(1 * 64 + g) * 64 + pp) * 16 + c];
        const size_t ci = ((size_t)(1 * 64 + g) * 16 + o) * 64 + pp;
        const float zr = pw.x * bb.x - pw.y * bb.y, zi = pw.x * bb.y + pw.y * bb.x;
        kb += cre[ci] * zr - cim[ci] * zi;
      }
    }
    bf16_t* Mg = MYT + (size_t)g * 256 * 512;
    if (lag == 0) {
      const bf16_t v = f2bf(kf + kb + (o == c ? dsk[g * 16 + o] : 0.f));
      for (int j = 0; j < 16; ++j) Mg[(size_t)(j * 16 + o) * 512 + j * 16 + c] = v;
    } else {
      const bf16_t vf = f2bf(kf), vb = f2bf(kb);
      for (int i = 0; i + lag < 16; ++i) {
        Mg[(size_t)((i + lag) * 16 + o) * 512 + i * 16 + c] = vf;
        Mg[(size_t)(i * 16 + o) * 512 + (i + lag) * 16 + c] = vb;
      }
    }
  }
}

DI void s5_scan_one(const Params& p, int b, int g, int dir, int pp) {
  char* ws = p.ws;
  const float2* POW = (const float2*)(ws + O_POW);
  const float* SL = (const float*)(ws + O_SLOC);
  bf16_t* ACAT = (bf16_t*)(ws + O_ACAT);
  const float2 lam = POW[((size_t)(dir * 64 + g) * 17 + 16) * 64 + pp];
  float hr = 0.f, hi = 0.f;
  auto chunk_of = [&](int q) { return q < 16 ? (1024 + b * 16 + (dir ? 15 - q : q)) : (b * 128 + (dir ? 127 - (q - 16) : (q - 16))); };
  auto loadb = [&](int q0, float2 (&sx)[16]) {
    _Pragma("unroll") for (int j = 0; j < 16; ++j) sx[j] = *(const float2*)(SL + ((size_t)g * NCHP + chunk_of(q0 + j)) * 256 + dir * 128 + 2 * pp);
  };
  auto procb = [&](int q0, const float2 (&sx)[16]) {
    _Pragma("unroll") for (int j = 0; j < 16; ++j) {
      *(unsigned*)(ACAT + ((size_t)g * NCH + chunk_of(q0 + j)) * 512 + 256 + dir * 128 + 2 * pp) = pack2(hr, hi);
      const float nr = lam.x * hr - lam.y * hi + sx[j].x, ni = lam.x * hi + lam.y * hr + sx[j].y;
      hr = nr; hi = ni;
    }
  };
  float2 sA[16], sB[16];
  loadb(0, sA);
  for (int q0 = 0; q0 < 144; q0 += 32) {
    if (q0 + 16 < 144) loadb(q0 + 16, sB);
    procb(q0, sA);
    if (q0 + 16 >= 144) break;
    if (q0 + 32 < 144) loadb(q0 + 32, sA);
    procb(q0 + 16, sB);
  }
}
DI void s5_scan_phase(const Params& p) {
  for (int gid = blockIdx.x * blockDim.x + threadIdx.x; gid < 65536; gid += gridDim.x * blockDim.x)
    s5_scan_one(p, gid >> 13, (gid >> 6) & 63, (gid >> 12) & 1, gid & 63);
}

#define XB_TMO      128
#define XB_XCNT(j)  (256  + 64 * (j))
#define XB_XSUB(j)  (1280 + 64 * (j))
#define XB_XGEN(j)  (2304 + 64 * (j))
#define XB_TOP      3328
#define XB_TOPGEN   3392
#define XCD_BAR_WORDS 3456
#define XB_SPIN_CAP (1u << 18)
#define LAS __attribute__((address_space(3)))
DI unsigned xb_ld(unsigned* p)              { return __hip_atomic_load(p, __ATOMIC_RELAXED, __HIP_MEMORY_SCOPE_AGENT); }
DI unsigned xb_add(unsigned* p, unsigned v) { return __hip_atomic_fetch_add(p, v, __ATOMIC_RELAXED, __HIP_MEMORY_SCOPE_AGENT); }
DI unsigned xb_xcc_id() { return (unsigned)__builtin_amdgcn_s_getreg((3 << 11) | 20) & 0xFu; }
#define XB_SPIN(cond, bar) do { unsigned _sp = 0; while (cond) { __builtin_amdgcn_s_sleep(1); \
    if ((++_sp & 255u) == 0u) { if (xb_ld(&(bar)[XB_TMO])) break; if (_sp > XB_SPIN_CAP) { atomicAdd(&(bar)[XB_TMO], 1u); break; } } } } while (0)
struct XcdBarrier { unsigned* bar; unsigned x; volatile LAS unsigned* st; };
DI XcdBarrier xcd_barrier_post(unsigned* bar, volatile LAS unsigned* st) {
    XcdBarrier b; b.bar = bar; b.x = xb_xcc_id(); b.st = st;
    if (threadIdx.x == 0) (void)xb_add(&bar[XB_XCNT(b.x)], 1u);
    return b;
}
DI void xcd_barrier_complete(unsigned* bar, unsigned x, unsigned& nloc, unsigned& nx) {
    const unsigned G = gridDim.x * gridDim.y * gridDim.z;
    unsigned sum, cnt, mine, sp = 0u;
    for (;;) {
        sum = 0u; cnt = 0u; mine = 0u;
#pragma unroll
        for (unsigned j = 0; j < 16; ++j) { const unsigned c = xb_ld(&bar[XB_XCNT(j)]); sum += c; cnt += (c > 0u) ? 1u : 0u; mine = (j == x) ? c : mine; }
        if (sum == G) break;
        __builtin_amdgcn_s_sleep(1);
        if ((++sp & 255u) == 0u) { if (xb_ld(&bar[XB_TMO])) break; if (sp > XB_SPIN_CAP) { atomicAdd(&bar[XB_TMO], 1u); break; } }
    }
    nloc = mine > 0u ? mine : 1u; nx = cnt > 0u ? cnt : 1u;
}
DI void xcd_barrier(const XcdBarrier& b) {
    asm volatile("s_waitcnt vmcnt(0)" ::: "memory");
    __syncthreads();
    if (threadIdx.x == 0) {
        unsigned* bar = b.bar;
        __builtin_amdgcn_s_waitcnt(0);
        unsigned nloc = b.st[0], nx = b.st[1];
        if (nloc == 0u) { xcd_barrier_complete(bar, b.x, nloc, nx); b.st[0] = nloc; b.st[1] = nx; }
        const unsigned old = xb_add(&bar[XB_XSUB(b.x)], 1u);
        const unsigned gen = old / nloc;
        if (old + 1u == (gen + 1u) * nloc) {
            __builtin_amdgcn_fence(__ATOMIC_RELEASE, "agent");
            asm volatile("s_waitcnt vmcnt(0)" ::: "memory");
            const unsigned og = xb_add(&bar[XB_TOP], 1u);
            const unsigned tg = og / nx;
            if (og + 1u == (tg + 1u) * nx) xb_add(&bar[XB_TOPGEN], 1u);
            else XB_SPIN(xb_ld(&bar[XB_TOPGEN]) == tg, bar);
            __builtin_amdgcn_fence(__ATOMIC_ACQUIRE, "agent");
            xb_add(&bar[XB_XGEN(b.x)], 1u);
            asm volatile("s_waitcnt vmcnt(0)" ::: "memory");
        } else {
            XB_SPIN(xb_ld(&bar[XB_XGEN(b.x)]) == gen, bar);
            __builtin_amdgcn_fence(__ATOMIC_ACQUIRE, "agent");
            asm volatile("s_waitcnt vmcnt(0)" ::: "memory");
        }
    }
    __syncthreads();
}

#define RP_GIN 1
#define RP_OUT0 1
#define RP_LRU 1
#define RP_SWA 1
#define RP_NA 1
#define RP_S5 1
#define RP_NORM 1
#define RP_GLU 1
#define RP_SYNC 0
#define REPEAT(n) for (int rep_ = 0; rep_ < (n); ++rep_)
constexpr int LDS_BYTES = 147456;

__global__ void __launch_bounds__(512, 2) fwd_megakernel(Params p) {
  extern __shared__ __attribute__((aligned(16))) unsigned char lds_raw[];
  LAS unsigned char* lds = (LAS unsigned char*)lds_raw;
  char* smem = (char*)lds_raw;
  cg::grid_group grid = cg::this_grid();
  char* ws = p.ws;
  volatile LAS unsigned* xst = (volatile LAS unsigned*)(lds + 131072 + 256);
  if (threadIdx.x == 0) { xst[0] = 0u; xst[1] = 0u; }
  __syncthreads();
  XcdBarrier xb = xcd_barrier_post((unsigned*)(ws + O_BAR), xst);
#define GSYNC() xcd_barrier(xb)
  float* MOD = (float*)(ws + O_MOD);
  float* HCTX = (float*)(ws + O_HCTX);
  const bf16_t* NBUF = (const bf16_t*)(ws + O_NBUF);
  using pg8::Gemm;

  phase0(p, smem);
  GSYNC();
  if (p.out == nullptr) grid.sync();
  float* SS = (float*)(ws + O_SS);
  const float* GS = (const float*)(ws + O_GS);
  const float* SHW = (const float*)(ws + O_SHW);
  bf16_t* NBW = (bf16_t*)(ws + O_NBUF);
  norm_phase(p.in[0], p.in[2], p.in[6], MOD, (bf16_t*)(ws + O_NBUF0));
  GSYNC();
  {
    EpiL0In e{(bf16_t*)(ws + O_U0), (bf16_t*)(ws + O_G0)};
    Gemm g{(const bf16_t*)(ws + O_NBUF0), (const bf16_t*)(ws + O_WT_IN0), 1024, 1024, 1024, 72, 11, 1, 0, 0, 0};
    pg8::gemm_phase(lds, g, e);
  }
  modfold_phase(p, smem);
  tables_phase(p, gridDim.x == 256 ? 24 : 0);
  if (gridDim.x == 256) transpose_range(p, smem, 16 * 44, 16 * 44 + 22 * 16 + 16 * 40 + 256, 24, 0);
  else transpose_range(p, smem, 16 * 44, 16 * 44 + 22 * 16 + 16 * 40 + 256, 0, 0);
  GSYNC();
  lru_phase(p, smem);
  GSYNC();
  {
    EpiOut<true> e{p.in[0], p.in[2], p.out, HCTX, MOD + 2048, GS, NBW, SS};
    Gemm g{(const bf16_t*)(ws + O_ACT0), (const bf16_t*)(ws + O_WT_OUT0), LW, LW, LW, 72, 4, 1, 0, 0, 0};
    pg8::gemm_phase(lds, g, e);
  }
  {
    constexpr int J0 = 16 * 44 + 22 * 16 + 16 * 40 + 256, J1 = J0 + 16 * 64 + 256 + 16 * 32 + 256 + 256;
    transpose_range(p, smem, J0, J1, gridDim.x == 256 ? 32 : 0, 0);
  }
  GSYNC();
  {
    EpiL1 e{(bf16_t*)(ws + O_Q1), (bf16_t*)(ws + O_QR1), (bf16_t*)(ws + O_K1), (bf16_t*)(ws + O_G1), (const float*)(ws + O_ROPEC), (const float*)(ws + O_ROPES), SS, SHW};
    Gemm g{NBUF, (const bf16_t*)(ws + O_WT_IN1), 1024, 1024, 1024, 72, 9, 1, 0, 0, 0};
    pg8::gemm_phase(lds, g, e);
    EpiV<4, 1280> ev{(bf16_t*)(ws + O_VTL1), (bf16_t*)(ws + O_VTC1), SS, SHW};
    Gemm gv{(const bf16_t*)(ws + O_WT_IN1) + (size_t)2304 * 1024, NBUF, 1024, 1024, 1024, 1, 72, 1, 0, 0, 256 - 136};
    pg8::gemm_phase(lds, gv, ev);
  }
  GSYNC();
  swa_phase(p);
  GSYNC();
  {
    EpiOut<true> e{p.out, HCTX, p.out, HCTX, MOD + 9 * 3072 + 2048, GS + 9 * 1024, NBW, SS + R};
    Gemm g{(const bf16_t*)(ws + O_ACT1), (const bf16_t*)(ws + O_WT_OUT1), 1024, 1024, 1024, 72, 4, 1, 0, 0, 0};
    pg8::gemm_phase(lds, g, e);
  }
  s5_mats_phase(p, 1, gridDim.x == 256 ? 32 : 0);
  GSYNC();
  {
    EpiL2 e{(bf16_t*)(ws + O_Q2), (bf16_t*)(ws + O_K2), (bf16_t*)(ws + O_G2), SS + R, SHW + 9 * 4096};
    Gemm g{NBUF, (const bf16_t*)(ws + O_WT_IN2), 1024, 1024, 1024, 72, 12, 1, 0, 0, 0};
    pg8::gemm_phase(lds, g, e);
    EpiV<16, 2048> ev{(bf16_t*)(ws + O_VTL2), (bf16_t*)(ws + O_VTC2), SS + R, SHW + 9 * 4096};
    Gemm gv{(const bf16_t*)(ws + O_WT_IN2) + (size_t)3072 * 1024, NBUF, 1024, 1024, 1024, 4, 72, 1, 0, 0, 256 - 96};
    pg8::gemm_phase(lds, gv, ev);
  }
  GSYNC();
  na_phase(p, smem);
  GSYNC();
  {
    EpiOut<true> e{p.out, HCTX, p.out, HCTX, MOD + 2 * 9 * 3072 + 2048, GS + 2 * 9 * 1024, NBW, SS + 2 * R};
    Gemm g{(const bf16_t*)(ws + O_ACT2), (const bf16_t*)(ws + O_WT_OUT2), 1024, 1024, 1024, 72, 4, 1, 0, 0, 0};
    pg8::gemm_phase(lds, g, e);
  }
  s5_mats_phase(p, 2, gridDim.x == 256 ? 32 : 0);
  GSYNC();
  {
    EpiL3In e{(bf16_t*)(ws + O_ACAT), (bf16_t*)(ws + O_G3), SS + 2 * R, SHW + 2 * 9 * 4096};
    Gemm g{NBUF, (const bf16_t*)(ws + O_WT_IN3), 1024, 1024, 1024, 72, 8, 1, 0, 0, 0};
    pg8::gemm_phase(lds, g, e);
  }
  GSYNC();
  {
    EpiS5State e{(float*)(ws + O_SLOC)};
    Gemm g{(const bf16_t*)(ws + O_ACAT), (const bf16_t*)(ws + O_GT), 512, 256, 256, 5, 1, 64, NCH * 512, 256 * 256, 0};
    pg8::gemm_phase(lds, g, e);
  }
  GSYNC();
  {
    EpiS5Y e{(bf16_t*)(ws + O_YG)};
    Gemm g{(const bf16_t*)(ws + O_ACAT), (const bf16_t*)(ws + O_MYT), 512, 512, 512, 4, 1, 64, NCH * 512, 256 * 512, 0};
    if (gridDim.x == 256) {
      pg8::Unit u;
      if (pg8::next_unit(g, 0, u)) {
        const int t_ = opaque_tid();
        if (t_ < 256) s5_scan_one(p, 2 * u.pm + (t_ >> 7), u.pb, (t_ >> 6) & 1, t_ & 63);
      }
      asm volatile("s_waitcnt vmcnt(0)" ::: "memory");
      __syncthreads();
    } else {
      s5_scan_phase(p);
      GSYNC();
    }
    pg8::gemm_phase(lds, g, e);
  }
  GSYNC();
  {
    EpiGlu e{(const bf16_t*)(ws + O_YG), (const bf16_t*)(ws + O_G3), p.in[41], (bf16_t*)(ws + O_ACT3)};
    Gemm g{(const bf16_t*)(ws + O_YG), (const bf16_t*)(ws + O_WT_GLU), 1024, 1024, 1024, 64, 4, 1, 0, 0, 0};
    pg8::gemm_phase(lds, g, e);
  }
  GSYNC();
  {
    EpiOut<false> e{p.out, HCTX, p.out, HCTX, MOD + 3 * 9 * 3072 + 2048, nullptr, nullptr, nullptr};
    Gemm g{(const bf16_t*)(ws + O_ACT3), (const bf16_t*)(ws + O_WT_OUT3), 1024, 1024, 1024, 64, 4, 1, 0, 0, 0};
    pg8::gemm_phase(lds, g, e);
  }
  GSYNC();
  final_norm_phase(p.out, p.in[43]);
}

extern "C" void kernel_launch(void* const* d_in, const int* in_sizes, int n_in, void* d_out, int out_size, void* d_ws, size_t ws_size,
                              hipStream_t stream) {
  static int grid_blocks = 0;
  if (!grid_blocks) {
    int dev = 0, cus = 0, per_cu = 0;
    (void)hipGetDevice(&dev);
    (void)hipDeviceGetAttribute(&cus, hipDeviceAttributeMultiprocessorCount, dev);
    if (hipFuncSetAttribute((const void*)fwd_megakernel, hipFuncAttributeMaxDynamicSharedMemorySize, LDS_BYTES) != hipSuccess) { fprintf(stderr, "kernel_launch: hipFuncSetAttribute failed\n"); grid_blocks = -1; return; }
    (void)hipOccupancyMaxActiveBlocksPerMultiprocessor(&per_cu, (const void*)fwd_megakernel, 512, LDS_BYTES);
    (void)hipGetLastError();
    grid_blocks = cus;
  }
  if (grid_blocks < 0) return;
  if (n_in != 44 || ws_size < WS_END) { fprintf(stderr, "kernel_launch: unexpected n_in %d or ws_size %zu < %zu\n", n_in, ws_size, (size_t)WS_END); return; }
  Params p{};
  for (int i = 0; i < 44; ++i) p.in[i] = (const float*)d_in[i];
  p.out = (float*)d_out;
  p.ws = (char*)d_ws;
  if (hipMemsetAsync((char*)d_ws + O_BAR, 0, 16384, stream) != hipSuccess) { fprintf(stderr, "memset failed\n"); return; }
  void* args[] = {&p};
  hipError_t e = hipLaunchCooperativeKernel((void*)fwd_megakernel, dim3(grid_blocks), dim3(512), args, LDS_BYTES, stream);
  if (e != hipSuccess) fprintf(stderr, "cooperative launch failed: %s (grid %d)\n", hipGetErrorString(e), grid_blocks);
}
```

```cpp
#include <hip/hip_runtime.h>
#include <hip/hip_cooperative_groups.h>
#include <cstdio>
namespace cg = cooperative_groups;

#define DI __device__ __forceinline__
typedef unsigned short bf16_t;
typedef short bf16x8 __attribute__((ext_vector_type(8)));
typedef short s16x4 __attribute__((ext_vector_type(4)));
typedef float f32x16 __attribute__((ext_vector_type(16)));
typedef float f32x4 __attribute__((ext_vector_type(4)));
typedef unsigned u32x2 __attribute__((ext_vector_type(2)));
typedef unsigned u32x4 __attribute__((ext_vector_type(4)));

#define MFMA32(a, b, c) __builtin_amdgcn_mfma_f32_32x32x16_bf16((a), (b), (c), 0, 0, 0)
#define MFMA16(a, b, c) __builtin_amdgcn_mfma_f32_16x16x32_bf16((a), (b), (c), 0, 0, 0)

constexpr int D = 1024, NB = 8, SEQ = 2048, CTXL = 256;
constexpr int RL = NB * SEQ;
constexpr int RC = NB * CTXL;
constexpr int R = RL + RC;
constexpr int LW = 1408;
constexpr int NCH = R / 16;
constexpr int NCHP = 1280;

constexpr size_t O_WT_IN0 = 0;
constexpr size_t O_WT_OUT0 = O_WT_IN0 + (size_t)2816 * 1024 * 2;
constexpr size_t O_WT_IN1 = O_WT_OUT0 + (size_t)1024 * 2816 * 2;
constexpr size_t O_WT_OUT1 = O_WT_IN1 + (size_t)2560 * 1024 * 2;
constexpr size_t O_WT_IN2 = O_WT_OUT1 + (size_t)1024 * 1024 * 2;
constexpr size_t O_WT_OUT2 = O_WT_IN2 + (size_t)4096 * 1024 * 2;
constexpr size_t O_WT_IN3 = O_WT_OUT2 + (size_t)1024 * 1024 * 2;
constexpr size_t O_WT_GLU = O_WT_IN3 + (size_t)2048 * 1024 * 2;
constexpr size_t O_WT_OUT3 = O_WT_GLU + (size_t)1024 * 1024 * 2;
constexpr size_t O_WG = O_WT_OUT3 + (size_t)1024 * 1024 * 2;
constexpr size_t O_MOD = O_WG + (size_t)16 * 2 * 192 * 96 * 2;
constexpr size_t O_ROPEC = O_MOD + (size_t)4 * 9 * 3072 * 4;
constexpr size_t O_ROPES = O_ROPEC + (size_t)2048 * 32 * 4;
constexpr size_t O_POW = O_ROPES + (size_t)2048 * 32 * 4;
constexpr size_t O_BBAR = O_POW + (size_t)2 * 64 * 17 * 64 * 8;
constexpr size_t O_HCTX = O_BBAR + (size_t)2 * 64 * 64 * 16 * 8;
constexpr size_t O_SS = O_HCTX + (size_t)RC * 1024 * 4;
constexpr size_t O_GS = O_SS + (size_t)3 * R * 4;
constexpr size_t O_SHW = O_GS + (size_t)3 * 9 * 1024 * 4;
constexpr size_t O_BAR = O_SHW + (size_t)3 * 9 * 4096 * 4;
constexpr size_t O_DYN = O_BAR + 16384;
constexpr size_t O_U0 = O_DYN;
constexpr size_t O_G0 = O_U0 + (size_t)R * LW * 2;
constexpr size_t O_ACT0 = O_G0 + (size_t)R * LW * 2;
constexpr size_t O_NBUF0 = O_ACT0;
constexpr size_t O_NBUF = O_DYN;
constexpr size_t O_Q1 = O_NBUF + (size_t)R * 1024 * 2;
constexpr size_t O_QR1 = O_Q1 + (size_t)R * 1024 * 2;
constexpr size_t O_K1 = O_QR1 + (size_t)RL * 1024 * 2;
constexpr size_t O_VTL1 = O_K1 + (size_t)R * 256 * 2;
constexpr size_t O_VTC1 = O_VTL1 + (size_t)8 * 4 * 64 * 2048 * 2;
constexpr size_t O_G1 = O_VTC1 + (size_t)8 * 4 * 64 * 256 * 2;
constexpr size_t O_ACT1 = O_G1 + (size_t)R * 1024 * 2;
constexpr size_t O_Q2 = O_NBUF + (size_t)R * 1024 * 2;
constexpr size_t O_K2 = O_Q2 + (size_t)R * 1024 * 2;
constexpr size_t O_VTL2 = O_K2 + (size_t)R * 1024 * 2;
constexpr size_t O_VTC2 = O_VTL2 + (size_t)8 * 16 * 64 * 2048 * 2;
constexpr size_t O_G2 = O_VTC2 + (size_t)8 * 16 * 64 * 256 * 2;
constexpr size_t O_ACT2 = O_Q2;
constexpr size_t O_SLOC = O_DYN;
constexpr size_t O_YG = O_DYN;
constexpr size_t O_ACT3 = O_YG + (size_t)RL * 1024 * 2;
constexpr size_t O_ACAT = O_DYN + (size_t)64 * NCHP * 256 * 4;
constexpr size_t O_G3 = O_ACAT + (size_t)64 * NCH * 512 * 2;
constexpr size_t O_GT = O_WT_IN2;
constexpr size_t O_MYT = O_WT_IN0;
static_assert(O_WT_OUT1 - O_WT_IN0 == (size_t)64 * 256 * 512 * 2 && O_WT_OUT2 - O_WT_IN2 == (size_t)64 * 256 * 256 * 2, "S5 matrix aliases");
constexpr size_t WS_END = O_ACT0 + (size_t)R * LW * 2 * 2;
static_assert(O_G3 + (size_t)RL * 1024 * 2 <= WS_END && O_ACT1 + (size_t)R * 1024 * 2 <= WS_END && O_G2 + (size_t)R * 1024 * 2 <= WS_END, "workspace map");
static_assert(WS_END <= (size_t)256 * 1024 * 1024, "workspace budget");

struct Params {
  const float* in[44];
  float* out;
  char* ws;
};

typedef __bf16 bf16n2 __attribute__((ext_vector_type(2)));
DI bf16_t f2bf(float x) { const __bf16 b = (__bf16)x; return __builtin_bit_cast(unsigned short, b); }
DI float bf2f(bf16_t b) { return __uint_as_float(((unsigned)b) << 16); }
DI unsigned pack2(float lo, float hi) { bf16n2 v; v[0] = (__bf16)lo; v[1] = (__bf16)hi; return __builtin_bit_cast(unsigned, v); }
DI float bflo(unsigned u) { return __uint_as_float(u << 16); }
DI float bfhi(unsigned u) { return __uint_as_float(u & 0xffff0000u); }
DI float frcp(float x) { return __builtin_amdgcn_rcpf(x); }
DI float sigm(float x) { return frcp(1.f + __expf(-x)); }
DI float silu(float x) { return x * frcp(1.f + __expf(-x)); }
DI float gelu_tanh(float x) {
  const float w = -x * (2.3022081986f + 0.1029432396f * x * x);
  return x * frcp(1.f + __builtin_amdgcn_exp2f(w));
}
DI int opaque_tid() { int t = threadIdx.x; asm volatile("" : "+v"(t)); return t; }
constexpr float QSCALE = 0.125f * 1.4426950408889634f;
DI int crow(int i, int h) { return (i & 3) + 8 * (i >> 2) + 4 * h; }
DI f32x16 zero16() { f32x16 z; _Pragma("unroll") for (int i = 0; i < 16; ++i) z[i] = 0.f; return z; }
DI void sincos_rev(float rev, float& s, float& c) { rev = rev - rintf(rev); s = __builtin_amdgcn_sinf(rev); c = __builtin_amdgcn_cosf(rev); }

#define LAS __attribute__((address_space(3)))
namespace pg8 {
constexpr int BM = 256, BK = 64, HALF = 128, HTB = HALF * BK * 2, STAGE_BYTES = 8 * HTB;
DI int lds_byte(int r, int c) { const int st = (r >> 4) * 2 + (c >> 5), rr = r & 15, cc = c & 31, ob = rr * 64 + cc * 2; return st * 1024 + (ob ^ (((ob >> 9) & 1) << 5)); }
DI void stage_rc(int b, int& R_, int& C_) { const int st = b / 1024, sb = b % 1024, swz = sb ^ (((sb >> 9) & 1) << 5); R_ = (st >> 1) * 16 + swz / 64; C_ = (st & 1) * 32 + (swz % 64) / 2; }
DI int perm32(int rho) { const int n = rho >> 4, i = rho & 15; return 8 * (i >> 2) + 4 * n + (i & 3); }
struct Unit { int pm, pn, pb; };
struct Gemm { const bf16_t* A; const bf16_t* Bt; int lda, ldb, K, nM, nN, nB; int strideA, strideB; int rot; };
DI bool next_unit(const Gemm& g, int i, Unit& u) {
  const int G = gridDim.x, per = g.nM * g.nN, nwg = per * g.nB;
  const int c = (blockIdx.x + g.rot) % G;
  const long L = (long)i * G + c;
  if (L >= nwg) return false;
  int wgid = (int)L;
  { const int q = nwg / 8, r = nwg % 8, xcd = wgid % 8, off = wgid / 8; wgid = (xcd < r ? xcd * (q + 1) : r * (q + 1) + (xcd - r) * q) + off; }
  const int pb = wgid / per, w = wgid - pb * per;
  const int nig = 8 * g.nN, gid = w / nig, fm = gid * 8, gsz = (g.nM - fm) < 8 ? (g.nM - fm) : 8;
  u.pb = pb; u.pm = fm + ((w % nig) % gsz); u.pn = (w % nig) / gsz;
  return true;
}

template <class Epi>
DI void gemm_phase(LAS unsigned char* lds, const Gemm g, const Epi& E) {
  const int tid = opaque_tid(), wid = __builtin_amdgcn_readfirstlane(tid >> 6), lane = tid & 63, wr = wid >> 2, wc = wid & 3, fr = lane & 15, fq = lane >> 4;
  const int K = g.K, nt = K / BK;
  unsigned voffA[2], voffB[2];
#pragma unroll
  for (int i = 0; i < 2; ++i) { int R_, C_; stage_rc(tid * 16 + i * 8192, R_, C_); const int Rb = Epi::PERM ? ((R_ & ~31) + perm32(R_ & 31)) : R_;
    voffA[i] = (unsigned)(R_ * g.lda + C_) * 2u; voffB[i] = (unsigned)(Rb * g.ldb + C_) * 2u; }
  const size_t kstep = (size_t)(BK * 2);
  const size_t hstepA = (size_t)HALF * g.lda * 2, hstepB = (size_t)HALF * g.ldb * 2;
  const size_t tstepA = 2 * hstepA, tstepB = 2 * hstepB;
  const unsigned ldsw = (unsigned)wid * 1024u;
  const int aoff = lds_byte(wr * 64 + fr, fq * 8), boff = lds_byte(wc * 32 + fr, fq * 8);
#define PG8_SA(b, h) (((b) * 2 + (h)) * HTB)
#define PG8_SB(b, h) ((4 + (b) * 2 + (h)) * HTB)
#define PG8_STAGE(bufoff, gbase, voff) do { _Pragma("unroll") for (int _i = 0; _i < 2; ++_i) \
        __builtin_amdgcn_global_load_lds((const unsigned*)((const char*)(gbase) + (voff)[_i]), (LAS unsigned*)(lds + (bufoff) + ldsw + _i * 8192), 16, 0, 0); } while (0)
#define PG8_LDA(dst, b, h) do { _Pragma("unroll") for (int m = 0; m < 4; ++m) _Pragma("unroll") for (int k = 0; k < 2; ++k) dst[m][k] = *(const LAS bf16x8*)(lds + PG8_SA(b, h) + aoff + m * 2048 + k * 1024); } while (0)
#define PG8_LDB(dst, b, h) do { _Pragma("unroll") for (int n = 0; n < 2; ++n) _Pragma("unroll") for (int k = 0; k < 2; ++k) dst[n][k] = *(const LAS bf16x8*)(lds + PG8_SB(b, h) + boff + n * 2048 + k * 1024); } while (0)
#define PG8_MMA(ai, bj, At, Bt) do { __builtin_amdgcn_s_setprio(1); _Pragma("unroll") for (int m = 0; m < 4; ++m) _Pragma("unroll") for (int n = 0; n < 2; ++n) _Pragma("unroll") for (int k = 0; k < 2; ++k) \
        acc[ai][bj][m][n] = __builtin_amdgcn_mfma_f32_16x16x32_bf16(Bt[n][k], At[m][k], acc[ai][bj][m][n], 0, 0, 0); __builtin_amdgcn_s_setprio(0); } while (0)
#define PG8_WAIT_V(n) asm volatile("s_waitcnt vmcnt(" #n ")" ::: "memory")
#define PG8_WAIT_L(n) asm volatile("s_waitcnt lgkmcnt(" #n ")" ::: "memory")
#define PG8_BAR __builtin_amdgcn_s_barrier()
#define PG8_SCHED __builtin_amdgcn_sched_barrier(0)
  Unit cur, nxt; int ui = 0;
  if (!next_unit(g, 0, cur)) return;
  f32x4 acc[2][2][4][2];
#pragma unroll
  for (int a = 0; a < 2; ++a)
#pragma unroll
    for (int b = 0; b < 2; ++b)
#pragma unroll
      for (int m = 0; m < 4; ++m)
#pragma unroll
        for (int n = 0; n < 2; ++n) acc[a][b][m][n] = (f32x4){0.f, 0.f, 0.f, 0.f};
  bf16x8 At[4][2], B0[2][2], B1[2][2];
  const char* cA = (const char*)(g.A + (size_t)cur.pb * g.strideA) + (size_t)cur.pm * tstepA;
  const char* cB = (const char*)(g.Bt + (size_t)cur.pb * g.strideB) + (size_t)cur.pn * tstepB;
  PG8_STAGE(PG8_SB(0, 0), cB, voffB); PG8_STAGE(PG8_SA(0, 0), cA, voffA); PG8_STAGE(PG8_SB(0, 1), cB + hstepB, voffB); PG8_STAGE(PG8_SA(0, 1), cA + hstepA, voffA);
  if (wr == 1) PG8_BAR;
  PG8_WAIT_V(4); PG8_BAR;
  PG8_STAGE(PG8_SB(1, 0), cB + kstep, voffB); PG8_STAGE(PG8_SA(1, 0), cA + kstep, voffA); PG8_STAGE(PG8_SB(1, 1), cB + hstepB + kstep, voffB);
  PG8_WAIT_V(6); PG8_BAR;
  for (;;) {
    const bool has_next = next_unit(g, ui + 1, nxt);
    const char* nA = has_next ? (const char*)(g.A + (size_t)nxt.pb * g.strideA) + (size_t)nxt.pm * tstepA : cA;
    const char* nB = has_next ? (const char*)(g.Bt + (size_t)nxt.pb * g.strideB) + (size_t)nxt.pn * tstepB : cB;
    for (int t = 0; t < nt; t += 2) {
      const bool last = (t == nt - 2);
      const char* a1 = cA + (size_t)(t + 1) * kstep;
      const char* a2 = last ? nA : cA + (size_t)(t + 2) * kstep; const char* b2 = last ? nB : cB + (size_t)(t + 2) * kstep;
      const char* a3 = a2 + kstep; const char* b3 = b2 + kstep;
      PG8_LDB(B0, 0, 0); PG8_SCHED; PG8_LDA(At, 0, 0); PG8_STAGE(PG8_SA(1, 1), a1 + hstepA, voffA);
      PG8_WAIT_L(8); PG8_BAR; PG8_WAIT_L(0); PG8_MMA(0, 0, At, B0); PG8_BAR; PG8_SCHED;
      PG8_LDB(B1, 0, 1); PG8_STAGE(PG8_SB(0, 0), b2, voffB);
      PG8_BAR; PG8_WAIT_L(0); PG8_MMA(0, 1, At, B1); PG8_BAR;
      PG8_LDA(At, 0, 1); PG8_STAGE(PG8_SA(0, 0), a2, voffA);
      PG8_BAR; PG8_WAIT_L(0); PG8_MMA(1, 0, At, B0); PG8_BAR; PG8_SCHED;
      PG8_STAGE(PG8_SB(0, 1), b2 + hstepB, voffB);
      PG8_WAIT_V(6); PG8_BAR; PG8_MMA(1, 1, At, B1); PG8_BAR;
      PG8_LDB(B0, 1, 0); PG8_SCHED; PG8_LDA(At, 1, 0); PG8_STAGE(PG8_SA(0, 1), a2 + hstepA, voffA);
      PG8_WAIT_L(8); PG8_BAR; PG8_WAIT_L(0); PG8_MMA(0, 0, At, B0); PG8_BAR; PG8_SCHED;
      PG8_LDB(B1, 1, 1); PG8_STAGE(PG8_SB(1, 0), b3, voffB);
      PG8_BAR; PG8_WAIT_L(0); PG8_MMA(0, 1, At, B1); PG8_BAR;
      PG8_LDA(At, 1, 1); PG8_STAGE(PG8_SA(1, 0), a3, voffA);
      PG8_BAR; PG8_WAIT_L(0); PG8_MMA(1, 0, At, B0); PG8_BAR; PG8_SCHED;
      PG8_STAGE(PG8_SB(1, 1), b3 + hstepB, voffB);
      PG8_WAIT_V(6); PG8_BAR; PG8_MMA(1, 1, At, B1); PG8_BAR;
    }
    E(acc, cur, wr, wc, fr, fq);
    if (!has_next) break;
#pragma unroll
    for (int a = 0; a < 2; ++a)
#pragma unroll
      for (int b = 0; b < 2; ++b)
#pragma unroll
        for (int m = 0; m < 4; ++m)
#pragma unroll
          for (int n = 0; n < 2; ++n) acc[a][b][m][n] = (f32x4){0.f, 0.f, 0.f, 0.f};
    cur = nxt; cA = nA; cB = nB; ++ui;
  }
  PG8_WAIT_V(0);
  if (wr == 0) PG8_BAR;
  PG8_BAR;
#undef PG8_SA
#undef PG8_SB
#undef PG8_STAGE
#undef PG8_LDA
#undef PG8_LDB
#undef PG8_MMA
#undef PG8_WAIT_V
#undef PG8_WAIT_L
#undef PG8_BAR
#undef PG8_SCHED
}
}
using pg8::Unit;
typedef f32x4 AccT[2][2][4][2];

DI void asm_fence() { asm volatile("" ::: "memory"); }
#define EPI_ROWS4 _Pragma("unroll") for (int ai = 0; ai < 2; ++ai) if ((asm_fence(), true)) _Pragma("unroll") for (int m = 0; m < 4; ++m)
#define EPI_ROWS _Pragma("unroll") for (int ai = 0; ai < 2; ++ai) _Pragma("unroll") for (int m = 0; m < 4; ++m) if ((asm_fence(), true))
DI u32x4 pack8f(const f32x4& a, const f32x4& b) { u32x4 w; w[0] = pack2(a[0], a[1]); w[1] = pack2(a[2], a[3]); w[2] = pack2(b[0], b[1]); w[3] = pack2(b[2], b[3]); return w; }
DI size_t k_off(int t, int d) { return (size_t)(t >> 5) * 2048 + (((d >> 4) * 64 + ((d >> 3) & 1) * 32 + (t & 31)) << 3) + (d & 7); }

struct EpiL0In {
  static constexpr bool PERM = true;
  bf16_t* U0; bf16_t* G0;
  DI void operator()(const AccT& acc, const Unit& u, int wr, int wc, int fr, int fq) const {
    EPI_ROWS { const int row = u.pm * 256 + ai * 128 + wr * 64 + m * 16 + fr;
      _Pragma("unroll") for (int bj = 0; bj < 2; ++bj) { const int c0 = u.pn * 256 + bj * 128 + wc * 32 + 8 * fq;
        const bool isu = u.pn * 256 + bj * 128 < LW;
        bf16_t* dst = isu ? U0 + (size_t)row * LW + c0 : G0 + (size_t)row * LW + (c0 - LW);
        *(u32x4*)dst = pack8f(acc[ai][bj][m][0], acc[ai][bj][m][1]); } }
  }
};

template <bool NEXT>
struct EpiOut {
  static constexpr bool PERM = false;
  const float* in_lat; const float* in_ctx; float* out_lat; float* out_ctx; const float* gate;
  const float* gs; bf16_t* NB_; float* ss;
  DI void operator()(const AccT& acc, const Unit& u, int wr, int wc, int fr, int fq) const {
    const int rb = u.pm * 256;
    const float* src; float* dst; const float* g; const float* gsv; int rr;
    if (rb < RL) { src = in_lat; dst = out_lat; rr = rb; g = gate + (size_t)(rb >> 11) * 3072; gsv = gs + (size_t)(rb >> 11) * 1024; }
    else { src = in_ctx; dst = out_ctx; rr = rb - RL; g = gate + (size_t)8 * 3072; gsv = gs + (size_t)8 * 1024; }
    const int cb = u.pn * 256 + wc * 32 + 4 * fq;
    f32x4 gv[4], sv[4];
    _Pragma("unroll") for (int q = 0; q < 4; ++q) { gv[q] = *(const f32x4*)(g + cb + (q >> 1) * 128 + (q & 1) * 16); if (NEXT) sv[q] = *(const f32x4*)(gsv + cb + (q >> 1) * 128 + (q & 1) * 16); }
    const int r0 = rr + wr * 64 + fr;
    f32x4 hc[4], hn[4];
    _Pragma("unroll") for (int q = 0; q < 4; ++q) hc[q] = *(const f32x4*)(src + (size_t)r0 * 1024 + cb + (q >> 1) * 128 + (q & 1) * 16);
    _Pragma("unroll") for (int r_ = 0; r_ < 8; ++r_) {
      const int ai = r_ >> 2, m = r_ & 3, row = r0 + 128 * ai + 16 * m;
      if (r_ + 1 < 8) { const int rown = r0 + 128 * ((r_ + 1) >> 2) + 16 * ((r_ + 1) & 3);
        _Pragma("unroll") for (int q = 0; q < 4; ++q) hn[q] = *(const f32x4*)(src + (size_t)rown * 1024 + cb + (q >> 1) * 128 + (q & 1) * 16); }
      float sq = 0.f;
      _Pragma("unroll") for (int q = 0; q < 4; ++q) {
        const int c = cb + (q >> 1) * 128 + (q & 1) * 16;
        const f32x4 o = hc[q] + gv[q] * acc[ai][q >> 1][m][q & 1];
        *(f32x4*)(dst + (size_t)row * 1024 + c) = o;
        if (NEXT) {
          u32x2 w; w[0] = pack2(o[0] * sv[q][0], o[1] * sv[q][1]); w[1] = pack2(o[2] * sv[q][2], o[3] * sv[q][3]);
          *(u32x2*)(NB_ + (size_t)(row - rr + rb) * 1024 + c) = w;
          sq += o[0] * o[0] + o[1] * o[1] + o[2] * o[2] + o[3] * o[3];
        }
      }
      if (NEXT) {
        sq += __shfl_xor(sq, 16); sq += __shfl_xor(sq, 32);
        if (fq == 0) atomicAdd(ss + (row - rr + rb), sq);
      }
      asm_fence();
      _Pragma("unroll") for (int q = 0; q < 4; ++q) hc[q] = hn[q];
    }
  }
};

struct EpiL1 {
  static constexpr bool PERM = true;
  bf16_t *Q, *QR, *Kb, *G; const float *rc, *rs; const float* ss; const float* shw;
  DI void operator()(const AccT& acc, const Unit& u, int wr, int wc, int fr, int fq) const {
    const int rb = u.pm * 256; const bool lat = rb < RL;
    const float* sh = shw + (size_t)(lat ? (rb >> 11) : 8) * 4096;
    const int r0 = rb + wr * 64 + fr;
    float rstd[8];
    _Pragma("unroll") for (int r_ = 0; r_ < 8; ++r_) rstd[r_] = ss[r0 + 128 * (r_ >> 2) + 16 * (r_ & 3)];
    _Pragma("unroll") for (int r_ = 0; r_ < 8; ++r_) rstd[r_] = rsqrtf(rstd[r_] * (1.f / 1024.f) + 1e-6f);
    const bool qk = u.pn * 256 < 1280;
    f32x4 b1[2], b2v[2];
    int c0s[2], d0s[2];
    _Pragma("unroll") for (int bj = 0; bj < 2; ++bj) {
      const int c0 = u.pn * 256 + bj * 128 + wc * 32 + 8 * fq; c0s[bj] = c0; d0s[bj] = (c0 & 63) >> 1;
      if (qk) { const int oc = (c0 & ~63) + d0s[bj]; b1[bj] = *(const f32x4*)(sh + oc); b2v[bj] = *(const f32x4*)(sh + oc + 32); }
      else { b1[bj] = *(const f32x4*)(sh + c0 + 256); b2v[bj] = *(const f32x4*)(sh + c0 + 260); }
    }
    f32x4 cc, sc, cn, sn;
    if (qk && lat) { const int t = r0 & 2047; cc = *(const f32x4*)(rc + t * 32 + d0s[0]); sc = *(const f32x4*)(rs + t * 32 + d0s[0]); }
    _Pragma("unroll") for (int r_ = 0; r_ < 8; ++r_) {
      const int ai = r_ >> 2, m = r_ & 3, row = r0 + 128 * ai + 16 * m;
      if (qk && lat && r_ + 1 < 8) { const int tn = (r0 + 128 * ((r_ + 1) >> 2) + 16 * ((r_ + 1) & 3)) & 2047;
        cn = *(const f32x4*)(rc + tn * 32 + d0s[0]); sn = *(const f32x4*)(rs + tn * 32 + d0s[0]); }
      _Pragma("unroll") for (int bj = 0; bj < 2; ++bj) { const int c0 = c0s[bj], d0 = d0s[bj];
        const f32x4 v0 = acc[ai][bj][m][0] * rstd[r_], v1 = acc[ai][bj][m][1] * rstd[r_];
        if (qk) {
          float x1[4] = {v0[0] + b1[bj][0], v0[2] + b1[bj][1], v1[0] + b1[bj][2], v1[2] + b1[bj][3]}, x2[4] = {v0[1] + b2v[bj][0], v0[3] + b2v[bj][1], v1[1] + b2v[bj][2], v1[3] + b2v[bj][3]};
          float y1[4], y2[4];
          int t;
          if (lat) { t = row & 2047; _Pragma("unroll") for (int j = 0; j < 4; ++j) { y1[j] = x1[j] * cc[j] - x2[j] * sc[j]; y2[j] = x2[j] * cc[j] + x1[j] * sc[j]; } }
          else { t = (row - RL) & 255; _Pragma("unroll") for (int j = 0; j < 4; ++j) { y1[j] = x1[j]; y2[j] = x2[j]; } }
          if (u.pn < 4) {
            const size_t o = (size_t)row * 1024 + (c0 & ~63) + d0;
            u32x2 a, b2; a[0] = pack2(x1[0] * QSCALE, x1[1] * QSCALE); a[1] = pack2(x1[2] * QSCALE, x1[3] * QSCALE);
            b2[0] = pack2(x2[0] * QSCALE, x2[1] * QSCALE); b2[1] = pack2(x2[2] * QSCALE, x2[3] * QSCALE);
            *(u32x2*)(Q + o) = a; *(u32x2*)(Q + o + 32) = b2;
            if (lat) {
              a[0] = pack2(y1[0] * QSCALE, y1[1] * QSCALE); a[1] = pack2(y1[2] * QSCALE, y1[3] * QSCALE);
              b2[0] = pack2(y2[0] * QSCALE, y2[1] * QSCALE); b2[1] = pack2(y2[2] * QSCALE, y2[3] * QSCALE);
              *(u32x2*)(QR + o) = a; *(u32x2*)(QR + o + 32) = b2;
            }
          } else {
            const int kvh = (c0 - 1024) >> 6;
            bf16_t* kh = lat ? Kb + (size_t)((row >> 11) * 4 + kvh) * 64 * 2048 : Kb + (size_t)RL * 256 + (size_t)(((row - RL) >> 8) * 4 + kvh) * 8 * 2048;
            u32x2 a, b2; a[0] = pack2(y1[0], y1[1]); a[1] = pack2(y1[2], y1[3]); b2[0] = pack2(y2[0], y2[1]); b2[1] = pack2(y2[2], y2[3]);
            *(u32x2*)(kh + k_off(t, d0)) = a; *(u32x2*)(kh + k_off(t, d0 + 32)) = b2;
          }
        } else {
          *(u32x4*)(G + (size_t)row * 1024 + (c0 - 1280)) = pack8f(v0 + b1[bj], v1 + b2v[bj]);
        } }
      asm_fence();
      cc = cn; sc = sn;
    }
  }
};

template <int H, int VCOL0  >
struct EpiV {
  static constexpr bool PERM = true;
  bf16_t *VtL, *VtC; const float* ss; const float* shw;
  DI void operator()(const AccT& acc, const Unit& u, int wr, int wc, int fr, int fq) const {
    const bool latn = u.pn * 256 < RL;
    bf16_t* basep = latn ? VtL : VtC;
    const int tsh = latn ? 11 : 8, tiles = latn ? 64 : 8;
    const int nb = (latn ? u.pn * 256 : u.pn * 256 - RL) + wc * 32 + 8 * fq;
    f32x4 r0[2], r1[2];
    _Pragma("unroll") for (int bj = 0; bj < 2; ++bj) {
      const float* sp = ss + u.pn * 256 + bj * 128 + wc * 32 + 8 * fq;
      const f32x4 a = *(const f32x4*)sp, b2 = *(const f32x4*)(sp + 4);
      _Pragma("unroll") for (int j = 0; j < 4; ++j) { r0[bj][j] = rsqrtf(a[j] * (1.f / 1024.f) + 1e-6f); r1[bj][j] = rsqrtf(b2[j] * (1.f / 1024.f) + 1e-6f); }
    }
    const int vb0 = latn ? (nb >> tsh) : 8;
    float biasr[8];
    _Pragma("unroll") for (int r_ = 0; r_ < 8; ++r_) biasr[r_] = shw[(size_t)vb0 * 4096 + VCOL0 + u.pm * 256 + (r_ >> 2) * 128 + wr * 64 + (r_ & 3) * 16 + fr];
    EPI_ROWS { const int rowd = u.pm * 256 + ai * 128 + wr * 64 + m * 16 + fr, head = rowd >> 6, d = rowd & 63;
      const unsigned rowoff = (unsigned)(((d >> 5) * 128 + (d & 31)) << 3);
      _Pragma("unroll") for (int bj = 0; bj < 2; ++bj) { const int nn = nb + bj * 128;
        const int bidx = nn >> tsh, t = nn & ((1 << tsh) - 1);
        const float bias = biasr[ai * 4 + m];
        const unsigned off = (unsigned)(((bidx * H + head) * tiles + (t >> 5)) * 2048) + rowoff + (unsigned)((((t & 31) >> 4) * 64) << 3) + (unsigned)(((t >> 3) & 1) * 4);
        const f32x4 v0 = acc[ai][bj][m][0] * r0[bj] + bias, v1 = acc[ai][bj][m][1] * r1[bj] + bias;
        u32x2 a, b2; a[0] = pack2(v0[0], v0[1]); a[1] = pack2(v0[2], v0[3]); b2[0] = pack2(v1[0], v1[1]); b2[1] = pack2(v1[2], v1[3]);
        *(u32x2*)(basep + off) = a; *(u32x2*)(basep + off + 256) = b2; } }
  }
};

struct EpiL2 {
  static constexpr bool PERM = true;
  bf16_t *Q, *Kb, *G; const float* ss; const float* shw;
  DI void operator()(const AccT& acc, const Unit& u, int wr, int wc, int fr, int fq) const {
    const int rb = u.pm * 256; const bool lat = rb < RL;
    const float* sh = shw + (size_t)(lat ? (rb >> 11) : 8) * 4096;
    const int r0 = rb + wr * 64 + fr;
    float rstd[8];
    _Pragma("unroll") for (int r_ = 0; r_ < 8; ++r_) rstd[r_] = ss[r0 + 128 * (r_ >> 2) + 16 * (r_ & 3)];
    _Pragma("unroll") for (int r_ = 0; r_ < 8; ++r_) rstd[r_] = rsqrtf(rstd[r_] * (1.f / 1024.f) + 1e-6f);
    f32x4 b1[2], b2v[2];
    _Pragma("unroll") for (int bj = 0; bj < 2; ++bj) { const int c0 = u.pn * 256 + bj * 128 + wc * 32 + 8 * fq, oc = u.pn < 8 ? c0 : c0 + 1024;
      b1[bj] = *(const f32x4*)(sh + oc); b2v[bj] = *(const f32x4*)(sh + oc + 4); }
    _Pragma("unroll") for (int r_ = 0; r_ < 8; ++r_) { const int ai = r_ >> 2, m = r_ & 3, row = r0 + 128 * ai + 16 * m;
      _Pragma("unroll") for (int bj = 0; bj < 2; ++bj) { const int c0 = u.pn * 256 + bj * 128 + wc * 32 + 8 * fq;
        const f32x4 v0 = acc[ai][bj][m][0] * rstd[r_] + b1[bj], v1 = acc[ai][bj][m][1] * rstd[r_] + b2v[bj];
        if (u.pn < 4) *(u32x4*)(Q + (size_t)row * 1024 + c0) = pack8f(v0 * QSCALE, v1 * QSCALE);
        else if (u.pn < 8) {
          const int hd = (c0 - 1024) >> 6, d0 = c0 & 63;
          bf16_t* kh; int t;
          if (lat) { kh = Kb + (size_t)((row >> 11) * 16 + hd) * 64 * 2048; t = row & 2047; }
          else { const int rr = row - RL; kh = Kb + (size_t)RL * 1024 + (size_t)((rr >> 8) * 16 + hd) * 8 * 2048; t = rr & 255; }
          *(u32x4*)(kh + k_off(t, d0)) = pack8f(v0, v1);
        } else *(u32x4*)(G + (size_t)row * 1024 + (c0 - 2048)) = pack8f(v0, v1); }
      asm_fence(); }
  }
};

struct EpiL3In {
  static constexpr bool PERM = true;
  bf16_t *ACAT, *G; const float* ss; const float* shw;
  DI void operator()(const AccT& acc, const Unit& u, int wr, int wc, int fr, int fq) const {
    const int rb = u.pm * 256;
    const float* sh = shw + (size_t)(rb < RL ? (rb >> 11) : 8) * 4096;
    const int r0 = rb + wr * 64 + fr;
    float rstd[8];
    _Pragma("unroll") for (int r_ = 0; r_ < 8; ++r_) rstd[r_] = ss[r0 + 128 * (r_ >> 2) + 16 * (r_ & 3)];
    _Pragma("unroll") for (int r_ = 0; r_ < 8; ++r_) rstd[r_] = rsqrtf(rstd[r_] * (1.f / 1024.f) + 1e-6f);
    f32x4 b1[2], b2v[2];
    _Pragma("unroll") for (int bj = 0; bj < 2; ++bj) { const int c0 = u.pn * 256 + bj * 128 + wc * 32 + 8 * fq; b1[bj] = *(const f32x4*)(sh + c0); b2v[bj] = *(const f32x4*)(sh + c0 + 4); }
    _Pragma("unroll") for (int r_ = 0; r_ < 8; ++r_) { const int ai = r_ >> 2, m = r_ & 3, row = r0 + 128 * ai + 16 * m;
      _Pragma("unroll") for (int bj = 0; bj < 2; ++bj) { const int c0 = u.pn * 256 + bj * 128 + wc * 32 + 8 * fq;
        const u32x4 w = pack8f(acc[ai][bj][m][0] * rstd[r_] + b1[bj], acc[ai][bj][m][1] * rstd[r_] + b2v[bj]);
        if (u.pn < 4) *(u32x4*)(ACAT + ((size_t)(c0 >> 4) * NCH + (row >> 4)) * 512 + (row & 15) * 16 + (c0 & 15)) = w;
        else if (rb < RL) *(u32x4*)(G + (size_t)row * 1024 + (c0 - 1024)) = w; }
      asm_fence(); }
  }
};

struct EpiS5State {
  static constexpr bool PERM = false;
  float* S;
  DI void operator()(const AccT& acc, const Unit& u, int wr, int wc, int fr, int fq) const {
    float* sp = S + ((size_t)u.pb * NCHP + u.pm * 256) * 256 + wc * 32 + 4 * fq;
    EPI_ROWS { const unsigned o = (unsigned)(ai * 128 + wr * 64 + m * 16 + fr) * 256u;
      *(f32x4*)(sp + o) = acc[ai][0][m][0]; *(f32x4*)(sp + o + 16) = acc[ai][0][m][1];
      *(f32x4*)(sp + o + 128) = acc[ai][1][m][0]; *(f32x4*)(sp + o + 144) = acc[ai][1][m][1]; }
  }
};

struct EpiS5Y {
  static constexpr bool PERM = true;
  bf16_t* YG;
  DI void operator()(const AccT& acc, const Unit& u, int wr, int wc, int fr, int fq) const {
    EPI_ROWS { const int chunk = u.pm * 256 + ai * 128 + wr * 64 + m * 16 + fr;
      _Pragma("unroll") for (int bj = 0; bj < 2; ++bj) { const int n0 = bj * 128 + wc * 32 + 8 * fq;
        f32x4 v0 = acc[ai][bj][m][0], v1 = acc[ai][bj][m][1];
        _Pragma("unroll") for (int j = 0; j < 4; ++j) { v0[j] = gelu_tanh(v0[j]); v1[j] = gelu_tanh(v1[j]); }
        *(u32x4*)(YG + ((size_t)chunk * 16 + (n0 >> 4)) * 1024 + u.pb * 16 + (n0 & 15)) = pack8f(v0, v1); } }
  }
};

struct EpiGlu {
  static constexpr bool PERM = true;
  const bf16_t *YG, *G; const float* gb; bf16_t* ACT;
  DI void operator()(const AccT& acc, const Unit& u, int wr, int wc, int fr, int fq) const {
    const int r0 = u.pm * 256 + wr * 64 + fr, cb = u.pn * 256 + wc * 32 + 8 * fq;
    f32x4 b0[2], b1[2];
    _Pragma("unroll") for (int bj = 0; bj < 2; ++bj) { b0[bj] = *(const f32x4*)(gb + cb + bj * 128); b1[bj] = *(const f32x4*)(gb + cb + bj * 128 + 4); }
    u32x4 yc[2], gc[2], yn[2], gn_[2];
    _Pragma("unroll") for (int bj = 0; bj < 2; ++bj) { yc[bj] = *(const u32x4*)(YG + (size_t)r0 * 1024 + cb + bj * 128); gc[bj] = *(const u32x4*)(G + (size_t)r0 * 1024 + cb + bj * 128); }
    _Pragma("unroll") for (int r_ = 0; r_ < 8; ++r_) {
      const int ai = r_ >> 2, m = r_ & 3, row = r0 + 128 * ai + 16 * m;
      if (r_ + 1 < 8) { const int rown = r0 + 128 * ((r_ + 1) >> 2) + 16 * ((r_ + 1) & 3);
        _Pragma("unroll") for (int bj = 0; bj < 2; ++bj) { yn[bj] = *(const u32x4*)(YG + (size_t)rown * 1024 + cb + bj * 128); gn_[bj] = *(const u32x4*)(G + (size_t)rown * 1024 + cb + bj * 128); } }
      _Pragma("unroll") for (int bj = 0; bj < 2; ++bj) {
        const u32x4 y = yc[bj], gg = gc[bj];
        const f32x4 v0 = acc[ai][bj][m][0], v1 = acc[ai][bj][m][1];
        u32x4 w;
        w[0] = pack2(bflo(y[0]) * sigm(v0[0] + b0[bj][0]) * silu(bflo(gg[0])), bfhi(y[0]) * sigm(v0[1] + b0[bj][1]) * silu(bfhi(gg[0])));
        w[1] = pack2(bflo(y[1]) * sigm(v0[2] + b0[bj][2]) * silu(bflo(gg[1])), bfhi(y[1]) * sigm(v0[3] + b0[bj][3]) * silu(bfhi(gg[1])));
        w[2] = pack2(bflo(y[2]) * sigm(v1[0] + b1[bj][0]) * silu(bflo(gg[2])), bfhi(y[2]) * sigm(v1[1] + b1[bj][1]) * silu(bfhi(gg[2])));
        w[3] = pack2(bflo(y[3]) * sigm(v1[2] + b1[bj][2]) * silu(bflo(gg[3])), bfhi(y[3]) * sigm(v1[3] + b1[bj][3]) * silu(bfhi(gg[3])));
        *(u32x4*)(ACT + (size_t)row * 1024 + cb + bj * 128) = w;
      }
      asm_fence();
      _Pragma("unroll") for (int bj = 0; bj < 2; ++bj) { yc[bj] = yn[bj]; gc[bj] = gn_[bj]; }
    }
  }
};

struct TrJob { const float* W; bf16_t* dst; int N, ldd, k0, n0, perm, dup; };
DI TrJob tr_job(const Params& p, int j) {
  constexpr int T0 = 16 * 44, T1 = T0 + 22 * 16, T2 = T1 + 16 * 40, T3 = T2 + 256, T4 = T3 + 16 * 64, T5 = T4 + 256, T6 = T5 + 16 * 32, T7 = T6 + 256;
  char* ws = p.ws;
  TrJob t; int tile, K; t.perm = 0; t.dup = 0;
  bf16_t* base;
  if (j < T0) { t.W = p.in[7]; K = 1024; t.N = 2816; base = (bf16_t*)(ws + O_WT_IN0); tile = j; }
  else if (j < T1) { t.W = p.in[15]; K = 1408; t.N = 1024; base = (bf16_t*)(ws + O_WT_OUT0); tile = j - T0; }
  else if (j < T2) { t.W = p.in[19]; K = 1024; t.N = 2560; base = (bf16_t*)(ws + O_WT_IN1); tile = j - T1; }
  else if (j < T3) { t.W = p.in[21]; K = 1024; t.N = 1024; base = (bf16_t*)(ws + O_WT_OUT1); tile = j - T2; }
  else if (j < T4) { t.W = p.in[25]; K = 1024; t.N = 4096; base = (bf16_t*)(ws + O_WT_IN2); tile = j - T3; }
  else if (j < T5) { t.W = p.in[27]; K = 1024; t.N = 1024; base = (bf16_t*)(ws + O_WT_OUT2); tile = j - T4; }
  else if (j < T6) { t.W = p.in[31]; K = 1024; t.N = 2048; base = (bf16_t*)(ws + O_WT_IN3); tile = j - T5; }
  else if (j < T7) { t.W = p.in[40]; K = 1024; t.N = 1024; base = (bf16_t*)(ws + O_WT_GLU); tile = j - T6; }
  else { t.W = p.in[42]; K = 1024; t.N = 1024; base = (bf16_t*)(ws + O_WT_OUT3); tile = j - T7; }
  const int tn = t.N >> 6, tk_i = tile / tn;
  t.k0 = tk_i * 64; t.n0 = (tile - tk_i * tn) * 64;
  t.ldd = K;
  int drow = t.n0;
  if (j >= T1 && j < T2) {
    if (t.n0 < 1280) t.perm = 1;
    else if (t.n0 < 1536) drow = 2304 + (t.n0 - 1280);
    else drow = t.n0 - 256;
  } else if (j >= T3 && j < T4) {
    if (t.n0 >= 3072) drow = t.n0 - 1024;
    else if (t.n0 >= 2048) drow = 3072 + (t.n0 - 2048);
  }
  t.dst = base + (size_t)drow * t.ldd + t.k0;
  return t;
}

DI void transpose_range(const Params& p, char* smem, int j0, int j1, int first_blk, int skew) {
  if ((int)blockIdx.x < first_blk) return;
  float* smf = (float*)smem;
  const int G = (int)gridDim.x - first_blk;
  const int c = threadIdx.x & 63, rr = threadIdx.x >> 6, kp = threadIdx.x & 31, nb = threadIdx.x >> 5;
  int j = j0 + ((int)blockIdx.x - first_blk + G - (skew % G)) % G;
  float v[8];
  TrJob cur{};
  __syncthreads();
  if (j < j1) { cur = tr_job(p, j); _Pragma("unroll") for (int i = 0; i < 8; ++i) v[i] = __builtin_nontemporal_load(cur.W + (size_t)(cur.k0 + i * 8 + rr) * cur.N + cur.n0 + c); }
  for (; j < j1; j += G) {
    _Pragma("unroll") for (int i = 0; i < 8; ++i) smf[(i * 8 + rr) * 65 + c] = v[i];
    const TrJob me = cur;
    if (j + G < j1) { cur = tr_job(p, j + G); _Pragma("unroll") for (int i = 0; i < 8; ++i) v[i] = __builtin_nontemporal_load(cur.W + (size_t)(cur.k0 + i * 8 + rr) * cur.N + cur.n0 + c); }
    __syncthreads();
    _Pragma("unroll") for (int i = 0; i < 4; ++i) {
      const int n = nb + 16 * i;
      const int dr = me.perm ? (((n & 31) << 1) | (n >> 5)) : n;
      const unsigned w = pack2(smf[(2 * kp) * 65 + n], smf[(2 * kp + 1) * 65 + n]);
      bf16_t* d = me.dst + (size_t)dr * me.ldd + 2 * kp;
      *(unsigned*)d = w;
      if (me.dup) *(unsigned*)(d + 1408) = w;
    }
    __syncthreads();
  }
}

DI void phase0(const Params& p, char* smem) {
  char* ws = p.ws;
  float* smf = (float*)smem;
  const int NT_ = blockDim.x;
  for (int job = blockIdx.x; job < 384; job += gridDim.x) {
    const int l = job / 96, n0 = (job % 96) * 32;
    const float* aw = l == 0 ? p.in[4] : l == 1 ? p.in[16] : l == 2 ? p.in[22] : p.in[28];
    const float* ab = l == 0 ? p.in[5] : l == 1 ? p.in[17] : l == 2 ? p.in[23] : p.in[29];
    float* sv = smf;
    float* red = smf + 9 * 1024;
    for (int idx = threadIdx.x; idx < 9 * 1024; idx += NT_) {
      const int v = idx >> 10, k = idx & 1023;
      const float x = v < 8 ? p.in[1][v * 1024 + k] : p.in[3][k];
      sv[idx] = silu(x);
    }
    __syncthreads();
    const int col = threadIdx.x & 31, ks = threadIdx.x >> 5;
    float a[9];
    _Pragma("unroll") for (int v = 0; v < 9; ++v) a[v] = 0.f;
    for (int kb = ks * 64; kb < ks * 64 + 64; kb += 16) {
      float wv[16];
      _Pragma("unroll") for (int u = 0; u < 16; ++u) wv[u] = aw[(size_t)(kb + u) * 3072 + n0 + col];
      _Pragma("unroll") for (int u = 0; u < 16; ++u) _Pragma("unroll") for (int v = 0; v < 9; ++v) a[v] += sv[v * 1024 + kb + u] * wv[u];
    }
    _Pragma("unroll") for (int v = 0; v < 9; ++v) red[(ks * 9 + v) * 32 + col] = a[v];
    __syncthreads();
    float* MOD = (float*)(ws + O_MOD);
    for (int idx = threadIdx.x; idx < 9 * 32; idx += NT_) {
      const int v = idx >> 5, cc = idx & 31;
      float sum = ab[n0 + cc];
      _Pragma("unroll") for (int q = 0; q < 16; ++q) sum += red[(q * 9 + v) * 32 + cc];
      MOD[(size_t)(l * 9 + v) * 3072 + n0 + cc] = sum;
    }
    __syncthreads();
  }
  transpose_range(p, smem, 0, 16 * 44, gridDim.x == 256 ? 128 : 0, 0);
}

DI void tables_phase(const Params& p, int first_blk) {
  if ((int)blockIdx.x < first_blk) return;
  char* ws = p.ws;
  const int gt = ((int)blockIdx.x - first_blk) * blockDim.x + threadIdx.x, gn = ((int)gridDim.x - first_blk) * blockDim.x;
  {
    bf16_t* WG = (bf16_t*)(ws + O_WG);
    for (int idx = gt; idx < 16 * 2 * 192 * 96; idx += gn) {
      const int kk = idx % 96; int t = idx / 96; const int n = t % 192; t /= 192; const int d = t & 1, k = t >> 1;
      const int c = n >> 5, gate = (n >> 4) & 1, ch = c * 16 + (n & 15);
      float v = 0.f;
      if (ch < 88 && kk < 88) { const float* w = gate ? p.in[12] : p.in[10]; v = w[((size_t)(d * 16 + k) * 88 + kk) * 88 + ch]; }
      WG[idx] = f2bf(v);
    }
  }
  { float* SS = (float*)(ws + O_SS); for (int idx = gt; idx < 3 * R; idx += gn) SS[idx] = 0.f; }
  {
    float* RCt = (float*)(ws + O_ROPEC); float* RSt = (float*)(ws + O_ROPES);
    for (int idx = gt; idx < 2048 * 32; idx += gn) {
      const int t = idx >> 5, j = idx & 31;
      const float pos = (float)(j < 16 ? (t >> 6) : (t & 63));
      const float freq = exp2f(-(float)(j & 15) * (13.287712379549449f / 16.f));
      float s, c; sincos_rev(pos * freq * 0.15915494309189535f, s, c);
      RCt[idx] = c; RSt[idx] = s;
    }
  }
  {
    float2* POW = (float2*)(ws + O_POW); float2* BB = (float2*)(ws + O_BBAR);
    for (int idx = gt; idx < 2 * 64 * 17 * 64; idx += gn) {
      const int pp = idx & 63; int t = idx >> 6; const int n = t % 17; t /= 17;
      const float are = p.in[32][t * 64 + pp], aim = p.in[33][t * 64 + pp], dt = expf(p.in[34][t]);
      const float mag = expf((float)n * are * dt);
      const double rev = (double)n * (double)aim * (double)dt * 0.15915494309189535;
      float s, c; sincos_rev((float)(rev - rint(rev)), s, c);
      POW[idx] = make_float2(mag * c, mag * s);
    }
    for (int idx = gt; idx < 2 * 64 * 64 * 16; idx += gn) {
      const int t = idx >> 4;
      const int dg = t >> 6;
      const float are = p.in[32][t], aim = p.in[33][t], dt = expf(p.in[34][dg]);
      const float mag = expf(are * dt);
      const double rev = (double)aim * (double)dt * 0.15915494309189535;
      float s, c; sincos_rev((float)(rev - rint(rev)), s, c);
      const float nr = mag * c - 1.f, ni = mag * s;
      const float den = 1.f / (are * are + aim * aim);
      const float cr = (nr * are + ni * aim) * den, ci = (ni * are - nr * aim) * den;
      const float br = p.in[35][idx], bi = p.in[36][idx];
      BB[idx] = make_float2(cr * br - ci * bi, cr * bi + ci * br);
    }
  }
}

DI void modfold_phase(const Params& p, char* smem) {
  char* ws = p.ws;
  const float* MOD = (const float*)(ws + O_MOD);
  float* GS = (float*)(ws + O_GS);
  float* SHW = (float*)(ws + O_SHW);
  const int NT_ = blockDim.x;
  for (int idx = blockIdx.x * NT_ + threadIdx.x; idx < 3 * 9 * 1024; idx += gridDim.x * NT_) {
    const int k = idx & 1023, lv = idx >> 10, l = lv / 9 + 1, v = lv - (l - 1) * 9;
    const float* gn = l == 1 ? p.in[18] : l == 2 ? p.in[24] : p.in[30];
    GS[idx] = gn[k] * (1.f + MOD[(size_t)(l * 9 + v) * 3072 + 1024 + k]);
  }
  float* smf = (float*)smem;
  float* sv = smf;
  float* red = smf + 9 * 1024;
  for (int job = (int)gridDim.x - 1 - (int)blockIdx.x; job < 80 + 128 + 64; job += gridDim.x) {
    int l, n0; const float* W; int N;
    if (job < 80) { l = 1; n0 = job * 32; W = p.in[19]; N = 2560; }
    else if (job < 208) { l = 2; n0 = (job - 80) * 32; W = p.in[25]; N = 4096; }
    else { l = 3; n0 = (job - 208) * 32; W = p.in[31]; N = 2048; }
    __syncthreads();
    for (int idx = threadIdx.x; idx < 9 * 1024; idx += NT_) sv[idx] = MOD[(size_t)(l * 9 + (idx >> 10)) * 3072 + (idx & 1023)];
    __syncthreads();
    const int col = threadIdx.x & 31, ks = threadIdx.x >> 5;
    float a[9];
    _Pragma("unroll") for (int v = 0; v < 9; ++v) a[v] = 0.f;
    for (int kb = ks * 64; kb < ks * 64 + 64; kb += 16) {
      float wv[16];
      _Pragma("unroll") for (int u = 0; u < 16; ++u) wv[u] = W[(size_t)(kb + u) * N + n0 + col];
      _Pragma("unroll") for (int u = 0; u < 16; ++u) _Pragma("unroll") for (int v = 0; v < 9; ++v) a[v] += sv[v * 1024 + kb + u] * wv[u];
    }
    _Pragma("unroll") for (int v = 0; v < 9; ++v) red[(ks * 9 + v) * 32 + col] = a[v];
    __syncthreads();
    for (int idx = threadIdx.x; idx < 9 * 32; idx += NT_) {
      const int v = idx >> 5, cc = idx & 31;
      float sum = 0.f;
      _Pragma("unroll") for (int q = 0; q < 16; ++q) sum += red[(q * 9 + v) * 32 + cc];
      SHW[(size_t)((l - 1) * 9 + v) * 4096 + n0 + cc] = sum;
    }
  }
  __syncthreads();
}

DI void norm_phase(const float* lat, const float* ctx, const float* gn, const float* mod  , bf16_t* NB_) {
  const int tid_ = opaque_tid();
  const int lane = tid_ & 63;
  const int w0 = blockIdx.x * 8 + (tid_ >> 6), nw = gridDim.x * 8;
  for (int row0 = w0 * 2; row0 < R; row0 += nw * 2) {
    f32x4 v[2][4]; float ss[2] = {0.f, 0.f};
    const float* m[2];
    _Pragma("unroll") for (int q = 0; q < 2; ++q) {
      const int row = row0 + q;
      const float* src;
      if (row < RL) { src = lat + (size_t)row * 1024; m[q] = mod + (size_t)(row >> 11) * 3072; }
      else { src = ctx + (size_t)(row - RL) * 1024; m[q] = mod + (size_t)8 * 3072; }
      _Pragma("unroll") for (int i = 0; i < 4; ++i) v[q][i] = __builtin_nontemporal_load((const f32x4*)(src + (i * 64 + lane) * 4));
    }
    _Pragma("unroll") for (int q = 0; q < 2; ++q) {
      _Pragma("unroll") for (int i = 0; i < 4; ++i) ss[q] += v[q][i][0] * v[q][i][0] + v[q][i][1] * v[q][i][1] + v[q][i][2] * v[q][i][2] + v[q][i][3] * v[q][i][3];
      _Pragma("unroll") for (int o = 32; o >= 1; o >>= 1) ss[q] += __shfl_xor(ss[q], o);
    }
    _Pragma("unroll") for (int q = 0; q < 2; ++q) {
      const float rstd = rsqrtf(ss[q] * (1.f / 1024.f) + 1e-6f);
      _Pragma("unroll") for (int i = 0; i < 4; ++i) {
        const int k = (i * 64 + lane) * 4;
        const f32x4 g = *(const f32x4*)(gn + k), sh = *(const f32x4*)(m[q] + k), sc = *(const f32x4*)(m[q] + 1024 + k);
        u32x2 o;
        o[0] = pack2(v[q][i][0] * rstd * g[0] * (1.f + sc[0]) + sh[0], v[q][i][1] * rstd * g[1] * (1.f + sc[1]) + sh[1]);
        o[1] = pack2(v[q][i][2] * rstd * g[2] * (1.f + sc[2]) + sh[2], v[q][i][3] * rstd * g[3] * (1.f + sc[3]) + sh[3]);
        *(u32x2*)(NB_ + (size_t)(row0 + q) * 1024 + k) = o;
      }
    }
  }
}

DI void final_norm_phase(float* H, const float* gn) {
  const int tid_ = opaque_tid();
  const int lane = tid_ & 63;
  const int w0 = blockIdx.x * 8 + (tid_ >> 6), nw = gridDim.x * 8;
  for (int row0 = w0 * 2; row0 < RL; row0 += nw * 2) {
    f32x4 v[2][4]; float ss[2] = {0.f, 0.f};
    _Pragma("unroll") for (int q = 0; q < 2; ++q) _Pragma("unroll") for (int i = 0; i < 4; ++i) v[q][i] = __builtin_nontemporal_load((const f32x4*)(H + (size_t)(row0 + q) * 1024 + (i * 64 + lane) * 4));
    _Pragma("unroll") for (int q = 0; q < 2; ++q) {
      _Pragma("unroll") for (int i = 0; i < 4; ++i) ss[q] += v[q][i][0] * v[q][i][0] + v[q][i][1] * v[q][i][1] + v[q][i][2] * v[q][i][2] + v[q][i][3] * v[q][i][3];
      _Pragma("unroll") for (int o = 32; o >= 1; o >>= 1) ss[q] += __shfl_xor(ss[q], o);
    }
    _Pragma("unroll") for (int q = 0; q < 2; ++q) {
      const float rstd = rsqrtf(ss[q] * (1.f / 1024.f) + 1e-6f);
      _Pragma("unroll") for (int i = 0; i < 4; ++i) {
        const int k = (i * 64 + lane) * 4;
        const f32x4 g = *(const f32x4*)(gn + k);
        f32x4 o; o[0] = v[q][i][0] * rstd * g[0]; o[1] = v[q][i][1] * rstd * g[1]; o[2] = v[q][i][2] * rstd * g[2]; o[3] = v[q][i][3] * rstd * g[3];
        __builtin_nontemporal_store(o, (f32x4*)(H + (size_t)(row0 + q) * 1024 + k));
      }
    }
  }
}

DI void lru_phase(const Params& p, char* smem) {
  char* ws = p.ws;
  const int tid_ = opaque_tid();
  const int sub = tid_ >> 8;
  smem += sub * 36864;
  bf16_t* Wl = (bf16_t*)smem;
  bf16_t* Uc = Wl + 96 * 96;
  float* aggA = (float*)(Uc + 64 * 96);
  float* aggH = aggA + 16 * 48;
  const bf16_t* U0 = (const bf16_t*)(ws + O_U0);
  const bf16_t* G0 = (const bf16_t*)(ws + O_G0);
  const int tid = tid_ & 255, lane = tid & 63, w = tid >> 6, col = lane & 15, quad = lane >> 4;
  const int vbl = (gridDim.x % 8 == 0) ? (blockIdx.x & 7) * (gridDim.x >> 3) + (blockIdx.x >> 3) : blockIdx.x;
  for (int item = vbl; item < 256; item += gridDim.x) {
    const int half = item & 1, dir = sub, k = (item >> 1) & 15, b = item >> 5;
    bf16_t* ACT = (bf16_t*)(ws + O_ACT0);
    __syncthreads();
    {
      const u32x4* src = (const u32x4*)((const bf16_t*)(ws + O_WG) + ((size_t)(k * 2 + dir) * 192 + half * 96) * 96);
      u32x4* dst = (u32x4*)Wl;
      for (int i = tid; i < 96 * 96 / 8; i += 256) dst[i] = src[i];
      if (tid < 64) { u32x4 z; z[0] = z[1] = z[2] = z[3] = 0u; *(u32x4*)(Uc + tid * 96 + 88) = z; }
    }
    float ba[3], bx[3], sp8[3];
    _Pragma("unroll") for (int c = 0; c < 3; ++c) {
      const int ch = 48 * half + 16 * c + col;
      if (ch < 88) {
        ba[c] = p.in[11][dir * LW + k * 88 + ch]; bx[c] = p.in[13][dir * LW + k * 88 + ch];
        sp8[c] = 8.f * log1pf(expf(-p.in[14][dir * LW + k * 88 + ch]));
      } else { ba[c] = 0.f; bx[c] = 0.f; sp8[c] = 0.f; }
    }
    const int cp = tid % 44, run = tid / 44;
    float cw[4][2], cb2[2];
    _Pragma("unroll") for (int t = 0; t < 4; ++t) { cw[t][0] = p.in[8][t * LW + k * 88 + 2 * cp]; cw[t][1] = p.in[8][t * LW + k * 88 + 2 * cp + 1]; }
    cb2[0] = p.in[9][k * 88 + 2 * cp]; cb2[1] = p.in[9][k * 88 + 2 * cp + 1];
    float carry = 0.f;
    unsigned un[19]; unsigned unmask = 0u;
    auto tile_info = [&](int ti, int& rowbase, int& L, int& t0) {
      if (ti < 4) { rowbase = RL + b * 256; L = 256; t0 = (dir ? 3 - ti : ti) * 64; }
      else { rowbase = b * 2048; L = 2048; t0 = (dir ? 31 - (ti - 4) : (ti - 4)) * 64; }
    };
    auto prefetch = [&](int ti) {
      int rowbase, L, t0; tile_info(ti, rowbase, L, t0);
      const unsigned* ub = (const unsigned*)(U0 + (size_t)rowbase * LW + k * 88 + 2 * cp);
      const int tb = t0 + 16 * (run < 4 ? run : 3) - 2;
      unsigned vm = 0u;
      _Pragma("unroll") for (int i = 0; i < 19; ++i) {
        const int tt = tb + i;
        un[i] = ub[(unsigned)min(max(tt, 0), L - 1) * (unsigned)(LW / 2)];
        vm |= (tt >= 0 && tt < L) ? (1u << i) : 0u;
      }
      unmask = vm;
    };
    prefetch(0);
    for (int ti = 0; ti < 36; ++ti) {
      int rowbase, L, t0; tile_info(ti, rowbase, L, t0);
      if (tid < 176) {
        if (unmask != 0x7ffffu) { _Pragma("unroll") for (int i = 0; i < 19; ++i) un[i] = ((unmask >> i) & 1u) ? un[i] : 0u; }
        _Pragma("unroll") for (int t = 0; t < 16; ++t) {
          const float y0 = cb2[0] + cw[0][0] * bflo(un[t]) + cw[1][0] * bflo(un[t + 1]) + cw[2][0] * bflo(un[t + 2]) + cw[3][0] * bflo(un[t + 3]);
          const float y1 = cb2[1] + cw[0][1] * bfhi(un[t]) + cw[1][1] * bfhi(un[t + 1]) + cw[2][1] * bfhi(un[t + 2]) + cw[3][1] * bfhi(un[t + 3]);
          *(unsigned*)(Uc + (16 * run + t) * 96 + 2 * cp) = pack2(y0, y1);
        }
      }
      if (ti + 1 < 36) prefetch(ti + 1);
      bf16_t gv[3][4];
      _Pragma("unroll") for (int c = 0; c < 3; ++c) {
        const int ch = 48 * half + 16 * c + col;
        _Pragma("unroll") for (int j = 0; j < 4; ++j)
          gv[c][j] = G0[(unsigned)(rowbase + t0 + 16 * w + 4 * quad) * (unsigned)LW + (unsigned)(j * LW + k * 88 + min(ch, 87))];
      }
      const bool second = ti < 4 ? (ti >= 2) : (ti >= 20);
      const bool adjacent = (ti == 2) || (ti == 20);
      bf16_t pv[3][4];
      if (second && !adjacent) {
        _Pragma("unroll") for (int c = 0; c < 3; ++c) {
          const int ch = 48 * half + 16 * c + col;
          _Pragma("unroll") for (int j = 0; j < 4; ++j) pv[c][j] = ACT[(unsigned)(rowbase + t0 + 16 * w + 4 * quad) * (unsigned)LW + (unsigned)(j * LW + k * 88 + min(ch, 87))];
        }
      } else { _Pragma("unroll") for (int c = 0; c < 3; ++c) _Pragma("unroll") for (int j = 0; j < 4; ++j) pv[c][j] = (bf16_t)0; }
      __syncthreads();
      bf16x8 af[3];
      _Pragma("unroll") for (int ks = 0; ks < 3; ++ks) af[ks] = *(const bf16x8*)(Uc + (16 * w + col) * 96 + ks * 32 + quad * 8);
      float hl[3][4], ac[3][4];
      _Pragma("unroll") for (int c = 0; c < 3; ++c) {
        f32x4 gA = {0.f, 0.f, 0.f, 0.f}, gX = {0.f, 0.f, 0.f, 0.f};
        _Pragma("unroll") for (int ks = 0; ks < 3; ++ks) {
          const bf16x8 bA = *(const bf16x8*)(Wl + ((c * 2 + 0) * 16 + col) * 96 + ks * 32 + quad * 8);
          const bf16x8 bX = *(const bf16x8*)(Wl + ((c * 2 + 1) * 16 + col) * 96 + ks * 32 + quad * 8);
          gA = MFMA16(af[ks], bA, gA);
          gX = MFMA16(af[ks], bX, gX);
        }
        float a[4], bb[4];
        _Pragma("unroll") for (int j = 0; j < 4; ++j) {
          const float uval = bf2f(Uc[(16 * w + 4 * quad + j) * 96 + 48 * half + 16 * c + col]);
          const float rg = sigm(gA[j] + ba[c]), ig = sigm(gX[j] + bx[c]);
          a[j] = __expf(-sp8[c] * rg);
          bb[j] = __builtin_amdgcn_sqrtf(fmaxf(1.f - a[j] * a[j], 0.f)) * ig * uval;
        }
        if (dir == 0) {
          hl[c][0] = bb[0]; ac[c][0] = a[0];
          _Pragma("unroll") for (int j = 1; j < 4; ++j) { hl[c][j] = a[j] * hl[c][j - 1] + bb[j]; ac[c][j] = a[j] * ac[c][j - 1]; }
          aggA[(4 * w + quad) * 48 + 16 * c + col] = ac[c][3]; aggH[(4 * w + quad) * 48 + 16 * c + col] = hl[c][3];
        } else {
          hl[c][3] = bb[3]; ac[c][3] = a[3];
          _Pragma("unroll") for (int j = 2; j >= 0; --j) { hl[c][j] = a[j] * hl[c][j + 1] + bb[j]; ac[c][j] = a[j] * ac[c][j + 1]; }
          aggA[(4 * w + quad) * 48 + 16 * c + col] = ac[c][0]; aggH[(4 * w + quad) * 48 + 16 * c + col] = hl[c][0];
        }
      }
      asm volatile("s_waitcnt vmcnt(0)" ::: "memory");
      __syncthreads();
      if (adjacent) {
        _Pragma("unroll") for (int c = 0; c < 3; ++c) {
          const int ch = 48 * half + 16 * c + col;
          _Pragma("unroll") for (int j = 0; j < 4; ++j)
            pv[c][j] = ACT[(unsigned)(rowbase + t0 + 16 * w + 4 * quad) * (unsigned)LW + (unsigned)(j * LW + k * 88 + min(ch, 87))];
        }
      }
      if (tid < 48) {
        float A_[16], H_[16];
        _Pragma("unroll") for (int s_ = 0; s_ < 16; ++s_) { A_[s_] = aggA[s_ * 48 + tid]; H_[s_] = aggH[s_ * 48 + tid]; }
        float cin = carry;
        if (dir == 0) { _Pragma("unroll") for (int s_ = 0; s_ < 16; ++s_) { aggA[s_ * 48 + tid] = cin; cin = A_[s_] * cin + H_[s_]; } }
        else { _Pragma("unroll") for (int s_ = 15; s_ >= 0; --s_) { aggA[s_ * 48 + tid] = cin; cin = A_[s_] * cin + H_[s_]; } }
        carry = cin;
      }
      __syncthreads();
      _Pragma("unroll") for (int c = 0; c < 3; ++c) {
        const int ch = 48 * half + 16 * c + col;
        if (ch < 88) {
          const float cin = aggA[(4 * w + quad) * 48 + 16 * c + col];
          _Pragma("unroll") for (int j = 0; j < 4; ++j) {
            const unsigned idx = (unsigned)(rowbase + t0 + 16 * w + 4 * quad) * (unsigned)LW + (unsigned)(j * LW + k * 88 + ch);
            const float hv = hl[c][j] + ac[c][j] * cin;
            ACT[idx] = f2bf(hv * silu(bf2f(gv[c][j])) + bf2f(pv[c][j]));
          }
        }
      }

    }
  }
}

struct AttnSt { f32x16 O0, O1; float m, l; };
DI bf16x8 ld16(const bf16_t* p) { return *(const bf16x8*)p; }
DI bf16x8 ld8x2(const bf16_t* p0) { const s16x4 a = *(const s16x4*)p0; const s16x4 b = *(const s16x4*)(p0 + 8); return __builtin_shufflevector(a, b, 0, 1, 2, 3, 4, 5, 6, 7); }
DI bf16x8 pack8(const f32x16& P, int s) {
  u32x4 u;
  _Pragma("unroll") for (int j = 0; j < 4; ++j) u[j] = pack2(P[8 * s + 2 * j], P[8 * s + 2 * j + 1]);
  return __builtin_bit_cast(bf16x8, u);
}

struct KVt { bf16x8 k0, k1, k2, k3, v00, v01, v10, v11; };
DI void attn_load(KVt& t, const bf16_t* kt_, const bf16_t* vt_) {
  t.k0 = ld16(kt_); t.k1 = ld16(kt_ + 512); t.k2 = ld16(kt_ + 1024); t.k3 = ld16(kt_ + 1536);
  t.v00 = ld16(vt_); t.v01 = ld16(vt_ + 512); t.v10 = ld16(vt_ + 1024); t.v11 = ld16(vt_ + 1536);
}
template <class F>
DI void attn_compute(AttnSt& st, const bf16x8 (&qf)[4], const KVt& t, F fmod) {
  f32x16 S = zero16();
  S = MFMA32(t.k0, qf[0], S); S = MFMA32(t.k1, qf[1], S); S = MFMA32(t.k2, qf[2], S); S = MFMA32(t.k3, qf[3], S);
  float mx = -3.0e38f;
  _Pragma("unroll") for (int i = 0; i < 16; ++i) { S[i] = fmod(i, S[i]); mx = fmaxf(mx, S[i]); }
  mx = fmaxf(mx, __shfl_xor(mx, 32));
  const float mn = fmaxf(st.m, mx);
  float ls = 0.f;
  f32x16 P;
  _Pragma("unroll") for (int i = 0; i < 16; ++i) { P[i] = __builtin_amdgcn_exp2f(S[i] - mn); ls += P[i]; }
  if (__builtin_amdgcn_ballot_w64(mn > st.m) != 0ull) {
    const float alpha = __builtin_amdgcn_exp2f(st.m - mn);
    st.m = mn;
    st.l *= alpha;
    _Pragma("unroll") for (int i = 0; i < 16; ++i) { st.O0[i] *= alpha; st.O1[i] *= alpha; }
  }
  st.l += ls;
  const bf16x8 p0 = pack8(P, 0), p1 = pack8(P, 1);
  st.O0 = MFMA32(t.v00, p0, st.O0); st.O0 = MFMA32(t.v01, p1, st.O0);
  st.O1 = MFMA32(t.v10, p0, st.O1); st.O1 = MFMA32(t.v11, p1, st.O1);
}

struct GPre { u32x2 g0[4], g1[4]; };
DI void attn_gload(GPre& gp, const bf16_t* Grow  , int h) {
  _Pragma("unroll") for (int q = 0; q < 4; ++q) { gp.g0[q] = *(const u32x2*)(Grow + 8 * q + 4 * h); gp.g1[q] = *(const u32x2*)(Grow + 32 + 8 * q + 4 * h); }
}
DI void attn_finish(AttnSt& st, const GPre& gp, bf16_t* Arow  , int h) {
  const float lt = st.l + __shfl_xor(st.l, 32);
  const float inv = frcp(lt);
  unsigned w0[4][2], w1[4][2];
  _Pragma("unroll") for (int q = 0; q < 4; ++q) {
    const u32x2 g0 = gp.g0[q], g1 = gp.g1[q];
    w0[q][0] = pack2(st.O0[4 * q + 0] * inv * silu(bflo(g0[0])), st.O0[4 * q + 1] * inv * silu(bfhi(g0[0])));
    w0[q][1] = pack2(st.O0[4 * q + 2] * inv * silu(bflo(g0[1])), st.O0[4 * q + 3] * inv * silu(bfhi(g0[1])));
    w1[q][0] = pack2(st.O1[4 * q + 0] * inv * silu(bflo(g1[0])), st.O1[4 * q + 1] * inv * silu(bfhi(g1[0])));
    w1[q][1] = pack2(st.O1[4 * q + 2] * inv * silu(bflo(g1[1])), st.O1[4 * q + 3] * inv * silu(bfhi(g1[1])));
  }
  _Pragma("unroll") for (int qp = 0; qp < 2; ++qp) {
    const int q = 2 * qp;
    {
      const auto s0 = __builtin_amdgcn_permlane32_swap(w0[q][0], w0[q + 1][0], false, false);
      const auto s1 = __builtin_amdgcn_permlane32_swap(w0[q][1], w0[q + 1][1], false, false);
      u32x4 o; o[0] = s0[0]; o[1] = s1[0]; o[2] = s0[1]; o[3] = s1[1];
      *(u32x4*)(Arow + 8 * q + 8 * h) = o;
    }
    {
      const auto s0 = __builtin_amdgcn_permlane32_swap(w1[q][0], w1[q + 1][0], false, false);
      const auto s1 = __builtin_amdgcn_permlane32_swap(w1[q][1], w1[q + 1][1], false, false);
      u32x4 o; o[0] = s0[0]; o[1] = s1[0]; o[2] = s0[1]; o[3] = s1[1];
      *(u32x4*)(Arow + 32 + 8 * q + 8 * h) = o;
    }
  }
}

DI void swa_phase(const Params& p) {
  char* ws = p.ws;
  const bf16_t* Q = (const bf16_t*)(ws + O_Q1); const bf16_t* QR = (const bf16_t*)(ws + O_QR1); const bf16_t* Kb = (const bf16_t*)(ws + O_K1);
  const bf16_t* VtL = (const bf16_t*)(ws + O_VTL1); const bf16_t* VtC = (const bf16_t*)(ws + O_VTC1);
  const bf16_t* G = (const bf16_t*)(ws + O_G1); bf16_t* ACT = (bf16_t*)(ws + O_ACT1);
  const float* sink = p.in[20];
  const int tid_ = opaque_tid();
  const int lane = tid_ & 63, r = lane & 31, h = lane >> 5;
  const int vb_ = (gridDim.x % 8 == 0) ? (blockIdx.x & 7) * (gridDim.x >> 3) + (blockIdx.x >> 3) : blockIdx.x;
  const int wid = vb_ * 8 + (tid_ >> 6), nw = gridDim.x * 8;
  auto ident = [](int, float s) { return s; };
  auto do_item = [&](int it) {
    int b, kvh, g4, qt; const bool lat = it < 8192;
    if (lat) { g4 = it & 3; qt = (it >> 2) & 63; kvh = (it >> 8) & 3; b = it >> 10; }
    else { const int j = it - 8192; g4 = j & 3; qt = (j >> 2) & 7; kvh = (j >> 5) & 3; b = j >> 7; }
    const int head = kvh * 4 + g4;
    const size_t qrow = lat ? (size_t)b * 2048 + qt * 32 + r : (size_t)RL + b * 256 + qt * 32 + r;
    AttnSt st; st.O0 = zero16(); st.O1 = zero16(); st.m = sink[head] * 1.4426950408889634f; st.l = h == 0 ? 1.f : 0.f;
    bf16x8 qf[4], qfr[4];
    _Pragma("unroll") for (int ks = 0; ks < 4; ++ks) qf[ks] = ld16(Q + qrow * 1024 + head * 64 + ks * 16 + 8 * h);
    GPre gp; attn_gload(gp, G + qrow * 1024 + head * 64, h);
    if (lat) { _Pragma("unroll") for (int ks = 0; ks < 4; ++ks) qfr[ks] = ld16(QR + qrow * 1024 + head * 64 + ks * 16 + 8 * h); }
    else { _Pragma("unroll") for (int ks = 0; ks < 4; ++ks) qfr[ks] = qf[ks]; }
    const bf16_t* kc = Kb + (size_t)RL * 256 + (size_t)(b * 4 + kvh) * 8 * 2048 + lane * 8;
    const bf16_t* vc = VtC + (size_t)(b * 4 + kvh) * 8 * 2048 + lane * 8;
    const bf16_t* kl = Kb + (size_t)(b * 4 + kvh) * 64 * 2048 + lane * 8;
    const bf16_t* vl = VtL + (size_t)(b * 4 + kvh) * 64 * 2048 + lane * 8;
    const int kt_lo = max(qt - 4, 0), kt_hi = min(qt + 4, 63);
    const int nt = lat ? 8 + (kt_hi - kt_lo + 1) : 8;
    auto load_tile = [&](int j, KVt& t) {
      if (j < 8) attn_load(t, kc + (size_t)j * 2048, vc + (size_t)j * 2048);
      else { const int kt = kt_lo + j - 8; attn_load(t, kl + (size_t)kt * 2048, vl + (size_t)kt * 2048); }
    };
    KVt cur, nxt;
    load_tile(0, cur);
    for (int j = 0; j < 8; ++j) {
      nxt = cur;
      if (j + 1 < nt) load_tile(j + 1, nxt);
      attn_compute(st, qf, cur, ident);
      cur = nxt;
    }
    for (int j = 8; j < nt; ++j) {
      nxt = cur;
      if (j + 1 < nt) load_tile(j + 1, nxt);
      const int kt = kt_lo + j - 8;
      if (kt == qt - 4 || kt == qt + 4) {
        const int dq = qt * 32 + r - kt * 32;
        attn_compute(st, qfr, cur, [&](int i, float s) { const int d = dq - crow(i, h); return (d <= 128 && d >= -128) ? s : -1.0e30f; });
      } else attn_compute(st, qfr, cur, ident);
      cur = nxt;
    }
    attn_finish(st, gp, ACT + qrow * 1024 + head * 64, h);
  };
  for (int it = wid; it < 8192; it += nw) do_item(it);
  if (nw == 2048) {
    if ((wid & 7) < 4) do_item(8192 + (wid >> 3) * 4 + (wid & 3));
  } else { for (int it = 8192 + wid; it < 8192 + 1024; it += nw) do_item(it); }
}

DI void na_phase(const Params& p, char* smem) {
  char* ws = p.ws;
  const bf16_t* Q = (const bf16_t*)(ws + O_Q2); const bf16_t* Kb = (const bf16_t*)(ws + O_K2);
  const bf16_t* VtL = (const bf16_t*)(ws + O_VTL2); const bf16_t* VtC = (const bf16_t*)(ws + O_VTC2);
  const bf16_t* G = (const bf16_t*)(ws + O_G2); bf16_t* ACT = (bf16_t*)(ws + O_ACT2);
  float* rpbs = (float*)smem + 64;
  __syncthreads();
  for (int i = threadIdx.x; i < 16 * 15 * 31; i += blockDim.x) rpbs[i] = p.in[26][i] * 1.4426950408889634f;
  __syncthreads();
  const int tid_ = opaque_tid();
  const int lane = tid_ & 63, r = lane & 31, h = lane >> 5;
  const int vb_ = (gridDim.x % 8 == 0) ? (blockIdx.x & 7) * (gridDim.x >> 3) + (blockIdx.x >> 3) : blockIdx.x;
  const int wid = vb_ * 8 + (tid_ >> 6), nw = gridDim.x * 8;
  auto ident = [](int, float s) { return s; };
  auto do_item = [&](int it) {
    int b, head, half, gr; const bool lat = it < 8192;
    if (lat) { half = it & 1; head = (it >> 1) & 15; gr = (it >> 5) & 31; b = it >> 10; }
    else { const int j = it - 8192; half = 0; head = j & 15; gr = (j >> 4) & 7; b = j >> 7; }
    const size_t qrow = lat ? (size_t)b * 2048 + gr * 64 + half * 32 + r : (size_t)RL + b * 256 + gr * 32 + r;
    AttnSt st; st.O0 = zero16(); st.O1 = zero16(); st.m = -1.0e30f; st.l = 0.f;
    bf16x8 qf[4];
    _Pragma("unroll") for (int ks = 0; ks < 4; ++ks) qf[ks] = ld16(Q + qrow * 1024 + head * 64 + ks * 16 + 8 * h);
    GPre gp; attn_gload(gp, G + qrow * 1024 + head * 64, h);
    const bf16_t* kc = Kb + (size_t)RL * 1024 + (size_t)(b * 16 + head) * 8 * 2048 + lane * 8;
    const bf16_t* vc = VtC + (size_t)(b * 16 + head) * 8 * 2048 + lane * 8;
    const bf16_t* kl = Kb + (size_t)(b * 16 + head) * 64 * 2048 + lane * 8;
    const bf16_t* vl = VtL + (size_t)(b * 16 + head) * 64 * 2048 + lane * 8;
    const int cq = half * 32 + r;
    const int cs = min(max(cq - 8, 0), 48);
    const int rs_ = min(max(gr - 4, 0), 24);
    const int nt = lat ? 24 : 8;
    auto load_tile = [&](int j, KVt& t) {
      if (j < 8) attn_load(t, kc + (size_t)j * 2048, vc + (size_t)j * 2048);
      else { const int kt = (rs_ + ((j - 8) >> 1)) * 2 + ((j - 8) & 1); attn_load(t, kl + (size_t)kt * 2048, vl + (size_t)kt * 2048); }
    };
    KVt cur, nxt;
    load_tile(0, cur);
    for (int j = 0; j < 8; ++j) {
      nxt = cur;
      if (j + 1 < nt) load_tile(j + 1, nxt);
      attn_compute(st, qf, cur, ident);
      cur = nxt;
    }
    unsigned okm[2] = {0u, 0u};
    _Pragma("unroll") for (int ct = 0; ct < 2; ++ct) _Pragma("unroll") for (int i = 0; i < 16; ++i) {
      const int ck = ct * 32 + crow(i, h);
      okm[ct] |= ((ck >= cs) && (ck < cs + 16)) ? (1u << i) : 0u;
    }
    const int dxb = 4 * h - cq + 15;
    for (int j = 8; j < nt; j += 2) {
      const int krow = rs_ + ((j - 8) >> 1);
      const float* rp = rpbs + (head * 15 + (krow - gr + 7)) * 31 + dxb;
      nxt = cur;
      load_tile(j + 1, nxt);
      attn_compute(st, qf, cur, [&](int i, float s) { const float sb = s + rp[(i & 3) + 8 * (i >> 2)]; return ((okm[0] >> i) & 1u) ? sb : -1.0e30f; });
      cur = nxt;
      if (j + 2 < nt) load_tile(j + 2, nxt);
      attn_compute(st, qf, cur, [&](int i, float s) { const float sb = s + rp[32 + (i & 3) + 8 * (i >> 2)]; return ((okm[1] >> i) & 1u) ? sb : -1.0e30f; });
      cur = nxt;
    }
    attn_finish(st, gp, ACT + qrow * 1024 + head * 64, h);
  };
  for (int it = wid; it < 8192; it += nw) do_item(it);
  if (nw == 2048) {
    if ((wid & 7) < 4) do_item(8192 + (wid >> 3) * 4 + (wid & 3));
  } else { for (int it = 8192 + wid; it < 8192 + 1024; it += nw) do_item(it); }
}

DI void s5_mats_phase(const Params& p, int which, int first_blk) {
  if ((int)blockIdx.x < first_blk) return;
  char* ws = p.ws;
  const float2* POW = (const float2*)(ws + O_POW); const float2* BB = (const float2*)(ws + O_BBAR);
  bf16_t* GT = (bf16_t*)(ws + O_GT); bf16_t* MYT = (bf16_t*)(ws + O_MYT);
  const float* cre = p.in[37]; const float* cim = p.in[38]; const float* dsk = p.in[39];
  const int gt = ((int)blockIdx.x - first_blk) * blockDim.x + threadIdx.x, gn = ((int)gridDim.x - first_blk) * blockDim.x;
  if (which == 2) {
    for (int idx0 = gt; idx0 < 64 * 256 * 256; idx0 += 4 * gn) {
      float2 pw1[4], bb1[4];
      _Pragma("unroll") for (int u = 0; u < 4; ++u) {
        const int idx = min(idx0 + u * gn, 64 * 256 * 256 - 1);
        const int g = idx >> 16, n = (idx >> 8) & 255, k = idx & 255;
        const int dir = n >> 7, pp = (n >> 1) & 63, i = k >> 4, c = k & 15, e = dir ? i : 15 - i;
        pw1[u] = POW[((size_t)(dir * 64 + g) * 17 + e) * 64 + pp]; bb1[u] = BB[((size_t)(dir * 64 + g) * 64 + pp) * 16 + c];
      }
      _Pragma("unroll") for (int u = 0; u < 4; ++u) {
        const int idx = idx0 + u * gn;
        if (idx < 64 * 256 * 256) {
          const float zr = pw1[u].x * bb1[u].x - pw1[u].y * bb1[u].y, zi = pw1[u].x * bb1[u].y + pw1[u].y * bb1[u].x;
          GT[idx] = f2bf(((idx >> 8) & 1) ? zi : zr);
        }
      }
    }
    return;
  }
  for (int idx0 = gt; idx0 < 64 * 256 * 256; idx0 += 4 * gn) {
    float2 pw2[4]; float cr[4], cm[4];
    _Pragma("unroll") for (int u = 0; u < 4; ++u) {
      const int idx = min(idx0 + u * gn, 64 * 256 * 256 - 1);
      const int g = idx >> 16, n = (idx >> 8) & 255, k = idx & 255;
      const int j = n >> 4, o = n & 15, dir = k >> 7, pp = (k >> 1) & 63, e = dir ? 16 - j : j + 1;
      pw2[u] = POW[((size_t)(dir * 64 + g) * 17 + e) * 64 + pp];
      const size_t ci = ((size_t)(dir * 64 + g) * 16 + o) * 64 + pp; cr[u] = cre[ci]; cm[u] = cim[ci];
    }
    _Pragma("unroll") for (int u = 0; u < 4; ++u) {
      const int idx = idx0 + u * gn;
      if (idx < 64 * 256 * 256) {
        const int g = idx >> 16, n = (idx >> 8) & 255, k = idx & 255;
        const float zr = cr[u] * pw2[u].x - cm[u] * pw2[u].y, zi = cr[u] * pw2[u].y + cm[u] * pw2[u].x;
        MYT[((size_t)g * 256 + n) * 512 + 256 + k] = f2bf((k & 1) ? -zi : zr);
      }
    }
  }
  for (int idx = gt; idx < 64 * 16 * 256; idx += gn) {
    const int g = idx >> 12, lag = (idx >> 8) & 15, o = (idx >> 4) & 15, c = idx & 15;
    float kf = 0.f, kb = 0.f;
    _Pragma("unroll 8") for (int pp = 0; pp < 64; ++pp) {
      {
        const float2 pw = POW[((size_t)(0 * 64 + g) * 17 + lag) * 64 + pp];
        const float2 bb = BB[((size_t)(0 * 64 + g) * 64 + pp) * 16 + c];
        const size_t ci = ((size_t)(0 * 64 + g) * 16 + o) * 64 + pp;
        const float zr = pw.x * bb.x - pw.y * bb.y, zi = pw.x * bb.y + pw.y * bb.x;
        kf += cre[ci] * zr - cim[ci] * zi;
      }
      {
        const float2 pw = POW[((size_t)(1 * 64 + g) * 17 + lag) * 64 + pp];
        const float2 bb = BB[((size_t)(1 * 64 + g) * 64 + pp) * 16 + c];
        const size_t ci = ((size_t)(1 * 64 + g) * 16 + o) * 64 + pp;
        const float zr = pw.x * bb.x - pw.y * bb.y, zi = pw.x * bb.y + pw.y * bb.x;
        kb += cre[ci] * zr - cim[ci] * zi;
      }
    }
    bf16_t* Mg = MYT + (size_t)g * 256 * 512;
    if (lag == 0) {
      const bf16_t v = f2bf(kf + kb + (o == c ? dsk[g * 16 + o] : 0.f));
      for (int j = 0; j < 16; ++j) Mg[(size_t)(j * 16 + o) * 512 + j * 16 + c] = v;
    } else {
      const bf16_t vf = f2bf(kf), vb = f2bf(kb);
      for (int i = 0; i + lag < 16; ++i) {
        Mg[(size_t)((i + lag) * 16 + o) * 512 + i * 16 + c] = vf;
        Mg[(size_t)(i * 16 + o) * 512 + (i + lag) * 16 + c] = vb;
      }
    }
  }
}

DI void s5_scan_one(const Params& p, int b, int g, int dir, int pp) {
  char* ws = p.ws;
  const float2* POW = (const float2*)(ws + O_POW);
  const float* SL = (const float*)(ws + O_SLOC);
  bf16_t* ACAT = (bf16_t*)(ws + O_ACAT);
  const float2 lam = POW[((size_t)(dir * 64 + g) * 17 + 16) * 64 + pp];
  float hr = 0.f, hi = 0.f;
  auto chunk_of = [&](int q) { return q < 16 ? (1024 + b * 16 + (dir ? 15 - q : q)) : (b * 128 + (dir ? 127 - (q - 16) : (q - 16))); };
  auto loadb = [&](int q0, float2 (&sx)[16]) {
    _Pragma("unroll") for (int j = 0; j < 16; ++j) sx[j] = *(const float2*)(SL + ((size_t)g * NCHP + chunk_of(q0 + j)) * 256 + dir * 128 + 2 * pp);
  };
  auto procb = [&](int q0, const float2 (&sx)[16]) {
    _Pragma("unroll") for (int j = 0; j < 16; ++j) {
      *(unsigned*)(ACAT + ((size_t)g * NCH + chunk_of(q0 + j)) * 512 + 256 + dir * 128 + 2 * pp) = pack2(hr, hi);
      const float nr = lam.x * hr - lam.y * hi + sx[j].x, ni = lam.x * hi + lam.y * hr + sx[j].y;
      hr = nr; hi = ni;
    }
  };
  float2 sA[16], sB[16];
  loadb(0, sA);
  for (int q0 = 0; q0 < 144; q0 += 32) {
    if (q0 + 16 < 144) loadb(q0 + 16, sB);
    procb(q0, sA);
    if (q0 + 16 >= 144) break;
    if (q0 + 32 < 144) loadb(q0 + 32, sA);
    procb(q0 + 16, sB);
  }
}
DI void s5_scan_phase(const Params& p) {
  for (int gid = blockIdx.x * blockDim.x + threadIdx.x; gid < 65536; gid += gridDim.x * blockDim.x)
    s5_scan_one(p, gid >> 13, (gid >> 6) & 63, (gid >> 12) & 1, gid & 63);
}

#define XB_TMO      128
#define XB_XCNT(j)  (256  + 64 * (j))
#define XB_XSUB(j)  (1280 + 64 * (j))
#define XB_XGEN(j)  (2304 + 64 * (j))
#define XB_TOP      3328
#define XB_TOPGEN   3392
#define XCD_BAR_WORDS 3456
#define XB_SPIN_CAP (1u << 18)
#define LAS __attribute__((address_space(3)))
DI unsigned xb_ld(unsigned* p)              { return __hip_atomic_load(p, __ATOMIC_RELAXED, __HIP_MEMORY_SCOPE_AGENT); }
DI unsigned xb_add(unsigned* p, unsigned v) { return __hip_atomic_fetch_add(p, v, __ATOMIC_RELAXED, __HIP_MEMORY_SCOPE_AGENT); }
DI unsigned xb_xcc_id() { return (unsigned)__builtin_amdgcn_s_getreg((3 << 11) | 20) & 0xFu; }
#define XB_SPIN(cond, bar) do { unsigned _sp = 0; while (cond) { __builtin_amdgcn_s_sleep(1); \
    if ((++_sp & 255u) == 0u) { if (xb_ld(&(bar)[XB_TMO])) break; if (_sp > XB_SPIN_CAP) { atomicAdd(&(bar)[XB_TMO], 1u); break; } } } } while (0)
struct XcdBarrier { unsigned* bar; unsigned x; volatile LAS unsigned* st; };
DI XcdBarrier xcd_barrier_post(unsigned* bar, volatile LAS unsigned* st) {
    XcdBarrier b; b.bar = bar; b.x = xb_xcc_id(); b.st = st;
    if (threadIdx.x == 0) (void)xb_add(&bar[XB_XCNT(b.x)], 1u);
    return b;
}
DI void xcd_barrier_complete(unsigned* bar, unsigned x, unsigned& nloc, unsigned& nx) {
    const unsigned G = gridDim.x * gridDim.y * gridDim.z;
    unsigned sum, cnt, mine, sp = 0u;
    for (;;) {
        sum = 0u; cnt = 0u; mine = 0u;
#pragma unroll
        for (unsigned j = 0; j < 16; ++j) { const unsigned c = xb_ld(&bar[XB_XCNT(j)]); sum += c; cnt += (c > 0u) ? 1u : 0u; mine = (j == x) ? c : mine; }
        if (sum == G) break;
        __builtin_amdgcn_s_sleep(1);
        if ((++sp & 255u) == 0u) { if (xb_ld(&bar[XB_TMO])) break; if (sp > XB_SPIN_CAP) { atomicAdd(&bar[XB_TMO], 1u); break; } }
    }
    nloc = mine > 0u ? mine : 1u; nx = cnt > 0u ? cnt : 1u;
}
DI void xcd_barrier(const XcdBarrier& b) {
    asm volatile("s_waitcnt vmcnt(0)" ::: "memory");
    __syncthreads();
    if (threadIdx.x == 0) {
        unsigned* bar = b.bar;
        __builtin_amdgcn_s_waitcnt(0);
        unsigned nloc = b.st[0], nx = b.st[1];
        if (nloc == 0u) { xcd_barrier_complete(bar, b.x, nloc, nx); b.st[0] = nloc; b.st[1] = nx; }
        const unsigned old = xb_add(&bar[XB_XSUB(b.x)], 1u);
        const unsigned gen = old / nloc;
        if (old + 1u == (gen + 1u) * nloc) {
            __builtin_amdgcn_fence(__ATOMIC_RELEASE, "agent");
            asm volatile("s_waitcnt vmcnt(0)" ::: "memory");
            const unsigned og = xb_add(&bar[XB_TOP], 1u);
            const unsigned tg = og / nx;
            if (og + 1u == (tg + 1u) * nx) xb_add(&bar[XB_TOPGEN], 1u);
            else XB_SPIN(xb_ld(&bar[XB_TOPGEN]) == tg, bar);
            __builtin_amdgcn_fence(__ATOMIC_ACQUIRE, "agent");
            xb_add(&bar[XB_XGEN(b.x)], 1u);
            asm volatile("s_waitcnt vmcnt(0)" ::: "memory");
        } else {
            XB_SPIN(xb_ld(&bar[XB_XGEN(b.x)]) == gen, bar);
            __builtin_amdgcn_fence(__ATOMIC_ACQUIRE, "agent");
            asm volatile("s_waitcnt vmcnt(0)" ::: "memory");
        }
    }
    __syncthreads();
}

#define RP_GIN 1
#define RP_OUT0 1
#define RP_LRU 1
#define RP_SWA 1
#define RP_NA 1
#define RP_S5 1
#define RP_NORM 1
#define RP_GLU 1
#define RP_SYNC 0
#define REPEAT(n) for (int rep_ = 0; rep_ < (n); ++rep_)
constexpr int LDS_BYTES = 147456;

__global__ void __launch_bounds__(512, 2) fwd_megakernel(Params p) {
  extern __shared__ __attribute__((aligned(16))) unsigned char lds_raw[];
  LAS unsigned char* lds = (LAS unsigned char*)lds_raw;
  char* smem = (char*)lds_raw;
  cg::grid_group grid = cg::this_grid();
  char* ws = p.ws;
  volatile LAS unsigned* xst = (volatile LAS unsigned*)(lds + 131072 + 256);
  if (threadIdx.x == 0) { xst[0] = 0u; xst[1] = 0u; }
  __syncthreads();
  XcdBarrier xb = xcd_barrier_post((unsigned*)(ws + O_BAR), xst);
#define GSYNC() xcd_barrier(xb)
  float* MOD = (float*)(ws + O_MOD);
  float* HCTX = (float*)(ws + O_HCTX);
  const bf16_t* NBUF = (const bf16_t*)(ws + O_NBUF);
  using pg8::Gemm;

  phase0(p, smem);
  GSYNC();
  if (p.out == nullptr) grid.sync();
  float* SS = (float*)(ws + O_SS);
  const float* GS = (const float*)(ws + O_GS);
  const float* SHW = (const float*)(ws + O_SHW);
  bf16_t* NBW = (bf16_t*)(ws + O_NBUF);
  norm_phase(p.in[0], p.in[2], p.in[6], MOD, (bf16_t*)(ws + O_NBUF0));
  GSYNC();
  {
    EpiL0In e{(bf16_t*)(ws + O_U0), (bf16_t*)(ws + O_G0)};
    Gemm g{(const bf16_t*)(ws + O_NBUF0), (const bf16_t*)(ws + O_WT_IN0), 1024, 1024, 1024, 72, 11, 1, 0, 0, 0};
    pg8::gemm_phase(lds, g, e);
  }
  modfold_phase(p, smem);
  tables_phase(p, gridDim.x == 256 ? 24 : 0);
  if (gridDim.x == 256) transpose_range(p, smem, 16 * 44, 16 * 44 + 22 * 16 + 16 * 40 + 256, 24, 0);
  else transpose_range(p, smem, 16 * 44, 16 * 44 + 22 * 16 + 16 * 40 + 256, 0, 0);
  GSYNC();
  lru_phase(p, smem);
  GSYNC();
  {
    EpiOut<true> e{p.in[0], p.in[2], p.out, HCTX, MOD + 2048, GS, NBW, SS};
    Gemm g{(const bf16_t*)(ws + O_ACT0), (const bf16_t*)(ws + O_WT_OUT0), LW, LW, LW, 72, 4, 1, 0, 0, 0};
    pg8::gemm_phase(lds, g, e);
  }
  {
    constexpr int J0 = 16 * 44 + 22 * 16 + 16 * 40 + 256, J1 = J0 + 16 * 64 + 256 + 16 * 32 + 256 + 256;
    transpose_range(p, smem, J0, J1, gridDim.x == 256 ? 32 : 0, 0);
  }
  GSYNC();
  {
    EpiL1 e{(bf16_t*)(ws + O_Q1), (bf16_t*)(ws + O_QR1), (bf16_t*)(ws + O_K1), (bf16_t*)(ws + O_G1), (const float*)(ws + O_ROPEC), (const float*)(ws + O_ROPES), SS, SHW};
    Gemm g{NBUF, (const bf16_t*)(ws + O_WT_IN1), 1024, 1024, 1024, 72, 9, 1, 0, 0, 0};
    pg8::gemm_phase(lds, g, e);
    EpiV<4, 1280> ev{(bf16_t*)(ws + O_VTL1), (bf16_t*)(ws + O_VTC1), SS, SHW};
    Gemm gv{(const bf16_t*)(ws + O_WT_IN1) + (size_t)2304 * 1024, NBUF, 1024, 1024, 1024, 1, 72, 1, 0, 0, 256 - 136};
    pg8::gemm_phase(lds, gv, ev);
  }
  GSYNC();
  swa_phase(p);
  GSYNC();
  {
    EpiOut<true> e{p.out, HCTX, p.out, HCTX, MOD + 9 * 3072 + 2048, GS + 9 * 1024, NBW, SS + R};
    Gemm g{(const bf16_t*)(ws + O_ACT1), (const bf16_t*)(ws + O_WT_OUT1), 1024, 1024, 1024, 72, 4, 1, 0, 0, 0};
    pg8::gemm_phase(lds, g, e);
  }
  s5_mats_phase(p, 1, gridDim.x == 256 ? 32 : 0);
  GSYNC();
  {
    EpiL2 e{(bf16_t*)(ws + O_Q2), (bf16_t*)(ws + O_K2), (bf16_t*)(ws + O_G2), SS + R, SHW + 9 * 4096};
    Gemm g{NBUF, (const bf16_t*)(ws + O_WT_IN2), 1024, 1024, 1024, 72, 12, 1, 0, 0, 0};
    pg8::gemm_phase(lds, g, e);
    EpiV<16, 2048> ev{(bf16_t*)(ws + O_VTL2), (bf16_t*)(ws + O_VTC2), SS + R, SHW + 9 * 4096};
    Gemm gv{(const bf16_t*)(ws + O_WT_IN2) + (size_t)3072 * 1024, NBUF, 1024, 1024, 1024, 4, 72, 1, 0, 0, 256 - 96};
    pg8::gemm_phase(lds, gv, ev);
  }
  GSYNC();
  na_phase(p, smem);
  GSYNC();
  {
    EpiOut<true> e{p.out, HCTX, p.out, HCTX, MOD + 2 * 9 * 3072 + 2048, GS + 2 * 9 * 1024, NBW, SS + 2 * R};
    Gemm g{(const bf16_t*)(ws + O_ACT2), (const bf16_t*)(ws + O_WT_OUT2), 1024, 1024, 1024, 72, 4, 1, 0, 0, 0};
    pg8::gemm_phase(lds, g, e);
  }
  s5_mats_phase(p, 2, gridDim.x == 256 ? 32 : 0);
  GSYNC();
  {
    EpiL3In e{(bf16_t*)(ws + O_ACAT), (bf16_t*)(ws + O_G3), SS + 2 * R, SHW + 2 * 9 * 4096};
    Gemm g{NBUF, (const bf16_t*)(ws + O_WT_IN3), 1024, 1024, 1024, 72, 8, 1, 0, 0, 0};
    pg8::gemm_phase(lds, g, e);
  }
  GSYNC();
  {
    EpiS5State e{(float*)(ws + O_SLOC)};
    Gemm g{(const bf16_t*)(ws + O_ACAT), (const bf16_t*)(ws + O_GT), 512, 256, 256, 5, 1, 64, NCH * 512, 256 * 256, 0};
    pg8::gemm_phase(lds, g, e);
  }
  GSYNC();
  {
    EpiS5Y e{(bf16_t*)(ws + O_YG)};
    Gemm g{(const bf16_t*)(ws + O_ACAT), (const bf16_t*)(ws + O_MYT), 512, 512, 512, 4, 1, 64, NCH * 512, 256 * 512, 0};
    if (gridDim.x == 256) {
      pg8::Unit u;
      if (pg8::next_unit(g, 0, u)) {
        const int t_ = opaque_tid();
        if (t_ < 256) s5_scan_one(p, 2 * u.pm + (t_ >> 7), u.pb, (t_ >> 6) & 1, t_ & 63);
      }
      asm volatile("s_waitcnt vmcnt(0)" ::: "memory");
      __syncthreads();
    } else {
      s5_scan_phase(p);
      GSYNC();
    }
    pg8::gemm_phase(lds, g, e);
  }
  GSYNC();
  {
    EpiGlu e{(const bf16_t*)(ws + O_YG), (const bf16_t*)(ws + O_G3), p.in[41], (bf16_t*)(ws + O_ACT3)};
    Gemm g{(const bf16_t*)(ws + O_YG), (const bf16_t*)(ws + O_WT_GLU), 1024, 1024, 1024, 64, 4, 1, 0, 0, 0};
    pg8::gemm_phase(lds, g, e);
  }
  GSYNC();
  {
    EpiOut<false> e{p.out, HCTX, p.out, HCTX, MOD + 3 * 9 * 3072 + 2048, nullptr, nullptr, nullptr};
    Gemm g{(const bf16_t*)(ws + O_ACT3), (const bf16_t*)(ws + O_WT_OUT3), 1024, 1024, 1024, 64, 4, 1, 0, 0, 0};
    pg8::gemm_phase(lds, g, e);
  }
  GSYNC();
  final_norm_phase(p.out, p.in[43]);
}

extern "C" void kernel_launch(void* const* d_in, const int* in_sizes, int n_in, void* d_out, int out_size, void* d_ws, size_t ws_size,
                              hipStream_t stream) {
  static int grid_blocks = 0;
  if (!grid_blocks) {
    int dev = 0, cus = 0, per_cu = 0;
    (void)hipGetDevice(&dev);
    (void)hipDeviceGetAttribute(&cus, hipDeviceAttributeMultiprocessorCount, dev);
    if (hipFuncSetAttribute((const void*)fwd_megakernel, hipFuncAttributeMaxDynamicSharedMemorySize, LDS_BYTES) != hipSuccess) { fprintf(stderr, "kernel_launch: hipFuncSetAttribute failed\n"); grid_blocks = -1; return; }
    (void)hipOccupancyMaxActiveBlocksPerMultiprocessor(&per_cu, (const void*)fwd_megakernel, 512, LDS_BYTES);
    (void)hipGetLastError();
    grid_blocks = cus;
  }
  if (grid_blocks < 0) return;
  if (n_in != 44 || ws_size < WS_END) { fprintf(stderr, "kernel_launch: unexpected n_in %d or ws_size %zu < %zu\n", n_in, ws_size, (size_t)WS_END); return; }
  Params p{};
  for (int i = 0; i < 44; ++i) p.in[i] = (const float*)d_in[i];
  p.out = (float*)d_out;
  p.ws = (char*)d_ws;
  if (hipMemsetAsync((char*)d_ws + O_BAR, 0, 16384, stream) != hipSuccess) { fprintf(stderr, "memset failed\n"); return; }
  void* args[] = {&p};
  hipError_t e = hipLaunchCooperativeKernel((void*)fwd_megakernel, dim3(grid_blocks), dim3(512), args, LDS_BYTES, stream);
  if (e != hipSuccess) fprintf(stderr, "cooperative launch failed: %s (grid %d)\n", hipGetErrorString(e), grid_blocks);
}
```

```cpp
#include <hip/hip_runtime.h>
#include <hip/hip_cooperative_groups.h>
#include <cstdio>
namespace cg = cooperative_groups;

#define DI __device__ __forceinline__
typedef unsigned short bf16_t;
typedef short bf16x8 __attribute__((ext_vector_type(8)));
typedef short s16x4 __attribute__((ext_vector_type(4)));
typedef float f32x16 __attribute__((ext_vector_type(16)));
typedef float f32x4 __attribute__((ext_vector_type(4)));
typedef unsigned u32x2 __attribute__((ext_vector_type(2)));
typedef unsigned u32x4 __attribute__((ext_vector_type(4)));

#define MFMA32(a, b, c) __builtin_amdgcn_mfma_f32_32x32x16_bf16((a), (b), (c), 0, 0, 0)
#define MFMA16(a, b, c) __builtin_amdgcn_mfma_f32_16x16x32_bf16((a), (b), (c), 0, 0, 0)

constexpr int D = 1024, NB = 8, SEQ = 2048, CTXL = 256;
constexpr int RL = NB * SEQ;
constexpr int RC = NB * CTXL;
constexpr int R = RL + RC;
constexpr int LW = 1408;
constexpr int NCH = R / 16;
constexpr int NCHP = 1280;

constexpr size_t O_WT_IN0 = 0;
constexpr size_t O_WT_OUT0 = O_WT_IN0 + (size_t)2816 * 1024 * 2;
constexpr size_t O_WT_IN1 = O_WT_OUT0 + (size_t)1024 * 2816 * 2;
constexpr size_t O_WT_OUT1 = O_WT_IN1 + (size_t)2560 * 1024 * 2;
constexpr size_t O_WT_IN2 = O_WT_OUT1 + (size_t)1024 * 1024 * 2;
constexpr size_t O_WT_OUT2 = O_WT_IN2 + (size_t)4096 * 1024 * 2;
constexpr size_t O_WT_IN3 = O_WT_OUT2 + (size_t)1024 * 1024 * 2;
constexpr size_t O_WT_GLU = O_WT_IN3 + (size_t)2048 * 1024 * 2;
constexpr size_t O_WT_OUT3 = O_WT_GLU + (size_t)1024 * 1024 * 2;
constexpr size_t O_WG = O_WT_OUT3 + (size_t)1024 * 1024 * 2;
constexpr size_t O_MOD = O_WG + (size_t)16 * 2 * 192 * 96 * 2;
constexpr size_t O_ROPEC = O_MOD + (size_t)4 * 9 * 3072 * 4;
constexpr size_t O_ROPES = O_ROPEC + (size_t)2048 * 32 * 4;
constexpr size_t O_POW = O_ROPES + (size_t)2048 * 32 * 4;
constexpr size_t O_BBAR = O_POW + (size_t)2 * 64 * 17 * 64 * 8;
constexpr size_t O_HCTX = O_BBAR + (size_t)2 * 64 * 64 * 16 * 8;
constexpr size_t O_SS = O_HCTX + (size_t)RC * 1024 * 4;
constexpr size_t O_GS = O_SS + (size_t)3 * R * 4;
constexpr size_t O_SHW = O_GS + (size_t)3 * 9 * 1024 * 4;
constexpr size_t O_BAR = O_SHW + (size_t)3 * 9 * 4096 * 4;
constexpr size_t O_DYN = O_BAR + 16384;
constexpr size_t O_U0 = O_DYN;
constexpr size_t O_G0 = O_U0 + (size_t)R * LW * 2;
constexpr size_t O_ACT0 = O_G0 + (size_t)R * LW * 2;
constexpr size_t O_NBUF0 = O_ACT0;
constexpr size_t O_NBUF = O_DYN;
constexpr size_t O_Q1 = O_NBUF + (size_t)R * 1024 * 2;
constexpr size_t O_QR1 = O_Q1 + (size_t)R * 1024 * 2;
constexpr size_t O_K1 = O_QR1 + (size_t)RL * 1024 * 2;
constexpr size_t O_VTL1 = O_K1 + (size_t)R * 256 * 2;
constexpr size_t O_VTC1 = O_VTL1 + (size_t)8 * 4 * 64 * 2048 * 2;
constexpr size_t O_G1 = O_VTC1 + (size_t)8 * 4 * 64 * 256 * 2;
constexpr size_t O_ACT1 = O_G1 + (size_t)R * 1024 * 2;
constexpr size_t O_Q2 = O_NBUF + (size_t)R * 1024 * 2;
constexpr size_t O_K2 = O_Q2 + (size_t)R * 1024 * 2;
constexpr size_t O_VTL2 = O_K2 + (size_t)R * 1024 * 2;
constexpr size_t O_VTC2 = O_VTL2 + (size_t)8 * 16 * 64 * 2048 * 2;
constexpr size_t O_G2 = O_VTC2 + (size_t)8 * 16 * 64 * 256 * 2;
constexpr size_t O_ACT2 = O_Q2;
constexpr size_t O_SLOC = O_DYN;
constexpr size_t O_YG = O_DYN;
constexpr size_t O_ACT3 = O_YG + (size_t)RL * 1024 * 2;
constexpr size_t O_ACAT = O_DYN + (size_t)64 * NCHP * 256 * 4;
constexpr size_t O_G3 = O_ACAT + (size_t)64 * NCH * 512 * 2;
constexpr size_t O_GT = O_WT_IN2;
constexpr size_t O_MYT = O_WT_IN0;
static_assert(O_WT_OUT1 - O_WT_IN0 == (size_t)64 * 256 * 512 * 2 && O_WT_OUT2 - O_WT_IN2 == (size_t)64 * 256 * 256 * 2, "S5 matrix aliases");
constexpr size_t WS_END = O_ACT0 + (size_t)R * LW * 2 * 2;
static_assert(O_G3 + (size_t)RL * 1024 * 2 <= WS_END && O_ACT1 + (size_t)R * 1024 * 2 <= WS_END && O_G2 + (size_t)R * 1024 * 2 <= WS_END, "workspace map");
static_assert(WS_END <= (size_t)256 * 1024 * 1024, "workspace budget");

struct Params {
  const float* in[44];
  float* out;
  char* ws;
};

typedef __bf16 bf16n2 __attribute__((ext_vector_type(2)));
DI bf16_t f2bf(float x) { const __bf16 b = (__bf16)x; return __builtin_bit_cast(unsigned short, b); }
DI float bf2f(bf16_t b) { return __uint_as_float(((unsigned)b) << 16); }
DI unsigned pack2(float lo, float hi) { bf16n2 v; v[0] = (__bf16)lo; v[1] = (__bf16)hi; return __builtin_bit_cast(unsigned, v); }
DI float bflo(unsigned u) { return __uint_as_float(u << 16); }
DI float bfhi(unsigned u) { return __uint_as_float(u & 0xffff0000u); }
DI float frcp(float x) { return __builtin_amdgcn_rcpf(x); }
DI float sigm(float x) { return frcp(1.f + __expf(-x)); }
DI float silu(float x) { return x * frcp(1.f + __expf(-x)); }
DI float gelu_tanh(float x) {
  const float w = -x * (2.3022081986f + 0.1029432396f * x * x);
  return x * frcp(1.f + __builtin_amdgcn_exp2f(w));
}
DI int opaque_tid() { int t = threadIdx.x; asm volatile("" : "+v"(t)); return t; }
constexpr float QSCALE = 0.125f * 1.4426950408889634f;
DI int crow(int i, int h) { return (i & 3) + 8 * (i >> 2) + 4 * h; }
DI f32x16 zero16() { f32x16 z; _Pragma("unroll") for (int i = 0; i < 16; ++i) z[i] = 0.f; return z; }
DI void sincos_rev(float rev, float& s, float& c) { rev = rev - rintf(rev); s = __builtin_amdgcn_sinf(rev); c = __builtin_amdgcn_cosf(rev); }

#define LAS __attribute__((address_space(3)))
namespace pg8 {
constexpr int BM = 256, BK = 64, HALF = 128, HTB = HALF * BK * 2, STAGE_BYTES = 8 * HTB;
DI int lds_byte(int r, int c) { const int st = (r >> 4) * 2 + (c >> 5), rr = r & 15, cc = c & 31, ob = rr * 64 + cc * 2; return st * 1024 + (ob ^ (((ob >> 9) & 1) << 5)); }
DI void stage_rc(int b, int& R_, int& C_) { const int st = b / 1024, sb = b % 1024, swz = sb ^ (((sb >> 9) & 1) << 5); R_ = (st >> 1) * 16 + swz / 64; C_ = (st & 1) * 32 + (swz % 64) / 2; }
DI int perm32(int rho) { const int n = rho >> 4, i = rho & 15; return 8 * (i >> 2) + 4 * n + (i & 3); }
struct Unit { int pm, pn, pb; };
struct Gemm { const bf16_t* A; const bf16_t* Bt; int lda, ldb, K, nM, nN, nB; int strideA, strideB; int rot; };
DI bool next_unit(const Gemm& g, int i, Unit& u) {
  const int G = gridDim.x, per = g.nM * g.nN, nwg = per * g.nB;
  const int c = (blockIdx.x + g.rot) % G;
  const long L = (long)i * G + c;
  if (L >= nwg) return false;
  int wgid = (int)L;
  { const int q = nwg / 8, r = nwg % 8, xcd = wgid % 8, off = wgid / 8; wgid = (xcd < r ? xcd * (q + 1) : r * (q + 1) + (xcd - r) * q) + off; }
  const int pb = wgid / per, w = wgid - pb * per;
  const int nig = 8 * g.nN, gid = w / nig, fm = gid * 8, gsz = (g.nM - fm) < 8 ? (g.nM - fm) : 8;
  u.pb = pb; u.pm = fm + ((w % nig) % gsz); u.pn = (w % nig) / gsz;
  return true;
}

template <class Epi>
DI void gemm_phase(LAS unsigned char* lds, const Gemm g, const Epi& E) {
  const int tid = opaque_tid(), wid = __builtin_amdgcn_readfirstlane(tid >> 6), lane = tid & 63, wr = wid >> 2, wc = wid & 3, fr = lane & 15, fq = lane >> 4;
  const int K = g.K, nt = K / BK;
  unsigned voffA[2], voffB[2];
#pragma unroll
  for (int i = 0; i < 2; ++i) { int R_, C_; stage_rc(tid * 16 + i * 8192, R_, C_); const int Rb = Epi::PERM ? ((R_ & ~31) + perm32(R_ & 31)) : R_;
    voffA[i] = (unsigned)(R_ * g.lda + C_) * 2u; voffB[i] = (unsigned)(Rb * g.ldb + C_) * 2u; }
  const size_t kstep = (size_t)(BK * 2);
  const size_t hstepA = (size_t)HALF * g.lda * 2, hstepB = (size_t)HALF * g.ldb * 2;
  const size_t tstepA = 2 * hstepA, tstepB = 2 * hstepB;
  const unsigned ldsw = (unsigned)wid * 1024u;
  const int aoff = lds_byte(wr * 64 + fr, fq * 8), boff = lds_byte(wc * 32 + fr, fq * 8);
#define PG8_SA(b, h) (((b) * 2 + (h)) * HTB)
#define PG8_SB(b, h) ((4 + (b) * 2 + (h)) * HTB)
#define PG8_STAGE(bufoff, gbase, voff) do { _Pragma("unroll") for (int _i = 0; _i < 2; ++_i) \
        __builtin_amdgcn_global_load_lds((const unsigned*)((const char*)(gbase) + (voff)[_i]), (LAS unsigned*)(lds + (bufoff) + ldsw + _i * 8192), 16, 0, 0); } while (0)
#define PG8_LDA(dst, b, h) do { _Pragma("unroll") for (int m = 0; m < 4; ++m) _Pragma("unroll") for (int k = 0; k < 2; ++k) dst[m][k] = *(const LAS bf16x8*)(lds + PG8_SA(b, h) + aoff + m * 2048 + k * 1024); } while (0)
#define PG8_LDB(dst, b, h) do { _Pragma("unroll") for (int n = 0; n < 2; ++n) _Pragma("unroll") for (int k = 0; k < 2; ++k) dst[n][k] = *(const LAS bf16x8*)(lds + PG8_SB(b, h) + boff + n * 2048 + k * 1024); } while (0)
#define PG8_MMA(ai, bj, At, Bt) do { __builtin_amdgcn_s_setprio(1); _Pragma("unroll") for (int m = 0; m < 4; ++m) _Pragma("unroll") for (int n = 0; n < 2; ++n) _Pragma("unroll") for (int k = 0; k < 2; ++k) \
        acc[ai][bj][m][n] = __builtin_amdgcn_mfma_f32_16x16x32_bf16(Bt[n][k], At[m][k], acc[ai][bj][m][n], 0, 0, 0); __builtin_amdgcn_s_setprio(0); } while (0)
#define PG8_WAIT_V(n) asm volatile("s_waitcnt vmcnt(" #n ")" ::: "memory")
#define PG8_WAIT_L(n) asm volatile("s_waitcnt lgkmcnt(" #n ")" ::: "memory")
#define PG8_BAR __builtin_amdgcn_s_barrier()
#define PG8_SCHED __builtin_amdgcn_sched_barrier(0)
  Unit cur, nxt; int ui = 0;
  if (!next_unit(g, 0, cur)) return;
  f32x4 acc[2][2][4][2];
#pragma unroll
  for (int a = 0; a < 2; ++a)
#pragma unroll
    for (int b = 0; b < 2; ++b)
#pragma unroll
      for (int m = 0; m < 4; ++m)
#pragma unroll
        for (int n = 0; n < 2; ++n) acc[a][b][m][n] = (f32x4){0.f, 0.f, 0.f, 0.f};
  bf16x8 At[4][2], B0[2][2], B1[2][2];
  const char* cA = (const char*)(g.A + (size_t)cur.pb * g.strideA) + (size_t)cur.pm * tstepA;
  const char* cB = (const char*)(g.Bt + (size_t)cur.pb * g.strideB) + (size_t)cur.pn * tstepB;
  PG8_STAGE(PG8_SB(0, 0), cB, voffB); PG8_STAGE(PG8_SA(0, 0), cA, voffA); PG8_STAGE(PG8_SB(0, 1), cB + hstepB, voffB); PG8_STAGE(PG8_SA(0, 1), cA + hstepA, voffA);
  if (wr == 1) PG8_BAR;
  PG8_WAIT_V(4); PG8_BAR;
  PG8_STAGE(PG8_SB(1, 0), cB + kstep, voffB); PG8_STAGE(PG8_SA(1, 0), cA + kstep, voffA); PG8_STAGE(PG8_SB(1, 1), cB + hstepB + kstep, voffB);
  PG8_WAIT_V(6); PG8_BAR;
  for (;;) {
    const bool has_next = next_unit(g, ui + 1, nxt);
    const char* nA = has_next ? (const char*)(g.A + (size_t)nxt.pb * g.strideA) + (size_t)nxt.pm * tstepA : cA;
    const char* nB = has_next ? (const char*)(g.Bt + (size_t)nxt.pb * g.strideB) + (size_t)nxt.pn * tstepB : cB;
    for (int t = 0; t < nt; t += 2) {
      const bool last = (t == nt - 2);
      const char* a1 = cA + (size_t)(t + 1) * kstep;
      const char* a2 = last ? nA : cA + (size_t)(t + 2) * kstep; const char* b2 = last ? nB : cB + (size_t)(t + 2) * kstep;
      const char* a3 = a2 + kstep; const char* b3 = b2 + kstep;
      PG8_LDB(B0, 0, 0); PG8_SCHED; PG8_LDA(At, 0, 0); PG8_STAGE(PG8_SA(1, 1), a1 + hstepA, voffA);
      PG8_WAIT_L(8); PG8_BAR; PG8_WAIT_L(0); PG8_MMA(0, 0, At, B0); PG8_BAR; PG8_SCHED;
      PG8_LDB(B1, 0, 1); PG8_STAGE(PG8_SB(0, 0), b2, voffB);
      PG8_BAR; PG8_WAIT_L(0); PG8_MMA(0, 1, At, B1); PG8_BAR;
      PG8_LDA(At, 0, 1); PG8_STAGE(PG8_SA(0, 0), a2, voffA);
      PG8_BAR; PG8_WAIT_L(0); PG8_MMA(1, 0, At, B0); PG8_BAR; PG8_SCHED;
      PG8_STAGE(PG8_SB(0, 1), b2 + hstepB, voffB);
      PG8_WAIT_V(6); PG8_BAR; PG8_MMA(1, 1, At, B1); PG8_BAR;
      PG8_LDB(B0, 1, 0); PG8_SCHED; PG8_LDA(At, 1, 0); PG8_STAGE(PG8_SA(0, 1), a2 + hstepA, voffA);
      PG8_WAIT_L(8); PG8_BAR; PG8_WAIT_L(0); PG8_MMA(0, 0, At, B0); PG8_BAR; PG8_SCHED;
      PG8_LDB(B1, 1, 1); PG8_STAGE(PG8_SB(1, 0), b3, voffB);
      PG8_BAR; PG8_WAIT_L(0); PG8_MMA(0, 1, At, B1); PG8_BAR;
      PG8_LDA(At, 1, 1); PG8_STAGE(PG8_SA(1, 0), a3, voffA);
      PG8_BAR; PG8_WAIT_L(0); PG8_MMA(1, 0, At, B0); PG8_BAR; PG8_SCHED;
      PG8_STAGE(PG8_SB(1, 1), b3 + hstepB, voffB);
      PG8_WAIT_V(6); PG8_BAR; PG8_MMA(1, 1, At, B1); PG8_BAR;
    }
    E(acc, cur, wr, wc, fr, fq);
    if (!has_next) break;
#pragma unroll
    for (int a = 0; a < 2; ++a)
#pragma unroll
      for (int b = 0; b < 2; ++b)
#pragma unroll
        for (int m = 0; m < 4; ++m)
#pragma unroll
          for (int n = 0; n < 2; ++n) acc[a][b][m][n] = (f32x4){0.f, 0.f, 0.f, 0.f};
    cur = nxt; cA = nA; cB = nB; ++ui;
  }
  PG8_WAIT_V(0);
  if (wr == 0) PG8_BAR;
  PG8_BAR;
#undef PG8_SA
#undef PG8_SB
#undef PG8_STAGE
#undef PG8_LDA
#undef PG8_LDB
#undef PG8_MMA
#undef PG8_WAIT_V
#undef PG8_WAIT_L
#undef PG8_BAR
#undef PG8_SCHED
}
}
using pg8::Unit;
typedef f32x4 AccT[2][2][4][2];

DI void asm_fence() { asm volatile("" ::: "memory"); }
#define EPI_ROWS4 _Pragma("unroll") for (int ai = 0; ai < 2; ++ai) if ((asm_fence(), true)) _Pragma("unroll") for (int m = 0; m < 4; ++m)
#define EPI_ROWS _Pragma("unroll") for (int ai = 0; ai < 2; ++ai) _Pragma("unroll") for (int m = 0; m < 4; ++m) if ((asm_fence(), true))
DI u32x4 pack8f(const f32x4& a, const f32x4& b) { u32x4 w; w[0] = pack2(a[0], a[1]); w[1] = pack2(a[2], a[3]); w[2] = pack2(b[0], b[1]); w[3] = pack2(b[2], b[3]); return w; }
DI size_t k_off(int t, int d) { return (size_t)(t >> 5) * 2048 + (((d >> 4) * 64 + ((d >> 3) & 1) * 32 + (t & 31)) << 3) + (d & 7); }

struct EpiL0In {
  static constexpr bool PERM = true;
  bf16_t* U0; bf16_t* G0;
  DI void operator()(const AccT& acc, const Unit& u, int wr, int wc, int fr, int fq) const {
    EPI_ROWS { const int row = u.pm * 256 + ai * 128 + wr * 64 + m * 16 + fr;
      _Pragma("unroll") for (int bj = 0; bj < 2; ++bj) { const int c0 = u.pn * 256 + bj * 128 + wc * 32 + 8 * fq;
        const bool isu = u.pn * 256 + bj * 128 < LW;
        bf16_t* dst = isu ? U0 + (size_t)row * LW + c0 : G0 + (size_t)row * LW + (c0 - LW);
        *(u32x4*)dst = pack8f(acc[ai][bj][m][0], acc[ai][bj][m][1]); } }
  }
};

template <bool NEXT>
struct EpiOut {
  static constexpr bool PERM = false;
  const float* in_lat; const float* in_ctx; float* out_lat; float* out_ctx; const float* gate;
  const float* gs; bf16_t* NB_; float* ss;
  DI void operator()(const AccT& acc, const Unit& u, int wr, int wc, int fr, int fq) const {
    const int rb = u.pm * 256;
    const float* src; float* dst; const float* g; const float* gsv; int rr;
    if (rb < RL) { src = in_lat; dst = out_lat; rr = rb; g = gate + (size_t)(rb >> 11) * 3072; gsv = gs + (size_t)(rb >> 11) * 1024; }
    else { src = in_ctx; dst = out_ctx; rr = rb - RL; g = gate + (size_t)8 * 3072; gsv = gs + (size_t)8 * 1024; }
    const int cb = u.pn * 256 + wc * 32 + 4 * fq;
    f32x4 gv[4], sv[4];
    _Pragma("unroll") for (int q = 0; q < 4; ++q) { gv[q] = *(const f32x4*)(g + cb + (q >> 1) * 128 + (q & 1) * 16); if (NEXT) sv[q] = *(const f32x4*)(gsv + cb + (q >> 1) * 128 + (q & 1) * 16); }
    const int r0 = rr + wr * 64 + fr;
    f32x4 hc[4], hn[4];
    _Pragma("unroll") for (int q = 0; q < 4; ++q) hc[q] = *(const f32x4*)(src + (size_t)r0 * 1024 + cb + (q >> 1) * 128 + (q & 1) * 16);
    _Pragma("unroll") for (int r_ = 0; r_ < 8; ++r_) {
      const int ai = r_ >> 2, m = r_ & 3, row = r0 + 128 * ai + 16 * m;
      if (r_ + 1 < 8) { const int rown = r0 + 128 * ((r_ + 1) >> 2) + 16 * ((r_ + 1) & 3);
        _Pragma("unroll") for (int q = 0; q < 4; ++q) hn[q] = *(const f32x4*)(src + (size_t)rown * 1024 + cb + (q >> 1) * 128 + (q & 1) * 16); }
      float sq = 0.f;
      _Pragma("unroll") for (int q = 0; q < 4; ++q) {
        const int c = cb + (q >> 1) * 128 + (q & 1) * 16;
        const f32x4 o = hc[q] + gv[q] * acc[ai][q >> 1][m][q & 1];
        *(f32x4*)(dst + (size_t)row * 1024 + c) = o;
        if (NEXT) {
          u32x2 w; w[0] = pack2(o[0] * sv[q][0], o[1] * sv[q][1]); w[1] = pack2(o[2] * sv[q][2], o[3] * sv[q][3]);
          *(u32x2*)(NB_ + (size_t)(row - rr + rb) * 1024 + c) = w;
          sq += o[0] * o[0] + o[1] * o[1] + o[2] * o[2] + o[3] * o[3];
        }
      }
      if (NEXT) {
        sq += __shfl_xor(sq, 16); sq += __shfl_xor(sq, 32);
        if (fq == 0) atomicAdd(ss + (row - rr + rb), sq);
      }
      asm_fence();
      _Pragma("unroll") for (int q = 0; q < 4; ++q) hc[q] = hn[q];
    }
  }
};

struct EpiL1 {
  static constexpr bool PERM = true;
  bf16_t *Q, *QR, *Kb, *G; const float *rc, *rs; const float* ss; const float* shw;
  DI void operator()(const AccT& acc, const Unit& u, int wr, int wc, int fr, int fq) const {
    const int rb = u.pm * 256; const bool lat = rb < RL;
    const float* sh = shw + (size_t)(lat ? (rb >> 11) : 8) * 4096;
    const int r0 = rb + wr * 64 + fr;
    float rstd[8];
    _Pragma("unroll") for (int r_ = 0; r_ < 8; ++r_) rstd[r_] = ss[r0 + 128 * (r_ >> 2) + 16 * (r_ & 3)];
    _Pragma("unroll") for (int r_ = 0; r_ < 8; ++r_) rstd[r_] = rsqrtf(rstd[r_] * (1.f / 1024.f) + 1e-6f);
    const bool qk = u.pn * 256 < 1280;
    f32x4 b1[2], b2v[2];
    int c0s[2], d0s[2];
    _Pragma("unroll") for (int bj = 0; bj < 2; ++bj) {
      const int c0 = u.pn * 256 + bj * 128 + wc * 32 + 8 * fq; c0s[bj] = c0; d0s[bj] = (c0 & 63) >> 1;
      if (qk) { const int oc = (c0 & ~63) + d0s[bj]; b1[bj] = *(const f32x4*)(sh + oc); b2v[bj] = *(const f32x4*)(sh + oc + 32); }
      else { b1[bj] = *(const f32x4*)(sh + c0 + 256); b2v[bj] = *(const f32x4*)(sh + c0 + 260); }
    }
    f32x4 cc, sc, cn, sn;
    if (qk && lat) { const int t = r0 & 2047; cc = *(const f32x4*)(rc + t * 32 + d0s[0]); sc = *(const f32x4*)(rs + t * 32 + d0s[0]); }
    _Pragma("unroll") for (int r_ = 0; r_ < 8; ++r_) {
      const int ai = r_ >> 2, m = r_ & 3, row = r0 + 128 * ai + 16 * m;
      if (qk && lat && r_ + 1 < 8) { const int tn = (r0 + 128 * ((r_ + 1) >> 2) + 16 * ((r_ + 1) & 3)) & 2047;
        cn = *(const f32x4*)(rc + tn * 32 + d0s[0]); sn = *(const f32x4*)(rs + tn * 32 + d0s[0]); }
      _Pragma("unroll") for (int bj = 0; bj < 2; ++bj) { const int c0 = c0s[bj], d0 = d0s[bj];
        const f32x4 v0 = acc[ai][bj][m][0] * rstd[r_], v1 = acc[ai][bj][m][1] * rstd[r_];
        if (qk) {
          float x1[4] = {v0[0] + b1[bj][0], v0[2] + b1[bj][1], v1[0] + b1[bj][2], v1[2] + b1[bj][3]}, x2[4] = {v0[1] + b2v[bj][0], v0[3] + b2v[bj][1], v1[1] + b2v[bj][2], v1[3] + b2v[bj][3]};
          float y1[4], y2[4];
          int t;
          if (lat) { t = row & 2047; _Pragma("unroll") for (int j = 0; j < 4; ++j) { y1[j] = x1[j] * cc[j] - x2[j] * sc[j]; y2[j] = x2[j] * cc[j] + x1[j] * sc[j]; } }
          else { t = (row - RL) & 255; _Pragma("unroll") for (int j = 0; j < 4; ++j) { y1[j] = x1[j]; y2[j] = x2[j]; } }
          if (u.pn < 4) {
            const size_t o = (size_t)row * 1024 + (c0 & ~63) + d0;
            u32x2 a, b2; a[0] = pack2(x1[0] * QSCALE, x1[1] * QSCALE); a[1] = pack2(x1[2] * QSCALE, x1[3] * QSCALE);
            b2[0] = pack2(x2[0] * QSCALE, x2[1] * QSCALE); b2[1] = pack2(x2[2] * QSCALE, x2[3] * QSCALE);
            *(u32x2*)(Q + o) = a; *(u32x2*)(Q + o + 32) = b2;
            if (lat) {
              a[0] = pack2(y1[0] * QSCALE, y1[1] * QSCALE); a[1] = pack2(y1[2] * QSCALE, y1[3] * QSCALE);
              b2[0] = pack2(y2[0] * QSCALE, y2[1] * QSCALE); b2[1] = pack2(y2[2] * QSCALE, y2[3] * QSCALE);
              *(u32x2*)(QR + o) = a; *(u32x2*)(QR + o + 32) = b2;
            }
          } else {
            const int kvh = (c0 - 1024) >> 6;
            bf16_t* kh = lat ? Kb + (size_t)((row >> 11) * 4 + kvh) * 64 * 2048 : Kb + (size_t)RL * 256 + (size_t)(((row - RL) >> 8) * 4 + kvh) * 8 * 2048;
            u32x2 a, b2; a[0] = pack2(y1[0], y1[1]); a[1] = pack2(y1[2], y1[3]); b2[0] = pack2(y2[0], y2[1]); b2[1] = pack2(y2[2], y2[3]);
            *(u32x2*)(kh + k_off(t, d0)) = a; *(u32x2*)(kh + k_off(t, d0 + 32)) = b2;
          }
        } else {
          *(u32x4*)(G + (size_t)row * 1024 + (c0 - 1280)) = pack8f(v0 + b1[bj], v1 + b2v[bj]);
        } }
      asm_fence();
      cc = cn; sc = sn;
    }
  }
};

template <int H, int VCOL0  >
struct EpiV {
  static constexpr bool PERM = true;
  bf16_t *VtL, *VtC; const float* ss; const float* shw;
  DI void operator()(const AccT& acc, const Unit& u, int wr, int wc, int fr, int fq) const {
    const bool latn = u.pn * 256 < RL;
    bf16_t* basep = latn ? VtL : VtC;
    const int tsh = latn ? 11 : 8, tiles = latn ? 64 : 8;
    const int nb = (latn ? u.pn * 256 : u.pn * 256 - RL) + wc * 32 + 8 * fq;
    f32x4 r0[2], r1[2];
    _Pragma("unroll") for (int bj = 0; bj < 2; ++bj) {
      const float* sp = ss + u.pn * 256 + bj * 128 + wc * 32 + 8 * fq;
      const f32x4 a = *(const f32x4*)sp, b2 = *(const f32x4*)(sp + 4);
      _Pragma("unroll") for (int j = 0; j < 4; ++j) { r0[bj][j] = rsqrtf(a[j] * (1.f / 1024.f) + 1e-6f); r1[bj][j] = rsqrtf(b2[j] * (1.f / 1024.f) + 1e-6f); }
    }
    const int vb0 = latn ? (nb >> tsh) : 8;
    float biasr[8];
    _Pragma("unroll") for (int r_ = 0; r_ < 8; ++r_) biasr[r_] = shw[(size_t)vb0 * 4096 + VCOL0 + u.pm * 256 + (r_ >> 2) * 128 + wr * 64 + (r_ & 3) * 16 + fr];
    EPI_ROWS { const int rowd = u.pm * 256 + ai * 128 + wr * 64 + m * 16 + fr, head = rowd >> 6, d = rowd & 63;
      const unsigned rowoff = (unsigned)(((d >> 5) * 128 + (d & 31)) << 3);
      _Pragma("unroll") for (int bj = 0; bj < 2; ++bj) { const int nn = nb + bj * 128;
        const int bidx = nn >> tsh, t = nn & ((1 << tsh) - 1);
        const float bias = biasr[ai * 4 + m];
        const unsigned off = (unsigned)(((bidx * H + head) * tiles + (t >> 5)) * 2048) + rowoff + (unsigned)((((t & 31) >> 4) * 64) << 3) + (unsigned)(((t >> 3) & 1) * 4);
        const f32x4 v0 = acc[ai][bj][m][0] * r0[bj] + bias, v1 = acc[ai][bj][m][1] * r1[bj] + bias;
        u32x2 a, b2; a[0] = pack2(v0[0], v0[1]); a[1] = pack2(v0[2], v0[3]); b2[0] = pack2(v1[0], v1[1]); b2[1] = pack2(v1[2], v1[3]);
        *(u32x2*)(basep + off) = a; *(u32x2*)(basep + off + 256) = b2; } }
  }
};

struct EpiL2 {
  static constexpr bool PERM = true;
  bf16_t *Q, *Kb, *G; const float* ss; const float* shw;
  DI void operator()(const AccT& acc, const Unit& u, int wr, int wc, int fr, int fq) const {
    const int rb = u.pm * 256; const bool lat = rb < RL;
    const float* sh = shw + (size_t)(lat ? (rb >> 11) : 8) * 4096;
    const int r0 = rb + wr * 64 + fr;
    float rstd[8];
    _Pragma("unroll") for (int r_ = 0; r_ < 8; ++r_) rstd[r_] = ss[r0 + 128 * (r_ >> 2) + 16 * (r_ & 3)];
    _Pragma("unroll") for (int r_ = 0; r_ < 8; ++r_) rstd[r_] = rsqrtf(rstd[r_] * (1.f / 1024.f) + 1e-6f);
    f32x4 b1[2], b2v[2];
    _Pragma("unroll") for (int bj = 0; bj < 2; ++bj) { const int c0 = u.pn * 256 + bj * 128 + wc * 32 + 8 * fq, oc = u.pn < 8 ? c0 : c0 + 1024;
      b1[bj] = *(const f32x4*)(sh + oc); b2v[bj] = *(const f32x4*)(sh + oc + 4); }
    _Pragma("unroll") for (int r_ = 0; r_ < 8; ++r_) { const int ai = r_ >> 2, m = r_ & 3, row = r0 + 128 * ai + 16 * m;
      _Pragma("unroll") for (int bj = 0; bj < 2; ++bj) { const int c0 = u.pn * 256 + bj * 128 + wc * 32 + 8 * fq;
        const f32x4 v0 = acc[ai][bj][m][0] * rstd[r_] + b1[bj], v1 = acc[ai][bj][m][1] * rstd[r_] + b2v[bj];
        if (u.pn < 4) *(u32x4*)(Q + (size_t)row * 1024 + c0) = pack8f(v0 * QSCALE, v1 * QSCALE);
        else if (u.pn < 8) {
          const int hd = (c0 - 1024) >> 6, d0 = c0 & 63;
          bf16_t* kh; int t;
          if (lat) { kh = Kb + (size_t)((row >> 11) * 16 + hd) * 64 * 2048; t = row & 2047; }
          else { const int rr = row - RL; kh = Kb + (size_t)RL * 1024 + (size_t)((rr >> 8) * 16 + hd) * 8 * 2048; t = rr & 255; }
          *(u32x4*)(kh + k_off(t, d0)) = pack8f(v0, v1);
        } else *(u32x4*)(G + (size_t)row * 1024 + (c0 - 2048)) = pack8f(v0, v1); }
      asm_fence(); }
  }
};

struct EpiL3In {
  static constexpr bool PERM = true;
  bf16_t *ACAT, *G; const float* ss; const float* shw;
  DI void operator()(const AccT& acc, const Unit& u, int wr, int wc, int fr, int fq) const {
    const int rb = u.pm * 256;
    const float* sh = shw + (size_t)(rb < RL ? (rb >> 11) : 8) * 4096;
    const int r0 = rb + wr * 64 + fr;
    float rstd[8];
    _Pragma("unroll") for (int r_ = 0; r_ < 8; ++r_) rstd[r_] = ss[r0 + 128 * (r_ >> 2) + 16 * (r_ & 3)];
    _Pragma("unroll") for (int r_ = 0; r_ < 8; ++r_) rstd[r_] = rsqrtf(rstd[r_] * (1.f / 1024.f) + 1e-6f);
    f32x4 b1[2], b2v[2];
    _Pragma("unroll") for (int bj = 0; bj < 2; ++bj) { const int c0 = u.pn * 256 + bj * 128 + wc * 32 + 8 * fq; b1[bj] = *(const f32x4*)(sh + c0); b2v[bj] = *(const f32x4*)(sh + c0 + 4); }
    _Pragma("unroll") for (int r_ = 0; r_ < 8; ++r_) { const int ai = r_ >> 2, m = r_ & 3, row = r0 + 128 * ai + 16 * m;
      _Pragma("unroll") for (int bj = 0; bj < 2; ++bj) { const int c0 = u.pn * 256 + bj * 128 + wc * 32 + 8 * fq;
        const u32x4 w = pack8f(acc[ai][bj][m][0] * rstd[r_] + b1[bj], acc[ai][bj][m][1] * rstd[r_] + b2v[bj]);
        if (u.pn < 4) *(u32x4*)(ACAT + ((size_t)(c0 >> 4) * NCH + (row >> 4)) * 512 + (row & 15) * 16 + (c0 & 15)) = w;
        else if (rb < RL) *(u32x4*)(G + (size_t)row * 1024 + (c0 - 1024)) = w; }
      asm_fence(); }
  }
};

struct EpiS5State {
  static constexpr bool PERM = false;
  float* S;
  DI void operator()(const AccT& acc, const Unit& u, int wr, int wc, int fr, int fq) const {
    float* sp = S + ((size_t)u.pb * NCHP + u.pm * 256) * 256 + wc * 32 + 4 * fq;
    EPI_ROWS { const unsigned o = (unsigned)(ai * 128 + wr * 64 + m * 16 + fr) * 256u;
      *(f32x4*)(sp + o) = acc[ai][0][m][0]; *(f32x4*)(sp + o + 16) = acc[ai][0][m][1];
      *(f32x4*)(sp + o + 128) = acc[ai][1][m][0]; *(f32x4*)(sp + o + 144) = acc[ai][1][m][1]; }
  }
};

struct EpiS5Y {
  static constexpr bool PERM = true;
  bf16_t* YG;
  DI void operator()(const AccT& acc, const Unit& u, int wr, int wc, int fr, int fq) const {
    EPI_ROWS { const int chunk = u.pm * 256 + ai * 128 + wr * 64 + m * 16 + fr;
      _Pragma("unroll") for (int bj = 0; bj < 2; ++bj) { const int n0 = bj * 128 + wc * 32 + 8 * fq;
        f32x4 v0 = acc[ai][bj][m][0], v1 = acc[ai][bj][m][1];
        _Pragma("unroll") for (int j = 0; j < 4; ++j) { v0[j] = gelu_tanh(v0[j]); v1[j] = gelu_tanh(v1[j]); }
        *(u32x4*)(YG + ((size_t)chunk * 16 + (n0 >> 4)) * 1024 + u.pb * 16 + (n0 & 15)) = pack8f(v0, v1); } }
  }
};

struct EpiGlu {
  static constexpr bool PERM = true;
  const bf16_t *YG, *G; const float* gb; bf16_t* ACT;
  DI void operator()(const AccT& acc, const Unit& u, int wr, int wc, int fr, int fq) const {
    const int r0 = u.pm * 256 + wr * 64 + fr, cb = u.pn * 256 + wc * 32 + 8 * fq;
    f32x4 b0[2], b1[2];
    _Pragma("unroll") for (int bj = 0; bj < 2; ++bj) { b0[bj] = *(const f32x4*)(gb + cb + bj * 128); b1[bj] = *(const f32x4*)(gb + cb + bj * 128 + 4); }
    u32x4 yc[2], gc[2], yn[2], gn_[2];
    _Pragma("unroll") for (int bj = 0; bj < 2; ++bj) { yc[bj] = *(const u32x4*)(YG + (size_t)r0 * 1024 + cb + bj * 128); gc[bj] = *(const u32x4*)(G + (size_t)r0 * 1024 + cb + bj * 128); }
    _Pragma("unroll") for (int r_ = 0; r_ < 8; ++r_) {
      const int ai = r_ >> 2, m = r_ & 3, row = r0 + 128 * ai + 16 * m;
      if (r_ + 1 < 8) { const int rown = r0 + 128 * ((r_ + 1) >> 2) + 16 * ((r_ + 1) & 3);
        _Pragma("unroll") for (int bj = 0; bj < 2; ++bj) { yn[bj] = *(const u32x4*)(YG + (size_t)rown * 1024 + cb + bj * 128); gn_[bj] = *(const u32x4*)(G + (size_t)rown * 1024 + cb + bj * 128); } }
      _Pragma("unroll") for (int bj = 0; bj < 2; ++bj) {
        const u32x4 y = yc[bj], gg = gc[bj];
        const f32x4 v0 = acc[ai][bj][m][0], v1 = acc[ai][bj][m][1];
        u32x4 w;
        w[0] = pack2(bflo(y[0]) * sigm(v0[0] + b0[bj][0]) * silu(bflo(gg[0])), bfhi(y[0]) * sigm(v0[1] + b0[bj][1]) * silu(bfhi(gg[0])));
        w[1] = pack2(bflo(y[1]) * sigm(v0[2] + b0[bj][2]) * silu(bflo(gg[1])), bfhi(y[1]) * sigm(v0[3] + b0[bj][3]) * silu(bfhi(gg[1])));
        w[2] = pack2(bflo(y[2]) * sigm(v1[0] + b1[bj][0]) * silu(bflo(gg[2])), bfhi(y[2]) * sigm(v1[1] + b1[bj][1]) * silu(bfhi(gg[2])));
        w[3] = pack2(bflo(y[3]) * sigm(v1[2] + b1[bj][2]) * silu(bflo(gg[3])), bfhi(y[3]) * sigm(v1[3] + b1[bj][3]) * silu(bfhi(gg[3])));
        *(u32x4*)(ACT + (size_t)row * 1024 + cb + bj * 128) = w;
      }
      asm_fence();
      _Pragma("unroll") for (int bj = 0; bj < 2; ++bj) { yc[bj] = yn[bj]; gc[bj] = gn_[bj]; }
    }
  }
};

struct TrJob { const float* W; bf16_t* dst; int N, ldd, k0, n0, perm, dup; };
DI TrJob tr_job(const Params& p, int j) {
  constexpr int T0 = 16 * 44, T1 = T0 + 22 * 16, T2 = T1 + 16 * 40, T3 = T2 + 256, T4 = T3 + 16 * 64, T5 = T4 + 256, T6 = T5 + 16 * 32, T7 = T6 + 256;
  char* ws = p.ws;
  TrJob t; int tile, K; t.perm = 0; t.dup = 0;
  bf16_t* base;
  if (j < T0) { t.W = p.in[7]; K = 1024; t.N = 2816; base = (bf16_t*)(ws + O_WT_IN0); tile = j; }
  else if (j < T1) { t.W = p.in[15]; K = 1408; t.N = 1024; base = (bf16_t*)(ws + O_WT_OUT0); tile = j - T0; }
  else if (j < T2) { t.W = p.in[19]; K = 1024; t.N = 2560; base = (bf16_t*)(ws + O_WT_IN1); tile = j - T1; }
  else if (j < T3) { t.W = p.in[21]; K = 1024; t.N = 1024; base = (bf16_t*)(ws + O_WT_OUT1); tile = j - T2; }
  else if (j < T4) { t.W = p.in[25]; K = 1024; t.N = 4096; base = (bf16_t*)(ws + O_WT_IN2); tile = j - T3; }
  else if (j < T5) { t.W = p.in[27]; K = 1024; t.N = 1024; base = (bf16_t*)(ws + O_WT_OUT2); tile = j - T4; }
  else if (j < T6) { t.W = p.in[31]; K = 1024; t.N = 2048; base = (bf16_t*)(ws + O_WT_IN3); tile = j - T5; }
  else if (j < T7) { t.W = p.in[40]; K = 1024; t.N = 1024; base = (bf16_t*)(ws + O_WT_GLU); tile = j - T6; }
  else { t.W = p.in[42]; K = 1024; t.N = 1024; base = (bf16_t*)(ws + O_WT_OUT3); tile = j - T7; }
  const int tn = t.N >> 6, tk_i = tile / tn;
  t.k0 = tk_i * 64; t.n0 = (tile - tk_i * tn) * 64;
  t.ldd = K;
  int drow = t.n0;
  if (j >= T1 && j < T2) {
    if (t.n0 < 1280) t.perm = 1;
    else if (t.n0 < 1536) drow = 2304 + (t.n0 - 1280);
    else drow = t.n0 - 256;
  } else if (j >= T3 && j < T4) {
    if (t.n0 >= 3072) drow = t.n0 - 1024;
    else if (t.n0 >= 2048) drow = 3072 + (t.n0 - 2048);
  }
  t.dst = base + (size_t)drow * t.ldd + t.k0;
  return t;
}

DI void transpose_range(const Params& p, char* smem, int j0, int j1, int first_blk, int skew) {
  if ((int)blockIdx.x < first_blk) return;
  float* smf = (float*)smem;
  const int G = (int)gridDim.x - first_blk;
  const int c = threadIdx.x & 63, rr = threadIdx.x >> 6, kp = threadIdx.x & 31, nb = threadIdx.x >> 5;
  int j = j0 + ((int)blockIdx.x - first_blk + G - (skew % G)) % G;
  float v[8];
  TrJob cur{};
  __syncthreads();
  if (j < j1) { cur = tr_job(p, j); _Pragma("unroll") for (int i = 0; i < 8; ++i) v[i] = __builtin_nontemporal_load(cur.W + (size_t)(cur.k0 + i * 8 + rr) * cur.N + cur.n0 + c); }
  for (; j < j1; j += G) {
    _Pragma("unroll") for (int i = 0; i < 8; ++i) smf[(i * 8 + rr) * 65 + c] = v[i];
    const TrJob me = cur;
    if (j + G < j1) { cur = tr_job(p, j + G); _Pragma("unroll") for (int i = 0; i < 8; ++i) v[i] = __builtin_nontemporal_load(cur.W + (size_t)(cur.k0 + i * 8 + rr) * cur.N + cur.n0 + c); }
    __syncthreads();
    _Pragma("unroll") for (int i = 0; i < 4; ++i) {
      const int n = nb + 16 * i;
      const int dr = me.perm ? (((n & 31) << 1) | (n >> 5)) : n;
      const unsigned w = pack2(smf[(2 * kp) * 65 + n], smf[(2 * kp + 1) * 65 + n]);
      bf16_t* d = me.dst + (size_t)dr * me.ldd + 2 * kp;
      *(unsigned*)d = w;
      if (me.dup) *(unsigned*)(d + 1408) = w;
    }
    __syncthreads();
  }
}

DI void phase0(const Params& p, char* smem) {
  char* ws = p.ws;
  float* smf = (float*)smem;
  const int NT_ = blockDim.x;
  for (int job = blockIdx.x; job < 384; job += gridDim.x) {
    const int l = job / 96, n0 = (job % 96) * 32;
    const float* aw = l == 0 ? p.in[4] : l == 1 ? p.in[16] : l == 2 ? p.in[22] : p.in[28];
    const float* ab = l == 0 ? p.in[5] : l == 1 ? p.in[17] : l == 2 ? p.in[23] : p.in[29];
    float* sv = smf;
    float* red = smf + 9 * 1024;
    for (int idx = threadIdx.x; idx < 9 * 1024; idx += NT_) {
      const int v = idx >> 10, k = idx & 1023;
      const float x = v < 8 ? p.in[1][v * 1024 + k] : p.in[3][k];
      sv[idx] = silu(x);
    }
    __syncthreads();
    const int col = threadIdx.x & 31, ks = threadIdx.x >> 5;
    float a[9];
    _Pragma("unroll") for (int v = 0; v < 9; ++v) a[v] = 0.f;
    for (int kb = ks * 64; kb < ks * 64 + 64; kb += 16) {
      float wv[16];
      _Pragma("unroll") for (int u = 0; u < 16; ++u) wv[u] = aw[(size_t)(kb + u) * 3072 + n0 + col];
      _Pragma("unroll") for (int u = 0; u < 16; ++u) _Pragma("unroll") for (int v = 0; v < 9; ++v) a[v] += sv[v * 1024 + kb + u] * wv[u];
    }
    _Pragma("unroll") for (int v = 0; v < 9; ++v) red[(ks * 9 + v) * 32 + col] = a[v];
    __syncthreads();
    float* MOD = (float*)(ws + O_MOD);
    for (int idx = threadIdx.x; idx < 9 * 32; idx += NT_) {
      const int v = idx >> 5, cc = idx & 31;
      float sum = ab[n0 + cc];
      _Pragma("unroll") for (int q = 0; q < 16; ++q) sum += red[(q * 9 + v) * 32 + cc];
      MOD[(size_t)(l * 9 + v) * 3072 + n0 + cc] = sum;
    }
    __syncthreads();
  }
  transpose_range(p, smem, 0, 16 * 44, gridDim.x == 256 ? 128 : 0, 0);
}

DI void tables_phase(const Params& p, int first_blk) {
  if ((int)blockIdx.x < first_blk) return;
  char* ws = p.ws;
  const int gt = ((int)blockIdx.x - first_blk) * blockDim.x + threadIdx.x, gn = ((int)gridDim.x - first_blk) * blockDim.x;
  {
    bf16_t* WG = (bf16_t*)(ws + O_WG);
    for (int idx = gt; idx < 16 * 2 * 192 * 96; idx += gn) {
      const int kk = idx % 96; int t = idx / 96; const int n = t % 192; t /= 192; const int d = t & 1, k = t >> 1;
      const int c = n >> 5, gate = (n >> 4) & 1, ch = c * 16 + (n & 15);
      float v = 0.f;
      if (ch < 88 && kk < 88) { const float* w = gate ? p.in[12] : p.in[10]; v = w[((size_t)(d * 16 + k) * 88 + kk) * 88 + ch]; }
      WG[idx] = f2bf(v);
    }
  }
  { float* SS = (float*)(ws + O_SS); for (int idx = gt; idx < 3 * R; idx += gn) SS[idx] = 0.f; }
  {
    float* RCt = (float*)(ws + O_ROPEC); float* RSt = (float*)(ws + O_ROPES);
    for (int idx = gt; idx < 2048 * 32; idx += gn) {
      const int t = idx >> 5, j = idx & 31;
      const float pos = (float)(j < 16 ? (t >> 6) : (t & 63));
      const float freq = exp2f(-(float)(j & 15) * (13.287712379549449f / 16.f));
      float s, c; sincos_rev(pos * freq * 0.15915494309189535f, s, c);
      RCt[idx] = c; RSt[idx] = s;
    }
  }
  {
    float2* POW = (float2*)(ws + O_POW); float2* BB = (float2*)(ws + O_BBAR);
    for (int idx = gt; idx < 2 * 64 * 17 * 64; idx += gn) {
      const int pp = idx & 63; int t = idx >> 6; const int n = t % 17; t /= 17;
      const float are = p.in[32][t * 64 + pp], aim = p.in[33][t * 64 + pp], dt = expf(p.in[34][t]);
      const float mag = expf((float)n * are * dt);
      const double rev = (double)n * (double)aim * (double)dt * 0.15915494309189535;
      float s, c; sincos_rev((float)(rev - rint(rev)), s, c);
      POW[idx] = make_float2(mag * c, mag * s);
    }
    for (int idx = gt; idx < 2 * 64 * 64 * 16; idx += gn) {
      const int t = idx >> 4;
      const int dg = t >> 6;
      const float are = p.in[32][t], aim = p.in[33][t], dt = expf(p.in[34][dg]);
      const float mag = expf(are * dt);
      const double rev = (double)aim * (double)dt * 0.15915494309189535;
      float s, c; sincos_rev((float)(rev - rint(rev)), s, c);
      const float nr = mag * c - 1.f, ni = mag * s;
      const float den = 1.f / (are * are + aim * aim);
      const float cr = (nr * are + ni * aim) * den, ci = (ni * are - nr * aim) * den;
      const float br = p.in[35][idx], bi = p.in[36][idx];
      BB[idx] = make_float2(cr * br - ci * bi, cr * bi + ci * br);
    }
  }
}

DI void modfold_phase(const Params& p, char* smem) {
  char* ws = p.ws;
  const float* MOD = (const float*)(ws + O_MOD);
  float* GS = (float*)(ws + O_GS);
  float* SHW = (float*)(ws + O_SHW);
  const int NT_ = blockDim.x;
  for (int idx = blockIdx.x * NT_ + threadIdx.x; idx < 3 * 9 * 1024; idx += gridDim.x * NT_) {
    const int k = idx & 1023, lv = idx >> 10, l = lv / 9 + 1, v = lv - (l - 1) * 9;
    const float* gn = l == 1 ? p.in[18] : l == 2 ? p.in[24] : p.in[30];
    GS[idx] = gn[k] * (1.f + MOD[(size_t)(l * 9 + v) * 3072 + 1024 + k]);
  }
  float* smf = (float*)smem;
  float* sv = smf;
  float* red = smf + 9 * 1024;
  for (int job = (int)gridDim.x - 1 - (int)blockIdx.x; job < 80 + 128 + 64; job += gridDim.x) {
    int l, n0; const float* W; int N;
    if (job < 80) { l = 1; n0 = job * 32; W = p.in[19]; N = 2560; }
    else if (job < 208) { l = 2; n0 = (job - 80) * 32; W = p.in[25]; N = 4096; }
    else { l = 3; n0 = (job - 208) * 32; W = p.in[31]; N = 2048; }
    __syncthreads();
    for (int idx = threadIdx.x; idx < 9 * 1024; idx += NT_) sv[idx] = MOD[(size_t)(l * 9 + (idx >> 10)) * 3072 + (idx & 1023)];
    __syncthreads();
    const int col = threadIdx.x & 31, ks = threadIdx.x >> 5;
    float a[9];
    _Pragma("unroll") for (int v = 0; v < 9; ++v) a[v] = 0.f;
    for (int kb = ks * 64; kb < ks * 64 + 64; kb += 16) {
      float wv[16];
      _Pragma("unroll") for (int u = 0; u < 16; ++u) wv[u] = W[(size_t)(kb + u) * N + n0 + col];
      _Pragma("unroll") for (int u = 0; u < 16; ++u) _Pragma("unroll") for (int v = 0; v < 9; ++v) a[v] += sv[v * 1024 + kb + u] * wv[u];
    }
    _Pragma("unroll") for (int v = 0; v < 9; ++v) red[(ks * 9 + v) * 32 + col] = a[v];
    __syncthreads();
    for (int idx = threadIdx.x; idx < 9 * 32; idx += NT_) {
      const int v = idx >> 5, cc = idx & 31;
      float sum = 0.f;
      _Pragma("unroll") for (int q = 0; q < 16; ++q) sum += red[(q * 9 + v) * 32 + cc];
      SHW[(size_t)((l - 1) * 9 + v) * 4096 + n0 + cc] = sum;
    }
  }
  __syncthreads();
}

DI void norm_phase(const float* lat, const float* ctx, const float* gn, const float* mod  , bf16_t* NB_) {
  const int tid_ = opaque_tid();
  const int lane = tid_ & 63;
  const int w0 = blockIdx.x * 8 + (tid_ >> 6), nw = gridDim.x * 8;
  for (int row0 = w0 * 2; row0 < R; row0 += nw * 2) {
    f32x4 v[2][4]; float ss[2] = {0.f, 0.f};
    const float* m[2];
    _Pragma("unroll") for (int q = 0; q < 2; ++q) {
      const int row = row0 + q;
      const float* src;
      if (row < RL) { src = lat + (size_t)row * 1024; m[q] = mod + (size_t)(row >> 11) * 3072; }
      else { src = ctx + (size_t)(row - RL) * 1024; m[q] = mod + (size_t)8 * 3072; }
      _Pragma("unroll") for (int i = 0; i < 4; ++i) v[q][i] = __builtin_nontemporal_load((const f32x4*)(src + (i * 64 + lane) * 4));
    }
    _Pragma("unroll") for (int q = 0; q < 2; ++q) {
      _Pragma("unroll") for (int i = 0; i < 4; ++i) ss[q] += v[q][i][0] * v[q][i][0] + v[q][i][1] * v[q][i][1] + v[q][i][2] * v[q][i][2] + v[q][i][3] * v[q][i][3];
      _Pragma("unroll") for (int o = 32; o >= 1; o >>= 1) ss[q] += __shfl_xor(ss[q], o);
    }
    _Pragma("unroll") for (int q = 0; q < 2; ++q) {
      const float rstd = rsqrtf(ss[q] * (1.f / 1024.f) + 1e-6f);
      _Pragma("unroll") for (int i = 0; i < 4; ++i) {
        const int k = (i * 64 + lane) * 4;
        const f32x4 g = *(const f32x4*)(gn + k), sh = *(const f32x4*)(m[q] + k), sc = *(const f32x4*)(m[q] + 1024 + k);
        u32x2 o;
        o[0] = pack2(v[q][i][0] * rstd * g[0] * (1.f + sc[0]) + sh[0], v[q][i][1] * rstd * g[1] * (1.f + sc[1]) + sh[1]);
        o[1] = pack2(v[q][i][2] * rstd * g[2] * (1.f + sc[2]) + sh[2], v[q][i][3] * rstd * g[3] * (1.f + sc[3]) + sh[3]);
        *(u32x2*)(NB_ + (size_t)(row0 + q) * 1024 + k) = o;
      }
    }
  }
}

DI void final_norm_phase(float* H, const float* gn) {
  const int tid_ = opaque_tid();
  const int lane = tid_ & 63;
  const int w0 = blockIdx.x * 8 + (tid_ >> 6), nw = gridDim.x * 8;
  for (int row0 = w0 * 2; row0 < RL; row0 += nw * 2) {
    f32x4 v[2][4]; float ss[2] = {0.f, 0.f};
    _Pragma("unroll") for (int q = 0; q < 2; ++q) _Pragma("unroll") for (int i = 0; i < 4; ++i) v[q][i] = __builtin_nontemporal_load((const f32x4*)(H + (size_t)(row0 + q) * 1024 + (i * 64 + lane) * 4));
    _Pragma("unroll") for (int q = 0; q < 2; ++q) {
      _Pragma("unroll") for (int i = 0; i < 4; ++i) ss[q] += v[q][i][0] * v[q][i][0] + v[q][i][1] * v[q][i][1] + v[q][i][2] * v[q][i][2] + v[q][i][3] * v[q][i][3];
      _Pragma("unroll") for (int o = 32; o >= 1; o >>= 1) ss[q] += __shfl_xor(ss[q], o);
    }
    _Pragma("unroll") for (int q = 0; q < 2; ++q) {
      const float rstd = rsqrtf(ss[q] * (1.f / 1024.f) + 1e-6f);
      _Pragma("unroll") for (int i = 0; i < 4; ++i) {
        const int k = (i * 64 + lane) * 4;
        const f32x4 g = *(const f32x4*)(gn + k);
        f32x4 o; o[0] = v[q][i][0] * rstd * g[0]; o[1] = v[q][i][1] * rstd * g[1]; o[2] = v[q][i][2] * rstd * g[2]; o[3] = v[q][i][3] * rstd * g[3];
        __builtin_nontemporal_store(o, (f32x4*)(H + (size_t)(row0 + q) * 1024 + k));
      }
    }
  }
}

DI void lru_phase(const Params& p, char* smem) {
  char* ws = p.ws;
  const int tid_ = opaque_tid();
  const int sub = tid_ >> 8;
  smem += sub * 36864;
  bf16_t* Wl = (bf16_t*)smem;
  bf16_t* Uc = Wl + 96 * 96;
  float* aggA = (float*)(Uc + 64 * 96);
  float* aggH = aggA + 16 * 48;
  const bf16_t* U0 = (const bf16_t*)(ws + O_U0);
  const bf16_t* G0 = (const bf16_t*)(ws + O_G0);
  const int tid = tid_ & 255, lane = tid & 63, w = tid >> 6, col = lane & 15, quad = lane >> 4;
  const int vbl = (gridDim.x % 8 == 0) ? (blockIdx.x & 7) * (gridDim.x >> 3) + (blockIdx.x >> 3) : blockIdx.x;
  for (int item = vbl; item < 256; item += gridDim.x) {
    const int half = item & 1, dir = sub, k = (item >> 1) & 15, b = item >> 5;
    bf16_t* ACT = (bf16_t*)(ws + O_ACT0);
    __syncthreads();
    {
      const u32x4* src = (const u32x4*)((const bf16_t*)(ws + O_WG) + ((size_t)(k * 2 + dir) * 192 + half * 96) * 96);
      u32x4* dst = (u32x4*)Wl;
      for (int i = tid; i < 96 * 96 / 8; i += 256) dst[i] = src[i];
      if (tid < 64) { u32x4 z; z[0] = z[1] = z[2] = z[3] = 0u; *(u32x4*)(Uc + tid * 96 + 88) = z; }
    }
    float ba[3], bx[3], sp8[3];
    _Pragma("unroll") for (int c = 0; c < 3; ++c) {
      const int ch = 48 * half + 16 * c + col;
      if (ch < 88) {
        ba[c] = -1.4426950408889634f * p.in[11][dir * LW + k * 88 + ch]; bx[c] = -1.4426950408889634f * p.in[13][dir * LW + k * 88 + ch];
        sp8[c] = 8.f * 1.4426950408889634f * log1pf(expf(-p.in[14][dir * LW + k * 88 + ch]));
      } else { ba[c] = 0.f; bx[c] = 0.f; sp8[c] = 0.f; }
    }
    const int cp = tid % 44, run = tid / 44;
    float cw[4][2], cb2[2];
    _Pragma("unroll") for (int t = 0; t < 4; ++t) { cw[t][0] = p.in[8][t * LW + k * 88 + 2 * cp]; cw[t][1] = p.in[8][t * LW + k * 88 + 2 * cp + 1]; }
    cb2[0] = p.in[9][k * 88 + 2 * cp]; cb2[1] = p.in[9][k * 88 + 2 * cp + 1];
    float carry = 0.f;
    unsigned un[19]; unsigned unmask = 0u;
    auto tile_info = [&](int ti, int& rowbase, int& L, int& t0) {
      if (ti < 4) { rowbase = RL + b * 256; L = 256; t0 = (dir ? 3 - ti : ti) * 64; }
      else { rowbase = b * 2048; L = 2048; t0 = (dir ? 31 - (ti - 4) : (ti - 4)) * 64; }
    };
    auto prefetch = [&](int ti) {
      int rowbase, L, t0; tile_info(ti, rowbase, L, t0);
      const unsigned* ub = (const unsigned*)(U0 + (size_t)rowbase * LW + k * 88 + 2 * cp);
      const int tb = t0 + 16 * (run < 4 ? run : 3) - 2;
      unsigned vm = 0u;
      _Pragma("unroll") for (int i = 0; i < 19; ++i) {
        const int tt = tb + i;
        un[i] = ub[(unsigned)min(max(tt, 0), L - 1) * (unsigned)(LW / 2)];
        vm |= (tt >= 0 && tt < L) ? (1u << i) : 0u;
      }
      unmask = vm;
    };
    prefetch(0);
    for (int ti = 0; ti < 36; ++ti) {
      int rowbase, L, t0; tile_info(ti, rowbase, L, t0);
      if (tid < 176) {
        if (unmask != 0x7ffffu) { _Pragma("unroll") for (int i = 0; i < 19; ++i) un[i] = ((unmask >> i) & 1u) ? un[i] : 0u; }
        _Pragma("unroll") for (int t = 0; t < 16; ++t) {
          const float y0 = cb2[0] + cw[0][0] * bflo(un[t]) + cw[1][0] * bflo(un[t + 1]) + cw[2][0] * bflo(un[t + 2]) + cw[3][0] * bflo(un[t + 3]);
          const float y1 = cb2[1] + cw[0][1] * bfhi(un[t]) + cw[1][1] * bfhi(un[t + 1]) + cw[2][1] * bfhi(un[t + 2]) + cw[3][1] * bfhi(un[t + 3]);
          *(unsigned*)(Uc + (16 * run + t) * 96 + 2 * cp) = pack2(y0, y1);
        }
      }
      if (ti + 1 < 36) prefetch(ti + 1);
      bf16_t gv[3][4];
      _Pragma("unroll") for (int c = 0; c < 3; ++c) {
        const int ch = 48 * half + 16 * c + col;
        _Pragma("unroll") for (int j = 0; j < 4; ++j)
          gv[c][j] = G0[(unsigned)(rowbase + t0 + 16 * w + 4 * quad) * (unsigned)LW + (unsigned)(j * LW + k * 88 + min(ch, 87))];
      }
      const bool second = ti < 4 ? (ti >= 2) : (ti >= 20);
      const bool adjacent = (ti == 2) || (ti == 20);
      bf16_t pv[3][4];
      if (second && !adjacent) {
        _Pragma("unroll") for (int c = 0; c < 3; ++c) {
          const int ch = 48 * half + 16 * c + col;
          _Pragma("unroll") for (int j = 0; j < 4; ++j) pv[c][j] = ACT[(unsigned)(rowbase + t0 + 16 * w + 4 * quad) * (unsigned)LW + (unsigned)(j * LW + k * 88 + min(ch, 87))];
        }
      } else { _Pragma("unroll") for (int c = 0; c < 3; ++c) _Pragma("unroll") for (int j = 0; j < 4; ++j) pv[c][j] = (bf16_t)0; }
      __syncthreads();
      bf16x8 af[3];
      _Pragma("unroll") for (int ks = 0; ks < 3; ++ks) af[ks] = *(const bf16x8*)(Uc + (16 * w + col) * 96 + ks * 32 + quad * 8);
      float hl[3][4], ac[3][4];
      _Pragma("unroll") for (int c = 0; c < 3; ++c) {
        f32x4 gA = {0.f, 0.f, 0.f, 0.f}, gX = {0.f, 0.f, 0.f, 0.f};
        _Pragma("unroll") for (int ks = 0; ks < 3; ++ks) {
          const bf16x8 bA = *(const bf16x8*)(Wl + ((c * 2 + 0) * 16 + col) * 96 + ks * 32 + quad * 8);
          const bf16x8 bX = *(const bf16x8*)(Wl + ((c * 2 + 1) * 16 + col) * 96 + ks * 32 + quad * 8);
          gA = MFMA16(af[ks], bA, gA);
          gX = MFMA16(af[ks], bX, gX);
        }
        float a[4], bb[4];
        _Pragma("unroll") for (int j = 0; j < 4; ++j) {
          const float uval = bf2f(Uc[(16 * w + 4 * quad + j) * 96 + 48 * half + 16 * c + col]);
          const float rg = frcp(1.f + __builtin_amdgcn_exp2f(fmaf(gA[j], -1.4426950408889634f, ba[c])));
          const float ig = frcp(1.f + __builtin_amdgcn_exp2f(fmaf(gX[j], -1.4426950408889634f, bx[c])));
          a[j] = __builtin_amdgcn_exp2f(-sp8[c] * rg);
          bb[j] = __builtin_amdgcn_sqrtf(fmaxf(1.f - a[j] * a[j], 0.f)) * ig * uval;
        }
        if (dir == 0) {
          hl[c][0] = bb[0]; ac[c][0] = a[0];
          _Pragma("unroll") for (int j = 1; j < 4; ++j) { hl[c][j] = a[j] * hl[c][j - 1] + bb[j]; ac[c][j] = a[j] * ac[c][j - 1]; }
          aggA[(4 * w + quad) * 48 + 16 * c + col] = ac[c][3]; aggH[(4 * w + quad) * 48 + 16 * c + col] = hl[c][3];
        } else {
          hl[c][3] = bb[3]; ac[c][3] = a[3];
          _Pragma("unroll") for (int j = 2; j >= 0; --j) { hl[c][j] = a[j] * hl[c][j + 1] + bb[j]; ac[c][j] = a[j] * ac[c][j + 1]; }
          aggA[(4 * w + quad) * 48 + 16 * c + col] = ac[c][0]; aggH[(4 * w + quad) * 48 + 16 * c + col] = hl[c][0];
        }
      }
      asm volatile("s_waitcnt vmcnt(0)" ::: "memory");
      __syncthreads();
      if (adjacent) {
        _Pragma("unroll") for (int c = 0; c < 3; ++c) {
          const int ch = 48 * half + 16 * c + col;
          _Pragma("unroll") for (int j = 0; j < 4; ++j)
            pv[c][j] = ACT[(unsigned)(rowbase + t0 + 16 * w + 4 * quad) * (unsigned)LW + (unsigned)(j * LW + k * 88 + min(ch, 87))];
        }
      }
      if (tid < 48) {
        float A_[16], H_[16];
        _Pragma("unroll") for (int s_ = 0; s_ < 16; ++s_) { A_[s_] = aggA[s_ * 48 + tid]; H_[s_] = aggH[s_ * 48 + tid]; }
        float cin = carry;
        if (dir == 0) { _Pragma("unroll") for (int s_ = 0; s_ < 16; ++s_) { aggA[s_ * 48 + tid] = cin; cin = A_[s_] * cin + H_[s_]; } }
        else { _Pragma("unroll") for (int s_ = 15; s_ >= 0; --s_) { aggA[s_ * 48 + tid] = cin; cin = A_[s_] * cin + H_[s_]; } }
        carry = cin;
      }
      __syncthreads();
      _Pragma("unroll") for (int c = 0; c < 3; ++c) {
        const int ch = 48 * half + 16 * c + col;
        if (ch < 88) {
          const float cin = aggA[(4 * w + quad) * 48 + 16 * c + col];
          _Pragma("unroll") for (int j = 0; j < 4; ++j) {
            const unsigned idx = (unsigned)(rowbase + t0 + 16 * w + 4 * quad) * (unsigned)LW + (unsigned)(j * LW + k * 88 + ch);
            const float hv = hl[c][j] + ac[c][j] * cin;
            ACT[idx] = f2bf(hv * silu(bf2f(gv[c][j])) + bf2f(pv[c][j]));
          }
        }
      }

    }
  }
}

struct AttnSt { f32x16 O0, O1; float m, l; };
DI bf16x8 ld16(const bf16_t* p) { return *(const bf16x8*)p; }
DI bf16x8 ld8x2(const bf16_t* p0) { const s16x4 a = *(const s16x4*)p0; const s16x4 b = *(const s16x4*)(p0 + 8); return __builtin_shufflevector(a, b, 0, 1, 2, 3, 4, 5, 6, 7); }
DI bf16x8 pack8(const f32x16& P, int s) {
  u32x4 u;
  _Pragma("unroll") for (int j = 0; j < 4; ++j) u[j] = pack2(P[8 * s + 2 * j], P[8 * s + 2 * j + 1]);
  return __builtin_bit_cast(bf16x8, u);
}

struct KVt { bf16x8 k0, k1, k2, k3, v00, v01, v10, v11; };
DI void attn_load(KVt& t, const bf16_t* kt_, const bf16_t* vt_) {
  t.k0 = ld16(kt_); t.k1 = ld16(kt_ + 512); t.k2 = ld16(kt_ + 1024); t.k3 = ld16(kt_ + 1536);
  t.v00 = ld16(vt_); t.v01 = ld16(vt_ + 512); t.v10 = ld16(vt_ + 1024); t.v11 = ld16(vt_ + 1536);
}
template <class F>
DI void attn_compute(AttnSt& st, const bf16x8 (&qf)[4], const KVt& t, F fmod) {
  f32x16 S = zero16();
  S = MFMA32(t.k0, qf[0], S); S = MFMA32(t.k1, qf[1], S); S = MFMA32(t.k2, qf[2], S); S = MFMA32(t.k3, qf[3], S);
  float mx = -3.0e38f;
  _Pragma("unroll") for (int i = 0; i < 16; ++i) { S[i] = fmod(i, S[i]); mx = fmaxf(mx, S[i]); }
  mx = fmaxf(mx, __shfl_xor(mx, 32));
  const float mn = fmaxf(st.m, mx);
  float ls = 0.f;
  f32x16 P;
  _Pragma("unroll") for (int i = 0; i < 16; ++i) { P[i] = __builtin_amdgcn_exp2f(S[i] - mn); ls += P[i]; }
  if (__builtin_amdgcn_ballot_w64(mn > st.m) != 0ull) {
    const float alpha = __builtin_amdgcn_exp2f(st.m - mn);
    st.m = mn;
    st.l *= alpha;
    _Pragma("unroll") for (int i = 0; i < 16; ++i) { st.O0[i] *= alpha; st.O1[i] *= alpha; }
  }
  st.l += ls;
  const bf16x8 p0 = pack8(P, 0), p1 = pack8(P, 1);
  st.O0 = MFMA32(t.v00, p0, st.O0); st.O0 = MFMA32(t.v01, p1, st.O0);
  st.O1 = MFMA32(t.v10, p0, st.O1); st.O1 = MFMA32(t.v11, p1, st.O1);
}

struct GPre { u32x2 g0[4], g1[4]; };
DI void attn_gload(GPre& gp, const bf16_t* Grow  , int h) {
  _Pragma("unroll") for (int q = 0; q < 4; ++q) { gp.g0[q] = *(const u32x2*)(Grow + 8 * q + 4 * h); gp.g1[q] = *(const u32x2*)(Grow + 32 + 8 * q + 4 * h); }
}
DI void attn_finish(AttnSt& st, const GPre& gp, bf16_t* Arow  , int h) {
  const float lt = st.l + __shfl_xor(st.l, 32);
  const float inv = frcp(lt);
  unsigned w0[4][2], w1[4][2];
  _Pragma("unroll") for (int q = 0; q < 4; ++q) {
    const u32x2 g0 = gp.g0[q], g1 = gp.g1[q];
    w0[q][0] = pack2(st.O0[4 * q + 0] * inv * silu(bflo(g0[0])), st.O0[4 * q + 1] * inv * silu(bfhi(g0[0])));
    w0[q][1] = pack2(st.O0[4 * q + 2] * inv * silu(bflo(g0[1])), st.O0[4 * q + 3] * inv * silu(bfhi(g0[1])));
    w1[q][0] = pack2(st.O1[4 * q + 0] * inv * silu(bflo(g1[0])), st.O1[4 * q + 1] * inv * silu(bfhi(g1[0])));
    w1[q][1] = pack2(st.O1[4 * q + 2] * inv * silu(bflo(g1[1])), st.O1[4 * q + 3] * inv * silu(bfhi(g1[1])));
  }
  _Pragma("unroll") for (int qp = 0; qp < 2; ++qp) {
    const int q = 2 * qp;
    {
      const auto s0 = __builtin_amdgcn_permlane32_swap(w0[q][0], w0[q + 1][0], false, false);
      const auto s1 = __builtin_amdgcn_permlane32_swap(w0[q][1], w0[q + 1][1], false, false);
      u32x4 o; o[0] = s0[0]; o[1] = s1[0]; o[2] = s0[1]; o[3] = s1[1];
      *(u32x4*)(Arow + 8 * q + 8 * h) = o;
    }
    {
      const auto s0 = __builtin_amdgcn_permlane32_swap(w1[q][0], w1[q + 1][0], false, false);
      const auto s1 = __builtin_amdgcn_permlane32_swap(w1[q][1], w1[q + 1][1], false, false);
      u32x4 o; o[0] = s0[0]; o[1] = s1[0]; o[2] = s0[1]; o[3] = s1[1];
      *(u32x4*)(Arow + 32 + 8 * q + 8 * h) = o;
    }
  }
}

DI void swa_phase(const Params& p) {
  char* ws = p.ws;
  const bf16_t* Q = (const bf16_t*)(ws + O_Q1); const bf16_t* QR = (const bf16_t*)(ws + O_QR1); const bf16_t* Kb = (const bf16_t*)(ws + O_K1);
  const bf16_t* VtL = (const bf16_t*)(ws + O_VTL1); const bf16_t* VtC = (const bf16_t*)(ws + O_VTC1);
  const bf16_t* G = (const bf16_t*)(ws + O_G1); bf16_t* ACT = (bf16_t*)(ws + O_ACT1);
  const float* sink = p.in[20];
  const int tid_ = opaque_tid();
  const int lane = tid_ & 63, r = lane & 31, h = lane >> 5;
  const int vb_ = (gridDim.x % 8 == 0) ? (blockIdx.x & 7) * (gridDim.x >> 3) + (blockIdx.x >> 3) : blockIdx.x;
  const int wid = vb_ * 8 + (tid_ >> 6), nw = gridDim.x * 8;
  auto ident = [](int, float s) { return s; };
  auto do_item = [&](int it) {
    int b, kvh, g4, qt; const bool lat = it < 8192;
    if (lat) { g4 = it & 3; qt = (it >> 2) & 63; kvh = (it >> 8) & 3; b = it >> 10; }
    else { const int j = it - 8192; g4 = j & 3; qt = (j >> 2) & 7; kvh = (j >> 5) & 3; b = j >> 7; }
    const int head = kvh * 4 + g4;
    const size_t qrow = lat ? (size_t)b * 2048 + qt * 32 + r : (size_t)RL + b * 256 + qt * 32 + r;
    AttnSt st; st.O0 = zero16(); st.O1 = zero16(); st.m = sink[head] * 1.4426950408889634f; st.l = h == 0 ? 1.f : 0.f;
    bf16x8 qf[4], qfr[4];
    _Pragma("unroll") for (int ks = 0; ks < 4; ++ks) qf[ks] = ld16(Q + qrow * 1024 + head * 64 + ks * 16 + 8 * h);
    GPre gp; attn_gload(gp, G + qrow * 1024 + head * 64, h);
    if (lat) { _Pragma("unroll") for (int ks = 0; ks < 4; ++ks) qfr[ks] = ld16(QR + qrow * 1024 + head * 64 + ks * 16 + 8 * h); }
    else { _Pragma("unroll") for (int ks = 0; ks < 4; ++ks) qfr[ks] = qf[ks]; }
    const bf16_t* kc = Kb + (size_t)RL * 256 + (size_t)(b * 4 + kvh) * 8 * 2048 + lane * 8;
    const bf16_t* vc = VtC + (size_t)(b * 4 + kvh) * 8 * 2048 + lane * 8;
    const bf16_t* kl = Kb + (size_t)(b * 4 + kvh) * 64 * 2048 + lane * 8;
    const bf16_t* vl = VtL + (size_t)(b * 4 + kvh) * 64 * 2048 + lane * 8;
    const int kt_lo = max(qt - 4, 0), kt_hi = min(qt + 4, 63);
    const int nt = lat ? 8 + (kt_hi - kt_lo + 1) : 8;
    auto load_tile = [&](int j, KVt& t) {
      if (j < 8) attn_load(t, kc + (size_t)j * 2048, vc + (size_t)j * 2048);
      else { const int kt = kt_lo + j - 8; attn_load(t, kl + (size_t)kt * 2048, vl + (size_t)kt * 2048); }
    };
    KVt cur, nxt;
    load_tile(0, cur);
    for (int j = 0; j < 8; ++j) {
      nxt = cur;
      if (j + 1 < nt) load_tile(j + 1, nxt);
      attn_compute(st, qf, cur, ident);
      cur = nxt;
    }
    for (int j = 8; j < nt; ++j) {
      nxt = cur;
      if (j + 1 < nt) load_tile(j + 1, nxt);
      const int kt = kt_lo + j - 8;
      if (kt == qt - 4 || kt == qt + 4) {
        const int dq = qt * 32 + r - kt * 32;
        attn_compute(st, qfr, cur, [&](int i, float s) { const int d = dq - crow(i, h); return (d <= 128 && d >= -128) ? s : -1.0e30f; });
      } else attn_compute(st, qfr, cur, ident);
      cur = nxt;
    }
    attn_finish(st, gp, ACT + qrow * 1024 + head * 64, h);
  };
  for (int it = wid; it < 8192; it += nw) do_item(it);
  if (nw == 2048) {
    if ((wid & 7) < 4) do_item(8192 + (wid >> 3) * 4 + (wid & 3));
  } else { for (int it = 8192 + wid; it < 8192 + 1024; it += nw) do_item(it); }
}

DI void na_phase(const Params& p, char* smem) {
  char* ws = p.ws;
  const bf16_t* Q = (const bf16_t*)(ws + O_Q2); const bf16_t* Kb = (const bf16_t*)(ws + O_K2);
  const bf16_t* VtL = (const bf16_t*)(ws + O_VTL2); const bf16_t* VtC = (const bf16_t*)(ws + O_VTC2);
  const bf16_t* G = (const bf16_t*)(ws + O_G2); bf16_t* ACT = (bf16_t*)(ws + O_ACT2);
  float* rpbs = (float*)smem + 64;
  __syncthreads();
  for (int i = threadIdx.x; i < 16 * 15 * 31; i += blockDim.x) rpbs[i] = p.in[26][i] * 1.4426950408889634f;
  __syncthreads();
  const int tid_ = opaque_tid();
  const int lane = tid_ & 63, r = lane & 31, h = lane >> 5;
  const int vb_ = (gridDim.x % 8 == 0) ? (blockIdx.x & 7) * (gridDim.x >> 3) + (blockIdx.x >> 3) : blockIdx.x;
  const int wid = vb_ * 8 + (tid_ >> 6), nw = gridDim.x * 8;
  auto ident = [](int, float s) { return s; };
  auto do_item = [&](int it) {
    int b, head, half, gr; const bool lat = it < 8192;
    if (lat) { half = it & 1; head = (it >> 1) & 15; gr = (it >> 5) & 31; b = it >> 10; }
    else { const int j = it - 8192; half = 0; head = j & 15; gr = (j >> 4) & 7; b = j >> 7; }
    const size_t qrow = lat ? (size_t)b * 2048 + gr * 64 + half * 32 + r : (size_t)RL + b * 256 + gr * 32 + r;
    AttnSt st; st.O0 = zero16(); st.O1 = zero16(); st.m = -1.0e30f; st.l = 0.f;
    bf16x8 qf[4];
    _Pragma("unroll") for (int ks = 0; ks < 4; ++ks) qf[ks] = ld16(Q + qrow * 1024 + head * 64 + ks * 16 + 8 * h);
    GPre gp; attn_gload(gp, G + qrow * 1024 + head * 64, h);
    const bf16_t* kc = Kb + (size_t)RL * 1024 + (size_t)(b * 16 + head) * 8 * 2048 + lane * 8;
    const bf16_t* vc = VtC + (size_t)(b * 16 + head) * 8 * 2048 + lane * 8;
    const bf16_t* kl = Kb + (size_t)(b * 16 + head) * 64 * 2048 + lane * 8;
    const bf16_t* vl = VtL + (size_t)(b * 16 + head) * 64 * 2048 + lane * 8;
    const int cq = half * 32 + r;
    const int cs = min(max(cq - 8, 0), 48);
    const int rs_ = min(max(gr - 4, 0), 24);
    const int nt = lat ? 24 : 8;
    auto load_tile = [&](int j, KVt& t) {
      if (j < 8) attn_load(t, kc + (size_t)j * 2048, vc + (size_t)j * 2048);
      else { const int kt = (rs_ + ((j - 8) >> 1)) * 2 + ((j - 8) & 1); attn_load(t, kl + (size_t)kt * 2048, vl + (size_t)kt * 2048); }
    };
    KVt cur, nxt;
    load_tile(0, cur);
    for (int j = 0; j < 8; ++j) {
      nxt = cur;
      if (j + 1 < nt) load_tile(j + 1, nxt);
      attn_compute(st, qf, cur, ident);
      cur = nxt;
    }
    unsigned okm[2] = {0u, 0u};
    _Pragma("unroll") for (int ct = 0; ct < 2; ++ct) _Pragma("unroll") for (int i = 0; i < 16; ++i) {
      const int ck = ct * 32 + crow(i, h);
      okm[ct] |= ((ck >= cs) && (ck < cs + 16)) ? (1u << i) : 0u;
    }
    const int dxb = 4 * h - cq + 15;
    for (int j = 8; j < nt; j += 2) {
      const int krow = rs_ + ((j - 8) >> 1);
      const float* rp = rpbs + (head * 15 + (krow - gr + 7)) * 31 + dxb;
      nxt = cur;
      load_tile(j + 1, nxt);
      attn_compute(st, qf, cur, [&](int i, float s) { const float sb = s + rp[(i & 3) + 8 * (i >> 2)]; return ((okm[0] >> i) & 1u) ? sb : -1.0e30f; });
      cur = nxt;
      if (j + 2 < nt) load_tile(j + 2, nxt);
      attn_compute(st, qf, cur, [&](int i, float s) { const float sb = s + rp[32 + (i & 3) + 8 * (i >> 2)]; return ((okm[1] >> i) & 1u) ? sb : -1.0e30f; });
      cur = nxt;
    }
    attn_finish(st, gp, ACT + qrow * 1024 + head * 64, h);
  };
  for (int it = wid; it < 8192; it += nw) do_item(it);
  if (nw == 2048) {
    if ((wid & 7) < 4) do_item(8192 + (wid >> 3) * 4 + (wid & 3));
  } else { for (int it = 8192 + wid; it < 8192 + 1024; it += nw) do_item(it); }
}

DI void s5_mats_phase(const Params& p, int which, int first_blk) {
  if ((int)blockIdx.x < first_blk) return;
  char* ws = p.ws;
  const float2* POW = (const float2*)(ws + O_POW); const float2* BB = (const float2*)(ws + O_BBAR);
  bf16_t* GT = (bf16_t*)(ws + O_GT); bf16_t* MYT = (bf16_t*)(ws + O_MYT);
  const float* cre = p.in[37]; const float* cim = p.in[38]; const float* dsk = p.in[39];
  const int gt = ((int)blockIdx.x - first_blk) * blockDim.x + threadIdx.x, gn = ((int)gridDim.x - first_blk) * blockDim.x;
  if (which == 2) {
    for (int idx0 = gt; idx0 < 64 * 256 * 256; idx0 += 4 * gn) {
      float2 pw1[4], bb1[4];
      _Pragma("unroll") for (int u = 0; u < 4; ++u) {
        const int idx = min(idx0 + u * gn, 64 * 256 * 256 - 1);
        const int g = idx >> 16, n = (idx >> 8) & 255, k = idx & 255;
        const int dir = n >> 7, pp = (n >> 1) & 63, i = k >> 4, c = k & 15, e = dir ? i : 15 - i;
        pw1[u] = POW[((size_t)(dir * 64 + g) * 17 + e) * 64 + pp]; bb1[u] = BB[((size_t)(dir * 64 + g) * 64 + pp) * 16 + c];
      }
      _Pragma("unroll") for (int u = 0; u < 4; ++u) {
        const int idx = idx0 + u * gn;
        if (idx < 64 * 256 * 256) {
          const float zr = pw1[u].x * bb1[u].x - pw1[u].y * bb1[u].y, zi = pw1[u].x * bb1[u].y + pw1[u].y * bb1[u].x;
          GT[idx] = f2bf(((idx >> 8) & 1) ? zi : zr);
        }
      }
    }
    return;
  }
  for (int idx0 = gt; idx0 < 64 * 256 * 256; idx0 += 4 * gn) {
    float2 pw2[4]; float cr[4], cm[4];
    _Pragma("unroll") for (int u = 0; u < 4; ++u) {
      const int idx = min(idx0 + u * gn, 64 * 256 * 256 - 1);
      const int g = idx >> 16, n = (idx >> 8) & 255, k = idx & 255;
      const int j = n >> 4, o = n & 15, dir = k >> 7, pp = (k >> 1) & 63, e = dir ? 16 - j : j + 1;
      pw2[u] = POW[((size_t)(dir * 64 + g) * 17 + e) * 64 + pp];
      const size_t ci = ((size_t)(dir * 64 + g) * 16 + o) * 64 + pp; cr[u] = cre[ci]; cm[u] = cim[ci];
    }
    _Pragma("unroll") for (int u = 0; u < 4; ++u) {
      const int idx = idx0 + u * gn;
      if (idx < 64 * 256 * 256) {
        const int g = idx >> 16, n = (idx >> 8) & 255, k = idx & 255;
        const float zr = cr[u] * pw2[u].x - cm[u] * pw2[u].y, zi = cr[u] * pw2[u].y + cm[u] * pw2[u].x;
        MYT[((size_t)g * 256 + n) * 512 + 256 + k] = f2bf((k & 1) ? -zi : zr);
      }
    }
  }
  for (int idx = gt; idx < 64 * 16 * 256; idx += gn) {
    const int g = idx >> 12, lag = (idx >> 8) & 15, o = (idx >> 4) & 15, c = idx & 15;
    float kf = 0.f, kb = 0.f;
    _Pragma("unroll 8") for (int pp = 0; pp < 64; ++pp) {
      {
        const float2 pw = POW[((size_t)(0 * 64 + g) * 17 + lag) * 64 + pp];
        const float2 bb = BB[((size_t)(0 * 64 + g) * 64 + pp) * 16 + c];
        const size_t ci = ((size_t)(0 * 64 + g) * 16 + o) * 64 + pp;
        const float zr = pw.x * bb.x - pw.y * bb.y, zi = pw.x * bb.y + pw.y * bb.x;
        kf += cre[ci] * zr - cim[ci] * zi;
      }
      {
        const float2 pw = POW[((size_t)(1 * 64 + g) * 17 + lag) * 64 + pp];
        const float2 bb = BB[((size_t)(1 * 64 + g) * 64 + pp) * 16 + c];
        const size_t ci = ((size_t)(1 * 64 + g) * 16 + o) * 64 + pp;
        const float zr = pw.x * bb.x - pw.y * bb.y, zi = pw.x * bb.y + pw.y * bb.x;
        kb += cre[ci] * zr - cim[ci] * zi;
      }
    }
    bf16_t* Mg = MYT + (size_t)g * 256 * 512;
    if (lag == 0) {
      const bf16_t v = f2bf(kf + kb + (o == c ? dsk[g * 16 + o] : 0.f));
      for (int j = 0; j < 16; ++j) Mg[(size_t)(j * 16 + o) * 512 + j * 16 + c] = v;
    } else {
      const bf16_t vf = f2bf(kf), vb = f2bf(kb);
      for (int i = 0; i + lag < 16; ++i) {
        Mg[(size_t)((i + lag) * 16 + o) * 512 + i * 16 + c] = vf;
        Mg[(size_t)(i * 16 + o) * 512 + (i + lag) * 16 + c] = vb;
      }
    }
  }
}

DI void s5_scan_one(const Params& p, int b, int g, int dir, int pp) {
  char* ws = p.ws;
  const float2* POW = (const float2*)(ws + O_POW);
  const float* SL = (const float*)(ws + O_SLOC);
  bf16_t* ACAT = (bf16_t*)(ws + O_ACAT);
  const float2 lam = POW[((size_t)(dir * 64 + g) * 17 + 16) * 64 + pp];
  float hr = 0.f, hi = 0.f;
  auto chunk_of = [&](int q) { return q < 16 ? (1024 + b * 16 + (dir ? 15 - q : q)) : (b * 128 + (dir ? 127 - (q - 16) : (q - 16))); };
  auto loadb = [&](int q0, float2 (&sx)[16]) {
    _Pragma("unroll") for (int j = 0; j < 16; ++j) sx[j] = *(const float2*)(SL + ((size_t)g * NCHP + chunk_of(q0 + j)) * 256 + dir * 128 + 2 * pp);
  };
  auto procb = [&](int q0, const float2 (&sx)[16]) {
    _Pragma("unroll") for (int j = 0; j < 16; ++j) {
      *(unsigned*)(ACAT + ((size_t)g * NCH + chunk_of(q0 + j)) * 512 + 256 + dir * 128 + 2 * pp) = pack2(hr, hi);
      const float nr = lam.x * hr - lam.y * hi + sx[j].x, ni = lam.x * hi + lam.y * hr + sx[j].y;
      hr = nr; hi = ni;
    }
  };
  float2 sA[16], sB[16];
  loadb(0, sA);
  for (int q0 = 0; q0 < 144; q0 += 32) {
    if (q0 + 16 < 144) loadb(q0 + 16, sB);
    procb(q0, sA);
    if (q0 + 16 >= 144) break;
    if (q0 + 32 < 144) loadb(q0 + 32, sA);
    procb(q0 + 16, sB);
  }
}
DI void s5_scan_phase(const Params& p) {
  for (int gid = blockIdx.x * blockDim.x + threadIdx.x; gid < 65536; gid += gridDim.x * blockDim.x)
    s5_scan_one(p, gid >> 13, (gid >> 6) & 63, (gid >> 12) & 1, gid & 63);
}

#define XB_TMO      128
#define XB_XCNT(j)  (256  + 64 * (j))
#define XB_XSUB(j)  (1280 + 64 * (j))
#define XB_XGEN(j)  (2304 + 64 * (j))
#define XB_TOP      3328
#define XB_TOPGEN   3392
#define XCD_BAR_WORDS 3456
#define XB_SPIN_CAP (1u << 18)
#define LAS __attribute__((address_space(3)))
DI unsigned xb_ld(unsigned* p)              { return __hip_atomic_load(p, __ATOMIC_RELAXED, __HIP_MEMORY_SCOPE_AGENT); }
DI unsigned xb_add(unsigned* p, unsigned v) { return __hip_atomic_fetch_add(p, v, __ATOMIC_RELAXED, __HIP_MEMORY_SCOPE_AGENT); }
DI unsigned xb_xcc_id() { return (unsigned)__builtin_amdgcn_s_getreg((3 << 11) | 20) & 0xFu; }
#define XB_SPIN(cond, bar) do { unsigned _sp = 0; while (cond) { __builtin_amdgcn_s_sleep(1); \
    if ((++_sp & 255u) == 0u) { if (xb_ld(&(bar)[XB_TMO])) break; if (_sp > XB_SPIN_CAP) { atomicAdd(&(bar)[XB_TMO], 1u); break; } } } } while (0)
struct XcdBarrier { unsigned* bar; unsigned x; volatile LAS unsigned* st; };
DI XcdBarrier xcd_barrier_post(unsigned* bar, volatile LAS unsigned* st) {
    XcdBarrier b; b.bar = bar; b.x = xb_xcc_id(); b.st = st;
    if (threadIdx.x == 0) (void)xb_add(&bar[XB_XCNT(b.x)], 1u);
    return b;
}
DI void xcd_barrier_complete(unsigned* bar, unsigned x, unsigned& nloc, unsigned& nx) {
    const unsigned G = gridDim.x * gridDim.y * gridDim.z;
    unsigned sum, cnt, mine, sp = 0u;
    for (;;) {
        sum = 0u; cnt = 0u; mine = 0u;
#pragma unroll
        for (unsigned j = 0; j < 16; ++j) { const unsigned c = xb_ld(&bar[XB_XCNT(j)]); sum += c; cnt += (c > 0u) ? 1u : 0u; mine = (j == x) ? c : mine; }
        if (sum == G) break;
        __builtin_amdgcn_s_sleep(1);
        if ((++sp & 255u) == 0u) { if (xb_ld(&bar[XB_TMO])) break; if (sp > XB_SPIN_CAP) { atomicAdd(&bar[XB_TMO], 1u); break; } }
    }
    nloc = mine > 0u ? mine : 1u; nx = cnt > 0u ? cnt : 1u;
}
DI void xcd_barrier(const XcdBarrier& b) {
    asm volatile("s_waitcnt vmcnt(0)" ::: "memory");
    __syncthreads();
    if (threadIdx.x == 0) {
        unsigned* bar = b.bar;
        __builtin_amdgcn_s_waitcnt(0);
        unsigned nloc = b.st[0], nx = b.st[1];
        if (nloc == 0u) { xcd_barrier_complete(bar, b.x, nloc, nx); b.st[0] = nloc; b.st[1] = nx; }
        const unsigned old = xb_add(&bar[XB_XSUB(b.x)], 1u);
        const unsigned gen = old / nloc;
        if (old + 1u == (gen + 1u) * nloc) {
            __builtin_amdgcn_fence(__ATOMIC_RELEASE, "agent");
            asm volatile("s_waitcnt vmcnt(0)" ::: "memory");
            const unsigned og = xb_add(&bar[XB_TOP], 1u);
            const unsigned tg = og / nx;
            if (og + 1u == (tg + 1u) * nx) xb_add(&bar[XB_TOPGEN], 1u);
            else XB_SPIN(xb_ld(&bar[XB_TOPGEN]) == tg, bar);
            __builtin_amdgcn_fence(__ATOMIC_ACQUIRE, "agent");
            xb_add(&bar[XB_XGEN(b.x)], 1u);
            asm volatile("s_waitcnt vmcnt(0)" ::: "memory");
        } else {
            XB_SPIN(xb_ld(&bar[XB_XGEN(b.x)]) == gen, bar);
            __builtin_amdgcn_fence(__ATOMIC_ACQUIRE, "agent");
            asm volatile("s_waitcnt vmcnt(0)" ::: "memory");
        }
    }
    __syncthreads();
}

#define RP_GIN 1
#define RP_OUT0 1
#define RP_LRU 1
#define RP_SWA 1
#define RP_NA 1
#define RP_S5 1
#define RP_NORM 1
#define RP_GLU 1
#define RP_SYNC 0
#define REPEAT(n) for (int rep_ = 0; rep_ < (n); ++rep_)
constexpr int LDS_BYTES = 147456;

__global__ void __launch_bounds__(512, 2) fwd_megakernel(Params p) {
  extern __shared__ __attribute__((aligned(16))) unsigned char lds_raw[];
  LAS unsigned char* lds = (LAS unsigned char*)lds_raw;
  char* smem = (char*)lds_raw;
  cg::grid_group grid = cg::this_grid();
  char* ws = p.ws;
  volatile LAS unsigned* xst = (volatile LAS unsigned*)(lds + 131072 + 256);
  if (threadIdx.x == 0) { xst[0] = 0u; xst[1] = 0u; }
  __syncthreads();
  XcdBarrier xb = xcd_barrier_post((unsigned*)(ws + O_BAR), xst);
#define GSYNC() xcd_barrier(xb)
  float* MOD = (float*)(ws + O_MOD);
  float* HCTX = (float*)(ws + O_HCTX);
  const bf16_t* NBUF = (const bf16_t*)(ws + O_NBUF);
  using pg8::Gemm;

  phase0(p, smem);
  GSYNC();
  if (p.out == nullptr) grid.sync();
  float* SS = (float*)(ws + O_SS);
  const float* GS = (const float*)(ws + O_GS);
  const float* SHW = (const float*)(ws + O_SHW);
  bf16_t* NBW = (bf16_t*)(ws + O_NBUF);
  norm_phase(p.in[0], p.in[2], p.in[6], MOD, (bf16_t*)(ws + O_NBUF0));
  GSYNC();
  {
    EpiL0In e{(bf16_t*)(ws + O_U0), (bf16_t*)(ws + O_G0)};
    Gemm g{(const bf16_t*)(ws + O_NBUF0), (const bf16_t*)(ws + O_WT_IN0), 1024, 1024, 1024, 72, 11, 1, 0, 0, 0};
    pg8::gemm_phase(lds, g, e);
  }
  modfold_phase(p, smem);
  tables_phase(p, gridDim.x == 256 ? 24 : 0);
  if (gridDim.x == 256) transpose_range(p, smem, 16 * 44, 16 * 44 + 22 * 16 + 16 * 40 + 256, 24, 0);
  else transpose_range(p, smem, 16 * 44, 16 * 44 + 22 * 16 + 16 * 40 + 256, 0, 0);
  GSYNC();
  lru_phase(p, smem);
  GSYNC();
  {
    EpiOut<true> e{p.in[0], p.in[2], p.out, HCTX, MOD + 2048, GS, NBW, SS};
    Gemm g{(const bf16_t*)(ws + O_ACT0), (const bf16_t*)(ws + O_WT_OUT0), LW, LW, LW, 72, 4, 1, 0, 0, 0};
    pg8::gemm_phase(lds, g, e);
  }
  {
    constexpr int J0 = 16 * 44 + 22 * 16 + 16 * 40 + 256, J1 = J0 + 16 * 64 + 256 + 16 * 32 + 256 + 256;
    transpose_range(p, smem, J0, J1, gridDim.x == 256 ? 32 : 0, 0);
  }
  GSYNC();
  {
    EpiL1 e{(bf16_t*)(ws + O_Q1), (bf16_t*)(ws + O_QR1), (bf16_t*)(ws + O_K1), (bf16_t*)(ws + O_G1), (const float*)(ws + O_ROPEC), (const float*)(ws + O_ROPES), SS, SHW};
    Gemm g{NBUF, (const bf16_t*)(ws + O_WT_IN1), 1024, 1024, 1024, 72, 9, 1, 0, 0, 0};
    pg8::gemm_phase(lds, g, e);
    EpiV<4, 1280> ev{(bf16_t*)(ws + O_VTL1), (bf16_t*)(ws + O_VTC1), SS, SHW};
    Gemm gv{(const bf16_t*)(ws + O_WT_IN1) + (size_t)2304 * 1024, NBUF, 1024, 1024, 1024, 1, 72, 1, 0, 0, 256 - 136};
    pg8::gemm_phase(lds, gv, ev);
  }
  GSYNC();
  swa_phase(p);
  GSYNC();
  {
    EpiOut<true> e{p.out, HCTX, p.out, HCTX, MOD + 9 * 3072 + 2048, GS + 9 * 1024, NBW, SS + R};
    Gemm g{(const bf16_t*)(ws + O_ACT1), (const bf16_t*)(ws + O_WT_OUT1), 1024, 1024, 1024, 72, 4, 1, 0, 0, 0};
    pg8::gemm_phase(lds, g, e);
  }
  s5_mats_phase(p, 1, gridDim.x == 256 ? 32 : 0);
  GSYNC();
  {
    EpiL2 e{(bf16_t*)(ws + O_Q2), (bf16_t*)(ws + O_K2), (bf16_t*)(ws + O_G2), SS + R, SHW + 9 * 4096};
    Gemm g{NBUF, (const bf16_t*)(ws + O_WT_IN2), 1024, 1024, 1024, 72, 12, 1, 0, 0, 0};
    pg8::gemm_phase(lds, g, e);
    EpiV<16, 2048> ev{(bf16_t*)(ws + O_VTL2), (bf16_t*)(ws + O_VTC2), SS + R, SHW + 9 * 4096};
    Gemm gv{(const bf16_t*)(ws + O_WT_IN2) + (size_t)3072 * 1024, NBUF, 1024, 1024, 1024, 4, 72, 1, 0, 0, 256 - 96};
    pg8::gemm_phase(lds, gv, ev);
  }
  GSYNC();
  na_phase(p, smem);
  GSYNC();
  {
    EpiOut<true> e{p.out, HCTX, p.out, HCTX, MOD + 2 * 9 * 3072 + 2048, GS + 2 * 9 * 1024, NBW, SS + 2 * R};
    Gemm g{(const bf16_t*)(ws + O_ACT2), (const bf16_t*)(ws + O_WT_OUT2), 1024, 1024, 1024, 72, 4, 1, 0, 0, 0};
    pg8::gemm_phase(lds, g, e);
  }
  s5_mats_phase(p, 2, gridDim.x == 256 ? 32 : 0);
  GSYNC();
  {
    EpiL3In e{(bf16_t*)(ws + O_ACAT), (bf16_t*)(ws + O_G3), SS + 2 * R, SHW + 2 * 9 * 4096};
    Gemm g{NBUF, (const bf16_t*)(ws + O_WT_IN3), 1024, 1024, 1024, 72, 8, 1, 0, 0, 0};
    pg8::gemm_phase(lds, g, e);
  }
  GSYNC();
  {
    EpiS5State e{(float*)(ws + O_SLOC)};
    Gemm g{(const bf16_t*)(ws + O_ACAT), (const bf16_t*)(ws + O_GT), 512, 256, 256, 5, 1, 64, NCH * 512, 256 * 256, 0};
    pg8::gemm_phase(lds, g, e);
  }
  GSYNC();
  {
    EpiS5Y e{(bf16_t*)(ws + O_YG)};
    Gemm g{(const bf16_t*)(ws + O_ACAT), (const bf16_t*)(ws + O_MYT), 512, 512, 512, 4, 1, 64, NCH * 512, 256 * 512, 0};
    if (gridDim.x == 256) {
      pg8::Unit u;
      if (pg8::next_unit(g, 0, u)) {
        const int t_ = opaque_tid();
        if (t_ < 256) s5_scan_one(p, 2 * u.pm + (t_ >> 7), u.pb, (t_ >> 6) & 1, t_ & 63);
      }
      asm volatile("s_waitcnt vmcnt(0)" ::: "memory");
      __syncthreads();
    } else {
      s5_scan_phase(p);
      GSYNC();
    }
    pg8::gemm_phase(lds, g, e);
  }
  GSYNC();
  {
    EpiGlu e{(const bf16_t*)(ws + O_YG), (const bf16_t*)(ws + O_G3), p.in[41], (bf16_t*)(ws + O_ACT3)};
    Gemm g{(const bf16_t*)(ws + O_YG), (const bf16_t*)(ws + O_WT_GLU), 1024, 1024, 1024, 64, 4, 1, 0, 0, 0};
    pg8::gemm_phase(lds, g, e);
  }
  GSYNC();
  {
    EpiOut<false> e{p.out, HCTX, p.out, HCTX, MOD + 3 * 9 * 3072 + 2048, nullptr, nullptr, nullptr};
    Gemm g{(const bf16_t*)(ws + O_ACT3), (const bf16_t*)(ws + O_WT_OUT3), 1024, 1024, 1024, 64, 4, 1, 0, 0, 0};
    pg8::gemm_phase(lds, g, e);
  }
  GSYNC();
  final_norm_phase(p.out, p.in[43]);
}

extern "C" void kernel_launch(void* const* d_in, const int* in_sizes, int n_in, void* d_out, int out_size, void* d_ws, size_t ws_size,
                              hipStream_t stream) {
  static int grid_blocks = 0;
  if (!grid_blocks) {
    int dev = 0, cus = 0, per_cu = 0;
    (void)hipGetDevice(&dev);
    (void)hipDeviceGetAttribute(&cus, hipDeviceAttributeMultiprocessorCount, dev);
    if (hipFuncSetAttribute((const void*)fwd_megakernel, hipFuncAttributeMaxDynamicSharedMemorySize, LDS_BYTES) != hipSuccess) { fprintf(stderr, "kernel_launch: hipFuncSetAttribute failed\n"); grid_blocks = -1; return; }
    (void)hipOccupancyMaxActiveBlocksPerMultiprocessor(&per_cu, (const void*)fwd_megakernel, 512, LDS_BYTES);
    (void)hipGetLastError();
    grid_blocks = cus;
  }
  if (grid_blocks < 0) return;
  if (n_in != 44 || ws_size < WS_END) { fprintf(stderr, "kernel_launch: unexpected n_in %d or ws_size %zu < %zu\n", n_in, ws_size, (size_t)WS_END); return; }
  Params p{};
  for (int i = 0; i < 44; ++i) p.in[i] = (const float*)d_in[i];
  p.out = (float*)d_out;
  p.ws = (char*)d_ws;
  if (hipMemsetAsync((char*)d_ws + O_BAR, 0, 16384, stream) != hipSuccess) { fprintf(stderr, "memset failed\n"); return; }
  void* args[] = {&p};
  hipError_t e = hipLaunchCooperativeKernel((void*)fwd_megakernel, dim3(grid_blocks), dim3(512), args, LDS_BYTES, stream);
  if (e != hipSuccess) fprintf(stderr, "cooperative launch failed: %s (grid %d)\n", hipGetErrorString(e), grid_blocks);
}
```

```cpp
#include <hip/hip_runtime.h>
#include <hip/hip_cooperative_groups.h>
#include <cstdio>
namespace cg = cooperative_groups;

#define DI __device__ __forceinline__
typedef unsigned short bf16_t;
typedef short bf16x8 __attribute__((ext_vector_type(8)));
typedef short s16x4 __attribute__((ext_vector_type(4)));
typedef float f32x16 __attribute__((ext_vector_type(16)));
typedef float f32x4 __attribute__((ext_vector_type(4)));
typedef unsigned u32x2 __attribute__((ext_vector_type(2)));
typedef unsigned u32x4 __attribute__((ext_vector_type(4)));

#define MFMA32(a, b, c) __builtin_amdgcn_mfma_f32_32x32x16_bf16((a), (b), (c), 0, 0, 0)
#define MFMA16(a, b, c) __builtin_amdgcn_mfma_f32_16x16x32_bf16((a), (b), (c), 0, 0, 0)

constexpr int D = 1024, NB = 8, SEQ = 2048, CTXL = 256;
constexpr int RL = NB * SEQ;
constexpr int RC = NB * CTXL;
constexpr int R = RL + RC;
constexpr int LW = 1408;
constexpr int NCH = R / 16;
constexpr int NCHP = 1280;

constexpr size_t O_WT_IN0 = 0;
constexpr size_t O_WT_OUT0 = O_WT_IN0 + (size_t)2816 * 1024 * 2;
constexpr size_t O_WT_IN1 = O_WT_OUT0 + (size_t)1024 * 2816 * 2;
constexpr size_t O_WT_OUT1 = O_WT_IN1 + (size_t)2560 * 1024 * 2;
constexpr size_t O_WT_IN2 = O_WT_OUT1 + (size_t)1024 * 1024 * 2;
constexpr size_t O_WT_OUT2 = O_WT_IN2 + (size_t)4096 * 1024 * 2;
constexpr size_t O_WT_IN3 = O_WT_OUT2 + (size_t)1024 * 1024 * 2;
constexpr size_t O_WT_GLU = O_WT_IN3 + (size_t)2048 * 1024 * 2;
constexpr size_t O_WT_OUT3 = O_WT_GLU + (size_t)1024 * 1024 * 2;
constexpr size_t O_WG = O_WT_OUT3 + (size_t)1024 * 1024 * 2;
constexpr size_t O_MOD = O_WG + (size_t)16 * 2 * 192 * 96 * 2;
constexpr size_t O_ROPEC = O_MOD + (size_t)4 * 9 * 3072 * 4;
constexpr size_t O_ROPES = O_ROPEC + (size_t)2048 * 32 * 4;
constexpr size_t O_POW = O_ROPES + (size_t)2048 * 32 * 4;
constexpr size_t O_BBAR = O_POW + (size_t)2 * 64 * 17 * 64 * 8;
constexpr size_t O_HCTX = O_BBAR + (size_t)2 * 64 * 64 * 16 * 8;
constexpr size_t O_SS = O_HCTX + (size_t)RC * 1024 * 4;
constexpr size_t O_GS = O_SS + (size_t)3 * R * 4;
constexpr size_t O_SHW = O_GS + (size_t)3 * 9 * 1024 * 4;
constexpr size_t O_BAR = O_SHW + (size_t)3 * 9 * 4096 * 4;
constexpr size_t O_DYN = O_BAR + 16384;
constexpr size_t O_U0 = O_DYN;
constexpr size_t O_G0 = O_U0 + (size_t)R * LW * 2;
constexpr size_t O_ACT0 = O_G0 + (size_t)R * LW * 2;
constexpr size_t O_NBUF0 = O_ACT0;
constexpr size_t O_NBUF = O_DYN;
constexpr size_t O_Q1 = O_NBUF + (size_t)R * 1024 * 2;
constexpr size_t O_QR1 = O_Q1 + (size_t)R * 1024 * 2;
constexpr size_t O_K1 = O_QR1 + (size_t)RL * 1024 * 2;
constexpr size_t O_VTL1 = O_K1 + (size_t)R * 256 * 2;
constexpr size_t O_VTC1 = O_VTL1 + (size_t)8 * 4 * 64 * 2048 * 2;
constexpr size_t O_G1 = O_VTC1 + (size_t)8 * 4 * 64 * 256 * 2;
constexpr size_t O_ACT1 = O_G1 + (size_t)R * 1024 * 2;
constexpr size_t O_Q2 = O_NBUF + (size_t)R * 1024 * 2;
constexpr size_t O_K2 = O_Q2 + (size_t)R * 1024 * 2;
constexpr size_t O_VTL2 = O_K2 + (size_t)R * 1024 * 2;
constexpr size_t O_VTC2 = O_VTL2 + (size_t)8 * 16 * 64 * 2048 * 2;
constexpr size_t O_G2 = O_VTC2 + (size_t)8 * 16 * 64 * 256 * 2;
constexpr size_t O_ACT2 = O_Q2;
constexpr size_t O_SLOC = O_DYN;
constexpr size_t O_YG = O_DYN;
constexpr size_t O_ACT3 = O_YG + (size_t)RL * 1024 * 2;
constexpr size_t O_ACAT = O_DYN + (size_t)64 * NCHP * 256 * 4;
constexpr size_t O_G3 = O_ACAT + (size_t)64 * NCH * 512 * 2;
constexpr size_t O_GT = O_WT_IN2;
constexpr size_t O_MYT = O_WT_IN0;
static_assert(O_WT_OUT1 - O_WT_IN0 == (size_t)64 * 256 * 512 * 2 && O_WT_OUT2 - O_WT_IN2 == (size_t)64 * 256 * 256 * 2, "S5 matrix aliases");
constexpr size_t WS_END = O_ACT0 + (size_t)R * LW * 2 * 2;
static_assert(O_G3 + (size_t)RL * 1024 * 2 <= WS_END && O_ACT1 + (size_t)R * 1024 * 2 <= WS_END && O_G2 + (size_t)R * 1024 * 2 <= WS_END, "workspace map");
static_assert(WS_END <= (size_t)256 * 1024 * 1024, "workspace budget");

struct Params {
  const float* in[44];
  float* out;
  char* ws;
};

typedef __bf16 bf16n2 __attribute__((ext_vector_type(2)));
DI bf16_t f2bf(float x) { const __bf16 b = (__bf16)x; return __builtin_bit_cast(unsigned short, b); }
DI float bf2f(bf16_t b) { return __uint_as_float(((unsigned)b) << 16); }
DI unsigned pack2(float lo, float hi) { bf16n2 v; v[0] = (__bf16)lo; v[1] = (__bf16)hi; return __builtin_bit_cast(unsigned, v); }
DI float bflo(unsigned u) { return __uint_as_float(u << 16); }
DI float bfhi(unsigned u) { return __uint_as_float(u & 0xffff0000u); }
DI float frcp(float x) { return __builtin_amdgcn_rcpf(x); }
DI float sigm(float x) { return frcp(1.f + __expf(-x)); }
DI float silu(float x) { return x * frcp(1.f + __expf(-x)); }
DI float gelu_tanh(float x) {
  const float w = -x * (2.3022081986f + 0.1029432396f * x * x);
  return x * frcp(1.f + __builtin_amdgcn_exp2f(w));
}
DI int opaque_tid() { int t = threadIdx.x; asm volatile("" : "+v"(t)); return t; }
constexpr float QSCALE = 0.125f * 1.4426950408889634f;
DI int crow(int i, int h) { return (i & 3) + 8 * (i >> 2) + 4 * h; }
DI f32x16 zero16() { f32x16 z; _Pragma("unroll") for (int i = 0; i < 16; ++i) z[i] = 0.f; return z; }
DI void sincos_rev(float rev, float& s, float& c) { rev = rev - rintf(rev); s = __builtin_amdgcn_sinf(rev); c = __builtin_amdgcn_cosf(rev); }

#define LAS __attribute__((address_space(3)))
namespace pg8 {
constexpr int BM = 256, BK = 64, HALF = 128, HTB = HALF * BK * 2, STAGE_BYTES = 8 * HTB;
DI int lds_byte(int r, int c) { const int st = (r >> 4) * 2 + (c >> 5), rr = r & 15, cc = c & 31, ob = rr * 64 + cc * 2; return st * 1024 + (ob ^ (((ob >> 9) & 1) << 5)); }
DI void stage_rc(int b, int& R_, int& C_) { const int st = b / 1024, sb = b % 1024, swz = sb ^ (((sb >> 9) & 1) << 5); R_ = (st >> 1) * 16 + swz / 64; C_ = (st & 1) * 32 + (swz % 64) / 2; }
DI int perm32(int rho) { const int n = rho >> 4, i = rho & 15; return 8 * (i >> 2) + 4 * n + (i & 3); }
struct Unit { int pm, pn, pb; };
struct Gemm { const bf16_t* A; const bf16_t* Bt; int lda, ldb, K, nM, nN, nB; int strideA, strideB; int rot; };
DI bool next_unit(const Gemm& g, int i, Unit& u) {
  const int G = gridDim.x, per = g.nM * g.nN, nwg = per * g.nB;
  const int c = (blockIdx.x + g.rot) % G;
  const long L = (long)i * G + c;
  if (L >= nwg) return false;
  int wgid = (int)L;
  { const int q = nwg / 8, r = nwg % 8, xcd = wgid % 8, off = wgid / 8; wgid = (xcd < r ? xcd * (q + 1) : r * (q + 1) + (xcd - r) * q) + off; }
  const int pb = wgid / per, w = wgid - pb * per;
  const int nig = 8 * g.nN, gid = w / nig, fm = gid * 8, gsz = (g.nM - fm) < 8 ? (g.nM - fm) : 8;
  u.pb = pb; u.pm = fm + ((w % nig) % gsz); u.pn = (w % nig) / gsz;
  return true;
}

template <class Epi>
DI void gemm_phase(LAS unsigned char* lds, const Gemm g, const Epi& E) {
  const int tid = opaque_tid(), wid = __builtin_amdgcn_readfirstlane(tid >> 6), lane = tid & 63, wr = wid >> 2, wc = wid & 3, fr = lane & 15, fq = lane >> 4;
  const int K = g.K, nt = K / BK;
  unsigned voffA[2], voffB[2];
#pragma unroll
  for (int i = 0; i < 2; ++i) { int R_, C_; stage_rc(tid * 16 + i * 8192, R_, C_); const int Rb = Epi::PERM ? ((R_ & ~31) + perm32(R_ & 31)) : R_;
    voffA[i] = (unsigned)(R_ * g.lda + C_) * 2u; voffB[i] = (unsigned)(Rb * g.ldb + C_) * 2u; }
  const size_t kstep = (size_t)(BK * 2);
  const size_t hstepA = (size_t)HALF * g.lda * 2, hstepB = (size_t)HALF * g.ldb * 2;
  const size_t tstepA = 2 * hstepA, tstepB = 2 * hstepB;
  const unsigned ldsw = (unsigned)wid * 1024u;
  const int aoff = lds_byte(wr * 64 + fr, fq * 8), boff = lds_byte(wc * 32 + fr, fq * 8);
#define PG8_SA(b, h) (((b) * 2 + (h)) * HTB)
#define PG8_SB(b, h) ((4 + (b) * 2 + (h)) * HTB)
#define PG8_STAGE(bufoff, gbase, voff) do { _Pragma("unroll") for (int _i = 0; _i < 2; ++_i) \
        __builtin_amdgcn_global_load_lds((const unsigned*)((const char*)(gbase) + (voff)[_i]), (LAS unsigned*)(lds + (bufoff) + ldsw + _i * 8192), 16, 0, 0); } while (0)
#define PG8_LDA(dst, b, h) do { _Pragma("unroll") for (int m = 0; m < 4; ++m) _Pragma("unroll") for (int k = 0; k < 2; ++k) dst[m][k] = *(const LAS bf16x8*)(lds + PG8_SA(b, h) + aoff + m * 2048 + k * 1024); } while (0)
#define PG8_LDB(dst, b, h) do { _Pragma("unroll") for (int n = 0; n < 2; ++n) _Pragma("unroll") for (int k = 0; k < 2; ++k) dst[n][k] = *(const LAS bf16x8*)(lds + PG8_SB(b, h) + boff + n * 2048 + k * 1024); } while (0)
#define PG8_MMA(ai, bj, At, Bt) do { __builtin_amdgcn_s_setprio(1); _Pragma("unroll") for (int m = 0; m < 4; ++m) _Pragma("unroll") for (int n = 0; n < 2; ++n) _Pragma("unroll") for (int k = 0; k < 2; ++k) \
        acc[ai][bj][m][n] = __builtin_amdgcn_mfma_f32_16x16x32_bf16(Bt[n][k], At[m][k], acc[ai][bj][m][n], 0, 0, 0); __builtin_amdgcn_s_setprio(0); } while (0)
#define PG8_WAIT_V(n) asm volatile("s_waitcnt vmcnt(" #n ")" ::: "memory")
#define PG8_WAIT_L(n) asm volatile("s_waitcnt lgkmcnt(" #n ")" ::: "memory")
#define PG8_BAR __builtin_amdgcn_s_barrier()
#define PG8_SCHED __builtin_amdgcn_sched_barrier(0)
  Unit cur, nxt; int ui = 0;
  if (!next_unit(g, 0, cur)) return;
  f32x4 acc[2][2][4][2];
#pragma unroll
  for (int a = 0; a < 2; ++a)
#pragma unroll
    for (int b = 0; b < 2; ++b)
#pragma unroll
      for (int m = 0; m < 4; ++m)
#pragma unroll
        for (int n = 0; n < 2; ++n) acc[a][b][m][n] = (f32x4){0.f, 0.f, 0.f, 0.f};
  bf16x8 At[4][2], B0[2][2], B1[2][2];
  const char* cA = (const char*)(g.A + (size_t)cur.pb * g.strideA) + (size_t)cur.pm * tstepA;
  const char* cB = (const char*)(g.Bt + (size_t)cur.pb * g.strideB) + (size_t)cur.pn * tstepB;
  PG8_STAGE(PG8_SB(0, 0), cB, voffB); PG8_STAGE(PG8_SA(0, 0), cA, voffA); PG8_STAGE(PG8_SB(0, 1), cB + hstepB, voffB); PG8_STAGE(PG8_SA(0, 1), cA + hstepA, voffA);
  if (wr == 1) PG8_BAR;
  PG8_WAIT_V(4); PG8_BAR;
  PG8_STAGE(PG8_SB(1, 0), cB + kstep, voffB); PG8_STAGE(PG8_SA(1, 0), cA + kstep, voffA); PG8_STAGE(PG8_SB(1, 1), cB + hstepB + kstep, voffB);
  PG8_WAIT_V(6); PG8_BAR;
  for (;;) {
    const bool has_next = next_unit(g, ui + 1, nxt);
    const char* nA = has_next ? (const char*)(g.A + (size_t)nxt.pb * g.strideA) + (size_t)nxt.pm * tstepA : cA;
    const char* nB = has_next ? (const char*)(g.Bt + (size_t)nxt.pb * g.strideB) + (size_t)nxt.pn * tstepB : cB;
    for (int t = 0; t < nt; t += 2) {
      const bool last = (t == nt - 2);
      const char* a1 = cA + (size_t)(t + 1) * kstep;
      const char* a2 = last ? nA : cA + (size_t)(t + 2) * kstep; const char* b2 = last ? nB : cB + (size_t)(t + 2) * kstep;
      const char* a3 = a2 + kstep; const char* b3 = b2 + kstep;
      PG8_LDB(B0, 0, 0); PG8_SCHED; PG8_LDA(At, 0, 0); PG8_STAGE(PG8_SA(1, 1), a1 + hstepA, voffA);
      PG8_WAIT_L(8); PG8_BAR; PG8_WAIT_L(0); PG8_MMA(0, 0, At, B0); PG8_BAR; PG8_SCHED;
      PG8_LDB(B1, 0, 1); PG8_STAGE(PG8_SB(0, 0), b2, voffB);
      PG8_BAR; PG8_WAIT_L(0); PG8_MMA(0, 1, At, B1); PG8_BAR;
      PG8_LDA(At, 0, 1); PG8_STAGE(PG8_SA(0, 0), a2, voffA);
      PG8_BAR; PG8_WAIT_L(0); PG8_MMA(1, 0, At, B0); PG8_BAR; PG8_SCHED;
      PG8_STAGE(PG8_SB(0, 1), b2 + hstepB, voffB);
      PG8_WAIT_V(6); PG8_BAR; PG8_MMA(1, 1, At, B1); PG8_BAR;
      PG8_LDB(B0, 1, 0); PG8_SCHED; PG8_LDA(At, 1, 0); PG8_STAGE(PG8_SA(0, 1), a2 + hstepA, voffA);
      PG8_WAIT_L(8); PG8_BAR; PG8_WAIT_L(0); PG8_MMA(0, 0, At, B0); PG8_BAR; PG8_SCHED;
      PG8_LDB(B1, 1, 1); PG8_STAGE(PG8_SB(1, 0), b3, voffB);
      PG8_BAR; PG8_WAIT_L(0); PG8_MMA(0, 1, At, B1); PG8_BAR;
      PG8_LDA(At, 1, 1); PG8_STAGE(PG8_SA(1, 0), a3, voffA);
      PG8_BAR; PG8_WAIT_L(0); PG8_MMA(1, 0, At, B0); PG8_BAR; PG8_SCHED;
      PG8_STAGE(PG8_SB(1, 1), b3 + hstepB, voffB);
      PG8_WAIT_V(6); PG8_BAR; PG8_MMA(1, 1, At, B1); PG8_BAR;
    }
    E(acc, cur, wr, wc, fr, fq);
    if (!has_next) break;
#pragma unroll
    for (int a = 0; a < 2; ++a)
#pragma unroll
      for (int b = 0; b < 2; ++b)
#pragma unroll
        for (int m = 0; m < 4; ++m)
#pragma unroll
          for (int n = 0; n < 2; ++n) acc[a][b][m][n] = (f32x4){0.f, 0.f, 0.f, 0.f};
    cur = nxt; cA = nA; cB = nB; ++ui;
  }
  PG8_WAIT_V(0);
  if (wr == 0) PG8_BAR;
  PG8_BAR;
#undef PG8_SA
#undef PG8_SB
#undef PG8_STAGE
#undef PG8_LDA
#undef PG8_LDB
#undef PG8_MMA
#undef PG8_WAIT_V
#undef PG8_WAIT_L
#undef PG8_BAR
#undef PG8_SCHED
}
}
using pg8::Unit;
typedef f32x4 AccT[2][2][4][2];

DI void asm_fence() { asm volatile("" ::: "memory"); }
#define EPI_ROWS4 _Pragma("unroll") for (int ai = 0; ai < 2; ++ai) if ((asm_fence(), true)) _Pragma("unroll") for (int m = 0; m < 4; ++m)
#define EPI_ROWS _Pragma("unroll") for (int ai = 0; ai < 2; ++ai) _Pragma("unroll") for (int m = 0; m < 4; ++m) if ((asm_fence(), true))
DI u32x4 pack8f(const f32x4& a, const f32x4& b) { u32x4 w; w[0] = pack2(a[0], a[1]); w[1] = pack2(a[2], a[3]); w[2] = pack2(b[0], b[1]); w[3] = pack2(b[2], b[3]); return w; }
DI size_t k_off(int t, int d) { return (size_t)(t >> 5) * 2048 + (((d >> 4) * 64 + ((d >> 3) & 1) * 32 + (t & 31)) << 3) + (d & 7); }

struct EpiL0In {
  static constexpr bool PERM = true;
  bf16_t* U0; bf16_t* G0;
  DI void operator()(const AccT& acc, const Unit& u, int wr, int wc, int fr, int fq) const {
    EPI_ROWS { const int row = u.pm * 256 + ai * 128 + wr * 64 + m * 16 + fr;
      _Pragma("unroll") for (int bj = 0; bj < 2; ++bj) { const int c0 = u.pn * 256 + bj * 128 + wc * 32 + 8 * fq;
        const bool isu = u.pn * 256 + bj * 128 < LW;
        bf16_t* dst = isu ? U0 + (size_t)row * LW + c0 : G0 + (size_t)row * LW + (c0 - LW);
        *(u32x4*)dst = pack8f(acc[ai][bj][m][0], acc[ai][bj][m][1]); } }
  }
};

template <bool NEXT>
struct EpiOut {
  static constexpr bool PERM = false;
  const float* in_lat; const float* in_ctx; float* out_lat; float* out_ctx; const float* gate;
  const float* gs; bf16_t* NB_; float* ss;
  DI void operator()(const AccT& acc, const Unit& u, int wr, int wc, int fr, int fq) const {
    const int rb = u.pm * 256;
    const float* src; float* dst; const float* g; const float* gsv; int rr;
    if (rb < RL) { src = in_lat; dst = out_lat; rr = rb; g = gate + (size_t)(rb >> 11) * 3072; gsv = gs + (size_t)(rb >> 11) * 1024; }
    else { src = in_ctx; dst = out_ctx; rr = rb - RL; g = gate + (size_t)8 * 3072; gsv = gs + (size_t)8 * 1024; }
    const int cb = u.pn * 256 + wc * 32 + 4 * fq;
    f32x4 gv[4], sv[4];
    _Pragma("unroll") for (int q = 0; q < 4; ++q) { gv[q] = *(const f32x4*)(g + cb + (q >> 1) * 128 + (q & 1) * 16); if (NEXT) sv[q] = *(const f32x4*)(gsv + cb + (q >> 1) * 128 + (q & 1) * 16); }
    const int r0 = rr + wr * 64 + fr;
    f32x4 hc[4], hn[4];
    _Pragma("unroll") for (int q = 0; q < 4; ++q) hc[q] = *(const f32x4*)(src + (size_t)r0 * 1024 + cb + (q >> 1) * 128 + (q & 1) * 16);
    _Pragma("unroll") for (int r_ = 0; r_ < 8; ++r_) {
      const int ai = r_ >> 2, m = r_ & 3, row = r0 + 128 * ai + 16 * m;
      if (r_ + 1 < 8) { const int rown = r0 + 128 * ((r_ + 1) >> 2) + 16 * ((r_ + 1) & 3);
        _Pragma("unroll") for (int q = 0; q < 4; ++q) hn[q] = *(const f32x4*)(src + (size_t)rown * 1024 + cb + (q >> 1) * 128 + (q & 1) * 16); }
      float sq = 0.f;
      _Pragma("unroll") for (int q = 0; q < 4; ++q) {
        const int c = cb + (q >> 1) * 128 + (q & 1) * 16;
        const f32x4 o = hc[q] + gv[q] * acc[ai][q >> 1][m][q & 1];
        *(f32x4*)(dst + (size_t)row * 1024 + c) = o;
        if (NEXT) {
          u32x2 w; w[0] = pack2(o[0] * sv[q][0], o[1] * sv[q][1]); w[1] = pack2(o[2] * sv[q][2], o[3] * sv[q][3]);
          *(u32x2*)(NB_ + (size_t)(row - rr + rb) * 1024 + c) = w;
          sq += o[0] * o[0] + o[1] * o[1] + o[2] * o[2] + o[3] * o[3];
        }
      }
      if (NEXT) {
        sq += __shfl_xor(sq, 16); sq += __shfl_xor(sq, 32);
        if (fq == 0) atomicAdd(ss + (row - rr + rb), sq);
      }
      asm_fence();
      _Pragma("unroll") for (int q = 0; q < 4; ++q) hc[q] = hn[q];
    }
  }
};

struct EpiL1 {
  static constexpr bool PERM = true;
  bf16_t *Q, *QR, *Kb, *G; const float *rc, *rs; const float* ss; const float* shw;
  DI void operator()(const AccT& acc, const Unit& u, int wr, int wc, int fr, int fq) const {
    const int rb = u.pm * 256; const bool lat = rb < RL;
    const float* sh = shw + (size_t)(lat ? (rb >> 11) : 8) * 4096;
    const int r0 = rb + wr * 64 + fr;
    float rstd[8];
    _Pragma("unroll") for (int r_ = 0; r_ < 8; ++r_) rstd[r_] = ss[r0 + 128 * (r_ >> 2) + 16 * (r_ & 3)];
    _Pragma("unroll") for (int r_ = 0; r_ < 8; ++r_) rstd[r_] = rsqrtf(rstd[r_] * (1.f / 1024.f) + 1e-6f);
    const bool qk = u.pn * 256 < 1280;
    f32x4 b1[2], b2v[2];
    int c0s[2], d0s[2];
    _Pragma("unroll") for (int bj = 0; bj < 2; ++bj) {
      const int c0 = u.pn * 256 + bj * 128 + wc * 32 + 8 * fq; c0s[bj] = c0; d0s[bj] = (c0 & 63) >> 1;
      if (qk) { const int oc = (c0 & ~63) + d0s[bj]; b1[bj] = *(const f32x4*)(sh + oc); b2v[bj] = *(const f32x4*)(sh + oc + 32); }
      else { b1[bj] = *(const f32x4*)(sh + c0 + 256); b2v[bj] = *(const f32x4*)(sh + c0 + 260); }
    }
    f32x4 cc, sc, cn, sn;
    if (qk && lat) { const int t = r0 & 2047; cc = *(const f32x4*)(rc + t * 32 + d0s[0]); sc = *(const f32x4*)(rs + t * 32 + d0s[0]); }
    _Pragma("unroll") for (int r_ = 0; r_ < 8; ++r_) {
      const int ai = r_ >> 2, m = r_ & 3, row = r0 + 128 * ai + 16 * m;
      if (qk && lat && r_ + 1 < 8) { const int tn = (r0 + 128 * ((r_ + 1) >> 2) + 16 * ((r_ + 1) & 3)) & 2047;
        cn = *(const f32x4*)(rc + tn * 32 + d0s[0]); sn = *(const f32x4*)(rs + tn * 32 + d0s[0]); }
      _Pragma("unroll") for (int bj = 0; bj < 2; ++bj) { const int c0 = c0s[bj], d0 = d0s[bj];
        const f32x4 v0 = acc[ai][bj][m][0] * rstd[r_], v1 = acc[ai][bj][m][1] * rstd[r_];
        if (qk) {
          float x1[4] = {v0[0] + b1[bj][0], v0[2] + b1[bj][1], v1[0] + b1[bj][2], v1[2] + b1[bj][3]}, x2[4] = {v0[1] + b2v[bj][0], v0[3] + b2v[bj][1], v1[1] + b2v[bj][2], v1[3] + b2v[bj][3]};
          float y1[4], y2[4];
          int t;
          if (lat) { t = row & 2047; _Pragma("unroll") for (int j = 0; j < 4; ++j) { y1[j] = x1[j] * cc[j] - x2[j] * sc[j]; y2[j] = x2[j] * cc[j] + x1[j] * sc[j]; } }
          else { t = (row - RL) & 255; _Pragma("unroll") for (int j = 0; j < 4; ++j) { y1[j] = x1[j]; y2[j] = x2[j]; } }
          if (u.pn < 4) {
            const size_t o = (size_t)row * 1024 + (c0 & ~63) + d0;
            u32x2 a, b2; a[0] = pack2(x1[0] * QSCALE, x1[1] * QSCALE); a[1] = pack2(x1[2] * QSCALE, x1[3] * QSCALE);
            b2[0] = pack2(x2[0] * QSCALE, x2[1] * QSCALE); b2[1] = pack2(x2[2] * QSCALE, x2[3] * QSCALE);
            *(u32x2*)(Q + o) = a; *(u32x2*)(Q + o + 32) = b2;
            if (lat) {
              a[0] = pack2(y1[0] * QSCALE, y1[1] * QSCALE); a[1] = pack2(y1[2] * QSCALE, y1[3] * QSCALE);
              b2[0] = pack2(y2[0] * QSCALE, y2[1] * QSCALE); b2[1] = pack2(y2[2] * QSCALE, y2[3] * QSCALE);
              *(u32x2*)(QR + o) = a; *(u32x2*)(QR + o + 32) = b2;
            }
          } else {
            const int kvh = (c0 - 1024) >> 6;
            bf16_t* kh = lat ? Kb + (size_t)((row >> 11) * 4 + kvh) * 64 * 2048 : Kb + (size_t)RL * 256 + (size_t)(((row - RL) >> 8) * 4 + kvh) * 8 * 2048;
            u32x2 a, b2; a[0] = pack2(y1[0], y1[1]); a[1] = pack2(y1[2], y1[3]); b2[0] = pack2(y2[0], y2[1]); b2[1] = pack2(y2[2], y2[3]);
            *(u32x2*)(kh + k_off(t, d0)) = a; *(u32x2*)(kh + k_off(t, d0 + 32)) = b2;
          }
        } else {
          *(u32x4*)(G + (size_t)row * 1024 + (c0 - 1280)) = pack8f(v0 + b1[bj], v1 + b2v[bj]);
        } }
      asm_fence();
      cc = cn; sc = sn;
    }
  }
};

template <int H, int VCOL0  >
struct EpiV {
  static constexpr bool PERM = true;
  bf16_t *VtL, *VtC; const float* ss; const float* shw;
  DI void operator()(const AccT& acc, const Unit& u, int wr, int wc, int fr, int fq) const {
    const bool latn = u.pn * 256 < RL;
    bf16_t* basep = latn ? VtL : VtC;
    const int tsh = latn ? 11 : 8, tiles = latn ? 64 : 8;
    const int nb = (latn ? u.pn * 256 : u.pn * 256 - RL) + wc * 32 + 8 * fq;
    f32x4 r0[2], r1[2];
    _Pragma("unroll") for (int bj = 0; bj < 2; ++bj) {
      const float* sp = ss + u.pn * 256 + bj * 128 + wc * 32 + 8 * fq;
      const f32x4 a = *(const f32x4*)sp, b2 = *(const f32x4*)(sp + 4);
      _Pragma("unroll") for (int j = 0; j < 4; ++j) { r0[bj][j] = rsqrtf(a[j] * (1.f / 1024.f) + 1e-6f); r1[bj][j] = rsqrtf(b2[j] * (1.f / 1024.f) + 1e-6f); }
    }
    const int vb0 = latn ? (nb >> tsh) : 8;
    float biasr[8];
    _Pragma("unroll") for (int r_ = 0; r_ < 8; ++r_) biasr[r_] = shw[(size_t)vb0 * 4096 + VCOL0 + u.pm * 256 + (r_ >> 2) * 128 + wr * 64 + (r_ & 3) * 16 + fr];
    EPI_ROWS { const int rowd = u.pm * 256 + ai * 128 + wr * 64 + m * 16 + fr, head = rowd >> 6, d = rowd & 63;
      const unsigned rowoff = (unsigned)(((d >> 5) * 128 + (d & 31)) << 3);
      _Pragma("unroll") for (int bj = 0; bj < 2; ++bj) { const int nn = nb + bj * 128;
        const int bidx = nn >> tsh, t = nn & ((1 << tsh) - 1);
        const float bias = biasr[ai * 4 + m];
        const unsigned off = (unsigned)(((bidx * H + head) * tiles + (t >> 5)) * 2048) + rowoff + (unsigned)((((t & 31) >> 4) * 64) << 3) + (unsigned)(((t >> 3) & 1) * 4);
        const f32x4 v0 = acc[ai][bj][m][0] * r0[bj] + bias, v1 = acc[ai][bj][m][1] * r1[bj] + bias;
        u32x2 a, b2; a[0] = pack2(v0[0], v0[1]); a[1] = pack2(v0[2], v0[3]); b2[0] = pack2(v1[0], v1[1]); b2[1] = pack2(v1[2], v1[3]);
        *(u32x2*)(basep + off) = a; *(u32x2*)(basep + off + 256) = b2; } }
  }
};

struct EpiL2 {
  static constexpr bool PERM = true;
  bf16_t *Q, *Kb, *G; const float* ss; const float* shw;
  DI void operator()(const AccT& acc, const Unit& u, int wr, int wc, int fr, int fq) const {
    const int rb = u.pm * 256; const bool lat = rb < RL;
    const float* sh = shw + (size_t)(lat ? (rb >> 11) : 8) * 4096;
    const int r0 = rb + wr * 64 + fr;
    float rstd[8];
    _Pragma("unroll") for (int r_ = 0; r_ < 8; ++r_) rstd[r_] = ss[r0 + 128 * (r_ >> 2) + 16 * (r_ & 3)];
    _Pragma("unroll") for (int r_ = 0; r_ < 8; ++r_) rstd[r_] = rsqrtf(rstd[r_] * (1.f / 1024.f) + 1e-6f);
    f32x4 b1[2], b2v[2];
    _Pragma("unroll") for (int bj = 0; bj < 2; ++bj) { const int c0 = u.pn * 256 + bj * 128 + wc * 32 + 8 * fq, oc = u.pn < 8 ? c0 : c0 + 1024;
      b1[bj] = *(const f32x4*)(sh + oc); b2v[bj] = *(const f32x4*)(sh + oc + 4); }
    _Pragma("unroll") for (int r_ = 0; r_ < 8; ++r_) { const int ai = r_ >> 2, m = r_ & 3, row = r0 + 128 * ai + 16 * m;
      _Pragma("unroll") for (int bj = 0; bj < 2; ++bj) { const int c0 = u.pn * 256 + bj * 128 + wc * 32 + 8 * fq;
        const f32x4 v0 = acc[ai][bj][m][0] * rstd[r_] + b1[bj], v1 = acc[ai][bj][m][1] * rstd[r_] + b2v[bj];
        if (u.pn < 4) *(u32x4*)(Q + (size_t)row * 1024 + c0) = pack8f(v0 * QSCALE, v1 * QSCALE);
        else if (u.pn < 8) {
          const int hd = (c0 - 1024) >> 6, d0 = c0 & 63;
          bf16_t* kh; int t;
          if (lat) { kh = Kb + (size_t)((row >> 11) * 16 + hd) * 64 * 2048; t = row & 2047; }
          else { const int rr = row - RL; kh = Kb + (size_t)RL * 1024 + (size_t)((rr >> 8) * 16 + hd) * 8 * 2048; t = rr & 255; }
          *(u32x4*)(kh + k_off(t, d0)) = pack8f(v0, v1);
        } else *(u32x4*)(G + (size_t)row * 1024 + (c0 - 2048)) = pack8f(v0, v1); }
      asm_fence(); }
  }
};

struct EpiL3In {
  static constexpr bool PERM = true;
  bf16_t *ACAT, *G; const float* ss; const float* shw;
  DI void operator()(const AccT& acc, const Unit& u, int wr, int wc, int fr, int fq) const {
    const int rb = u.pm * 256;
    const float* sh = shw + (size_t)(rb < RL ? (rb >> 11) : 8) * 4096;
    const int r0 = rb + wr * 64 + fr;
    float rstd[8];
    _Pragma("unroll") for (int r_ = 0; r_ < 8; ++r_) rstd[r_] = ss[r0 + 128 * (r_ >> 2) + 16 * (r_ & 3)];
    _Pragma("unroll") for (int r_ = 0; r_ < 8; ++r_) rstd[r_] = rsqrtf(rstd[r_] * (1.f / 1024.f) + 1e-6f);
    f32x4 b1[2], b2v[2];
    _Pragma("unroll") for (int bj = 0; bj < 2; ++bj) { const int c0 = u.pn * 256 + bj * 128 + wc * 32 + 8 * fq; b1[bj] = *(const f32x4*)(sh + c0); b2v[bj] = *(const f32x4*)(sh + c0 + 4); }
    _Pragma("unroll") for (int r_ = 0; r_ < 8; ++r_) { const int ai = r_ >> 2, m = r_ & 3, row = r0 + 128 * ai + 16 * m;
      _Pragma("unroll") for (int bj = 0; bj < 2; ++bj) { const int c0 = u.pn * 256 + bj * 128 + wc * 32 + 8 * fq;
        const u32x4 w = pack8f(acc[ai][bj][m][0] * rstd[r_] + b1[bj], acc[ai][bj][m][1] * rstd[r_] + b2v[bj]);
        if (u.pn < 4) *(u32x4*)(ACAT + ((size_t)(c0 >> 4) * NCH + (row >> 4)) * 512 + (row & 15) * 16 + (c0 & 15)) = w;
        else if (rb < RL) *(u32x4*)(G + (size_t)row * 1024 + (c0 - 1024)) = w; }
      asm_fence(); }
  }
};

struct EpiS5State {
  static constexpr bool PERM = false;
  float* S;
  DI void operator()(const AccT& acc, const Unit& u, int wr, int wc, int fr, int fq) const {
    float* sp = S + ((size_t)u.pb * NCHP + u.pm * 256) * 256 + wc * 32 + 4 * fq;
    EPI_ROWS { const unsigned o = (unsigned)(ai * 128 + wr * 64 + m * 16 + fr) * 256u;
      *(f32x4*)(sp + o) = acc[ai][0][m][0]; *(f32x4*)(sp + o + 16) = acc[ai][0][m][1];
      *(f32x4*)(sp + o + 128) = acc[ai][1][m][0]; *(f32x4*)(sp + o + 144) = acc[ai][1][m][1]; }
  }
};

struct EpiS5Y {
  static constexpr bool PERM = true;
  bf16_t* YG;
  DI void operator()(const AccT& acc, const Unit& u, int wr, int wc, int fr, int fq) const {
    EPI_ROWS { const int chunk = u.pm * 256 + ai * 128 + wr * 64 + m * 16 + fr;
      _Pragma("unroll") for (int bj = 0; bj < 2; ++bj) { const int n0 = bj * 128 + wc * 32 + 8 * fq;
        f32x4 v0 = acc[ai][bj][m][0], v1 = acc[ai][bj][m][1];
        _Pragma("unroll") for (int j = 0; j < 4; ++j) { v0[j] = gelu_tanh(v0[j]); v1[j] = gelu_tanh(v1[j]); }
        *(u32x4*)(YG + ((size_t)chunk * 16 + (n0 >> 4)) * 1024 + u.pb * 16 + (n0 & 15)) = pack8f(v0, v1); } }
  }
};

DI float sg2(float v, float nb) { return frcp(1.f + __builtin_amdgcn_exp2f(fmaf(v, -1.4426950408889634f, nb))); }
struct EpiGlu {
  static constexpr bool PERM = true;
  const bf16_t *YG, *G; const float* gb; bf16_t* ACT;
  DI void operator()(const AccT& acc, const Unit& u, int wr, int wc, int fr, int fq) const {
    const int r0 = u.pm * 256 + wr * 64 + fr, cb = u.pn * 256 + wc * 32 + 8 * fq;
    f32x4 b0[2], b1[2];
    _Pragma("unroll") for (int bj = 0; bj < 2; ++bj) { b0[bj] = *(const f32x4*)(gb + cb + bj * 128) * -1.4426950408889634f; b1[bj] = *(const f32x4*)(gb + cb + bj * 128 + 4) * -1.4426950408889634f; }
    u32x4 yc[2], gc[2], yn[2], gn_[2];
    _Pragma("unroll") for (int bj = 0; bj < 2; ++bj) { yc[bj] = *(const u32x4*)(YG + (size_t)r0 * 1024 + cb + bj * 128); gc[bj] = *(const u32x4*)(G + (size_t)r0 * 1024 + cb + bj * 128); }
    _Pragma("unroll") for (int r_ = 0; r_ < 8; ++r_) {
      const int ai = r_ >> 2, m = r_ & 3, row = r0 + 128 * ai + 16 * m;
      if (r_ + 1 < 8) { const int rown = r0 + 128 * ((r_ + 1) >> 2) + 16 * ((r_ + 1) & 3);
        _Pragma("unroll") for (int bj = 0; bj < 2; ++bj) { yn[bj] = *(const u32x4*)(YG + (size_t)rown * 1024 + cb + bj * 128); gn_[bj] = *(const u32x4*)(G + (size_t)rown * 1024 + cb + bj * 128); } }
      _Pragma("unroll") for (int bj = 0; bj < 2; ++bj) {
        const u32x4 y = yc[bj], gg = gc[bj];
        const f32x4 v0 = acc[ai][bj][m][0], v1 = acc[ai][bj][m][1];
        u32x4 w;
        w[0] = pack2(bflo(y[0]) * sg2(v0[0], b0[bj][0]) * silu(bflo(gg[0])), bfhi(y[0]) * sg2(v0[1], b0[bj][1]) * silu(bfhi(gg[0])));
        w[1] = pack2(bflo(y[1]) * sg2(v0[2], b0[bj][2]) * silu(bflo(gg[1])), bfhi(y[1]) * sg2(v0[3], b0[bj][3]) * silu(bfhi(gg[1])));
        w[2] = pack2(bflo(y[2]) * sg2(v1[0], b1[bj][0]) * silu(bflo(gg[2])), bfhi(y[2]) * sg2(v1[1], b1[bj][1]) * silu(bfhi(gg[2])));
        w[3] = pack2(bflo(y[3]) * sg2(v1[2], b1[bj][2]) * silu(bflo(gg[3])), bfhi(y[3]) * sg2(v1[3], b1[bj][3]) * silu(bfhi(gg[3])));
        *(u32x4*)(ACT + (size_t)row * 1024 + cb + bj * 128) = w;
      }
      asm_fence();
      _Pragma("unroll") for (int bj = 0; bj < 2; ++bj) { yc[bj] = yn[bj]; gc[bj] = gn_[bj]; }
    }
  }
};

struct TrJob { const float* W; bf16_t* dst; int N, ldd, k0, n0, perm, dup; };
DI TrJob tr_job(const Params& p, int j) {
  constexpr int T0 = 16 * 44, T1 = T0 + 22 * 16, T2 = T1 + 16 * 40, T3 = T2 + 256, T4 = T3 + 16 * 64, T5 = T4 + 256, T6 = T5 + 16 * 32, T7 = T6 + 256;
  char* ws = p.ws;
  TrJob t; int tile, K; t.perm = 0; t.dup = 0;
  bf16_t* base;
  if (j < T0) { t.W = p.in[7]; K = 1024; t.N = 2816; base = (bf16_t*)(ws + O_WT_IN0); tile = j; }
  else if (j < T1) { t.W = p.in[15]; K = 1408; t.N = 1024; base = (bf16_t*)(ws + O_WT_OUT0); tile = j - T0; }
  else if (j < T2) { t.W = p.in[19]; K = 1024; t.N = 2560; base = (bf16_t*)(ws + O_WT_IN1); tile = j - T1; }
  else if (j < T3) { t.W = p.in[21]; K = 1024; t.N = 1024; base = (bf16_t*)(ws + O_WT_OUT1); tile = j - T2; }
  else if (j < T4) { t.W = p.in[25]; K = 1024; t.N = 4096; base = (bf16_t*)(ws + O_WT_IN2); tile = j - T3; }
  else if (j < T5) { t.W = p.in[27]; K = 1024; t.N = 1024; base = (bf16_t*)(ws + O_WT_OUT2); tile = j - T4; }
  else if (j < T6) { t.W = p.in[31]; K = 1024; t.N = 2048; base = (bf16_t*)(ws + O_WT_IN3); tile = j - T5; }
  else if (j < T7) { t.W = p.in[40]; K = 1024; t.N = 1024; base = (bf16_t*)(ws + O_WT_GLU); tile = j - T6; }
  else { t.W = p.in[42]; K = 1024; t.N = 1024; base = (bf16_t*)(ws + O_WT_OUT3); tile = j - T7; }
  const int tn = t.N >> 6, tk_i = tile / tn;
  t.k0 = tk_i * 64; t.n0 = (tile - tk_i * tn) * 64;
  t.ldd = K;
  int drow = t.n0;
  if (j >= T1 && j < T2) {
    if (t.n0 < 1280) t.perm = 1;
    else if (t.n0 < 1536) drow = 2304 + (t.n0 - 1280);
    else drow = t.n0 - 256;
  } else if (j >= T3 && j < T4) {
    if (t.n0 >= 3072) drow = t.n0 - 1024;
    else if (t.n0 >= 2048) drow = 3072 + (t.n0 - 2048);
  }
  t.dst = base + (size_t)drow * t.ldd + t.k0;
  return t;
}

DI void transpose_range(const Params& p, char* smem, int j0, int j1, int first_blk, int skew) {
  if ((int)blockIdx.x < first_blk) return;
  float* smf = (float*)smem;
  const int G = (int)gridDim.x - first_blk;
  const int c = threadIdx.x & 63, rr = threadIdx.x >> 6, kp = threadIdx.x & 31, nb = threadIdx.x >> 5;
  int j = j0 + ((int)blockIdx.x - first_blk + G - (skew % G)) % G;
  float v[8];
  TrJob cur{};
  __syncthreads();
  if (j < j1) { cur = tr_job(p, j); _Pragma("unroll") for (int i = 0; i < 8; ++i) v[i] = __builtin_nontemporal_load(cur.W + (size_t)(cur.k0 + i * 8 + rr) * cur.N + cur.n0 + c); }
  for (; j < j1; j += G) {
    _Pragma("unroll") for (int i = 0; i < 8; ++i) smf[(i * 8 + rr) * 65 + c] = v[i];
    const TrJob me = cur;
    if (j + G < j1) { cur = tr_job(p, j + G); _Pragma("unroll") for (int i = 0; i < 8; ++i) v[i] = __builtin_nontemporal_load(cur.W + (size_t)(cur.k0 + i * 8 + rr) * cur.N + cur.n0 + c); }
    __syncthreads();
    _Pragma("unroll") for (int i = 0; i < 4; ++i) {
      const int n = nb + 16 * i;
      const int dr = me.perm ? (((n & 31) << 1) | (n >> 5)) : n;
      const unsigned w = pack2(smf[(2 * kp) * 65 + n], smf[(2 * kp + 1) * 65 + n]);
      bf16_t* d = me.dst + (size_t)dr * me.ldd + 2 * kp;
      *(unsigned*)d = w;
      if (me.dup) *(unsigned*)(d + 1408) = w;
    }
    __syncthreads();
  }
}

DI void phase0(const Params& p, char* smem) {
  char* ws = p.ws;
  float* smf = (float*)smem;
  const int NT_ = blockDim.x;
  for (int job = blockIdx.x; job < 384; job += gridDim.x) {
    const int l = job / 96, n0 = (job % 96) * 32;
    const float* aw = l == 0 ? p.in[4] : l == 1 ? p.in[16] : l == 2 ? p.in[22] : p.in[28];
    const float* ab = l == 0 ? p.in[5] : l == 1 ? p.in[17] : l == 2 ? p.in[23] : p.in[29];
    float* sv = smf;
    float* red = smf + 9 * 1024;
    for (int idx = threadIdx.x; idx < 9 * 1024; idx += NT_) {
      const int v = idx >> 10, k = idx & 1023;
      const float x = v < 8 ? p.in[1][v * 1024 + k] : p.in[3][k];
      sv[idx] = silu(x);
    }
    __syncthreads();
    const int col = threadIdx.x & 31, ks = threadIdx.x >> 5;
    float a[9];
    _Pragma("unroll") for (int v = 0; v < 9; ++v) a[v] = 0.f;
    for (int kb = ks * 64; kb < ks * 64 + 64; kb += 16) {
      float wv[16];
      _Pragma("unroll") for (int u = 0; u < 16; ++u) wv[u] = aw[(size_t)(kb + u) * 3072 + n0 + col];
      _Pragma("unroll") for (int u = 0; u < 16; ++u) _Pragma("unroll") for (int v = 0; v < 9; ++v) a[v] += sv[v * 1024 + kb + u] * wv[u];
    }
    _Pragma("unroll") for (int v = 0; v < 9; ++v) red[(ks * 9 + v) * 32 + col] = a[v];
    __syncthreads();
    float* MOD = (float*)(ws + O_MOD);
    for (int idx = threadIdx.x; idx < 9 * 32; idx += NT_) {
      const int v = idx >> 5, cc = idx & 31;
      float sum = ab[n0 + cc];
      _Pragma("unroll") for (int q = 0; q < 16; ++q) sum += red[(q * 9 + v) * 32 + cc];
      MOD[(size_t)(l * 9 + v) * 3072 + n0 + cc] = sum;
    }
    __syncthreads();
  }
  transpose_range(p, smem, 0, 16 * 44, gridDim.x == 256 ? 128 : 0, 0);
}

DI void tables_phase(const Params& p, int first_blk) {
  if ((int)blockIdx.x < first_blk) return;
  char* ws = p.ws;
  const int gt = ((int)blockIdx.x - first_blk) * blockDim.x + threadIdx.x, gn = ((int)gridDim.x - first_blk) * blockDim.x;
  {
    bf16_t* WG = (bf16_t*)(ws + O_WG);
    for (int idx = gt; idx < 16 * 2 * 192 * 96; idx += gn) {
      const int kk = idx % 96; int t = idx / 96; const int n = t % 192; t /= 192; const int d = t & 1, k = t >> 1;
      const int c = n >> 5, gate = (n >> 4) & 1, ch = c * 16 + (n & 15);
      float v = 0.f;
      if (ch < 88 && kk < 88) { const float* w = gate ? p.in[12] : p.in[10]; v = w[((size_t)(d * 16 + k) * 88 + kk) * 88 + ch]; }
      WG[idx] = f2bf(v);
    }
  }
  { float* SS = (float*)(ws + O_SS); for (int idx = gt; idx < 3 * R; idx += gn) SS[idx] = 0.f; }
  {
    float* RCt = (float*)(ws + O_ROPEC); float* RSt = (float*)(ws + O_ROPES);
    for (int idx = gt; idx < 2048 * 32; idx += gn) {
      const int t = idx >> 5, j = idx & 31;
      const float pos = (float)(j < 16 ? (t >> 6) : (t & 63));
      const float freq = exp2f(-(float)(j & 15) * (13.287712379549449f / 16.f));
      float s, c; sincos_rev(pos * freq * 0.15915494309189535f, s, c);
      RCt[idx] = c; RSt[idx] = s;
    }
  }
  {
    float2* POW = (float2*)(ws + O_POW); float2* BB = (float2*)(ws + O_BBAR);
    for (int idx = gt; idx < 2 * 64 * 17 * 64; idx += gn) {
      const int pp = idx & 63; int t = idx >> 6; const int n = t % 17; t /= 17;
      const float are = p.in[32][t * 64 + pp], aim = p.in[33][t * 64 + pp], dt = expf(p.in[34][t]);
      const float mag = expf((float)n * are * dt);
      const double rev = (double)n * (double)aim * (double)dt * 0.15915494309189535;
      float s, c; sincos_rev((float)(rev - rint(rev)), s, c);
      POW[idx] = make_float2(mag * c, mag * s);
    }
    for (int idx = gt; idx < 2 * 64 * 64 * 16; idx += gn) {
      const int t = idx >> 4;
      const int dg = t >> 6;
      const float are = p.in[32][t], aim = p.in[33][t], dt = expf(p.in[34][dg]);
      const float mag = expf(are * dt);
      const double rev = (double)aim * (double)dt * 0.15915494309189535;
      float s, c; sincos_rev((float)(rev - rint(rev)), s, c);
      const float nr = mag * c - 1.f, ni = mag * s;
      const float den = 1.f / (are * are + aim * aim);
      const float cr = (nr * are + ni * aim) * den, ci = (ni * are - nr * aim) * den;
      const float br = p.in[35][idx], bi = p.in[36][idx];
      BB[idx] = make_float2(cr * br - ci * bi, cr * bi + ci * br);
    }
  }
}

DI void modfold_phase(const Params& p, char* smem) {
  char* ws = p.ws;
  const float* MOD = (const float*)(ws + O_MOD);
  float* GS = (float*)(ws + O_GS);
  float* SHW = (float*)(ws + O_SHW);
  const int NT_ = blockDim.x;
  for (int idx = blockIdx.x * NT_ + threadIdx.x; idx < 3 * 9 * 1024; idx += gridDim.x * NT_) {
    const int k = idx & 1023, lv = idx >> 10, l = lv / 9 + 1, v = lv - (l - 1) * 9;
    const float* gn = l == 1 ? p.in[18] : l == 2 ? p.in[24] : p.in[30];
    GS[idx] = gn[k] * (1.f + MOD[(size_t)(l * 9 + v) * 3072 + 1024 + k]);
  }
  float* smf = (float*)smem;
  float* sv = smf;
  float* red = smf + 9 * 1024;
  for (int job = (int)gridDim.x - 1 - (int)blockIdx.x; job < 80 + 128 + 64; job += gridDim.x) {
    int l, n0; const float* W; int N;
    if (job < 80) { l = 1; n0 = job * 32; W = p.in[19]; N = 2560; }
    else if (job < 208) { l = 2; n0 = (job - 80) * 32; W = p.in[25]; N = 4096; }
    else { l = 3; n0 = (job - 208) * 32; W = p.in[31]; N = 2048; }
    __syncthreads();
    for (int idx = threadIdx.x; idx < 9 * 1024; idx += NT_) sv[idx] = MOD[(size_t)(l * 9 + (idx >> 10)) * 3072 + (idx & 1023)];
    __syncthreads();
    const int col = threadIdx.x & 31, ks = threadIdx.x >> 5;
    float a[9];
    _Pragma("unroll") for (int v = 0; v < 9; ++v) a[v] = 0.f;
    for (int kb = ks * 64; kb < ks * 64 + 64; kb += 16) {
      float wv[16];
      _Pragma("unroll") for (int u = 0; u < 16; ++u) wv[u] = W[(size_t)(kb + u) * N + n0 + col];
      _Pragma("unroll") for (int u = 0; u < 16; ++u) _Pragma("unroll") for (int v = 0; v < 9; ++v) a[v] += sv[v * 1024 + kb + u] * wv[u];
    }
    _Pragma("unroll") for (int v = 0; v < 9; ++v) red[(ks * 9 + v) * 32 + col] = a[v];
    __syncthreads();
    for (int idx = threadIdx.x; idx < 9 * 32; idx += NT_) {
      const int v = idx >> 5, cc = idx & 31;
      float sum = 0.f;
      _Pragma("unroll") for (int q = 0; q < 16; ++q) sum += red[(q * 9 + v) * 32 + cc];
      SHW[(size_t)((l - 1) * 9 + v) * 4096 + n0 + cc] = sum;
    }
  }
  __syncthreads();
}

DI void norm_phase(const float* lat, const float* ctx, const float* gn, const float* mod  , bf16_t* NB_) {
  const int tid_ = opaque_tid();
  const int lane = tid_ & 63;
  const int w0 = blockIdx.x * 8 + (tid_ >> 6), nw = gridDim.x * 8;
  for (int row0 = w0 * 2; row0 < R; row0 += nw * 2) {
    f32x4 v[2][4]; float ss[2] = {0.f, 0.f};
    const float* m[2];
    _Pragma("unroll") for (int q = 0; q < 2; ++q) {
      const int row = row0 + q;
      const float* src;
      if (row < RL) { src = lat + (size_t)row * 1024; m[q] = mod + (size_t)(row >> 11) * 3072; }
      else { src = ctx + (size_t)(row - RL) * 1024; m[q] = mod + (size_t)8 * 3072; }
      _Pragma("unroll") for (int i = 0; i < 4; ++i) v[q][i] = __builtin_nontemporal_load((const f32x4*)(src + (i * 64 + lane) * 4));
    }
    _Pragma("unroll") for (int q = 0; q < 2; ++q) {
      _Pragma("unroll") for (int i = 0; i < 4; ++i) ss[q] += v[q][i][0] * v[q][i][0] + v[q][i][1] * v[q][i][1] + v[q][i][2] * v[q][i][2] + v[q][i][3] * v[q][i][3];
      _Pragma("unroll") for (int o = 32; o >= 1; o >>= 1) ss[q] += __shfl_xor(ss[q], o);
    }
    _Pragma("unroll") for (int q = 0; q < 2; ++q) {
      const float rstd = rsqrtf(ss[q] * (1.f / 1024.f) + 1e-6f);
      _Pragma("unroll") for (int i = 0; i < 4; ++i) {
        const int k = (i * 64 + lane) * 4;
        const f32x4 g = *(const f32x4*)(gn + k), sh = *(const f32x4*)(m[q] + k), sc = *(const f32x4*)(m[q] + 1024 + k);
        u32x2 o;
        o[0] = pack2(v[q][i][0] * rstd * g[0] * (1.f + sc[0]) + sh[0], v[q][i][1] * rstd * g[1] * (1.f + sc[1]) + sh[1]);
        o[1] = pack2(v[q][i][2] * rstd * g[2] * (1.f + sc[2]) + sh[2], v[q][i][3] * rstd * g[3] * (1.f + sc[3]) + sh[3]);
        *(u32x2*)(NB_ + (size_t)(row0 + q) * 1024 + k) = o;
      }
    }
  }
}

DI void final_norm_phase(float* H, const float* gn) {
  const int tid_ = opaque_tid();
  const int lane = tid_ & 63;
  const int w0 = blockIdx.x * 8 + (tid_ >> 6), nw = gridDim.x * 8;
  for (int row0 = w0 * 2; row0 < RL; row0 += nw * 2) {
    f32x4 v[2][4]; float ss[2] = {0.f, 0.f};
    _Pragma("unroll") for (int q = 0; q < 2; ++q) _Pragma("unroll") for (int i = 0; i < 4; ++i) v[q][i] = __builtin_nontemporal_load((const f32x4*)(H + (size_t)(row0 + q) * 1024 + (i * 64 + lane) * 4));
    _Pragma("unroll") for (int q = 0; q < 2; ++q) {
      _Pragma("unroll") for (int i = 0; i < 4; ++i) ss[q] += v[q][i][0] * v[q][i][0] + v[q][i][1] * v[q][i][1] + v[q][i][2] * v[q][i][2] + v[q][i][3] * v[q][i][3];
      _Pragma("unroll") for (int o = 32; o >= 1; o >>= 1) ss[q] += __shfl_xor(ss[q], o);
    }
    _Pragma("unroll") for (int q = 0; q < 2; ++q) {
      const float rstd = rsqrtf(ss[q] * (1.f / 1024.f) + 1e-6f);
      _Pragma("unroll") for (int i = 0; i < 4; ++i) {
        const int k = (i * 64 + lane) * 4;
        const f32x4 g = *(const f32x4*)(gn + k);
        f32x4 o; o[0] = v[q][i][0] * rstd * g[0]; o[1] = v[q][i][1] * rstd * g[1]; o[2] = v[q][i][2] * rstd * g[2]; o[3] = v[q][i][3] * rstd * g[3];
        __builtin_nontemporal_store(o, (f32x4*)(H + (size_t)(row0 + q) * 1024 + k));
      }
    }
  }
}

DI void lru_phase(const Params& p, char* smem) {
  char* ws = p.ws;
  const int tid_ = opaque_tid();
  const int sub = tid_ >> 8;
  smem += sub * 36864;
  bf16_t* Wl = (bf16_t*)smem;
  bf16_t* Uc = Wl + 96 * 96;
  float* aggA = (float*)(Uc + 64 * 96);
  float* aggH = aggA + 16 * 48;
  const bf16_t* U0 = (const bf16_t*)(ws + O_U0);
  const bf16_t* G0 = (const bf16_t*)(ws + O_G0);
  const int tid = tid_ & 255, lane = tid & 63, w = tid >> 6, col = lane & 15, quad = lane >> 4;
  const int vbl = (gridDim.x % 8 == 0) ? (blockIdx.x & 7) * (gridDim.x >> 3) + (blockIdx.x >> 3) : blockIdx.x;
  for (int item = vbl; item < 256; item += gridDim.x) {
    const int half = item & 1, dir = sub, k = (item >> 1) & 15, b = item >> 5;
    bf16_t* ACT = (bf16_t*)(ws + O_ACT0);
    __syncthreads();
    {
      const u32x4* src = (const u32x4*)((const bf16_t*)(ws + O_WG) + ((size_t)(k * 2 + dir) * 192 + half * 96) * 96);
      u32x4* dst = (u32x4*)Wl;
      for (int i = tid; i < 96 * 96 / 8; i += 256) dst[i] = src[i];
      if (tid < 64) { u32x4 z; z[0] = z[1] = z[2] = z[3] = 0u; *(u32x4*)(Uc + tid * 96 + 88) = z; }
    }
    float ba[3], bx[3], sp8[3];
    _Pragma("unroll") for (int c = 0; c < 3; ++c) {
      const int ch = 48 * half + 16 * c + col;
      if (ch < 88) {
        ba[c] = -1.4426950408889634f * p.in[11][dir * LW + k * 88 + ch]; bx[c] = -1.4426950408889634f * p.in[13][dir * LW + k * 88 + ch];
        sp8[c] = 8.f * 1.4426950408889634f * log1pf(expf(-p.in[14][dir * LW + k * 88 + ch]));
      } else { ba[c] = 0.f; bx[c] = 0.f; sp8[c] = 0.f; }
    }
    const int cp = tid % 44, run = tid / 44;
    float cw[4][2], cb2[2];
    _Pragma("unroll") for (int t = 0; t < 4; ++t) { cw[t][0] = p.in[8][t * LW + k * 88 + 2 * cp]; cw[t][1] = p.in[8][t * LW + k * 88 + 2 * cp + 1]; }
    cb2[0] = p.in[9][k * 88 + 2 * cp]; cb2[1] = p.in[9][k * 88 + 2 * cp + 1];
    float carry = 0.f;
    unsigned un[19]; unsigned unmask = 0u;
    auto tile_info = [&](int ti, int& rowbase, int& L, int& t0) {
      if (ti < 4) { rowbase = RL + b * 256; L = 256; t0 = (dir ? 3 - ti : ti) * 64; }
      else { rowbase = b * 2048; L = 2048; t0 = (dir ? 31 - (ti - 4) : (ti - 4)) * 64; }
    };
    auto prefetch = [&](int ti) {
      int rowbase, L, t0; tile_info(ti, rowbase, L, t0);
      const unsigned* ub = (const unsigned*)(U0 + (size_t)rowbase * LW + k * 88 + 2 * cp);
      const int tb = t0 + 16 * (run < 4 ? run : 3) - 2;
      unsigned vm = 0u;
      _Pragma("unroll") for (int i = 0; i < 19; ++i) {
        const int tt = tb + i;
        un[i] = ub[(unsigned)min(max(tt, 0), L - 1) * (unsigned)(LW / 2)];
        vm |= (tt >= 0 && tt < L) ? (1u << i) : 0u;
      }
      unmask = vm;
    };
    prefetch(0);
    for (int ti = 0; ti < 36; ++ti) {
      int rowbase, L, t0; tile_info(ti, rowbase, L, t0);
      if (tid < 176) {
        if (unmask != 0x7ffffu) { _Pragma("unroll") for (int i = 0; i < 19; ++i) un[i] = ((unmask >> i) & 1u) ? un[i] : 0u; }
        _Pragma("unroll") for (int t = 0; t < 16; ++t) {
          const float y0 = cb2[0] + cw[0][0] * bflo(un[t]) + cw[1][0] * bflo(un[t + 1]) + cw[2][0] * bflo(un[t + 2]) + cw[3][0] * bflo(un[t + 3]);
          const float y1 = cb2[1] + cw[0][1] * bfhi(un[t]) + cw[1][1] * bfhi(un[t + 1]) + cw[2][1] * bfhi(un[t + 2]) + cw[3][1] * bfhi(un[t + 3]);
          *(unsigned*)(Uc + (16 * run + t) * 96 + 2 * cp) = pack2(y0, y1);
        }
      }
      if (ti + 1 < 36) prefetch(ti + 1);
      bf16_t gv[3][4];
      _Pragma("unroll") for (int c = 0; c < 3; ++c) {
        const int ch = 48 * half + 16 * c + col;
        _Pragma("unroll") for (int j = 0; j < 4; ++j)
          gv[c][j] = G0[(unsigned)(rowbase + t0 + 16 * w + 4 * quad) * (unsigned)LW + (unsigned)(j * LW + k * 88 + min(ch, 87))];
      }
      const bool second = ti < 4 ? (ti >= 2) : (ti >= 20);
      const bool adjacent = (ti == 2) || (ti == 20);
      bf16_t pv[3][4];
      if (second && !adjacent) {
        _Pragma("unroll") for (int c = 0; c < 3; ++c) {
          const int ch = 48 * half + 16 * c + col;
          _Pragma("unroll") for (int j = 0; j < 4; ++j) pv[c][j] = ACT[(unsigned)(rowbase + t0 + 16 * w + 4 * quad) * (unsigned)LW + (unsigned)(j * LW + k * 88 + min(ch, 87))];
        }
      } else { _Pragma("unroll") for (int c = 0; c < 3; ++c) _Pragma("unroll") for (int j = 0; j < 4; ++j) pv[c][j] = (bf16_t)0; }
      __syncthreads();
      bf16x8 af[3];
      _Pragma("unroll") for (int ks = 0; ks < 3; ++ks) af[ks] = *(const bf16x8*)(Uc + (16 * w + col) * 96 + ks * 32 + quad * 8);
      float hl[3][4], ac[3][4];
      _Pragma("unroll") for (int c = 0; c < 3; ++c) {
        f32x4 gA = {0.f, 0.f, 0.f, 0.f}, gX = {0.f, 0.f, 0.f, 0.f};
        _Pragma("unroll") for (int ks = 0; ks < 3; ++ks) {
          const bf16x8 bA = *(const bf16x8*)(Wl + ((c * 2 + 0) * 16 + col) * 96 + ks * 32 + quad * 8);
          const bf16x8 bX = *(const bf16x8*)(Wl + ((c * 2 + 1) * 16 + col) * 96 + ks * 32 + quad * 8);
          gA = MFMA16(af[ks], bA, gA);
          gX = MFMA16(af[ks], bX, gX);
        }
        float a[4], bb[4];
        _Pragma("unroll") for (int j = 0; j < 4; ++j) {
          const float uval = bf2f(Uc[(16 * w + 4 * quad + j) * 96 + 48 * half + 16 * c + col]);
          const float rg = frcp(1.f + __builtin_amdgcn_exp2f(fmaf(gA[j], -1.4426950408889634f, ba[c])));
          const float ig = frcp(1.f + __builtin_amdgcn_exp2f(fmaf(gX[j], -1.4426950408889634f, bx[c])));
          a[j] = __builtin_amdgcn_exp2f(-sp8[c] * rg);
          bb[j] = __builtin_amdgcn_sqrtf(fmaxf(1.f - a[j] * a[j], 0.f)) * ig * uval;
        }
        if (dir == 0) {
          hl[c][0] = bb[0]; ac[c][0] = a[0];
          _Pragma("unroll") for (int j = 1; j < 4; ++j) { hl[c][j] = a[j] * hl[c][j - 1] + bb[j]; ac[c][j] = a[j] * ac[c][j - 1]; }
          aggA[(4 * w + quad) * 48 + 16 * c + col] = ac[c][3]; aggH[(4 * w + quad) * 48 + 16 * c + col] = hl[c][3];
        } else {
          hl[c][3] = bb[3]; ac[c][3] = a[3];
          _Pragma("unroll") for (int j = 2; j >= 0; --j) { hl[c][j] = a[j] * hl[c][j + 1] + bb[j]; ac[c][j] = a[j] * ac[c][j + 1]; }
          aggA[(4 * w + quad) * 48 + 16 * c + col] = ac[c][0]; aggH[(4 * w + quad) * 48 + 16 * c + col] = hl[c][0];
        }
      }
      asm volatile("s_waitcnt vmcnt(0)" ::: "memory");
      __syncthreads();
      if (adjacent) {
        _Pragma("unroll") for (int c = 0; c < 3; ++c) {
          const int ch = 48 * half + 16 * c + col;
          _Pragma("unroll") for (int j = 0; j < 4; ++j)
            pv[c][j] = ACT[(unsigned)(rowbase + t0 + 16 * w + 4 * quad) * (unsigned)LW + (unsigned)(j * LW + k * 88 + min(ch, 87))];
        }
      }
      if (tid < 48) {
        float A_[16], H_[16];
        _Pragma("unroll") for (int s_ = 0; s_ < 16; ++s_) { A_[s_] = aggA[s_ * 48 + tid]; H_[s_] = aggH[s_ * 48 + tid]; }
        float cin = carry;
        if (dir == 0) { _Pragma("unroll") for (int s_ = 0; s_ < 16; ++s_) { aggA[s_ * 48 + tid] = cin; cin = A_[s_] * cin + H_[s_]; } }
        else { _Pragma("unroll") for (int s_ = 15; s_ >= 0; --s_) { aggA[s_ * 48 + tid] = cin; cin = A_[s_] * cin + H_[s_]; } }
        carry = cin;
      }
      __syncthreads();
      _Pragma("unroll") for (int c = 0; c < 3; ++c) {
        const int ch = 48 * half + 16 * c + col;
        if (ch < 88) {
          const float cin = aggA[(4 * w + quad) * 48 + 16 * c + col];
          _Pragma("unroll") for (int j = 0; j < 4; ++j) {
            const unsigned idx = (unsigned)(rowbase + t0 + 16 * w + 4 * quad) * (unsigned)LW + (unsigned)(j * LW + k * 88 + ch);
            const float hv = hl[c][j] + ac[c][j] * cin;
            ACT[idx] = f2bf(hv * silu(bf2f(gv[c][j])) + bf2f(pv[c][j]));
          }
        }
      }

    }
  }
}

struct AttnSt { f32x16 O0, O1; float m, l; };
DI bf16x8 ld16(const bf16_t* p) { return *(const bf16x8*)p; }
DI bf16x8 ld8x2(const bf16_t* p0) { const s16x4 a = *(const s16x4*)p0; const s16x4 b = *(const s16x4*)(p0 + 8); return __builtin_shufflevector(a, b, 0, 1, 2, 3, 4, 5, 6, 7); }
DI bf16x8 pack8(const f32x16& P, int s) {
  u32x4 u;
  _Pragma("unroll") for (int j = 0; j < 4; ++j) u[j] = pack2(P[8 * s + 2 * j], P[8 * s + 2 * j + 1]);
  return __builtin_bit_cast(bf16x8, u);
}

struct KVt { bf16x8 k0, k1, k2, k3, v00, v01, v10, v11; };
DI void attn_load(KVt& t, const bf16_t* kt_, const bf16_t* vt_) {
  t.k0 = ld16(kt_); t.k1 = ld16(kt_ + 512); t.k2 = ld16(kt_ + 1024); t.k3 = ld16(kt_ + 1536);
  t.v00 = ld16(vt_); t.v01 = ld16(vt_ + 512); t.v10 = ld16(vt_ + 1024); t.v11 = ld16(vt_ + 1536);
}
template <class F>
DI void attn_compute(AttnSt& st, const bf16x8 (&qf)[4], const KVt& t, F fmod) {
  f32x16 S = zero16();
  S = MFMA32(t.k0, qf[0], S); S = MFMA32(t.k1, qf[1], S); S = MFMA32(t.k2, qf[2], S); S = MFMA32(t.k3, qf[3], S);
  float mx = -3.0e38f;
  _Pragma("unroll") for (int i = 0; i < 16; ++i) { S[i] = fmod(i, S[i]); mx = fmaxf(mx, S[i]); }
  mx = fmaxf(mx, __shfl_xor(mx, 32));
  const float mn = fmaxf(st.m, mx);
  float ls = 0.f;
  f32x16 P;
  _Pragma("unroll") for (int i = 0; i < 16; ++i) { P[i] = __builtin_amdgcn_exp2f(S[i] - mn); ls += P[i]; }
  if (__builtin_amdgcn_ballot_w64(mn > st.m) != 0ull) {
    const float alpha = __builtin_amdgcn_exp2f(st.m - mn);
    st.m = mn;
    st.l *= alpha;
    _Pragma("unroll") for (int i = 0; i < 16; ++i) { st.O0[i] *= alpha; st.O1[i] *= alpha; }
  }
  st.l += ls;
  const bf16x8 p0 = pack8(P, 0), p1 = pack8(P, 1);
  st.O0 = MFMA32(t.v00, p0, st.O0); st.O0 = MFMA32(t.v01, p1, st.O0);
  st.O1 = MFMA32(t.v10, p0, st.O1); st.O1 = MFMA32(t.v11, p1, st.O1);
}

struct GPre { u32x2 g0[4], g1[4]; };
DI void attn_gload(GPre& gp, const bf16_t* Grow  , int h) {
  _Pragma("unroll") for (int q = 0; q < 4; ++q) { gp.g0[q] = *(const u32x2*)(Grow + 8 * q + 4 * h); gp.g1[q] = *(const u32x2*)(Grow + 32 + 8 * q + 4 * h); }
}
DI void attn_finish(AttnSt& st, const GPre& gp, bf16_t* Arow  , int h) {
  const float lt = st.l + __shfl_xor(st.l, 32);
  const float inv = frcp(lt);
  unsigned w0[4][2], w1[4][2];
  _Pragma("unroll") for (int q = 0; q < 4; ++q) {
    const u32x2 g0 = gp.g0[q], g1 = gp.g1[q];
    w0[q][0] = pack2(st.O0[4 * q + 0] * inv * silu(bflo(g0[0])), st.O0[4 * q + 1] * inv * silu(bfhi(g0[0])));
    w0[q][1] = pack2(st.O0[4 * q + 2] * inv * silu(bflo(g0[1])), st.O0[4 * q + 3] * inv * silu(bfhi(g0[1])));
    w1[q][0] = pack2(st.O1[4 * q + 0] * inv * silu(bflo(g1[0])), st.O1[4 * q + 1] * inv * silu(bfhi(g1[0])));
    w1[q][1] = pack2(st.O1[4 * q + 2] * inv * silu(bflo(g1[1])), st.O1[4 * q + 3] * inv * silu(bfhi(g1[1])));
  }
  _Pragma("unroll") for (int qp = 0; qp < 2; ++qp) {
    const int q = 2 * qp;
    {
      const auto s0 = __builtin_amdgcn_permlane32_swap(w0[q][0], w0[q + 1][0], false, false);
      const auto s1 = __builtin_amdgcn_permlane32_swap(w0[q][1], w0[q + 1][1], false, false);
      u32x4 o; o[0] = s0[0]; o[1] = s1[0]; o[2] = s0[1]; o[3] = s1[1];
      *(u32x4*)(Arow + 8 * q + 8 * h) = o;
    }
    {
      const auto s0 = __builtin_amdgcn_permlane32_swap(w1[q][0], w1[q + 1][0], false, false);
      const auto s1 = __builtin_amdgcn_permlane32_swap(w1[q][1], w1[q + 1][1], false, false);
      u32x4 o; o[0] = s0[0]; o[1] = s1[0]; o[2] = s0[1]; o[3] = s1[1];
      *(u32x4*)(Arow + 32 + 8 * q + 8 * h) = o;
    }
  }
}

DI void swa_phase(const Params& p) {
  char* ws = p.ws;
  const bf16_t* Q = (const bf16_t*)(ws + O_Q1); const bf16_t* QR = (const bf16_t*)(ws + O_QR1); const bf16_t* Kb = (const bf16_t*)(ws + O_K1);
  const bf16_t* VtL = (const bf16_t*)(ws + O_VTL1); const bf16_t* VtC = (const bf16_t*)(ws + O_VTC1);
  const bf16_t* G = (const bf16_t*)(ws + O_G1); bf16_t* ACT = (bf16_t*)(ws + O_ACT1);
  const float* sink = p.in[20];
  const int tid_ = opaque_tid();
  const int lane = tid_ & 63, r = lane & 31, h = lane >> 5;
  const int vb_ = (gridDim.x % 8 == 0) ? (blockIdx.x & 7) * (gridDim.x >> 3) + (blockIdx.x >> 3) : blockIdx.x;
  const int wid = vb_ * 8 + (tid_ >> 6), nw = gridDim.x * 8;
  auto ident = [](int, float s) { return s; };
  auto do_item = [&](int it) {
    int b, kvh, g4, qt; const bool lat = it < 8192;
    if (lat) { g4 = it & 3; qt = (it >> 2) & 63; kvh = (it >> 8) & 3; b = it >> 10; }
    else { const int j = it - 8192; g4 = j & 3; qt = (j >> 2) & 7; kvh = (j >> 5) & 3; b = j >> 7; }
    const int head = kvh * 4 + g4;
    const size_t qrow = lat ? (size_t)b * 2048 + qt * 32 + r : (size_t)RL + b * 256 + qt * 32 + r;
    AttnSt st; st.O0 = zero16(); st.O1 = zero16(); st.m = sink[head] * 1.4426950408889634f; st.l = h == 0 ? 1.f : 0.f;
    bf16x8 qf[4], qfr[4];
    _Pragma("unroll") for (int ks = 0; ks < 4; ++ks) qf[ks] = ld16(Q + qrow * 1024 + head * 64 + ks * 16 + 8 * h);
    GPre gp; attn_gload(gp, G + qrow * 1024 + head * 64, h);
    if (lat) { _Pragma("unroll") for (int ks = 0; ks < 4; ++ks) qfr[ks] = ld16(QR + qrow * 1024 + head * 64 + ks * 16 + 8 * h); }
    else { _Pragma("unroll") for (int ks = 0; ks < 4; ++ks) qfr[ks] = qf[ks]; }
    const bf16_t* kc = Kb + (size_t)RL * 256 + (size_t)(b * 4 + kvh) * 8 * 2048 + lane * 8;
    const bf16_t* vc = VtC + (size_t)(b * 4 + kvh) * 8 * 2048 + lane * 8;
    const bf16_t* kl = Kb + (size_t)(b * 4 + kvh) * 64 * 2048 + lane * 8;
    const bf16_t* vl = VtL + (size_t)(b * 4 + kvh) * 64 * 2048 + lane * 8;
    const int kt_lo = max(qt - 4, 0), kt_hi = min(qt + 4, 63);
    const int nt = lat ? 8 + (kt_hi - kt_lo + 1) : 8;
    auto load_tile = [&](int j, KVt& t) {
      if (j < 8) attn_load(t, kc + (size_t)j * 2048, vc + (size_t)j * 2048);
      else { const int kt = kt_lo + j - 8; attn_load(t, kl + (size_t)kt * 2048, vl + (size_t)kt * 2048); }
    };
    KVt cur, nxt;
    load_tile(0, cur);
    for (int j = 0; j < 8; ++j) {
      nxt = cur;
      if (j + 1 < nt) load_tile(j + 1, nxt);
      attn_compute(st, qf, cur, ident);
      cur = nxt;
    }
    for (int j = 8; j < nt; ++j) {
      nxt = cur;
      if (j + 1 < nt) load_tile(j + 1, nxt);
      const int kt = kt_lo + j - 8;
      if (kt == qt - 4 || kt == qt + 4) {
        const int dq = qt * 32 + r - kt * 32;
        attn_compute(st, qfr, cur, [&](int i, float s) { const int d = dq - crow(i, h); return (d <= 128 && d >= -128) ? s : -1.0e30f; });
      } else attn_compute(st, qfr, cur, ident);
      cur = nxt;
    }
    attn_finish(st, gp, ACT + qrow * 1024 + head * 64, h);
  };
  for (int it = wid; it < 8192; it += nw) do_item(it);
  if (nw == 2048) {
    if ((wid & 7) < 4) do_item(8192 + (wid >> 3) * 4 + (wid & 3));
  } else { for (int it = 8192 + wid; it < 8192 + 1024; it += nw) do_item(it); }
}

DI void na_phase(const Params& p, char* smem) {
  char* ws = p.ws;
  const bf16_t* Q = (const bf16_t*)(ws + O_Q2); const bf16_t* Kb = (const bf16_t*)(ws + O_K2);
  const bf16_t* VtL = (const bf16_t*)(ws + O_VTL2); const bf16_t* VtC = (const bf16_t*)(ws + O_VTC2);
  const bf16_t* G = (const bf16_t*)(ws + O_G2); bf16_t* ACT = (bf16_t*)(ws + O_ACT2);
  float* rpbs = (float*)smem + 64;
  __syncthreads();
  for (int i = threadIdx.x; i < 16 * 15 * 31; i += blockDim.x) rpbs[i] = p.in[26][i] * 1.4426950408889634f;
  __syncthreads();
  const int tid_ = opaque_tid();
  const int lane = tid_ & 63, r = lane & 31, h = lane >> 5;
  const int vb_ = (gridDim.x % 8 == 0) ? (blockIdx.x & 7) * (gridDim.x >> 3) + (blockIdx.x >> 3) : blockIdx.x;
  const int wid = vb_ * 8 + (tid_ >> 6), nw = gridDim.x * 8;
  auto ident = [](int, float s) { return s; };
  auto do_item = [&](int it) {
    int b, head, half, gr; const bool lat = it < 8192;
    if (lat) { half = it & 1; head = (it >> 1) & 15; gr = (it >> 5) & 31; b = it >> 10; }
    else { const int j = it - 8192; half = 0; head = j & 15; gr = (j >> 4) & 7; b = j >> 7; }
    const size_t qrow = lat ? (size_t)b * 2048 + gr * 64 + half * 32 + r : (size_t)RL + b * 256 + gr * 32 + r;
    AttnSt st; st.O0 = zero16(); st.O1 = zero16(); st.m = -1.0e30f; st.l = 0.f;
    bf16x8 qf[4];
    _Pragma("unroll") for (int ks = 0; ks < 4; ++ks) qf[ks] = ld16(Q + qrow * 1024 + head * 64 + ks * 16 + 8 * h);
    GPre gp; attn_gload(gp, G + qrow * 1024 + head * 64, h);
    const bf16_t* kc = Kb + (size_t)RL * 1024 + (size_t)(b * 16 + head) * 8 * 2048 + lane * 8;
    const bf16_t* vc = VtC + (size_t)(b * 16 + head) * 8 * 2048 + lane * 8;
    const bf16_t* kl = Kb + (size_t)(b * 16 + head) * 64 * 2048 + lane * 8;
    const bf16_t* vl = VtL + (size_t)(b * 16 + head) * 64 * 2048 + lane * 8;
    const int cq = half * 32 + r;
    const int cs = min(max(cq - 8, 0), 48);
    const int rs_ = min(max(gr - 4, 0), 24);
    const int nt = lat ? 24 : 8;
    auto load_tile = [&](int j, KVt& t) {
      if (j < 8) attn_load(t, kc + (size_t)j * 2048, vc + (size_t)j * 2048);
      else { const int kt = (rs_ + ((j - 8) >> 1)) * 2 + ((j - 8) & 1); attn_load(t, kl + (size_t)kt * 2048, vl + (size_t)kt * 2048); }
    };
    KVt cur, nxt;
    load_tile(0, cur);
    for (int j = 0; j < 8; ++j) {
      nxt = cur;
      if (j + 1 < nt) load_tile(j + 1, nxt);
      attn_compute(st, qf, cur, ident);
      cur = nxt;
    }
    unsigned okm[2] = {0u, 0u};
    _Pragma("unroll") for (int ct = 0; ct < 2; ++ct) _Pragma("unroll") for (int i = 0; i < 16; ++i) {
      const int ck = ct * 32 + crow(i, h);
      okm[ct] |= ((ck >= cs) && (ck < cs + 16)) ? (1u << i) : 0u;
    }
    const int dxb = 4 * h - cq + 15;
    for (int j = 8; j < nt; j += 2) {
      const int krow = rs_ + ((j - 8) >> 1);
      const float* rp = rpbs + (head * 15 + (krow - gr + 7)) * 31 + dxb;
      nxt = cur;
      load_tile(j + 1, nxt);
      attn_compute(st, qf, cur, [&](int i, float s) { const float sb = s + rp[(i & 3) + 8 * (i >> 2)]; return ((okm[0] >> i) & 1u) ? sb : -1.0e30f; });
      cur = nxt;
      if (j + 2 < nt) load_tile(j + 2, nxt);
      attn_compute(st, qf, cur, [&](int i, float s) { const float sb = s + rp[32 + (i & 3) + 8 * (i >> 2)]; return ((okm[1] >> i) & 1u) ? sb : -1.0e30f; });
      cur = nxt;
    }
    attn_finish(st, gp, ACT + qrow * 1024 + head * 64, h);
  };
  for (int it = wid; it < 8192; it += nw) do_item(it);
  if (nw == 2048) {
    if ((wid & 7) < 4) do_item(8192 + (wid >> 3) * 4 + (wid & 3));
  } else { for (int it = 8192 + wid; it < 8192 + 1024; it += nw) do_item(it); }
}

DI void s5_mats_phase(const Params& p, int which, int first_blk) {
  if ((int)blockIdx.x < first_blk) return;
  char* ws = p.ws;
  const float2* POW = (const float2*)(ws + O_POW); const float2* BB = (const float2*)(ws + O_BBAR);
  bf16_t* GT = (bf16_t*)(ws + O_GT); bf16_t* MYT = (bf16_t*)(ws + O_MYT);
  const float* cre = p.in[37]; const float* cim = p.in[38]; const float* dsk = p.in[39];
  const int gt = ((int)blockIdx.x - first_blk) * blockDim.x + threadIdx.x, gn = ((int)gridDim.x - first_blk) * blockDim.x;
  if (which == 2) {
    for (int idx0 = gt; idx0 < 64 * 256 * 256; idx0 += 4 * gn) {
      float2 pw1[4], bb1[4];
      _Pragma("unroll") for (int u = 0; u < 4; ++u) {
        const int idx = min(idx0 + u * gn, 64 * 256 * 256 - 1);
        const int g = idx >> 16, n = (idx >> 8) & 255, k = idx & 255;
        const int dir = n >> 7, pp = (n >> 1) & 63, i = k >> 4, c = k & 15, e = dir ? i : 15 - i;
        pw1[u] = POW[((size_t)(dir * 64 + g) * 17 + e) * 64 + pp]; bb1[u] = BB[((size_t)(dir * 64 + g) * 64 + pp) * 16 + c];
      }
      _Pragma("unroll") for (int u = 0; u < 4; ++u) {
        const int idx = idx0 + u * gn;
        if (idx < 64 * 256 * 256) {
          const float zr = pw1[u].x * bb1[u].x - pw1[u].y * bb1[u].y, zi = pw1[u].x * bb1[u].y + pw1[u].y * bb1[u].x;
          GT[idx] = f2bf(((idx >> 8) & 1) ? zi : zr);
        }
      }
    }
    return;
  }
  for (int idx0 = gt; idx0 < 64 * 256 * 256; idx0 += 4 * gn) {
    float2 pw2[4]; float cr[4], cm[4];
    _Pragma("unroll") for (int u = 0; u < 4; ++u) {
      const int idx = min(idx0 + u * gn, 64 * 256 * 256 - 1);
      const int g = idx >> 16, n = (idx >> 8) & 255, k = idx & 255;
      const int j = n >> 4, o = n & 15, dir = k >> 7, pp = (k >> 1) & 63, e = dir ? 16 - j : j + 1;
      pw2[u] = POW[((size_t)(dir * 64 + g) * 17 + e) * 64 + pp];
      const size_t ci = ((size_t)(dir * 64 + g) * 16 + o) * 64 + pp; cr[u] = cre[ci]; cm[u] = cim[ci];
    }
    _Pragma("unroll") for (int u = 0; u < 4; ++u) {
      const int idx = idx0 + u * gn;
      if (idx < 64 * 256 * 256) {
        const int g = idx >> 16, n = (idx >> 8) & 255, k = idx & 255;
        const float zr = cr[u] * pw2[u].x - cm[u] * pw2[u].y, zi = cr[u] * pw2[u].y + cm[u] * pw2[u].x;
        MYT[((size_t)g * 256 + n) * 512 + 256 + k] = f2bf((k & 1) ? -zi : zr);
      }
    }
  }
  for (int idx = gt; idx < 64 * 16 * 256; idx += gn) {
    const int g = idx >> 12, lag = (idx >> 8) & 15, o = (idx >> 4) & 15, c = idx & 15;
    float kf = 0.f, kb = 0.f;
    _Pragma("unroll 8") for (int pp = 0; pp < 64; ++pp) {
      {
        const float2 pw = POW[((size_t)(0 * 64 + g) * 17 + lag) * 64 + pp];
        const float2 bb = BB[((size_t)(0 * 64 + g) * 64 + pp) * 16 + c];
        const size_t ci = ((size_t)(0 * 64 + g) * 16 + o) * 64 + pp;
        const float zr = pw.x * bb.x - pw.y * bb.y, zi = pw.x * bb.y + pw.y * bb.x;
        kf += cre[ci] * zr - cim[ci] * zi;
      }
      {
        const float2 pw = POW[((size_t)(1 * 64 + g) * 17 + lag) * 64 + pp];
        const float2 bb = BB[((size_t)(1 * 64 + g) * 64 + pp) * 16 + c];
        const size_t ci = ((size_t)(1 * 64 + g) * 16 + o) * 64 + pp;
        const float zr = pw.x * bb.x - pw.y * bb.y, zi = pw.x * bb.y + pw.y * bb.x;
        kb += cre[ci] * zr - cim[ci] * zi;
      }
    }
    bf16_t* Mg = MYT + (size_t)g * 256 * 512;
    if (lag == 0) {
      const bf16_t v = f2bf(kf + kb + (o == c ? dsk[g * 16 + o] : 0.f));
      for (int j = 0; j < 16; ++j) Mg[(size_t)(j * 16 + o) * 512 + j * 16 + c] = v;
    } else {
      const bf16_t vf = f2bf(kf), vb = f2bf(kb);
      for (int i = 0; i + lag < 16; ++i) {
        Mg[(size_t)((i + lag) * 16 + o) * 512 + i * 16 + c] = vf;
        Mg[(size_t)(i * 16 + o) * 512 + (i + lag) * 16 + c] = vb;
      }
    }
  }
}

DI void s5_scan_one(const Params& p, int b, int g, int dir, int pp) {
  char* ws = p.ws;
  const float2* POW = (const float2*)(ws + O_POW);
  const float* SL = (const float*)(ws + O_SLOC);
  bf16_t* ACAT = (bf16_t*)(ws + O_ACAT);
  const float2 lam = POW[((size_t)(dir * 64 + g) * 17 + 16) * 64 + pp];
  float hr = 0.f, hi = 0.f;
  auto chunk_of = [&](int q) { return q < 16 ? (1024 + b * 16 + (dir ? 15 - q : q)) : (b * 128 + (dir ? 127 - (q - 16) : (q - 16))); };
  auto loadb = [&](int q0, float2 (&sx)[16]) {
    _Pragma("unroll") for (int j = 0; j < 16; ++j) sx[j] = *(const float2*)(SL + ((size_t)g * NCHP + chunk_of(q0 + j)) * 256 + dir * 128 + 2 * pp);
  };
  auto procb = [&](int q0, const float2 (&sx)[16]) {
    _Pragma("unroll") for (int j = 0; j < 16; ++j) {
      *(unsigned*)(ACAT + ((size_t)g * NCH + chunk_of(q0 + j)) * 512 + 256 + dir * 128 + 2 * pp) = pack2(hr, hi);
      const float nr = lam.x * hr - lam.y * hi + sx[j].x, ni = lam.x * hi + lam.y * hr + sx[j].y;
      hr = nr; hi = ni;
    }
  };
  float2 sA[16], sB[16];
  loadb(0, sA);
  for (int q0 = 0; q0 < 144; q0 += 32) {
    if (q0 + 16 < 144) loadb(q0 + 16, sB);
    procb(q0, sA);
    if (q0 + 16 >= 144) break;
    if (q0 + 32 < 144) loadb(q0 + 32, sA);
    procb(q0 + 16, sB);
  }
}
DI void s5_scan_phase(const Params& p) {
  for (int gid = blockIdx.x * blockDim.x + threadIdx.x; gid < 65536; gid += gridDim.x * blockDim.x)
    s5_scan_one(p, gid >> 13, (gid >> 6) & 63, (gid >> 12) & 1, gid & 63);
}

#define XB_TMO      128
#define XB_XCNT(j)  (256  + 64 * (j))
#define XB_XSUB(j)  (1280 + 64 * (j))
#define XB_XGEN(j)  (2304 + 64 * (j))
#define XB_TOP      3328
#define XB_TOPGEN   3392
#define XCD_BAR_WORDS 3456
#define XB_SPIN_CAP (1u << 18)
#define LAS __attribute__((address_space(3)))
DI unsigned xb_ld(unsigned* p)              { return __hip_atomic_load(p, __ATOMIC_RELAXED, __HIP_MEMORY_SCOPE_AGENT); }
DI unsigned xb_add(unsigned* p, unsigned v) { return __hip_atomic_fetch_add(p, v, __ATOMIC_RELAXED, __HIP_MEMORY_SCOPE_AGENT); }
DI unsigned xb_xcc_id() { return (unsigned)__builtin_amdgcn_s_getreg((3 << 11) | 20) & 0xFu; }
#define XB_SPIN(cond, bar) do { unsigned _sp = 0; while (cond) { __builtin_amdgcn_s_sleep(1); \
    if ((++_sp & 255u) == 0u) { if (xb_ld(&(bar)[XB_TMO])) break; if (_sp > XB_SPIN_CAP) { atomicAdd(&(bar)[XB_TMO], 1u); break; } } } } while (0)
struct XcdBarrier { unsigned* bar; unsigned x; volatile LAS unsigned* st; };
DI XcdBarrier xcd_barrier_post(unsigned* bar, volatile LAS unsigned* st) {
    XcdBarrier b; b.bar = bar; b.x = xb_xcc_id(); b.st = st;
    if (threadIdx.x == 0) (void)xb_add(&bar[XB_XCNT(b.x)], 1u);
    return b;
}
DI void xcd_barrier_complete(unsigned* bar, unsigned x, unsigned& nloc, unsigned& nx) {
    const unsigned G = gridDim.x * gridDim.y * gridDim.z;
    unsigned sum, cnt, mine, sp = 0u;
    for (;;) {
        sum = 0u; cnt = 0u; mine = 0u;
#pragma unroll
        for (unsigned j = 0; j < 16; ++j) { const unsigned c = xb_ld(&bar[XB_XCNT(j)]); sum += c; cnt += (c > 0u) ? 1u : 0u; mine = (j == x) ? c : mine; }
        if (sum == G) break;
        __builtin_amdgcn_s_sleep(1);
        if ((++sp & 255u) == 0u) { if (xb_ld(&bar[XB_TMO])) break; if (sp > XB_SPIN_CAP) { atomicAdd(&bar[XB_TMO], 1u); break; } }
    }
    nloc = mine > 0u ? mine : 1u; nx = cnt > 0u ? cnt : 1u;
}
DI void xcd_barrier(const XcdBarrier& b) {
    asm volatile("s_waitcnt vmcnt(0)" ::: "memory");
    __syncthreads();
    if (threadIdx.x == 0) {
        unsigned* bar = b.bar;
        __builtin_amdgcn_s_waitcnt(0);
        unsigned nloc = b.st[0], nx = b.st[1];
        if (nloc == 0u) { xcd_barrier_complete(bar, b.x, nloc, nx); b.st[0] = nloc; b.st[1] = nx; }
        const unsigned old = xb_add(&bar[XB_XSUB(b.x)], 1u);
        const unsigned gen = old / nloc;
        if (old + 1u == (gen + 1u) * nloc) {
            __builtin_amdgcn_fence(__ATOMIC_RELEASE, "agent");
            asm volatile("s_waitcnt vmcnt(0)" ::: "memory");
            const unsigned og = xb_add(&bar[XB_TOP], 1u);
            const unsigned tg = og / nx;
            if (og + 1u == (tg + 1u) * nx) xb_add(&bar[XB_TOPGEN], 1u);
            else XB_SPIN(xb_ld(&bar[XB_TOPGEN]) == tg, bar);
            __builtin_amdgcn_fence(__ATOMIC_ACQUIRE, "agent");
            xb_add(&bar[XB_XGEN(b.x)], 1u);
            asm volatile("s_waitcnt vmcnt(0)" ::: "memory");
        } else {
            XB_SPIN(xb_ld(&bar[XB_XGEN(b.x)]) == gen, bar);
            __builtin_amdgcn_fence(__ATOMIC_ACQUIRE, "agent");
            asm volatile("s_waitcnt vmcnt(0)" ::: "memory");
        }
    }
    __syncthreads();
}

#define RP_GIN 1
#define RP_OUT0 1
#define RP_LRU 1
#define RP_SWA 1
#define RP_NA 1
#define RP_S5 1
#define RP_NORM 1
#define RP_GLU 1
#define RP_SYNC 0
#define REPEAT(n) for (int rep_ = 0; rep_ < (n); ++rep_)
constexpr int LDS_BYTES = 147456;

__global__ void __launch_bounds__(512, 2) fwd_megakernel(Params p) {
  extern __shared__ __attribute__((aligned(16))) unsigned char lds_raw[];
  LAS unsigned char* lds = (LAS unsigned char*)lds_raw;
  char* smem = (char*)lds_raw;
  cg::grid_group grid = cg::this_grid();
  char* ws = p.ws;
  volatile LAS unsigned* xst = (volatile LAS unsigned*)(lds + 131072 + 256);
  if (threadIdx.x == 0) { xst[0] = 0u; xst[1] = 0u; }
  __syncthreads();
  XcdBarrier xb = xcd_barrier_post((unsigned*)(ws + O_BAR), xst);
#define GSYNC() xcd_barrier(xb)
  float* MOD = (float*)(ws + O_MOD);
  float* HCTX = (float*)(ws + O_HCTX);
  const bf16_t* NBUF = (const bf16_t*)(ws + O_NBUF);
  using pg8::Gemm;

  phase0(p, smem);
  GSYNC();
  if (p.out == nullptr) grid.sync();
  float* SS = (float*)(ws + O_SS);
  const float* GS = (const float*)(ws + O_GS);
  const float* SHW = (const float*)(ws + O_SHW);
  bf16_t* NBW = (bf16_t*)(ws + O_NBUF);
  norm_phase(p.in[0], p.in[2], p.in[6], MOD, (bf16_t*)(ws + O_NBUF0));
  GSYNC();
  {
    EpiL0In e{(bf16_t*)(ws + O_U0), (bf16_t*)(ws + O_G0)};
    Gemm g{(const bf16_t*)(ws + O_NBUF0), (const bf16_t*)(ws + O_WT_IN0), 1024, 1024, 1024, 72, 11, 1, 0, 0, 0};
    pg8::gemm_phase(lds, g, e);
  }
  modfold_phase(p, smem);
  tables_phase(p, gridDim.x == 256 ? 24 : 0);
  if (gridDim.x == 256) transpose_range(p, smem, 16 * 44, 16 * 44 + 22 * 16 + 16 * 40 + 256, 24, 0);
  else transpose_range(p, smem, 16 * 44, 16 * 44 + 22 * 16 + 16 * 40 + 256, 0, 0);
  GSYNC();
  lru_phase(p, smem);
  GSYNC();
  {
    EpiOut<true> e{p.in[0], p.in[2], p.out, HCTX, MOD + 2048, GS, NBW, SS};
    Gemm g{(const bf16_t*)(ws + O_ACT0), (const bf16_t*)(ws + O_WT_OUT0), LW, LW, LW, 72, 4, 1, 0, 0, 0};
    pg8::gemm_phase(lds, g, e);
  }
  {
    constexpr int J0 = 16 * 44 + 22 * 16 + 16 * 40 + 256, J1 = J0 + 16 * 64 + 256 + 16 * 32 + 256 + 256;
    transpose_range(p, smem, J0, J1, gridDim.x == 256 ? 32 : 0, 0);
  }
  GSYNC();
  {
    EpiL1 e{(bf16_t*)(ws + O_Q1), (bf16_t*)(ws + O_QR1), (bf16_t*)(ws + O_K1), (bf16_t*)(ws + O_G1), (const float*)(ws + O_ROPEC), (const float*)(ws + O_ROPES), SS, SHW};
    Gemm g{NBUF, (const bf16_t*)(ws + O_WT_IN1), 1024, 1024, 1024, 72, 9, 1, 0, 0, 0};
    pg8::gemm_phase(lds, g, e);
    EpiV<4, 1280> ev{(bf16_t*)(ws + O_VTL1), (bf16_t*)(ws + O_VTC1), SS, SHW};
    Gemm gv{(const bf16_t*)(ws + O_WT_IN1) + (size_t)2304 * 1024, NBUF, 1024, 1024, 1024, 1, 72, 1, 0, 0, 256 - 136};
    pg8::gemm_phase(lds, gv, ev);
  }
  GSYNC();
  swa_phase(p);
  GSYNC();
  {
    EpiOut<true> e{p.out, HCTX, p.out, HCTX, MOD + 9 * 3072 + 2048, GS + 9 * 1024, NBW, SS + R};
    Gemm g{(const bf16_t*)(ws + O_ACT1), (const bf16_t*)(ws + O_WT_OUT1), 1024, 1024, 1024, 72, 4, 1, 0, 0, 0};
    pg8::gemm_phase(lds, g, e);
  }
  s5_mats_phase(p, 1, gridDim.x == 256 ? 32 : 0);
  GSYNC();
  {
    EpiL2 e{(bf16_t*)(ws + O_Q2), (bf16_t*)(ws + O_K2), (bf16_t*)(ws + O_G2), SS + R, SHW + 9 * 4096};
    Gemm g{NBUF, (const bf16_t*)(ws + O_WT_IN2), 1024, 1024, 1024, 72, 12, 1, 0, 0, 0};
    pg8::gemm_phase(lds, g, e);
    EpiV<16, 2048> ev{(bf16_t*)(ws + O_VTL2), (bf16_t*)(ws + O_VTC2), SS + R, SHW + 9 * 4096};
    Gemm gv{(const bf16_t*)(ws + O_WT_IN2) + (size_t)3072 * 1024, NBUF, 1024, 1024, 1024, 4, 72, 1, 0, 0, 256 - 96};
    pg8::gemm_phase(lds, gv, ev);
  }
  GSYNC();
  na_phase(p, smem);
  GSYNC();
  {
    EpiOut<true> e{p.out, HCTX, p.out, HCTX, MOD + 2 * 9 * 3072 + 2048, GS + 2 * 9 * 1024, NBW, SS + 2 * R};
    Gemm g{(const bf16_t*)(ws + O_ACT2), (const bf16_t*)(ws + O_WT_OUT2), 1024, 1024, 1024, 72, 4, 1, 0, 0, 0};
    pg8::gemm_phase(lds, g, e);
  }
  s5_mats_phase(p, 2, gridDim.x == 256 ? 32 : 0);
  GSYNC();
  {
    EpiL3In e{(bf16_t*)(ws + O_ACAT), (bf16_t*)(ws + O_G3), SS + 2 * R, SHW + 2 * 9 * 4096};
    Gemm g{NBUF, (const bf16_t*)(ws + O_WT_IN3), 1024, 1024, 1024, 72, 8, 1, 0, 0, 0};
    pg8::gemm_phase(lds, g, e);
  }
  GSYNC();
  {
    EpiS5State e{(float*)(ws + O_SLOC)};
    Gemm g{(const bf16_t*)(ws + O_ACAT), (const bf16_t*)(ws + O_GT), 512, 256, 256, 5, 1, 64, NCH * 512, 256 * 256, 0};
    pg8::gemm_phase(lds, g, e);
  }
  GSYNC();
  {
    EpiS5Y e{(bf16_t*)(ws + O_YG)};
    Gemm g{(const bf16_t*)(ws + O_ACAT), (const bf16_t*)(ws + O_MYT), 512, 512, 512, 4, 1, 64, NCH * 512, 256 * 512, 0};
    if (gridDim.x == 256) {
      pg8::Unit u;
      if (pg8::next_unit(g, 0, u)) {
        const int t_ = opaque_tid();
        if (t_ < 256) s5_scan_one(p, 2 * u.pm + (t_ >> 7), u.pb, (t_ >> 6) & 1, t_ & 63);
      }
      asm volatile("s_waitcnt vmcnt(0)" ::: "memory");
      __syncthreads();
    } else {
      s5_scan_phase(p);
      GSYNC();
    }
    pg8::gemm_phase(lds, g, e);
  }
  GSYNC();
  {
    EpiGlu e{(const bf16_t*)(ws + O_YG), (const bf16_t*)(ws + O_G3), p.in[41], (bf16_t*)(ws + O_ACT3)};
    Gemm g{(const bf16_t*)(ws + O_YG), (const bf16_t*)(ws + O_WT_GLU), 1024, 1024, 1024, 64, 4, 1, 0, 0, 0};
    pg8::gemm_phase(lds, g, e);
  }
  GSYNC();
  {
    EpiOut<false> e{p.out, HCTX, p.out, HCTX, MOD + 3 * 9 * 3072 + 2048, nullptr, nullptr, nullptr};
    Gemm g{(const bf16_t*)(ws + O_ACT3), (const bf16_t*)(ws + O_WT_OUT3), 1024, 1024, 1024, 64, 4, 1, 0, 0, 0};
    pg8::gemm_phase(lds, g, e);
  }
  GSYNC();
  final_norm_phase(p.out, p.in[43]);
}

extern "C" void kernel_launch(void* const* d_in, const int* in_sizes, int n_in, void* d_out, int out_size, void* d_ws, size_t ws_size,
                              hipStream_t stream) {
  static int grid_blocks = 0;
  if (!grid_blocks) {
    int dev = 0, cus = 0, per_cu = 0;
    (void)hipGetDevice(&dev);
    (void)hipDeviceGetAttribute(&cus, hipDeviceAttributeMultiprocessorCount, dev);
    if (hipFuncSetAttribute((const void*)fwd_megakernel, hipFuncAttributeMaxDynamicSharedMemorySize, LDS_BYTES) != hipSuccess) { fprintf(stderr, "kernel_launch: hipFuncSetAttribute failed\n"); grid_blocks = -1; return; }
    (void)hipOccupancyMaxActiveBlocksPerMultiprocessor(&per_cu, (const void*)fwd_megakernel, 512, LDS_BYTES);
    (void)hipGetLastError();
    grid_blocks = cus;
  }
  if (grid_blocks < 0) return;
  if (n_in != 44 || ws_size < WS_END) { fprintf(stderr, "kernel_launch: unexpected n_in %d or ws_size %zu < %zu\n", n_in, ws_size, (size_t)WS_END); return; }
  Params p{};
  for (int i = 0; i < 44; ++i) p.in[i] = (const float*)d_in[i];
  p.out = (float*)d_out;
  p.ws = (char*)d_ws;
  if (hipMemsetAsync((char*)d_ws + O_BAR, 0, 16384, stream) != hipSuccess) { fprintf(stderr, "memset failed\n"); return; }
  void* args[] = {&p};
  hipError_t e = hipLaunchCooperativeKernel((void*)fwd_megakernel, dim3(grid_blocks), dim3(512), args, LDS_BYTES, stream);
  if (e != hipSuccess) fprintf(stderr, "cooperative launch failed: %s (grid %d)\n", hipGetErrorString(e), grid_blocks);
}
```
